# Optimizing an MI355X kernel written in HIP

```python
import math
import jax, jax.numpy as jnp
from jax import lax
import numpy as np

D_MODEL = 1024
BATCH = 4
SEQ = 8192
DEPTH = 2

M_HEADS = 4
M_DHV = D_MODEL // M_HEADS
M_DHQK = M_DHV // 2
M_QK = M_HEADS * M_DHQK
M_V = M_HEADS * M_DHV
M_PROJ = 2 * M_QK + 2 * M_V + 2 * M_HEADS
CHUNK = 64
CONV_W = 3
N_MLSTM_LAYERS = (DEPTH + 1) // 2
N_CONV_LAYERS = DEPTH // 2
N_EXPERTS = 16
N_GROUPS = 4
EXPERTS_PER_GROUP = N_EXPERTS // N_GROUPS
TOP_K = 2
D_EXPERT = D_MODEL // 2
EPS = 1e-6

kernel_name = "hybrid_mlstm_shortconv_grouped_moe_adaln"


def _rmsnorm(x, g):
    x32 = x.astype(jnp.float32)
    y = x32 * lax.rsqrt(jnp.mean(x32 * x32, axis=-1, keepdims=True) + EPS)
    return (y * g.astype(jnp.float32)).astype(x.dtype)


def _modulate(h, shift, scale):
    return h * (1 + scale[:, None, :]) + shift[:, None, :]


def _mlstm_mixer(u, w_in, b_gates, norm_g, w_out):
    Bn, S, _ = u.shape
    NC = S // CHUNK
    proj = (u @ w_in).astype(jnp.float32)
    q, k, v, og, gi, gf = jnp.split(
        proj, [M_QK, 2 * M_QK, 2 * M_QK + M_V, 2 * M_QK + 2 * M_V, 2 * M_QK + 2 * M_V + M_HEADS], axis=-1)
    bg = b_gates.astype(jnp.float32)
    ig = gi + bg[:M_HEADS]
    lf = jax.nn.log_sigmoid(gf + bg[M_HEADS:])
    q = q * (M_DHQK ** -0.5)

    def chunks(t, d):
        return t.reshape(Bn, NC, CHUNK, M_HEADS, d).transpose(1, 0, 3, 2, 4)

    def gchunks(t):
        return t.reshape(Bn, NC, CHUNK, M_HEADS).transpose(1, 0, 3, 2)

    qc, kc, vc = chunks(q, M_DHQK), chunks(k, M_DHQK), chunks(v, M_DHV)
    igc, lfc = gchunks(ig), gchunks(lf)
    causal = jnp.tril(jnp.ones((CHUNK, CHUNK), dtype=bool))

    def step(carry, xs):
        C, n, m = carry
        qb, kb, vb, ib, fb = xs
        b = jnp.cumsum(fb, axis=-1)
        logD = jnp.where(causal, b[..., :, None] - b[..., None, :] + ib[..., None, :], -jnp.inf)
        inter = b + m[..., None]
        m_t = jnp.maximum(inter, jnp.max(logD, axis=-1))
        Dm = jnp.exp(logD - m_t[..., None])
        w_inter = jnp.exp(inter - m_t)
        s = jnp.einsum('bhtk,bhsk->bhts', qb, kb) * Dm
        num = w_inter[..., None] * jnp.einsum('bhtk,bhkv->bhtv', qb, C) + jnp.einsum('bhts,bhsv->bhtv', s, vb)
        den = w_inter * jnp.einsum('bhtk,bhk->bht', qb, n) + jnp.sum(s, axis=-1)
        h = num / jnp.maximum(jnp.abs(den), jnp.exp(-m_t))[..., None]
        bL = b[..., -1]
        a = bL[..., None] - b + ib
        m_new = jnp.maximum(bL + m, jnp.max(a, axis=-1))
        wk = jnp.exp(a - m_new[..., None])
        decay = jnp.exp(bL + m - m_new)
        C_new = decay[..., None, None] * C + jnp.einsum('bhs,bhsk,bhsv->bhkv', wk, kb, vb)
        n_new = decay[..., None] * n + jnp.einsum('bhs,bhsk->bhk', wk, kb)
        return (C_new, n_new, m_new), h

    init = (jnp.zeros((Bn, M_HEADS, M_DHQK, M_DHV), jnp.float32),
            jnp.zeros((Bn, M_HEADS, M_DHQK), jnp.float32),
            jnp.zeros((Bn, M_HEADS), jnp.float32))
    _, hc = lax.scan(step, init, (qc, kc, vc, igc, lfc))
    h = hc.transpose(1, 0, 3, 2, 4).reshape(Bn, S, M_HEADS, M_DHV)
    h = h * lax.rsqrt(jnp.mean(h * h, axis=-1, keepdims=True) + EPS)
    h = h.reshape(Bn, S, M_V) * norm_g.astype(jnp.float32) * jax.nn.sigmoid(og)
    return h.astype(u.dtype) @ w_out


def _shortconv_mixer(u, w_in, conv_w, conv_b, w_out):
    bg, cg, hx = jnp.split(u @ w_in, 3, axis=-1)
    z = cg * hx
    zc = lax.conv_general_dilated(
        z, conv_w[:, None, :].astype(z.dtype), window_strides=(1,), padding=[(CONV_W - 1, 0)],
        dimension_numbers=('NWC', 'WIO', 'NWC'), feature_group_count=z.shape[-1]) + conv_b
    return (bg * zc) @ w_out


def _moe(h, w_router, b_router, w_gate, w_up, w_down):
    Bn, S, D = h.shape
    T = Bn * S
    ht = h.reshape(T, D)
    probs = jax.nn.softmax((ht @ w_router).astype(jnp.float32), axis=-1)
    sel = probs + b_router.astype(jnp.float32)
    grp_score = lax.top_k(sel.reshape(T, N_GROUPS, EXPERTS_PER_GROUP), 2)[0].sum(-1)
    best = jnp.argmax(grp_score, axis=-1)
    in_grp = (jnp.arange(N_EXPERTS) // EXPERTS_PER_GROUP)[None, :] == best[:, None]
    _, idx = lax.top_k(jnp.where(in_grp, sel, -jnp.inf), TOP_K)
    wts = jnp.take_along_axis(probs, idx, axis=-1)
    wts = wts / jnp.sum(wts, axis=-1, keepdims=True)
    flat_e = idx.reshape(-1)
    flat_t = jnp.repeat(jnp.arange(T), TOP_K)
    order = jnp.argsort(flat_e)
    tok = flat_t[order]
    sizes = jnp.bincount(flat_e, length=N_EXPERTS).astype(jnp.int32)
    xs = ht[tok]
    a = jax.nn.silu(lax.ragged_dot(xs, w_gate, sizes)) * lax.ragged_dot(xs, w_up, sizes)
    out = lax.ragged_dot(a, w_down, sizes) * wts.reshape(-1)[order][:, None].astype(h.dtype)
    y = jax.ops.segment_sum(out, tok, num_segments=T)
    return y.reshape(Bn, S, D)


def setup_inputs(seed: int = 0) -> dict:
    key = jax.random.key(seed)
    ks = jax.random.split(key, 24)
    D = D_MODEL
    f32 = jnp.float32
    nrm = lambda k, shape, s: jax.random.normal(k, shape, f32) * s
    b_gates = jnp.concatenate([
        nrm(ks[7], (N_MLSTM_LAYERS, M_HEADS), 0.1),
        3.0 + nrm(ks[8], (N_MLSTM_LAYERS, M_HEADS), 0.5)], axis=-1)
    return {
        "x": nrm(ks[0], (BATCH, SEQ, D), 1.0),
        "c": nrm(ks[1], (BATCH, D), 1.0),
        "norm1_g": 1.0 + nrm(ks[2], (DEPTH, D), 0.02),
        "norm2_g": 1.0 + nrm(ks[3], (DEPTH, D), 0.02),
        "w_ada": nrm(ks[4], (DEPTH, D, 6 * D), 0.5 * D ** -0.5),
        "b_ada": nrm(ks[5], (DEPTH, 6 * D), 0.02),
        "m_w_in": nrm(ks[6], (N_MLSTM_LAYERS, D, M_PROJ), D ** -0.5),
        "m_b_gates": b_gates,
        "m_norm_g": 1.0 + nrm(ks[9], (N_MLSTM_LAYERS, M_V), 0.02),
        "m_w_out": nrm(ks[10], (N_MLSTM_LAYERS, M_V, D), M_V ** -0.5),
        "c_w_in": nrm(ks[11], (N_CONV_LAYERS, D, 3 * D), D ** -0.5),
        "c_conv_w": nrm(ks[12], (N_CONV_LAYERS, CONV_W, D), CONV_W ** -0.5),
        "c_conv_b": nrm(ks[13], (N_CONV_LAYERS, D), 0.02),
        "c_w_out": nrm(ks[14], (N_CONV_LAYERS, D, D), D ** -0.5),
        "w_router": nrm(ks[15], (D, N_EXPERTS), D ** -0.5),
        "b_router": nrm(ks[16], (N_EXPERTS,), 0.01),
        "e_w_gate": nrm(ks[17], (DEPTH, N_EXPERTS, D, D_EXPERT), D ** -0.5),
        "e_w_up": nrm(ks[18], (DEPTH, N_EXPERTS, D, D_EXPERT), D ** -0.5),
        "e_w_down": nrm(ks[19], (DEPTH, N_EXPERTS, D_EXPERT, D), D_EXPERT ** -0.5),
        "final_g": 1.0 + nrm(ks[20], (D,), 0.02),
    }


def reference(x, c, norm1_g, norm2_g, w_ada, b_ada, m_w_in, m_b_gates, m_norm_g, m_w_out,
              c_w_in, c_conv_w, c_conv_b, c_w_out, w_router, b_router,
              e_w_gate, e_w_up, e_w_down, final_g):
    cond = jax.nn.silu(c)
    for i in range(DEPTH):
        mod = cond @ w_ada[i] + b_ada[i]
        sh1, sc1, g1, sh2, sc2, g2 = jnp.split(mod, 6, axis=-1)
        u = _modulate(_rmsnorm(x, norm1_g[i]), sh1, sc1)
        j = i // 2
        if i % 2 == 0:
            mix = _mlstm_mixer(u, m_w_in[j], m_b_gates[j], m_norm_g[j], m_w_out[j])
        else:
            mix = _shortconv_mixer(u, c_w_in[j], c_conv_w[j], c_conv_b[j], c_w_out[j])
        x = x + g1[:, None, :] * mix
        u = _modulate(_rmsnorm(x, norm2_g[i]), sh2, sc2)
        x = x + g2[:, None, :] * _moe(u, w_router, b_router, e_w_gate[i], e_w_up[i], e_w_down[i])
    return _rmsnorm(x, final_g)
```

```cpp
#include <hip/hip_runtime.h>
#include <cstdio>
#include <cstdint>

#ifndef DBG_SKIP
#define DBG_SKIP 0
#endif
#ifndef MK_N_LAUNCHES
#define MK_N_LAUNCHES 0
#endif

#define LAS __attribute__((address_space(3)))
#define GAS __attribute__((address_space(1)))
typedef unsigned short bf16_t;
typedef short bf16x8 __attribute__((ext_vector_type(8)));
typedef float f32x4 __attribute__((ext_vector_type(4)));
typedef float f32x2 __attribute__((ext_vector_type(2)));
typedef unsigned u32x4 __attribute__((ext_vector_type(4)));
typedef unsigned u32x2 __attribute__((ext_vector_type(2)));
typedef GAS unsigned gu32;
#define RLX_AGENT __ATOMIC_RELAXED, __HIP_MEMORY_SCOPE_AGENT
#define LDS_WAIT() asm volatile("s_waitcnt lgkmcnt(0)" ::: "memory")
#define VM_WAIT() asm volatile("s_waitcnt vmcnt(0)" ::: "memory")

constexpr int NB = 4, SEQ = 8192, D = 1024, T = NB * SEQ;
constexpr int NH = 4, DK = 128, DV = 256, MQK = NH * DK, MV = NH * DV, MPROJ = 2 * MQK + 2 * MV + 2 * NH;
constexpr int CH = 64, NCH = SEQ / CH;
constexpr int NE = 16, DE = 512, LCAP = 65536;
constexpr int SLOT_ROWS = 2 * T + NE * 256;
constexpr float EPS = 1e-6f;
constexpr int NWAVES = 8, NTHR = 512;

constexpr size_t MiB = 1u << 20;
constexpr size_t WS_CTL = 0, CTL_ZERO_BYTES = 64 * 1024;
constexpr size_t WS_MOD = 1 * MiB;
constexpr size_t WS_W0 = 2 * MiB;
constexpr size_t WS_W1 = 8 * MiB;
constexpr size_t WS_WUP = 10 * MiB;
constexpr size_t WS_WDN = 42 * MiB;
constexpr size_t WS_IG = 62 * MiB;
constexpr size_t WS_LF = WS_IG + 512 * 1024;
constexpr size_t WS_GA = WS_LF + 512 * 1024;
constexpr size_t WS_RR = WS_GA + 512 * 1024;
constexpr size_t WS_MM = WS_RR + 512 * 1024;
constexpr size_t WS_RC = WS_MM + 512 * 1024;
constexpr size_t WS_NS = 65 * MiB;
constexpr size_t WS_TOK = 66 * MiB;
constexpr size_t WS_LIST = 67 * MiB;
constexpr size_t WS_U = 72 * MiB;
constexpr size_t WS_Q = 136 * MiB;
constexpr size_t WS_K = 168 * MiB;
constexpr size_t WS_KT = 200 * MiB;
constexpr size_t WS_VT = 232 * MiB;
constexpr size_t WS_OGS = 296 * MiB;
constexpr size_t WS_ST = 360 * MiB;
constexpr size_t WS_A = 136 * MiB;
constexpr size_t WS_O = 204 * MiB;
constexpr size_t WS_BG = 136 * MiB;
constexpr size_t WS_Z = 200 * MiB;
constexpr size_t WS_Y = 264 * MiB;
constexpr size_t WS_END = 488 * MiB;
static_assert(WS_A + (size_t)SLOT_ROWS * DE * 2 <= WS_O && WS_O + (size_t)SLOT_ROWS * D * 2 <= WS_ST, "moe map");

constexpr int CW_CNT = 64;
constexpr int CW_BAR = 1024;

constexpr int RING_BYTES = 131072;
constexpr int MISC_OFF = RING_BYTES;
constexpr int LDS_BYTES = 147456;

__device__ __forceinline__ unsigned f2bf(float f) { unsigned u = __builtin_bit_cast(unsigned, f); return (u + 0x7fffu + ((u >> 16) & 1u)) >> 16; }
__device__ __forceinline__ unsigned pk2(float lo, float hi) { return f2bf(lo) | (f2bf(hi) << 16); }
__device__ __forceinline__ float bf2f(unsigned short h) { return __builtin_bit_cast(float, (unsigned)h << 16); }
__device__ __forceinline__ float bflo(unsigned w) { return __builtin_bit_cast(float, w << 16); }
__device__ __forceinline__ float bfhi(unsigned w) { return __builtin_bit_cast(float, w & 0xffff0000u); }
__device__ __forceinline__ unsigned cvt_pk_bf16(float lo, float hi) { unsigned r; asm volatile("v_cvt_pk_bf16_f32 %0, %1, %2" : "=v"(r) : "v"(lo), "v"(hi)); return r; }
__device__ __forceinline__ float fast_exp(float x) { return __builtin_amdgcn_exp2f(x * 1.44269504089f); }
__device__ __forceinline__ float sigmoidf_(float x) { return __builtin_amdgcn_rcpf(1.0f + fast_exp(-x)); }

namespace pg8 {
constexpr int BM = 256, BK = 64, HALF = 128, HTB = HALF * BK * 2, STAGE_BYTES = 8 * HTB, NXCD = 8, WGM = 8;
__host__ __device__ __forceinline__ int lds_byte(int r, int c) { const int st = (r >> 4) * 2 + (c >> 5), rr = r & 15, cc = c & 31, ob = rr * 64 + cc * 2; return st * 1024 + (ob ^ (((ob >> 9) & 1) << 5)); }
__host__ __device__ __forceinline__ void stage_rc(int b, int& R, int& C) { const int st = b / 1024, sb = b % 1024, swz = sb ^ (((sb >> 9) & 1) << 5); R = (st >> 1) * 16 + swz / 64; C = (st & 1) * 32 + (swz % 64) / 2; }
__host__ __device__ __forceinline__ int perm32(int rho) { const int n = rho >> 4, i = rho & 15; return 8 * (i >> 2) + 4 * n + (i & 3); }

struct Unit { int arow0, brow0, pm, pn, e, nvalid; const int* alist; };
struct Gemm { const bf16_t* A; const bf16_t* Bt; int K; };

struct DenseOrder {
    int nM, nN, nwg, G, c;
    __device__ void init(int M, int N, int G_, int c_) { nM = M / BM; nN = N / BM; nwg = nM * nN; G = G_; c = c_; }
    __device__ bool next(int i, Unit& u) const {
        const long L = (long)i * G + c; if (L >= nwg) return false;
        int wgid = (int)L; { const int q = nwg / NXCD, r = nwg % NXCD, xcd = wgid % NXCD, off = wgid / NXCD; wgid = (xcd < r ? xcd * (q + 1) : r * (q + 1) + (xcd - r) * q) + off; }
        const int nig = WGM * nN, gid = wgid / nig, fm = gid * WGM, gsz = (nM - fm) < WGM ? (nM - fm) : WGM;
        u.pm = fm + ((wgid % nig) % gsz); u.pn = (wgid % nig) / gsz; u.arow0 = u.pm * BM; u.brow0 = u.pn * BM; u.e = 0; u.nvalid = 256; u.alist = nullptr; return true;
    }
};
struct MoeOrder {
    const LAS int* tpre; const LAS int* cnt; const int* list; int G, vcu, bn;
    __device__ bool next(int i, Unit& u) const {
        const int U = i * G + vcu, rt = U >> 2, pn = U & 3;
        if (rt >= tpre[NE]) return false;
        int e = 0;
#pragma unroll
        for (int k = 1; k < NE; ++k) e += (rt >= tpre[k]) ? 1 : 0;
        const int r = rt - tpre[e];
        u.arow0 = rt * BM; u.brow0 = e * bn + pn * BM; u.pm = rt; u.pn = pn; u.e = e; u.nvalid = min(256, cnt[e] - r * 256); u.alist = list + e * LCAP + r * 256; return true;
    }
};

template <class Epi, class Sched, bool GATHER, bool ALIGN_EPI, bool SP2>
__device__ __forceinline__ void gemm_phase(LAS unsigned char* lds, const Gemm g, const Sched& S, const Epi& E, const int tid) {
    const int wid = __builtin_amdgcn_readfirstlane(tid >> 6), lane = tid & 63, wr = wid >> 2, wc = wid & 3, fr = lane & 15, fq = lane >> 4;
    const int K = g.K, nt = K / BK;
    unsigned voffA[2], voffB[2];
#pragma unroll
    for (int i = 0; i < 2; ++i) { int R, C; stage_rc(tid * 16 + i * 8192, R, C); const int Rb = Epi::PERM ? ((R & ~31) + perm32(R & 31)) : R;
        voffA[i] = (unsigned)(R * K + C) * 2u; voffB[i] = (unsigned)(Rb * K + C) * 2u; }
    const size_t kstep = (size_t)(BK * 2);
    const size_t hstep = (size_t)HALF * K * 2;
    const unsigned ldsw = (unsigned)wid * 1024u;
    const int aoff = lds_byte(wr * 64 + fr, fq * 8), boff = lds_byte(wc * 32 + fr, fq * 8);
#define PG8_SA(b, h) (((b) * 2 + (h)) * HTB)
#define PG8_SB(b, h) ((4 + (b) * 2 + (h)) * HTB)
#define PG8_STAGE(bufoff, gbase, voff) do { _Pragma("unroll") for (int _i = 0; _i < 2; ++_i) \
        __builtin_amdgcn_global_load_lds((const unsigned*)((const char*)(gbase) + (voff)[_i]), (LAS unsigned*)(lds + (bufoff) + ldsw + _i * 8192), 16, 0, 0); } while (0)
#define PG8_STAGE_A(bufoff, kb, h, vo) do { if constexpr (GATHER) { PG8_STAGE(bufoff, kb, (vo)[h]); } else { PG8_STAGE(bufoff, (kb) + (h) * hstep, voffA); } } while (0)
#define PG8_LDA(dst, b, h) do { _Pragma("unroll") for (int m = 0; m < 4; ++m) _Pragma("unroll") for (int k = 0; k < 2; ++k) dst[m][k] = *(const LAS bf16x8*)(lds + PG8_SA(b, h) + aoff + m * 2048 + k * 1024); } while (0)
#define PG8_LDB(dst, b, h) do { _Pragma("unroll") for (int n = 0; n < 2; ++n) _Pragma("unroll") for (int k = 0; k < 2; ++k) dst[n][k] = *(const LAS bf16x8*)(lds + PG8_SB(b, h) + boff + n * 2048 + k * 1024); } while (0)
#define PG8_MMA(ai, bj, At, Bt) do { __builtin_amdgcn_s_setprio(1); _Pragma("unroll") for (int m = 0; m < 4; ++m) _Pragma("unroll") for (int n = 0; n < 2; ++n) _Pragma("unroll") for (int k = 0; k < 2; ++k) \
        acc[ai][bj][m][n] = __builtin_amdgcn_mfma_f32_16x16x32_bf16(Bt[n][k], At[m][k], acc[ai][bj][m][n], 0, 0, 0); __builtin_amdgcn_s_setprio(0); } while (0)
#define PG8_WAIT_V(n) asm volatile("s_waitcnt vmcnt(" #n ")" ::: "memory")
#define PG8_WAIT_L(n) asm volatile("s_waitcnt lgkmcnt(" #n ")" ::: "memory")
#define PG8_BAR __builtin_amdgcn_s_barrier()
#define PG8_SCHED __builtin_amdgcn_sched_barrier(0)
    Unit cur, nxt; int ui = 0;
    if (!S.next(0, cur)) return;
    f32x4 acc[2][2][4][2];
#pragma unroll
    for (int a = 0; a < 2; ++a)
#pragma unroll
        for (int b = 0; b < 2; ++b)
#pragma unroll
            for (int m = 0; m < 4; ++m)
#pragma unroll
                for (int n = 0; n < 2; ++n) acc[a][b][m][n] = (f32x4){0.f, 0.f, 0.f, 0.f};
    bf16x8 At[4][2], B0[2][2], B1[2][2];
    unsigned vg[2][2];
#define PG8_GATHER(u) do { _Pragma("unroll") for (int _h = 0; _h < 2; ++_h) _Pragma("unroll") for (int _i = 0; _i < 2; ++_i) { int _R, _C; stage_rc(tid * 16 + _i * 8192, _R, _C); \
        const int _r = _h * HALF + _R; const int _tok = (_r < (u).nvalid) ? (u).alist[_r] : 0; vg[_h][_i] = (unsigned)(_tok * K + _C) * 2u; } } while (0)
    const char* cA; const char* cB = (const char*)g.Bt + (size_t)cur.brow0 * K * 2;
    if constexpr (GATHER) { cA = (const char*)g.A; PG8_GATHER(cur); } else { cA = (const char*)g.A + (size_t)cur.arow0 * K * 2;
#pragma unroll
        for (int h = 0; h < 2; ++h)
#pragma unroll
            for (int i = 0; i < 2; ++i) vg[h][i] = 0u; }
    if constexpr (SP2) {
        PG8_STAGE(PG8_SB(0, 0), cB, voffB); PG8_STAGE(PG8_SB(0, 1), cB + hstep, voffB); PG8_STAGE_A(PG8_SA(0, 0), cA, 0, vg); PG8_STAGE_A(PG8_SA(0, 1), cA, 1, vg);
        if (wr == 1) PG8_BAR;
        PG8_WAIT_V(2); PG8_BAR;
        PG8_STAGE(PG8_SB(1, 0), cB + kstep, voffB); PG8_STAGE_A(PG8_SA(1, 0), cA + kstep, 0, vg); PG8_STAGE(PG8_SB(1, 1), cB + hstep + kstep, voffB);
        PG8_WAIT_V(6); PG8_BAR;
    } else {
        PG8_STAGE(PG8_SB(0, 0), cB, voffB); PG8_STAGE_A(PG8_SA(0, 0), cA, 0, vg); PG8_STAGE(PG8_SB(0, 1), cB + hstep, voffB); PG8_STAGE_A(PG8_SA(0, 1), cA, 1, vg);
        if (wr == 1) PG8_BAR;
        PG8_WAIT_V(4); PG8_BAR;
        PG8_STAGE(PG8_SB(1, 0), cB + kstep, voffB); PG8_STAGE_A(PG8_SA(1, 0), cA + kstep, 0, vg); PG8_STAGE(PG8_SB(1, 1), cB + hstep + kstep, voffB);
        PG8_WAIT_V(6); PG8_BAR;
    }
    for (;;) {
        const bool has_next = S.next(ui + 1, nxt);
        const char* nA; const char* nB = has_next ? (const char*)g.Bt + (size_t)nxt.brow0 * K * 2 : cB;
        if constexpr (GATHER) nA = cA; else nA = has_next ? (const char*)g.A + (size_t)nxt.arow0 * K * 2 : cA;
        for (int t = 0; t < nt; t += 2) {
            const bool last = (t == nt - 2);
            const char* a1 = cA + (size_t)(t + 1) * kstep;
            const char* a2 = last ? nA : cA + (size_t)(t + 2) * kstep; const char* b2 = last ? nB : cB + (size_t)(t + 2) * kstep;
            const char* a3 = a2 + kstep; const char* b3 = b2 + kstep;
            if constexpr (SP2) {
            PG8_LDB(B0, 0, 0); PG8_LDB(B1, 0, 1); PG8_SCHED; PG8_LDA(At, 0, 0); PG8_STAGE_A(PG8_SA(1, 1), a1, 1, vg);
            if constexpr (GATHER) { if (last && has_next) PG8_GATHER(nxt); }
            PG8_WAIT_V(8); PG8_WAIT_L(0); PG8_BAR; PG8_MMA(0, 0, At, B0); PG8_MMA(0, 1, At, B1); PG8_BAR; PG8_SCHED;
            PG8_LDA(At, 0, 1); PG8_STAGE(PG8_SB(0, 0), b2, voffB); PG8_STAGE(PG8_SB(0, 1), b2 + hstep, voffB); PG8_STAGE_A(PG8_SA(0, 0), a2, 0, vg);
            PG8_WAIT_V(8); PG8_WAIT_L(0); PG8_BAR; PG8_MMA(1, 0, At, B0); PG8_MMA(1, 1, At, B1); PG8_BAR; PG8_SCHED;
            PG8_LDB(B0, 1, 0); PG8_LDB(B1, 1, 1); PG8_SCHED; PG8_LDA(At, 1, 0); PG8_STAGE_A(PG8_SA(0, 1), a2, 1, vg);
            PG8_WAIT_V(8); PG8_WAIT_L(0); PG8_BAR; PG8_MMA(0, 0, At, B0); PG8_MMA(0, 1, At, B1); PG8_BAR; PG8_SCHED;
            PG8_LDA(At, 1, 1); PG8_STAGE(PG8_SB(1, 0), b3, voffB); PG8_STAGE(PG8_SB(1, 1), b3 + hstep, voffB); PG8_STAGE_A(PG8_SA(1, 0), a3, 0, vg);
            PG8_WAIT_V(8); PG8_WAIT_L(0); PG8_BAR; PG8_MMA(1, 0, At, B0); PG8_MMA(1, 1, At, B1); PG8_BAR; PG8_SCHED;
            } else {
            PG8_LDB(B0, 0, 0); PG8_SCHED; PG8_LDA(At, 0, 0); PG8_STAGE_A(PG8_SA(1, 1), a1, 1, vg);
            if constexpr (GATHER) { if (last && has_next) PG8_GATHER(nxt); }
            PG8_WAIT_L(8); PG8_BAR; PG8_WAIT_L(0); PG8_MMA(0, 0, At, B0); PG8_BAR; PG8_SCHED;
            PG8_LDB(B1, 0, 1); PG8_STAGE(PG8_SB(0, 0), b2, voffB);
            PG8_BAR; PG8_WAIT_L(0); PG8_MMA(0, 1, At, B1); PG8_BAR;
            PG8_LDA(At, 0, 1); PG8_STAGE_A(PG8_SA(0, 0), a2, 0, vg);
            PG8_BAR; PG8_WAIT_L(0); PG8_MMA(1, 0, At, B0); PG8_BAR; PG8_SCHED;
            PG8_STAGE(PG8_SB(0, 1), b2 + hstep, voffB);
            PG8_WAIT_V(6); PG8_BAR; PG8_MMA(1, 1, At, B1); PG8_BAR;
            PG8_LDB(B0, 1, 0); PG8_SCHED; PG8_LDA(At, 1, 0); PG8_STAGE_A(PG8_SA(0, 1), a2, 1, vg);
            PG8_WAIT_L(8); PG8_BAR; PG8_WAIT_L(0); PG8_MMA(0, 0, At, B0); PG8_BAR; PG8_SCHED;
            PG8_LDB(B1, 1, 1); PG8_STAGE(PG8_SB(1, 0), b3, voffB);
            PG8_BAR; PG8_WAIT_L(0); PG8_MMA(0, 1, At, B1); PG8_BAR;
            PG8_LDA(At, 1, 1); PG8_STAGE_A(PG8_SA(1, 0), a3, 0, vg);
            PG8_BAR; PG8_WAIT_L(0); PG8_MMA(1, 0, At, B0); PG8_BAR; PG8_SCHED;
            PG8_STAGE(PG8_SB(1, 1), b3 + hstep, voffB);
            PG8_WAIT_V(6); PG8_BAR; PG8_MMA(1, 1, At, B1); PG8_BAR;
            }
        }
        if constexpr (ALIGN_EPI) { if (wr == 0) PG8_BAR; }
        E(acc, cur, wr, wc, fr, fq);
        if (!has_next) break;
#pragma unroll
        for (int a = 0; a < 2; ++a)
#pragma unroll
            for (int b = 0; b < 2; ++b)
#pragma unroll
                for (int m = 0; m < 4; ++m)
#pragma unroll
                    for (int n = 0; n < 2; ++n) acc[a][b][m][n] = (f32x4){0.f, 0.f, 0.f, 0.f};
        cur = nxt; cA = nA; cB = nB; ++ui;
        if constexpr (ALIGN_EPI) { if (wr == 1) PG8_BAR; }
    }
    PG8_WAIT_V(0);
    if constexpr (!ALIGN_EPI) { if (wr == 0) PG8_BAR; }
    PG8_BAR;
#undef PG8_SA
#undef PG8_SB
#undef PG8_STAGE
#undef PG8_STAGE_A
#undef PG8_GATHER
#undef PG8_LDA
#undef PG8_LDB
#undef PG8_MMA
#undef PG8_WAIT_V
#undef PG8_WAIT_L
#undef PG8_BAR
#undef PG8_SCHED
}


struct EpiM1 {
    static constexpr bool PERM = true;
    bf16_t* Q; bf16_t* Kn; bf16_t* KT; bf16_t* VT; bf16_t* OGS;
    __device__ __forceinline__ void operator()(const f32x4 (&acc)[2][2][4][2], const Unit& u, int wr, int wc, int fr, int fq) const {
        const int row0 = u.arow0 + wr * 64 + fr, pn = u.pn;
        if (pn < 4 || pn >= 8) {
            bf16_t* base; int ldc, colt; float sc = 1.f; const bool sig = pn >= 8;
            if (pn < 2) { base = Q; ldc = MQK; colt = pn * 256; sc = 0.08838834764831845f; }
            else if (pn < 4) { base = Kn; ldc = MQK; colt = (pn - 2) * 256; }
            else { base = OGS; ldc = MV; colt = (pn - 8) * 256; }
            const int col0 = colt + wc * 32 + 8 * fq;
#pragma unroll
            for (int ai = 0; ai < 2; ++ai)
#pragma unroll
                for (int m = 0; m < 4; ++m) { bf16_t* rowp = base + (size_t)(row0 + ai * HALF + m * 16) * ldc + col0;
#pragma unroll
                    for (int bj = 0; bj < 2; ++bj) { f32x4 v0 = acc[ai][bj][m][0] * sc, v1 = acc[ai][bj][m][1] * sc;
                        if (sig) {
#pragma unroll
                            for (int j = 0; j < 4; ++j) { v0[j] = sigmoidf_(v0[j]); v1[j] = sigmoidf_(v1[j]); } }
                        u32x4 w; w.x = cvt_pk_bf16(v0[0], v0[1]); w.y = cvt_pk_bf16(v0[2], v0[3]); w.z = cvt_pk_bf16(v1[0], v1[1]); w.w = cvt_pk_bf16(v1[2], v1[3]);
                        *(u32x4*)(rowp + bj * HALF) = w; } }
        }
        if (pn >= 2 && pn < 8) {
            const int b = u.arow0 / SEQ, s0 = (u.arow0 % SEQ) + wr * 64 + fr;
            bf16_t* base; int colt, nc;
            if (pn < 4) { base = KT; colt = (pn - 2) * 256; nc = MQK; } else { base = VT; colt = (pn - 4) * 256; nc = MV; }
            bf16_t* xb = base + ((size_t)b * nc + colt + wc * 32 + 8 * fq) * SEQ + s0;
#pragma unroll
            for (int ai = 0; ai < 2; ++ai)
#pragma unroll
                for (int m = 0; m < 4; ++m)
#pragma unroll
                    for (int bj = 0; bj < 2; ++bj)
#pragma unroll
                        for (int n = 0; n < 2; ++n)
#pragma unroll
                            for (int j = 0; j < 4; ++j)
                                xb[(size_t)(bj * HALF + 4 * n + j) * SEQ + ai * HALF + m * 16] = (bf16_t)f2bf(acc[ai][bj][m][n][j]);
        }
    }
};
struct EpiRes {
    static constexpr bool PERM = false;
    const float* base; float* out; const float* gate; float mul;
    __device__ __forceinline__ void operator()(const f32x4 (&acc)[2][2][4][2], const Unit& u, int wr, int wc, int fr, int fq) const {
        const int row0 = u.arow0 + wr * 64 + fr, col0 = u.pn * BM + wc * 32 + 4 * fq, b = u.arow0 / SEQ;
        f32x4 gv[2][2];
#pragma unroll
        for (int bj = 0; bj < 2; ++bj)
#pragma unroll
            for (int n = 0; n < 2; ++n) gv[bj][n] = *(const f32x4*)(gate + (size_t)b * 6 * D + col0 + bj * HALF + n * 16);
#pragma unroll
        for (int ai = 0; ai < 2; ++ai)
#pragma unroll
            for (int m = 0; m < 4; ++m) { const size_t off = (size_t)(row0 + ai * HALF + m * 16) * D + col0;
#pragma unroll
                for (int bj = 0; bj < 2; ++bj)
#pragma unroll
                    for (int n = 0; n < 2; ++n) { const f32x4 bs = *(const f32x4*)(base + off + bj * HALF + n * 16);
                        *(f32x4*)(out + off + bj * HALF + n * 16) = bs + gv[bj][n] * acc[ai][bj][m][n] * mul; } }
    }
};
struct EpiBf {
    static constexpr bool PERM = true;
    bf16_t* O; int ldc;
    __device__ __forceinline__ void operator()(const f32x4 (&acc)[2][2][4][2], const Unit& u, int wr, int wc, int fr, int fq) const {
        const int row0 = u.arow0 + wr * 64 + fr, col0 = u.pn * BM + wc * 32 + 8 * fq;
#pragma unroll
        for (int ai = 0; ai < 2; ++ai)
#pragma unroll
            for (int m = 0; m < 4; ++m) { bf16_t* rowp = O + (size_t)(row0 + ai * HALF + m * 16) * ldc + col0;
#pragma unroll
                for (int bj = 0; bj < 2; ++bj) { const f32x4 v0 = acc[ai][bj][m][0], v1 = acc[ai][bj][m][1];
                    u32x4 w; w.x = cvt_pk_bf16(v0[0], v0[1]); w.y = cvt_pk_bf16(v0[2], v0[3]); w.z = cvt_pk_bf16(v1[0], v1[1]); w.w = cvt_pk_bf16(v1[2], v1[3]);
                    *(u32x4*)(rowp + bj * HALF) = w; } }
    }
};
template <bool SILU> struct EpiGlu {
    static constexpr bool PERM = true;
    bf16_t* O; int ldc; int plain_tiles; bf16_t* P; int ldp;
    __device__ __forceinline__ void operator()(const f32x4 (&acc)[2][2][4][2], const Unit& u, int wr, int wc, int fr, int fq) const {
        const int row0 = u.arow0 + wr * 64 + fr;
        if (u.pn < plain_tiles) {
            const int col0 = u.pn * BM + wc * 32 + 8 * fq;
#pragma unroll
            for (int ai = 0; ai < 2; ++ai)
#pragma unroll
                for (int m = 0; m < 4; ++m) { bf16_t* rowp = P + (size_t)(row0 + ai * HALF + m * 16) * ldp + col0;
#pragma unroll
                    for (int bj = 0; bj < 2; ++bj) { const f32x4 v0 = acc[ai][bj][m][0], v1 = acc[ai][bj][m][1];
                        u32x4 w; w.x = cvt_pk_bf16(v0[0], v0[1]); w.y = cvt_pk_bf16(v0[2], v0[3]); w.z = cvt_pk_bf16(v1[0], v1[1]); w.w = cvt_pk_bf16(v1[2], v1[3]);
                        *(u32x4*)(rowp + bj * HALF) = w; } }
            return;
        }
        const int col0 = (u.pn - plain_tiles) * HALF + wc * 32 + 8 * fq;
#pragma unroll
        for (int ai = 0; ai < 2; ++ai)
#pragma unroll
            for (int m = 0; m < 4; ++m) { bf16_t* rowp = O + (size_t)(row0 + ai * HALF + m * 16) * ldc + col0;
                f32x4 v0 = acc[ai][0][m][0], v1 = acc[ai][0][m][1]; const f32x4 u0 = acc[ai][1][m][0], u1 = acc[ai][1][m][1];
                if (SILU) {
#pragma unroll
                    for (int j = 0; j < 4; ++j) { v0[j] = v0[j] * sigmoidf_(v0[j]); v1[j] = v1[j] * sigmoidf_(v1[j]); } }
                v0 = v0 * u0; v1 = v1 * u1;
                u32x4 w; w.x = cvt_pk_bf16(v0[0], v0[1]); w.y = cvt_pk_bf16(v0[2], v0[3]); w.z = cvt_pk_bf16(v1[0], v1[1]); w.w = cvt_pk_bf16(v1[2], v1[3]);
                *(u32x4*)rowp = w; }
    }
};
}

#define XB_TMO      128
#define XB_XCNT(j)  (256  + 64 * (j))
#define XB_XSUB(j)  (1280 + 64 * (j))
#define XB_XGEN(j)  (2304 + 64 * (j))
#define XB_TOP      3328
#define XB_TOPGEN   3392
#define XCD_BAR_WORDS 3456
#define XB_SPIN_CAP (1u << 18)
__device__ __forceinline__ unsigned xb_ld(unsigned* p)              { return __hip_atomic_load(p, __ATOMIC_RELAXED, __HIP_MEMORY_SCOPE_AGENT); }
__device__ __forceinline__ unsigned xb_add(unsigned* p, unsigned v) { return __hip_atomic_fetch_add(p, v, __ATOMIC_RELAXED, __HIP_MEMORY_SCOPE_AGENT); }
__device__ __forceinline__ unsigned xb_xcc_id() { return (unsigned)__builtin_amdgcn_s_getreg((3 << 11) | 20) & 0xFu; }
#define XB_SPIN(cond, bar) do { unsigned _sp = 0; while (cond) { __builtin_amdgcn_s_sleep(1); \
    if ((++_sp & 255u) == 0u) { if (xb_ld(&(bar)[XB_TMO])) break; if (_sp > XB_SPIN_CAP) { atomicAdd(&(bar)[XB_TMO], 1u); break; } } } } while (0)
struct XcdBarrier { unsigned* bar; unsigned x; volatile LAS unsigned* st; };
__device__ __forceinline__ XcdBarrier xcd_barrier_post(unsigned* bar, volatile LAS unsigned* st) {
    XcdBarrier b; b.bar = bar; b.x = xb_xcc_id(); b.st = st;
    if (threadIdx.x == 0) (void)xb_add(&bar[XB_XCNT(b.x)], 1u);
    return b;
}
__device__ __forceinline__ void xcd_barrier_complete(unsigned* bar, unsigned x, unsigned& nloc, unsigned& nx) {
    const unsigned G = gridDim.x * gridDim.y * gridDim.z;
    unsigned sum, cnt, mine, sp = 0u;
    for (;;) {
        sum = 0u; cnt = 0u; mine = 0u;
#pragma unroll
        for (unsigned j = 0; j < 16; ++j) { const unsigned c = xb_ld(&bar[XB_XCNT(j)]); sum += c; cnt += (c > 0u) ? 1u : 0u; mine = (j == x) ? c : mine; }
        if (sum == G) break;
        __builtin_amdgcn_s_sleep(1);
        if ((++sp & 255u) == 0u) { if (xb_ld(&bar[XB_TMO])) break; if (sp > XB_SPIN_CAP) { atomicAdd(&bar[XB_TMO], 1u); break; } }
    }
    nloc = mine > 0u ? mine : 1u; nx = cnt > 0u ? cnt : 1u;
}
__device__ __forceinline__ void xcd_barrier(const XcdBarrier& b) {
    asm volatile("s_waitcnt vmcnt(0)" ::: "memory");
    __syncthreads();
    if (threadIdx.x == 0) {
        unsigned* bar = b.bar;
        __builtin_amdgcn_s_waitcnt(0);
        unsigned nloc = b.st[0], nx = b.st[1];
        if (nloc == 0u) { xcd_barrier_complete(bar, b.x, nloc, nx); b.st[0] = nloc; b.st[1] = nx; }
        const unsigned old = xb_add(&bar[XB_XSUB(b.x)], 1u);
        const unsigned gen = old / nloc;
        if (old + 1u == (gen + 1u) * nloc) {
            __builtin_amdgcn_fence(__ATOMIC_RELEASE, "agent");
            asm volatile("s_waitcnt vmcnt(0)" ::: "memory");
            const unsigned og = xb_add(&bar[XB_TOP], 1u);
            const unsigned tg = og / nx;
            if (og + 1u == (tg + 1u) * nx) xb_add(&bar[XB_TOPGEN], 1u);
            else XB_SPIN(xb_ld(&bar[XB_TOPGEN]) == tg, bar);
            __builtin_amdgcn_fence(__ATOMIC_ACQUIRE, "agent");
            xb_add(&bar[XB_XGEN(b.x)], 1u);
            asm volatile("s_waitcnt vmcnt(0)" ::: "memory");
        } else {
            XB_SPIN(xb_ld(&bar[XB_XGEN(b.x)]) == gen, bar);
            __builtin_amdgcn_fence(__ATOMIC_ACQUIRE, "agent");
            asm volatile("s_waitcnt vmcnt(0)" ::: "memory");
        }
    }
    __syncthreads();
}

struct Args { const float* in[20]; float* out; unsigned char* ws; int ph_lo, ph_hi; };
__device__ __forceinline__ const void* karg_ptr(int idx) {
    const void* p = ((const void* const __attribute__((address_space(4)))*)__builtin_amdgcn_kernarg_segment_ptr())[idx];
    asm volatile("" : "+s"(p)); return p;
}
struct InProxy { __device__ __forceinline__ const float* operator[](int i) const { return (const float*)karg_ptr(i); } };
struct WsProxy { __device__ __forceinline__ operator unsigned char*() const { return (unsigned char*)karg_ptr(21); }
                 __device__ __forceinline__ unsigned char* operator+(size_t o) const { return (unsigned char*)karg_ptr(21) + o; } };
struct OutProxy { __device__ __forceinline__ operator float*() const { return (float*)karg_ptr(20); }
                  __device__ __forceinline__ float* operator+(size_t o) const { return (float*)karg_ptr(20) + o; } };
struct CtlProxy { __device__ __forceinline__ operator gu32*() const { return (gu32*)karg_ptr(21); }
                  __device__ __forceinline__ gu32* operator+(int o) const { return (gu32*)karg_ptr(21) + o; } };
struct Frame {
    LAS unsigned char* lds; volatile LAS unsigned* MISC; CtlProxy ctl;
    int tid, lane, wave, vcu, G, bx;
    InProxy in; OutProxy out; WsProxy ws;
};
enum { I_X = 0, I_C, I_N1G, I_N2G, I_WADA, I_BADA, I_MWIN, I_MBG, I_MNG, I_MWOUT, I_CWIN, I_CCW, I_CCB, I_CWOUT, I_WR, I_BR, I_EWG, I_EWU, I_EWD, I_FG };

__device__ __forceinline__ float wave_sum(float v) {
#pragma unroll
    for (int o = 1; o < 64; o <<= 1) v += __shfl_xor(v, o);
    return v;
}

__device__ __forceinline__ void cvt_item(const float* W, int ldw, int K, int k0, int n0, bf16_t* WT, int drow0, LAS float* scr, int lane) {
#pragma unroll 8
    for (int i = 0; i < 32; ++i) { const int kk = 2 * i + (lane >> 5); scr[kk * 33 + (lane & 31)] = W[(size_t)(k0 + kk) * ldw + n0 + (lane & 31)]; }
    LDS_WAIT(); asm volatile("" ::: "memory");
    const int c = lane & 7;
#pragma unroll
    for (int j = 0; j < 4; ++j) { const int n = (lane >> 3) + 8 * j; const LAS float* s = scr + (8 * c) * 33 + n;
        u32x4 o; o.x = pk2(s[0 * 33], s[1 * 33]); o.y = pk2(s[2 * 33], s[3 * 33]); o.z = pk2(s[4 * 33], s[5 * 33]); o.w = pk2(s[6 * 33], s[7 * 33]);
        *(GAS u32x4*)(WT + (size_t)(drow0 + n) * K + k0 + 8 * c) = o; }
    LDS_WAIT(); asm volatile("" ::: "memory");
}
__device__ __forceinline__ int glu_row(int n, int which) { return (n >> 7) * 256 + which * 128 + (n & 127); }

__device__ __forceinline__ void convert_weights(Frame& F, int L) {
    LAS float* scr = (LAS float*)(F.lds + F.wave * 16384);
    const int gw = F.vcu * NWAVES + F.wave, NGW = F.G * NWAVES;
    bf16_t* W0 = (bf16_t*)(F.ws + WS_W0); bf16_t* W1 = (bf16_t*)(F.ws + WS_W1); bf16_t* WUP = (bf16_t*)(F.ws + WS_WUP); bf16_t* WDN = (bf16_t*)(F.ws + WS_WDN);
    constexpr int I_IN = 16 * 96, I_OUT = 16 * 32, I_G = NE * 16 * 16, I_D = NE * 8 * 32;
    constexpr int NITEMS = I_IN + I_OUT + 2 * I_G + I_D;
    for (int it = gw; it < NITEMS; it += NGW) {
        int r = it;
        if (r < I_IN) { const int kb = r / 96, nb = r % 96, n0 = nb * 32;
            if (L == 0) cvt_item(F.in[I_MWIN], MPROJ, D, kb * 64, n0, W0, n0, scr, F.lane);
            else { int dr; if (n0 < D) dr = n0; else if (n0 < 2 * D) dr = D + glu_row(n0 - D, 0); else dr = D + glu_row(n0 - 2 * D, 1);
                cvt_item(F.in[I_CWIN], 3 * D, D, kb * 64, n0, W0, dr, scr, F.lane); }
            continue; } r -= I_IN;
        if (r < I_OUT) { const int kb = r / 32, nb = r % 32; cvt_item(L == 0 ? F.in[I_MWOUT] : F.in[I_CWOUT], D, D, kb * 64, nb * 32, W1, nb * 32, scr, F.lane); continue; } r -= I_OUT;
        if (r < 2 * I_G) { const int which = r / I_G; r %= I_G; const int e = r / 256, kb = (r % 256) / 16, nb = r % 16, n0 = nb * 32;
            const float* src = (which == 0 ? F.in[I_EWG] : F.in[I_EWU]) + ((size_t)L * NE + e) * D * DE;
            cvt_item(src, DE, D, kb * 64, n0, WUP + (size_t)e * 1024 * D, glu_row(n0, which), scr, F.lane); continue; } r -= 2 * I_G;
        { const int e = r / 256, kb = (r % 256) / 32, nb = r % 32;
          const float* src = F.in[I_EWD] + ((size_t)L * NE + e) * DE * D;
          cvt_item(src, D, DE, kb * 64, nb * 32, WDN + (size_t)e * D * DE, nb * 32, scr, F.lane); }
    }
}

__device__ __forceinline__ void phase_prologue(Frame& F) {
    float* MOD = (float*)(F.ws + WS_MOD);
    LAS float* cond = (LAS float*)(F.lds + 0);
    LAS float* red = (LAS float*)(F.lds + 16384);
    bool did = false;
    for (int task = F.bx; task < 192; task += F.G) {
        if (did) __syncthreads();
        did = true;
        for (int i = F.tid; i < NB * D; i += NTHR) { const int b = i / D, k = i % D; const float c = F.in[I_C][i]; cond[k * 4 + b] = c * sigmoidf_(c); }
        __syncthreads();
        const int layer = task / 96, col = (task % 96) * 64 + F.lane;
        const float* W = F.in[I_WADA] + (size_t)layer * D * 6 * D;
        float a0 = 0.f, a1 = 0.f, a2 = 0.f, a3 = 0.f;
#pragma unroll 8
        for (int kk = 0; kk < 128; ++kk) { const int k = F.wave * 128 + kk; const float w = W[(size_t)k * 6 * D + col]; const f32x4 c4 = *(const LAS f32x4*)(cond + k * 4);
            a0 += c4[0] * w; a1 += c4[1] * w; a2 += c4[2] * w; a3 += c4[3] * w; }
        red[(F.wave * 4 + 0) * 64 + F.lane] = a0; red[(F.wave * 4 + 1) * 64 + F.lane] = a1; red[(F.wave * 4 + 2) * 64 + F.lane] = a2; red[(F.wave * 4 + 3) * 64 + F.lane] = a3;
        __syncthreads();
        if (F.tid < 256) { const int b = F.tid >> 6, l = F.tid & 63; float s = 0.f;
#pragma unroll
            for (int w = 0; w < 8; ++w) s += red[(w * 4 + b) * 64 + l];
            const int c = (task % 96) * 64 + l;
            MOD[((size_t)layer * NB + b) * 6 * D + c] = s + F.in[I_BADA][(size_t)layer * 6 * D + c]; }
    }
    __syncthreads();
    convert_weights(F, 0);
}

__device__ __forceinline__ void xreduce32(float (&v)[32], int lane) {
#pragma unroll
    for (int step = 0; step < 5; ++step) {
        const int M = 32 >> step, n = 32 >> step;
        const bool up = (lane & M) != 0;
#pragma unroll
        for (int i = 0; i < n / 2; ++i) { float a = v[i], b = v[i + n / 2]; asm volatile("" : "+v"(a), "+v"(b));
            const float send = up ? a : b, keep = up ? b : a; v[i] = keep + __shfl_xor(send, M); }
    }
    v[0] += __shfl_xor(v[0], 1);
}

constexpr int RP_WL = 0, RP_RINFO = 65536, RP_LCNT = RP_RINFO + 128 * 8 * 4, RP_TPRE = RP_LCNT + 256;
template <int MODE>
__device__ __forceinline__ void row_pass(Frame& F, int layer) {
    constexpr int DOTS = (MODE == 0) ? 8 : (MODE == 1 ? 16 : 0);
    constexpr int RPI = (MODE == 1) ? 2 : 4;
    constexpr bool COMBINE = (MODE == 2 || MODE == 3), MODUL = (MODE != 3);
    const float* MOD = (const float*)(F.ws + WS_MOD);
    LAS float* wl = (LAS float*)(F.lds + RP_WL);
    LAS int* rinfo = (LAS int*)(F.lds + RP_RINFO);
    LAS int* lcnt = (LAS int*)(F.lds + RP_LCNT);
    LAS int* tpre = (LAS int*)(F.lds + RP_TPRE);
    const float* xin = (MODE == 0) ? F.in[I_X] : F.out;
    bf16_t* U = (bf16_t*)(F.ws + WS_U);
    const int lane = F.lane;
    const int clayer = (MODE == 2) ? 0 : 1;
    if (DOTS == 8) { for (int i = F.tid; i < D * 8; i += NTHR) { const int k = i >> 3, j = i & 7; wl[i] = F.in[I_MWIN][(size_t)k * MPROJ + 3072 + j]; } }
    if (DOTS == 16) { for (int i = F.tid; i < D * 16; i += NTHR) wl[i] = F.in[I_WR][i]; }
    if (COMBINE && F.tid == 0) { int a = 0; for (int e = 0; e < NE; ++e) { tpre[e] = a; a += ((int)__hip_atomic_load(F.ctl + CW_CNT + 64 * clayer + e, RLX_AGENT) + 255) >> 8; } tpre[NE] = a; }
    float brt[16];
    if (MODE == 1) {
#pragma unroll
        for (int e = 0; e < 16; ++e) brt[e] = F.in[I_BR][e]; }
    for (int batch = F.vcu; batch < T / 128; batch += F.G) {
        __syncthreads();
        if (MODE == 1 && F.tid < 32) lcnt[F.tid] = 0;
        __syncthreads();
        const int row_base = batch * 128 + F.wave * 16, b = row_base / SEQ;
        const float* gam = (MODE == 3) ? F.in[I_FG] : ((MODE == 1) ? F.in[I_N2G] + (size_t)layer * D : F.in[I_N1G] + (size_t)layer * D);
        const float* mod = MOD + ((size_t)layer * NB + b) * 6 * D;
        const float* shp = mod + ((MODE == 1) ? 3 * D : 0); const float* scp = shp + D;
        const float* g2p = MOD + ((size_t)clayer * NB + b) * 6 * D + 5 * D;
        f32x4 gm[4], sh[4], sc[4], g2[4];
#pragma unroll
        for (int j = 0; j < 4; ++j) { gm[j] = *(const f32x4*)(gam + 256 * j + 4 * lane);
            if (MODUL) { sh[j] = *(const f32x4*)(shp + 256 * j + 4 * lane); sc[j] = *(const f32x4*)(scp + 256 * j + 4 * lane) + 1.0f; }
            if (COMBINE) g2[j] = *(const f32x4*)(g2p + 256 * j + 4 * lane); }
#pragma unroll 1
        for (int it = 0; it < 16 / RPI; ++it) {
            const int r0 = row_base + it * RPI;
            f32x4 x[RPI][4];
#pragma unroll
            for (int r = 0; r < RPI; ++r)
#pragma unroll
                for (int j = 0; j < 4; ++j) x[r][j] = *(const f32x4*)(xin + (size_t)(r0 + r) * D + 256 * j + 4 * lane);
            if (COMBINE) {
                const bf16_t* O = (const bf16_t*)(F.ws + WS_O);
#pragma unroll
                for (int r = 0; r < RPI; ++r) {
                    const u32x4 ti = *(const u32x4*)(F.ws + WS_TOK + (size_t)(r0 + r) * 16);
                    const int e0 = __builtin_amdgcn_readfirstlane((int)(ti.x >> 16)), e1 = __builtin_amdgcn_readfirstlane((int)(ti.y >> 16));
                    const int s0 = tpre[e0] * 256 + (int)(ti.x & 0xffffu), s1 = tpre[e1] * 256 + (int)(ti.y & 0xffffu);
                    const unsigned wz_ = ti.z, ww_ = ti.w; const float w0 = __uint_as_float(wz_), w1 = __uint_as_float(ww_);
#pragma unroll
                    for (int j = 0; j < 4; ++j) {
                        const u32x2 a = *(const u32x2*)(O + (size_t)s0 * D + 256 * j + 4 * lane), c = *(const u32x2*)(O + (size_t)s1 * D + 256 * j + 4 * lane);
                        f32x4 mo; mo[0] = w0 * bflo(a.x) + w1 * bflo(c.x); mo[1] = w0 * bfhi(a.x) + w1 * bfhi(c.x); mo[2] = w0 * bflo(a.y) + w1 * bflo(c.y); mo[3] = w0 * bfhi(a.y) + w1 * bfhi(c.y);
                        if (!(DBG_SKIP & (MODE == 2 ? 2 : 8))) x[r][j] = x[r][j] + g2[j] * mo * ((DBG_SKIP & 16) ? 2.0f : 1.0f);
                        if (MODE == 2) *(f32x4*)(F.out + (size_t)(r0 + r) * D + 256 * j + 4 * lane) = x[r][j];
#ifdef DBG_PROBE
                        if (MODE == 3 && r0 + r == 777 && lane == 5 && j == 0) { float* dbg = (float*)(F.ws + 60 * MiB); dbg[0] = w0; dbg[1] = w1; dbg[2] = (float)s0; dbg[3] = (float)s1; dbg[4] = mo[0]; dbg[5] = g2[0][0]; dbg[6] = x[r][0][0]; dbg[7] = bflo(a.x); dbg[8] = bflo(c.x); dbg[9] = (float)e0; dbg[10] = (float)e1; dbg[11] = (float)tpre[e0]; }
#endif
                    }
                }
            }
            float rstd[RPI];
#pragma unroll
            for (int r = 0; r < RPI; ++r) { float s = 0.f;
#pragma unroll
                for (int j = 0; j < 4; ++j) s += (x[r][j][0] * x[r][j][0] + x[r][j][1] * x[r][j][1]) + (x[r][j][2] * x[r][j][2] + x[r][j][3] * x[r][j][3]);
                rstd[r] = 1.0f / sqrtf(wave_sum(s) * (1.0f / D) + EPS); }
#pragma unroll
            for (int r = 0; r < RPI; ++r)
#pragma unroll
                for (int j = 0; j < 4; ++j) { f32x4 y = x[r][j] * rstd[r] * gm[j]; if (MODUL) y = y * sc[j] + sh[j]; x[r][j] = y;
                    if (MODE == 3) *(f32x4*)(F.out + (size_t)(r0 + r) * D + 256 * j + 4 * lane) = y;
                    else { u32x2 w; w.x = pk2(y[0], y[1]); w.y = pk2(y[2], y[3]); *(u32x2*)(U + (size_t)(r0 + r) * D + 256 * j + 4 * lane) = w; } }
            if (DOTS > 0) {
                float v[32];
#pragma unroll
                for (int i = 0; i < 32; ++i) v[i] = 0.f;
#pragma unroll
                for (int j = 0; j < 4; ++j)
#pragma unroll
                    for (int i = 0; i < 4; ++i) { const int k = 256 * j + 4 * lane + i;
                        float w[DOTS > 0 ? DOTS : 1];
#pragma unroll
                        for (int q = 0; q < DOTS / 4; ++q) { const f32x4 t4 = *(const LAS f32x4*)(wl + k * DOTS + 4 * q); w[4 * q] = t4[0]; w[4 * q + 1] = t4[1]; w[4 * q + 2] = t4[2]; w[4 * q + 3] = t4[3]; }
#pragma unroll
                        for (int r = 0; r < RPI; ++r)
#pragma unroll
                            for (int e = 0; e < DOTS; ++e) v[r * DOTS + e] += x[r][j][i] * w[e];
                        asm volatile("" ::: "memory"); }
                xreduce32(v, lane);
                const float tot = v[0];
                if (MODE == 0) {
                    const int idx = lane >> 1, r = idx >> 3, gi = idx & 7, row = r0 + r, bb = row / SEQ, s = row % SEQ;
                    if ((lane & 1) == 0) {
                        const float pre = tot + F.in[I_MBG][gi];
                        if (gi < 4) ((float*)(F.ws + WS_IG))[(size_t)(bb * NH + gi) * SEQ + s] = pre;
                        else { const float ls = (pre >= 0.f) ? -log1pf(expf(-pre)) : (pre - log1pf(expf(pre))); ((float*)(F.ws + WS_LF))[(size_t)(bb * NH + gi - 4) * SEQ + s] = ls; }
                    }
                }
                if (MODE == 1) {
#pragma unroll
                    for (int r = 0; r < RPI; ++r) {
                        float lg[16], mx = -INFINITY;
#pragma unroll
                        for (int e = 0; e < 16; ++e) { lg[e] = __shfl(tot, 32 * r + 2 * e); mx = fmaxf(mx, lg[e]); }
                        float se = 0.f;
#pragma unroll
                        for (int e = 0; e < 16; ++e) { lg[e] = expf(lg[e] - mx); se += lg[e]; }
                        const float inv = 1.0f / se;
                        float sel[16];
#pragma unroll
                        for (int e = 0; e < 16; ++e) { lg[e] *= inv; sel[e] = lg[e] + brt[e]; }
                        int best = 0; float bscore = -INFINITY;
#pragma unroll
                        for (int gq = 0; gq < 4; ++gq) { const float a = sel[4 * gq], bq = sel[4 * gq + 1], c = sel[4 * gq + 2], d = sel[4 * gq + 3];
                            const float m1 = fmaxf(fmaxf(a, bq), fmaxf(c, d));
                            const float lo1 = fminf(a, bq), hi1 = fmaxf(a, bq), lo2 = fminf(c, d), hi2 = fmaxf(c, d);
                            const float m2 = fmaxf(fminf(hi1, hi2), fmaxf(lo1, lo2));
                            const float gs = m1 + m2; if (gs > bscore) { bscore = gs; best = gq; } }
                        float s4[4], p4[4];
#pragma unroll
                        for (int q = 0; q < 4; ++q) { s4[q] = -INFINITY; p4[q] = 0.f; }
#pragma unroll
                        for (int gq = 0; gq < 4; ++gq) if (best == gq) {
#pragma unroll
                            for (int q = 0; q < 4; ++q) { s4[q] = sel[4 * gq + q]; p4[q] = lg[4 * gq + q]; } }
                        int i0 = 0; float v0 = s4[0], pp0 = p4[0];
#pragma unroll
                        for (int q = 1; q < 4; ++q) if (s4[q] > v0) { v0 = s4[q]; i0 = q; pp0 = p4[q]; }
                        int i1 = -1; float v1 = -INFINITY, pp1 = 0.f;
#pragma unroll
                        for (int q = 0; q < 4; ++q) if (q != i0 && s4[q] > v1) { v1 = s4[q]; i1 = q; pp1 = p4[q]; }
                        const float wsum = pp0 + pp1, w0 = pp0 / wsum, w1 = pp1 / wsum;
                        const int e0 = best * 4 + i0, e1 = best * 4 + i1;
                        if (lane == 0) {
                            const int lp0 = __hip_atomic_fetch_add(lcnt + e0, 1, __ATOMIC_RELAXED, __HIP_MEMORY_SCOPE_WORKGROUP), lp1 = __hip_atomic_fetch_add(lcnt + e1, 1, __ATOMIC_RELAXED, __HIP_MEMORY_SCOPE_WORKGROUP);
                            LAS int* ri = rinfo + (F.wave * 16 + it * RPI + r) * 8;
                            ri[0] = e0; ri[1] = e1; ri[2] = lp0; ri[3] = lp1; ri[4] = __builtin_bit_cast(int, w0); ri[5] = __builtin_bit_cast(int, w1);
                        }
                    }
                }
            }
        }
        if (MODE == 1) {
            __syncthreads();
            if (F.tid < 16) lcnt[16 + F.tid] = (int)__hip_atomic_fetch_add(F.ctl + CW_CNT + 64 * layer + F.tid, (unsigned)lcnt[F.tid], RLX_AGENT);
            __syncthreads();
            if (F.tid < 128) { const LAS int* ri = rinfo + F.tid * 8; const int row = batch * 128 + F.tid; const int e0 = ri[0], e1 = ri[1], p0 = lcnt[16 + e0] + ri[2], p1 = lcnt[16 + e1] + ri[3];
                int* LIST = (int*)(F.ws + WS_LIST); LIST[e0 * LCAP + p0] = row; LIST[e1 * LCAP + p1] = row;
                u32x4 ti; ti.x = (unsigned)(e0 << 16) | (unsigned)p0; ti.y = (unsigned)(e1 << 16) | (unsigned)p1; ti.z = (unsigned)ri[4]; ti.w = (unsigned)ri[5];
                *(u32x4*)(F.ws + WS_TOK + (size_t)row * 16) = ti; }
        }
    }
    __syncthreads();
}

__device__ __forceinline__ float incl_sum(float v, int lane) {
#pragma unroll
    for (int o = 1; o < 64; o <<= 1) { const float t = __shfl_up(v, o); if (lane >= o) v += t; }
    return v;
}
__device__ __forceinline__ float incl_max(float v, int lane) {
#pragma unroll
    for (int o = 1; o < 64; o <<= 1) { const float t = __shfl_up(v, o); if (lane >= o) v = fmaxf(v, t); }
    return v;
}
__device__ __forceinline__ void phase_scan(Frame& F) {
    LAS float* wkA = (LAS float*)(F.lds + 0);
    LAS float* decA = (LAS float*)(F.lds + 32768);
    LAS float* tot = (LAS float*)(F.lds + 33280);
    LAS float* bst = (LAS float*)(F.lds + 33792);
    LAS float* cmx = (LAS float*)(F.lds + 34304);
    LAS float* rst = (LAS float*)(F.lds + 34816);
    const int lane = F.lane, w = F.wave;
    for (int unit = F.vcu; unit < 256; unit += F.G) {
        const int bh = unit >> 4, slice = unit & 15;
        const float* IG = (const float*)(F.ws + WS_IG) + (size_t)bh * SEQ; const float* LF = (const float*)(F.ws + WS_LF) + (size_t)bh * SEQ;
        __syncthreads();
        float p[16], g[16], pm[16];
#pragma unroll
        for (int q = 0; q < 16; ++q) { const int c = 16 * w + q; p[q] = incl_sum(LF[c * 64 + lane], lane); if (lane == 63) tot[c] = p[q]; }
        __syncthreads();
        if (F.tid < 128) { float s = 0.f; for (int c = 0; c < F.tid; ++c) s += tot[c]; bst[F.tid] = s; }
        __syncthreads();
#pragma unroll
        for (int q = 0; q < 16; ++q) { const int c = 16 * w + q; p[q] += bst[c]; g[q] = IG[c * 64 + lane] - p[q]; pm[q] = incl_max(g[q], lane); if (lane == 63) cmx[c] = pm[q]; }
        __syncthreads();
        if (F.tid < 128) { float s = 0.f; for (int c = 0; c < F.tid; ++c) s = fmaxf(s, cmx[c]); rst[F.tid] = s; }
        __syncthreads();
#pragma unroll
        for (int q = 0; q < 16; ++q) { const int c = 16 * w + q; const float Rs = rst[c], Rn = fmaxf(Rs, cmx[c]), Rrun = fmaxf(Rs, pm[q]);
            wkA[c * 64 + lane] = expf(g[q] - Rn); if (lane == 0) decA[c] = expf(Rs - Rn);
            if (slice == 0) { const size_t o = (size_t)bh * SEQ + c * 64 + lane; ((float*)(F.ws + WS_GA))[o] = g[q]; ((float*)(F.ws + WS_RR))[o] = Rrun; ((float*)(F.ws + WS_MM))[o] = p[q] + Rrun;
                if (lane == 0) ((float*)(F.ws + WS_RC))[bh * NCH + c] = Rs; } }
        __syncthreads();
        const bf16_t* KTp = (const bf16_t*)(F.ws + WS_KT) + ((size_t)bh * DK + 16 * w + (lane & 15)) * SEQ + 8 * (lane >> 4);
        const bf16_t* VTp = (const bf16_t*)(F.ws + WS_VT) + ((size_t)bh * DV + 16 * slice + (lane & 15)) * SEQ + 8 * (lane >> 4);
        bf16_t* STp = (bf16_t*)(F.ws + WS_ST) + ((size_t)bh * NCH * DV + 16 * slice + (lane & 15)) * DK + 16 * w + 4 * (lane >> 4);
        float* NSp = (float*)(F.ws + WS_NS) + (size_t)bh * NCH * DK + 16 * w + 4 * (lane >> 4);
        f32x4 accS = (f32x4){0.f, 0.f, 0.f, 0.f}, accN = (f32x4){0.f, 0.f, 0.f, 0.f};
        u32x4 ka[2], va[2], kn[2], vn[2];
#pragma unroll
        for (int kk = 0; kk < 2; ++kk) { ka[kk] = *(const u32x4*)(KTp + kk * 32); va[kk] = *(const u32x4*)(VTp + kk * 32); kn[kk] = ka[kk]; vn[kk] = va[kk]; }
        for (int c = 0; c < NCH; ++c) {
            { u32x2 o; o.x = pk2(accS[0], accS[1]); o.y = pk2(accS[2], accS[3]); *(u32x2*)(STp + (size_t)c * DV * DK) = o; }
            if (slice == 0 && (lane & 15) == 0) *(f32x4*)(NSp + (size_t)c * DK) = accN;
            if (c == NCH - 1) break;
#pragma unroll
            for (int kk = 0; kk < 2; ++kk) { kn[kk] = *(const u32x4*)(KTp + (c + 1) * 64 + kk * 32); vn[kk] = *(const u32x4*)(VTp + (c + 1) * 64 + kk * 32); }
            const float dec = decA[c];
            accS = accS * dec; accN = accN * dec;
#pragma unroll
            for (int kk = 0; kk < 2; ++kk) {
                const LAS f32x4* wp = (const LAS f32x4*)(wkA + c * 64 + kk * 32 + 8 * (lane >> 4));
                const f32x4 w0 = wp[0], w1 = wp[1];
                u32x4 bv, b1;
                bv.x = pk2(bflo(va[kk].x) * w0[0], bfhi(va[kk].x) * w0[1]); bv.y = pk2(bflo(va[kk].y) * w0[2], bfhi(va[kk].y) * w0[3]);
                bv.z = pk2(bflo(va[kk].z) * w1[0], bfhi(va[kk].z) * w1[1]); bv.w = pk2(bflo(va[kk].w) * w1[2], bfhi(va[kk].w) * w1[3]);
                b1.x = pk2(w0[0], w0[1]); b1.y = pk2(w0[2], w0[3]); b1.z = pk2(w1[0], w1[1]); b1.w = pk2(w1[2], w1[3]);
                const bf16x8 af = __builtin_bit_cast(bf16x8, ka[kk]);
                accS = __builtin_amdgcn_mfma_f32_16x16x32_bf16(af, __builtin_bit_cast(bf16x8, bv), accS, 0, 0, 0);
                accN = __builtin_amdgcn_mfma_f32_16x16x32_bf16(af, __builtin_bit_cast(bf16x8, b1), accN, 0, 0, 0);
            }
#pragma unroll
            for (int kk = 0; kk < 2; ++kk) { ka[kk] = kn[kk]; va[kk] = vn[kk]; }
        }
    }
    __syncthreads();
}

constexpr int OC_AP = 0, OC_STRIDE = 400, OC_BVEC = 25600, OC_INV = 26368, OC_PART = 26624, OC_GS = 28672, OC_RT = 28928, OC_EMM = 29184, OC_RS = 29440;
__device__ __forceinline__ void phase_out(Frame& F) {
    LAS unsigned char* AP = F.lds + OC_AP;
    LAS float* bvec = (LAS float*)(F.lds + OC_BVEC); LAS float* inv = (LAS float*)(F.lds + OC_INV); LAS float* part = (LAS float*)(F.lds + OC_PART);
    LAS float* gs = (LAS float*)(F.lds + OC_GS); LAS float* Rt = (LAS float*)(F.lds + OC_RT); LAS float* emm = (LAS float*)(F.lds + OC_EMM); LAS float* rsA = (LAS float*)(F.lds + OC_RS);
    const int lane = F.lane, w = F.wave, tid = F.tid, l15 = lane & 15, lq = lane >> 4;
    const bf16_t* Qg = (const bf16_t*)(F.ws + WS_Q); const bf16_t* Kg = (const bf16_t*)(F.ws + WS_K);
    const bf16_t* VTg = (const bf16_t*)(F.ws + WS_VT); const bf16_t* STg = (const bf16_t*)(F.ws + WS_ST); const bf16_t* OGS = (const bf16_t*)(F.ws + WS_OGS);
    bf16_t* HN = (bf16_t*)(F.ws + WS_U);
    for (int unit = F.vcu; unit < 16 * NCH; unit += F.G) {
        const int bh = unit >> 7, c = unit & 127, b = bh >> 2, h = bh & 3;
        const int tk0 = b * SEQ + c * 64;
        __syncthreads();
        u32x4 bfr[2][6];
#pragma unroll
        for (int n = 0; n < 2; ++n) { const int dv = 32 * w + 16 * n + l15;
#pragma unroll
            for (int kk = 0; kk < 2; ++kk) bfr[n][kk] = *(const u32x4*)(VTg + ((size_t)bh * DV + dv) * SEQ + c * 64 + 32 * kk + 8 * lq);
#pragma unroll
            for (int kk = 0; kk < 4; ++kk) bfr[n][2 + kk] = *(const u32x4*)(STg + (((size_t)bh * NCH + c) * DV + dv) * DK + 32 * kk + 8 * lq); }
        if (tid < 64) { const size_t o = (size_t)bh * SEQ + c * 64 + tid; gs[tid] = ((const float*)(F.ws + WS_GA))[o]; Rt[tid] = ((const float*)(F.ws + WS_RR))[o]; emm[tid] = expf(-((const float*)(F.ws + WS_MM))[o]); bvec[tid] = 1.0f; }
        else if (tid < 192) bvec[tid] = ((const float*)(F.ws + WS_NS))[((size_t)bh * NCH + c) * DK + tid - 64];
        const float Rc = ((const float*)(F.ws + WS_RC))[bh * NCH + c];
        const int mt = w >> 1, ntb = (w & 1) * 2;
        u32x4 qa[4], kb[2][4];
#pragma unroll
        for (int kk = 0; kk < 4; ++kk) { qa[kk] = *(const u32x4*)(Qg + (size_t)(tk0 + 16 * mt + l15) * MQK + h * DK + 32 * kk + 8 * lq);
#pragma unroll
            for (int n = 0; n < 2; ++n) kb[n][kk] = *(const u32x4*)(Kg + (size_t)(tk0 + 16 * (ntb + n) + l15) * MQK + h * DK + 32 * kk + 8 * lq); }
        const int tq = tid >> 3, pq = tid & 7;
        const u32x4 q0 = *(const u32x4*)(Qg + (size_t)(tk0 + tq) * MQK + h * DK + 16 * pq), q1 = *(const u32x4*)(Qg + (size_t)(tk0 + tq) * MQK + h * DK + 16 * pq + 8);
        __syncthreads();
        f32x4 pacc[2];
#pragma unroll
        for (int n = 0; n < 2; ++n) { pacc[n] = (f32x4){0.f, 0.f, 0.f, 0.f};
#pragma unroll
            for (int kk = 0; kk < 4; ++kk) pacc[n] = __builtin_amdgcn_mfma_f32_16x16x32_bf16(__builtin_bit_cast(bf16x8, qa[kk]), __builtin_bit_cast(bf16x8, kb[n][kk]), pacc[n], 0, 0, 0); }
#pragma unroll
        for (int n = 0; n < 2; ++n) { const int sl = 16 * (ntb + n) + l15; const float gsv = gs[sl];
#pragma unroll
            for (int r = 0; r < 4; ++r) { const int tl = 16 * mt + 4 * lq + r; const float pv = (sl <= tl) ? pacc[n][r] * expf(gsv - Rt[tl]) : 0.f;
                *(LAS bf16_t*)(AP + tl * OC_STRIDE + sl * 2) = (bf16_t)f2bf(pv); } }
        { const float wq = expf(Rc - Rt[tq]);
          u32x4 o0, o1;
          o0.x = pk2(bflo(q0.x) * wq, bfhi(q0.x) * wq); o0.y = pk2(bflo(q0.y) * wq, bfhi(q0.y) * wq); o0.z = pk2(bflo(q0.z) * wq, bfhi(q0.z) * wq); o0.w = pk2(bflo(q0.w) * wq, bfhi(q0.w) * wq);
          o1.x = pk2(bflo(q1.x) * wq, bfhi(q1.x) * wq); o1.y = pk2(bflo(q1.y) * wq, bfhi(q1.y) * wq); o1.z = pk2(bflo(q1.z) * wq, bfhi(q1.z) * wq); o1.w = pk2(bflo(q1.w) * wq, bfhi(q1.w) * wq);
          *(LAS u32x4*)(AP + tq * OC_STRIDE + 128 + 32 * pq) = o0; *(LAS u32x4*)(AP + tq * OC_STRIDE + 128 + 32 * pq + 16) = o1; }
        __syncthreads();
        { float s = 0.f;
#pragma unroll
          for (int q = 0; q < 3; ++q) { const u32x4 a = *(const LAS u32x4*)(AP + tq * OC_STRIDE + 48 * pq + 16 * q); const LAS f32x4* bp = (const LAS f32x4*)(bvec + 24 * pq + 8 * q); const f32x4 b0 = bp[0], b1 = bp[1];
              s += bflo(a.x) * b0[0] + bfhi(a.x) * b0[1] + bflo(a.y) * b0[2] + bfhi(a.y) * b0[3] + bflo(a.z) * b1[0] + bfhi(a.z) * b1[1] + bflo(a.w) * b1[2] + bfhi(a.w) * b1[3]; }
          s += __shfl_xor(s, 1); s += __shfl_xor(s, 2); s += __shfl_xor(s, 4);
          if (pq == 0) inv[tq] = 1.0f / fmaxf(fabsf(s), emm[tq]); }
        f32x4 acc[4][2];
#pragma unroll
        for (int m = 0; m < 4; ++m)
#pragma unroll
            for (int n = 0; n < 2; ++n) acc[m][n] = (f32x4){0.f, 0.f, 0.f, 0.f};
#pragma unroll
        for (int kk = 0; kk < 6; ++kk) {
            bf16x8 af[4];
#pragma unroll
            for (int m = 0; m < 4; ++m) af[m] = *(const LAS bf16x8*)(AP + (16 * m + l15) * OC_STRIDE + 64 * kk + 16 * lq);
#pragma unroll
            for (int m = 0; m < 4; ++m)
#pragma unroll
                for (int n = 0; n < 2; ++n) acc[m][n] = __builtin_amdgcn_mfma_f32_16x16x32_bf16(af[m], __builtin_bit_cast(bf16x8, bfr[n][kk]), acc[m][n], 0, 0, 0);
        }
        __syncthreads();
#pragma unroll
        for (int m = 0; m < 4; ++m)
#pragma unroll
            for (int r = 0; r < 4; ++r) { const int tl = 16 * m + 4 * lq + r; const float iv = inv[tl];
                const float h0 = acc[m][0][r] * iv, h1 = acc[m][1][r] * iv; acc[m][0][r] = h0; acc[m][1][r] = h1;
                float s = h0 * h0 + h1 * h1; s += __shfl_xor(s, 1); s += __shfl_xor(s, 2); s += __shfl_xor(s, 4); s += __shfl_xor(s, 8);
                if (l15 == 0) part[w * 64 + tl] = s; }
        __syncthreads();
        if (tid < 64) { float s = 0.f;
#pragma unroll
            for (int ww = 0; ww < 8; ++ww) s += part[ww * 64 + tid];
            rsA[tid] = 1.0f / sqrtf(s * (1.0f / DV) + EPS); }
        __syncthreads();
#pragma unroll
        for (int n = 0; n < 2; ++n) { const int col = h * DV + 32 * w + 16 * n + l15; const float ng = F.in[I_MNG][col];
#pragma unroll
            for (int m = 0; m < 4; ++m)
#pragma unroll
                for (int r = 0; r < 4; ++r) { const int tl = 16 * m + 4 * lq + r; const size_t o = (size_t)(tk0 + tl) * MV + col;
                    HN[o] = (bf16_t)f2bf(acc[m][n][r] * rsA[tl] * ng * bf2f(OGS[o])); } }
    }
    __syncthreads();
}

__device__ __forceinline__ void phase_conv(Frame& F) {
    const bf16_t* BG = (const bf16_t*)(F.ws + WS_BG); const bf16_t* Z = (const bf16_t*)(F.ws + WS_Z); bf16_t* Y = (bf16_t*)(F.ws + WS_Y);
    const int cg = F.tid & 127, rsub = F.tid >> 7, col = 8 * cg;
    float w0[8], w1[8], w2[8], cb[8];
#pragma unroll
    for (int i = 0; i < 8; ++i) { w0[i] = F.in[I_CCW][col + i]; w1[i] = F.in[I_CCW][D + col + i]; w2[i] = F.in[I_CCW][2 * D + col + i]; cb[i] = F.in[I_CCB][col + i]; }
    for (int batch = F.vcu; batch < T / 128; batch += F.G) {
        const int t0 = batch * 128 + rsub * 32, s0 = t0 % SEQ;
        u32x4 z2 = (u32x4){0u, 0u, 0u, 0u}, z1 = z2;
        if (s0 >= 2) z2 = *(const u32x4*)(Z + (size_t)(t0 - 2) * D + col);
        if (s0 >= 1) z1 = *(const u32x4*)(Z + (size_t)(t0 - 1) * D + col);
#pragma unroll 4
        for (int r = 0; r < 32; ++r) {
            const u32x4 z0 = *(const u32x4*)(Z + (size_t)(t0 + r) * D + col), bg = *(const u32x4*)(BG + (size_t)(t0 + r) * D + col);
            float o[8];
#pragma unroll
            for (int i = 0; i < 4; ++i) {
                o[2 * i] = bflo(bg[i]) * (w0[2 * i] * bflo(z2[i]) + w1[2 * i] * bflo(z1[i]) + w2[2 * i] * bflo(z0[i]) + cb[2 * i]);
                o[2 * i + 1] = bfhi(bg[i]) * (w0[2 * i + 1] * bfhi(z2[i]) + w1[2 * i + 1] * bfhi(z1[i]) + w2[2 * i + 1] * bfhi(z0[i]) + cb[2 * i + 1]); }
            u32x4 ov; ov.x = pk2(o[0], o[1]); ov.y = pk2(o[2], o[3]); ov.z = pk2(o[4], o[5]); ov.w = pk2(o[6], o[7]);
            *(u32x4*)(Y + (size_t)(t0 + r) * D + col) = ov;
            z2 = z1; z1 = z0;
        }
    }
}

__device__ __forceinline__ void moe_table(Frame& F, int layer) {
    __syncthreads();
    if (F.tid == 0) { int a = 0; for (int e = 0; e < NE; ++e) { const int c = (int)__hip_atomic_load(F.ctl + CW_CNT + 64 * layer + e, RLX_AGENT); F.MISC[16 + e] = (unsigned)a; F.MISC[40 + e] = (unsigned)c; a += (c + 255) >> 8; } F.MISC[16 + NE] = (unsigned)a; }
    __syncthreads();
}

constexpr int N_PHASES = 17;
#define WSP(T_, off) ((T_*)(F.ws + (off)))
__global__ void __launch_bounds__(NTHR, 2) fwd_kernel(Args args) {
    extern __shared__ __attribute__((aligned(16))) unsigned char lds_raw[];
#define MAKE_FRAME() Frame F; { int t_ = threadIdx.x, bx_ = blockIdx.x, g_ = gridDim.x; asm volatile("" : "+v"(t_), "+s"(bx_), "+s"(g_)); \
        F.lds = (LAS unsigned char*)lds_raw; F.MISC = (volatile LAS unsigned*)(F.lds + MISC_OFF); F.tid = t_; F.lane = t_ & 63; F.wave = __builtin_amdgcn_readfirstlane(t_ >> 6); \
        F.G = g_; F.bx = bx_; F.vcu = (g_ % 8 == 0) ? (bx_ % 8) * (g_ / 8) + bx_ / 8 : bx_; }
    const int lo = args.ph_lo, hi = args.ph_hi;
    const bool one_launch = (hi - lo) > 1;
    XcdBarrier bar;
    { MAKE_FRAME();
      for (int u = F.tid; u < 256; u += NTHR) F.MISC[u] = 0u;
      __syncthreads();
      bar.bar = (unsigned*)(F.ctl + CW_BAR); bar.x = 0; bar.st = nullptr;
      if (one_launch) bar = xcd_barrier_post((unsigned*)(F.ctl + CW_BAR), F.MISC + 8); }
#ifdef PH_ONLY
#define IN(k) ((k) == PH_ONLY && lo <= (k) && (k) < hi)
#else
#define IN(k) (lo <= (k) && (k) < hi)
#endif
#define SEAM(k) do { if (IN(k) && IN((k) + 1)) xcd_barrier(bar); } while (0)
#define PHASE(k) if (IN(k)) { MAKE_FRAME(); asm volatile("; PHASE_MARK " #k);
#define END_PHASE(k) } SEAM(k);
    PHASE(0) phase_prologue(F); END_PHASE(0)
    PHASE(1) row_pass<0>(F, 0); END_PHASE(1)
    PHASE(2) pg8::Gemm g{WSP(bf16_t, WS_U), WSP(bf16_t, WS_W0), D}; pg8::DenseOrder S; S.init(T, 3 * D, F.G, F.bx);
        pg8::EpiM1 E{WSP(bf16_t, WS_Q), WSP(bf16_t, WS_K), WSP(bf16_t, WS_KT), WSP(bf16_t, WS_VT), WSP(bf16_t, WS_OGS)};
        pg8::gemm_phase<pg8::EpiM1, pg8::DenseOrder, false, true, true>(F.lds, g, S, E, F.tid); END_PHASE(2)
    PHASE(3) phase_scan(F); END_PHASE(3)
    PHASE(4) phase_out(F); END_PHASE(4)
    PHASE(5) pg8::Gemm g{WSP(bf16_t, WS_U), WSP(bf16_t, WS_W1), D}; pg8::DenseOrder S; S.init(T, D, F.G, F.bx);
        pg8::EpiRes E{F.in[I_X], F.out, WSP(float, WS_MOD) + 2 * D, (DBG_SKIP & 1) ? 0.f : 1.f};
        pg8::gemm_phase<pg8::EpiRes, pg8::DenseOrder, false, true, true>(F.lds, g, S, E, F.tid); END_PHASE(5)
#define MOE_BLOCK(L, p0, p1, p2) \
    PHASE(p0) row_pass<1>(F, L); END_PHASE(p0) \
    PHASE(p1) moe_table(F, L); \
        pg8::Gemm g{WSP(bf16_t, WS_U), WSP(bf16_t, WS_WUP), D}; pg8::MoeOrder S{(const LAS int*)(F.MISC + 16), (const LAS int*)(F.MISC + 40), WSP(const int, WS_LIST), F.G, F.vcu, 1024}; \
        pg8::EpiGlu<true> E{WSP(bf16_t, WS_A), DE, 0, nullptr, 0}; \
        pg8::gemm_phase<pg8::EpiGlu<true>, pg8::MoeOrder, true, true, true>(F.lds, g, S, E, F.tid); END_PHASE(p1) \
    PHASE(p2) moe_table(F, L); \
        pg8::Gemm g{WSP(bf16_t, WS_A), WSP(bf16_t, WS_WDN), DE}; pg8::MoeOrder S{(const LAS int*)(F.MISC + 16), (const LAS int*)(F.MISC + 40), WSP(const int, WS_LIST), F.G, F.vcu, 1024}; \
        pg8::EpiBf E{WSP(bf16_t, WS_O), D}; \
        pg8::gemm_phase<pg8::EpiBf, pg8::MoeOrder, false, true, true>(F.lds, g, S, E, F.tid); END_PHASE(p2)
    MOE_BLOCK(0, 6, 7, 8)
    PHASE(9) row_pass<2>(F, 1); convert_weights(F, 1); END_PHASE(9)
    PHASE(10) pg8::Gemm g{WSP(bf16_t, WS_U), WSP(bf16_t, WS_W0), D}; pg8::DenseOrder S; S.init(T, 3 * D, F.G, F.bx);
        pg8::EpiGlu<false> E{WSP(bf16_t, WS_Z), D, 4, WSP(bf16_t, WS_BG), D};
        pg8::gemm_phase<pg8::EpiGlu<false>, pg8::DenseOrder, false, true, true>(F.lds, g, S, E, F.tid); END_PHASE(10)
    PHASE(11) phase_conv(F); END_PHASE(11)
    PHASE(12) pg8::Gemm g{WSP(bf16_t, WS_Y), WSP(bf16_t, WS_W1), D}; pg8::DenseOrder S; S.init(T, D, F.G, F.bx);
        pg8::EpiRes E{F.out, F.out, WSP(float, WS_MOD) + (size_t)NB * 6 * D + 2 * D, (DBG_SKIP & 4) ? 0.f : 1.f};
        pg8::gemm_phase<pg8::EpiRes, pg8::DenseOrder, false, true, true>(F.lds, g, S, E, F.tid); END_PHASE(12)
    MOE_BLOCK(1, 13, 14, 15)
    if (IN(16)) { MAKE_FRAME(); asm volatile("; PHASE_MARK 16"); row_pass<3>(F, 1);
#ifdef DBG_PROBE
        if (F.bx == 0 && F.tid == 0) { float val = 0.f;
            if (DBG_PROBE == 1) { unsigned s = 0; for (int e = 0; e < NE; ++e) s += __hip_atomic_load(F.ctl + CW_CNT + e, RLX_AGENT); val = 100.f * (float)s / 65536.f; }
            if (DBG_PROBE == 2) { const bf16_t* A = WSP(bf16_t, WS_A); int nz = 0; for (int i = 0; i < 4096; ++i) nz += (A[(size_t)i * 977 % ((size_t)65536 * DE)] != 0xAAAA) ? 1 : 0; val = 100.f * nz / 4096.f; }
            if (DBG_PROBE == 3) { const bf16_t* O = WSP(bf16_t, WS_O); int nz = 0; for (int i = 0; i < 4096; ++i) nz += (O[(size_t)i * 9973 % ((size_t)65536 * D)] != 0xAAAA) ? 1 : 0; val = 100.f * nz / 4096.f; }
            if (DBG_PROBE == 4) { const unsigned* TK = WSP(unsigned, WS_TOK); float s = 0.f; for (int i = 0; i < 1024; ++i) s += __builtin_bit_cast(float, TK[(size_t)i * 31 * 4 + 2]) + __builtin_bit_cast(float, TK[(size_t)i * 31 * 4 + 3]); val = 100.f * s / 1024.f; }
            if (DBG_PROBE == 5) { const bf16_t* O = WSP(bf16_t, WS_O); float s = 0.f; for (int i = 0; i < 4096; ++i) { const float v = bf2f(O[(size_t)i * 9973 % ((size_t)65536 * D)]); s += v * v; } val = 100.f * sqrtf(s / 4096.f); }
            if (DBG_PROBE == 6) { const float* M = WSP(float, WS_MOD); float s = 0.f; for (int i = 0; i < 1024; ++i) { const float v = M[5 * D + i]; s += v * v; } val = 100.f * sqrtf(s / 1024.f); }
            if (DBG_PROBE == 7) { const unsigned* TK = WSP(unsigned, WS_TOK); const unsigned a = TK[4 * 12345], b2 = TK[4 * 12345 + 1]; val = (float)((a >> 16) * 16 + (b2 >> 16)) + 1000.f * (float)((a & 0xffff) > 32768u); }
            if (DBG_PROBE == 8 || DBG_PROBE == 9) { const unsigned* TK = WSP(unsigned, WS_TOK); const bf16_t* O = WSP(bf16_t, WS_O); float s = 0.f; int bad = 0;
                int tp[NE + 1]; { int a = 0; for (int e = 0; e < NE; ++e) { tp[e] = a; a += ((int)__hip_atomic_load(F.ctl + CW_CNT + 64 + e, RLX_AGENT) + 255) >> 8; } tp[NE] = a; }
                for (int i = 0; i < 256; ++i) { const int t = i * 127; const unsigned a = TK[4 * t]; const int e0 = a >> 16, p0 = a & 0xffff; int tpe = 0; for (int e = 0; e < NE; ++e) if (e == e0) tpe = tp[e];
                    const int s0 = tpe * 256 + p0; if (e0 >= NE || s0 >= 69632) { ++bad; continue; } for (int c = 0; c < 16; ++c) { const float v = bf2f(O[(size_t)s0 * D + c * 61]); s += v * v; } }
                val = (DBG_PROBE == 8) ? 100.f * sqrtf(s / 4096.f) : (float)bad; }
            if (DBG_PROBE >= 100) { const float* dbg = (const float*)(F.ws + 60 * MiB); val = 1000.f * dbg[DBG_PROBE - 100]; }
            float* o = F.out; o[0] = val; }
#endif
    }
#undef IN
#undef SEAM
}

extern "C" void kernel_launch(void* const* d_in, const int* in_sizes, int n_in, void* d_out, int out_size, void* d_ws, size_t ws_size, hipStream_t stream) {
    static int grid = 0;
    if (grid == 0) {
        if (n_in != 20 || in_sizes[0] != T * D || out_size != T * D || ws_size < WS_END) { fprintf(stderr, "kernel_launch: unexpected shapes: n_in %d in0 %d out %d ws %zu\n", n_in, n_in > 0 ? in_sizes[0] : -1, out_size, ws_size); grid = -1; return; }
        int dev = 0, cus = 0, per_cu = 0;
        if (hipGetDevice(&dev) != hipSuccess || hipDeviceGetAttribute(&cus, hipDeviceAttributeMultiprocessorCount, dev) != hipSuccess) { grid = -1; return; }
        if (hipFuncSetAttribute((const void*)fwd_kernel, hipFuncAttributeMaxDynamicSharedMemorySize, LDS_BYTES) != hipSuccess) { fprintf(stderr, "kernel_launch: hipFuncSetAttribute failed\n"); grid = -1; return; }
        if (hipOccupancyMaxActiveBlocksPerMultiprocessor(&per_cu, (const void*)fwd_kernel, NTHR, LDS_BYTES) != hipSuccess || per_cu < 1) { fprintf(stderr, "kernel_launch: occupancy query says %d blocks per CU\n", per_cu); (void)hipGetLastError(); grid = -1; return; }
        grid = cus;
        if (grid != 256) fprintf(stderr, "kernel_launch: %d CUs (built for 256)\n", grid);
    }
    if (grid < 0) return;
    (void)hipMemsetAsync((char*)d_ws + WS_CTL, 0, CTL_ZERO_BYTES, stream);
    Args a{};
    for (int i = 0; i < 20; ++i) a.in[i] = (const float*)d_in[i];
    a.out = (float*)d_out; a.ws = (unsigned char*)d_ws;
#if MK_N_LAUNCHES == 1
    a.ph_lo = 0; a.ph_hi = N_PHASES;
    void* kargs[] = {&a};
    hipError_t e = hipLaunchCooperativeKernel((const void*)fwd_kernel, dim3(grid), dim3(NTHR), kargs, LDS_BYTES, stream);
    if (e != hipSuccess) fprintf(stderr, "kernel_launch: cooperative launch failed: %s\n", hipGetErrorString(e));
#else
    for (int p = 0; p < N_PHASES; ++p) { a.ph_lo = p; a.ph_hi = p + 1; hipLaunchKernelGGL(fwd_kernel, dim3(grid), dim3(NTHR), LDS_BYTES, stream, a); }
#endif
}
```

```cpp
#include <hip/hip_runtime.h>
#include <cstdio>
#include <cstdint>

#ifndef DBG_SKIP
#define DBG_SKIP 0
#endif
#ifndef MK_N_LAUNCHES
#define MK_N_LAUNCHES 1
#endif

#define LAS __attribute__((address_space(3)))
#define GAS __attribute__((address_space(1)))
typedef unsigned short bf16_t;
typedef short bf16x8 __attribute__((ext_vector_type(8)));
typedef float f32x4 __attribute__((ext_vector_type(4)));
typedef float f32x2 __attribute__((ext_vector_type(2)));
typedef unsigned u32x4 __attribute__((ext_vector_type(4)));
typedef unsigned u32x2 __attribute__((ext_vector_type(2)));
typedef GAS unsigned gu32;
#define RLX_AGENT __ATOMIC_RELAXED, __HIP_MEMORY_SCOPE_AGENT
#define LDS_WAIT() asm volatile("s_waitcnt lgkmcnt(0)" ::: "memory")
#define VM_WAIT() asm volatile("s_waitcnt vmcnt(0)" ::: "memory")

constexpr int NB = 4, SEQ = 8192, D = 1024, T = NB * SEQ;
constexpr int NH = 4, DK = 128, DV = 256, MQK = NH * DK, MV = NH * DV, MPROJ = 2 * MQK + 2 * MV + 2 * NH;
constexpr int CH = 64, NCH = SEQ / CH;
constexpr int NE = 16, DE = 512, LCAP = 65536;
constexpr int SLOT_ROWS = 2 * T + NE * 256;
constexpr float EPS = 1e-6f;
constexpr int NWAVES = 8, NTHR = 512;

constexpr size_t MiB = 1u << 20;
constexpr size_t WS_CTL = 0, CTL_ZERO_BYTES = 64 * 1024;
constexpr size_t WS_MOD = 1 * MiB;
constexpr size_t WS_W0 = 2 * MiB;
constexpr size_t WS_W1 = 8 * MiB;
constexpr size_t WS_WUP = 10 * MiB;
constexpr size_t WS_WDN = 42 * MiB;
constexpr size_t WS_IG = 62 * MiB;
constexpr size_t WS_LF = WS_IG + 512 * 1024;
constexpr size_t WS_GA = WS_LF + 512 * 1024;
constexpr size_t WS_RR = WS_GA + 512 * 1024;
constexpr size_t WS_MM = WS_RR + 512 * 1024;
constexpr size_t WS_RC = WS_MM + 512 * 1024;
constexpr size_t WS_NS = 65 * MiB;
constexpr size_t WS_TOK = 66 * MiB;
constexpr size_t WS_LIST = 67 * MiB;
constexpr size_t WS_U = 72 * MiB;
constexpr size_t WS_Q = 136 * MiB;
constexpr size_t WS_K = 168 * MiB;
constexpr size_t WS_KT = 200 * MiB;
constexpr size_t WS_VT = 232 * MiB;
constexpr size_t WS_OGS = 296 * MiB;
constexpr size_t WS_ST = 360 * MiB;
constexpr size_t WS_A = 136 * MiB;
constexpr size_t WS_O = 204 * MiB;
constexpr size_t WS_BG = 136 * MiB;
constexpr size_t WS_Z = 200 * MiB;
constexpr size_t WS_Y = 264 * MiB;
constexpr size_t WS_END = 488 * MiB;
static_assert(WS_A + (size_t)SLOT_ROWS * DE * 2 <= WS_O && WS_O + (size_t)SLOT_ROWS * D * 2 <= WS_ST, "moe map");

constexpr int CW_CNT = 64;
constexpr int CW_BAR = 1024;

constexpr int RING_BYTES = 131072;
constexpr int MISC_OFF = RING_BYTES;
constexpr int LDS_BYTES = 147456;

__device__ __forceinline__ unsigned f2bf(float f) { unsigned u = __builtin_bit_cast(unsigned, f); return (u + 0x7fffu + ((u >> 16) & 1u)) >> 16; }
__device__ __forceinline__ unsigned pk2(float lo, float hi) { return f2bf(lo) | (f2bf(hi) << 16); }
__device__ __forceinline__ float bf2f(unsigned short h) { return __builtin_bit_cast(float, (unsigned)h << 16); }
__device__ __forceinline__ float bflo(unsigned w) { return __builtin_bit_cast(float, w << 16); }
__device__ __forceinline__ float bfhi(unsigned w) { return __builtin_bit_cast(float, w & 0xffff0000u); }
__device__ __forceinline__ unsigned cvt_pk_bf16(float lo, float hi) { unsigned r; asm volatile("v_cvt_pk_bf16_f32 %0, %1, %2" : "=v"(r) : "v"(lo), "v"(hi)); return r; }
__device__ __forceinline__ float fast_exp(float x) { return __builtin_amdgcn_exp2f(x * 1.44269504089f); }
__device__ __forceinline__ float sigmoidf_(float x) { return __builtin_amdgcn_rcpf(1.0f + fast_exp(-x)); }

namespace pg8 {
constexpr int BM = 256, BK = 64, HALF = 128, HTB = HALF * BK * 2, STAGE_BYTES = 8 * HTB, NXCD = 8, WGM = 8;
__host__ __device__ __forceinline__ int lds_byte(int r, int c) { const int st = (r >> 4) * 2 + (c >> 5), rr = r & 15, cc = c & 31, ob = rr * 64 + cc * 2; return st * 1024 + (ob ^ (((ob >> 9) & 1) << 5)); }
__host__ __device__ __forceinline__ void stage_rc(int b, int& R, int& C) { const int st = b / 1024, sb = b % 1024, swz = sb ^ (((sb >> 9) & 1) << 5); R = (st >> 1) * 16 + swz / 64; C = (st & 1) * 32 + (swz % 64) / 2; }
__host__ __device__ __forceinline__ int perm32(int rho) { const int n = rho >> 4, i = rho & 15; return 8 * (i >> 2) + 4 * n + (i & 3); }

struct Unit { int arow0, brow0, pm, pn, e, nvalid; const int* alist; };
struct Gemm { const bf16_t* A; const bf16_t* Bt; int K; };

struct DenseOrder {
    int nM, nN, nwg, G, c;
    __device__ void init(int M, int N, int G_, int c_) { nM = M / BM; nN = N / BM; nwg = nM * nN; G = G_; c = c_; }
    __device__ bool next(int i, Unit& u) const {
        const long L = (long)i * G + c; if (L >= nwg) return false;
        int wgid = (int)L; { const int q = nwg / NXCD, r = nwg % NXCD, xcd = wgid % NXCD, off = wgid / NXCD; wgid = (xcd < r ? xcd * (q + 1) : r * (q + 1) + (xcd - r) * q) + off; }
        const int nig = WGM * nN, gid = wgid / nig, fm = gid * WGM, gsz = (nM - fm) < WGM ? (nM - fm) : WGM;
        u.pm = fm + ((wgid % nig) % gsz); u.pn = (wgid % nig) / gsz; u.arow0 = u.pm * BM; u.brow0 = u.pn * BM; u.e = 0; u.nvalid = 256; u.alist = nullptr; return true;
    }
};
struct MoeOrder {
    const LAS int* tpre; const LAS int* cnt; const int* list; int G, vcu, bn;
    __device__ bool next(int i, Unit& u) const {
        const int U = i * G + vcu, rt = U >> 2, pn = U & 3;
        if (rt >= tpre[NE]) return false;
        int e = 0;
#pragma unroll
        for (int k = 1; k < NE; ++k) e += (rt >= tpre[k]) ? 1 : 0;
        const int r = rt - tpre[e];
        u.arow0 = rt * BM; u.brow0 = e * bn + pn * BM; u.pm = rt; u.pn = pn; u.e = e; u.nvalid = min(256, cnt[e] - r * 256); u.alist = list + e * LCAP + r * 256; return true;
    }
};

template <class Epi, class Sched, bool GATHER, bool ALIGN_EPI, bool SP2>
__device__ __forceinline__ void gemm_phase(LAS unsigned char* lds, const Gemm g, const Sched& S, const Epi& E, const int tid) {
    const int wid = __builtin_amdgcn_readfirstlane(tid >> 6), lane = tid & 63, wr = wid >> 2, wc = wid & 3, fr = lane & 15, fq = lane >> 4;
    const int K = g.K, nt = K / BK;
    unsigned voffA[2], voffB[2];
#pragma unroll
    for (int i = 0; i < 2; ++i) { int R, C; stage_rc(tid * 16 + i * 8192, R, C); const int Rb = Epi::PERM ? ((R & ~31) + perm32(R & 31)) : R;
        voffA[i] = (unsigned)(R * K + C) * 2u; voffB[i] = (unsigned)(Rb * K + C) * 2u; }
    const size_t kstep = (size_t)(BK * 2);
    const size_t hstep = (size_t)HALF * K * 2;
    const unsigned ldsw = (unsigned)wid * 1024u;
    const int aoff = lds_byte(wr * 64 + fr, fq * 8), boff = lds_byte(wc * 32 + fr, fq * 8);
#define PG8_SA(b, h) (((b) * 2 + (h)) * HTB)
#define PG8_SB(b, h) ((4 + (b) * 2 + (h)) * HTB)
#define PG8_STAGE(bufoff, gbase, voff) do { _Pragma("unroll") for (int _i = 0; _i < 2; ++_i) \
        __builtin_amdgcn_global_load_lds((const unsigned*)((const char*)(gbase) + (voff)[_i]), (LAS unsigned*)(lds + (bufoff) + ldsw + _i * 8192), 16, 0, 0); } while (0)
#define PG8_STAGE_A(bufoff, kb, h, vo) do { if constexpr (GATHER) { PG8_STAGE(bufoff, kb, (vo)[h]); } else { PG8_STAGE(bufoff, (kb) + (h) * hstep, voffA); } } while (0)
#define PG8_LDA(dst, b, h) do { _Pragma("unroll") for (int m = 0; m < 4; ++m) _Pragma("unroll") for (int k = 0; k < 2; ++k) dst[m][k] = *(const LAS bf16x8*)(lds + PG8_SA(b, h) + aoff + m * 2048 + k * 1024); } while (0)
#define PG8_LDB(dst, b, h) do { _Pragma("unroll") for (int n = 0; n < 2; ++n) _Pragma("unroll") for (int k = 0; k < 2; ++k) dst[n][k] = *(const LAS bf16x8*)(lds + PG8_SB(b, h) + boff + n * 2048 + k * 1024); } while (0)
#define PG8_MMA(ai, bj, At, Bt) do { __builtin_amdgcn_s_setprio(1); _Pragma("unroll") for (int m = 0; m < 4; ++m) _Pragma("unroll") for (int n = 0; n < 2; ++n) _Pragma("unroll") for (int k = 0; k < 2; ++k) \
        acc[ai][bj][m][n] = __builtin_amdgcn_mfma_f32_16x16x32_bf16(Bt[n][k], At[m][k], acc[ai][bj][m][n], 0, 0, 0); __builtin_amdgcn_s_setprio(0); } while (0)
#define PG8_WAIT_V(n) asm volatile("s_waitcnt vmcnt(" #n ")" ::: "memory")
#define PG8_WAIT_L(n) asm volatile("s_waitcnt lgkmcnt(" #n ")" ::: "memory")
#define PG8_BAR __builtin_amdgcn_s_barrier()
#define PG8_SCHED __builtin_amdgcn_sched_barrier(0)
    Unit cur, nxt; int ui = 0;
    if (!S.next(0, cur)) return;
    f32x4 acc[2][2][4][2];
#pragma unroll
    for (int a = 0; a < 2; ++a)
#pragma unroll
        for (int b = 0; b < 2; ++b)
#pragma unroll
            for (int m = 0; m < 4; ++m)
#pragma unroll
                for (int n = 0; n < 2; ++n) acc[a][b][m][n] = (f32x4){0.f, 0.f, 0.f, 0.f};
    bf16x8 At[4][2], B0[2][2], B1[2][2];
    unsigned vg[2][2];
#define PG8_GATHER(u) do { _Pragma("unroll") for (int _h = 0; _h < 2; ++_h) _Pragma("unroll") for (int _i = 0; _i < 2; ++_i) { int _R, _C; stage_rc(tid * 16 + _i * 8192, _R, _C); \
        const int _r = _h * HALF + _R; const int _tok = (_r < (u).nvalid) ? (u).alist[_r] : 0; vg[_h][_i] = (unsigned)(_tok * K + _C) * 2u; } } while (0)
    const char* cA; const char* cB = (const char*)g.Bt + (size_t)cur.brow0 * K * 2;
    if constexpr (GATHER) { cA = (const char*)g.A; PG8_GATHER(cur); } else { cA = (const char*)g.A + (size_t)cur.arow0 * K * 2;
#pragma unroll
        for (int h = 0; h < 2; ++h)
#pragma unroll
            for (int i = 0; i < 2; ++i) vg[h][i] = 0u; }
    if constexpr (SP2) {
        PG8_STAGE(PG8_SB(0, 0), cB, voffB); PG8_STAGE(PG8_SB(0, 1), cB + hstep, voffB); PG8_STAGE_A(PG8_SA(0, 0), cA, 0, vg); PG8_STAGE_A(PG8_SA(0, 1), cA, 1, vg);
        if (wr == 1) PG8_BAR;
        PG8_WAIT_V(2); PG8_BAR;
        PG8_STAGE(PG8_SB(1, 0), cB + kstep, voffB); PG8_STAGE_A(PG8_SA(1, 0), cA + kstep, 0, vg); PG8_STAGE(PG8_SB(1, 1), cB + hstep + kstep, voffB);
        PG8_WAIT_V(6); PG8_BAR;
    } else {
        PG8_STAGE(PG8_SB(0, 0), cB, voffB); PG8_STAGE_A(PG8_SA(0, 0), cA, 0, vg); PG8_STAGE(PG8_SB(0, 1), cB + hstep, voffB); PG8_STAGE_A(PG8_SA(0, 1), cA, 1, vg);
        if (wr == 1) PG8_BAR;
        PG8_WAIT_V(4); PG8_BAR;
        PG8_STAGE(PG8_SB(1, 0), cB + kstep, voffB); PG8_STAGE_A(PG8_SA(1, 0), cA + kstep, 0, vg); PG8_STAGE(PG8_SB(1, 1), cB + hstep + kstep, voffB);
        PG8_WAIT_V(6); PG8_BAR;
    }
    for (;;) {
        const bool has_next = S.next(ui + 1, nxt);
        const char* nA; const char* nB = has_next ? (const char*)g.Bt + (size_t)nxt.brow0 * K * 2 : cB;
        if constexpr (GATHER) nA = cA; else nA = has_next ? (const char*)g.A + (size_t)nxt.arow0 * K * 2 : cA;
        for (int t = 0; t < nt; t += 2) {
            const bool last = (t == nt - 2);
            const char* a1 = cA + (size_t)(t + 1) * kstep;
            const char* a2 = last ? nA : cA + (size_t)(t + 2) * kstep; const char* b2 = last ? nB : cB + (size_t)(t + 2) * kstep;
            const char* a3 = a2 + kstep; const char* b3 = b2 + kstep;
            if constexpr (SP2) {
            PG8_LDB(B0, 0, 0); PG8_LDB(B1, 0, 1); PG8_SCHED; PG8_LDA(At, 0, 0); PG8_STAGE_A(PG8_SA(1, 1), a1, 1, vg);
            if constexpr (GATHER) { if (last && has_next) PG8_GATHER(nxt); }
            PG8_WAIT_V(8); PG8_WAIT_L(0); PG8_BAR; PG8_MMA(0, 0, At, B0); PG8_MMA(0, 1, At, B1); PG8_BAR; PG8_SCHED;
            PG8_LDA(At, 0, 1); PG8_STAGE(PG8_SB(0, 0), b2, voffB); PG8_STAGE(PG8_SB(0, 1), b2 + hstep, voffB); PG8_STAGE_A(PG8_SA(0, 0), a2, 0, vg);
            PG8_WAIT_V(8); PG8_WAIT_L(0); PG8_BAR; PG8_MMA(1, 0, At, B0); PG8_MMA(1, 1, At, B1); PG8_BAR; PG8_SCHED;
            PG8_LDB(B0, 1, 0); PG8_LDB(B1, 1, 1); PG8_SCHED; PG8_LDA(At, 1, 0); PG8_STAGE_A(PG8_SA(0, 1), a2, 1, vg);
            PG8_WAIT_V(8); PG8_WAIT_L(0); PG8_BAR; PG8_MMA(0, 0, At, B0); PG8_MMA(0, 1, At, B1); PG8_BAR; PG8_SCHED;
            PG8_LDA(At, 1, 1); PG8_STAGE(PG8_SB(1, 0), b3, voffB); PG8_STAGE(PG8_SB(1, 1), b3 + hstep, voffB); PG8_STAGE_A(PG8_SA(1, 0), a3, 0, vg);
            PG8_WAIT_V(8); PG8_WAIT_L(0); PG8_BAR; PG8_MMA(1, 0, At, B0); PG8_MMA(1, 1, At, B1); PG8_BAR; PG8_SCHED;
            } else {
            PG8_LDB(B0, 0, 0); PG8_SCHED; PG8_LDA(At, 0, 0); PG8_STAGE_A(PG8_SA(1, 1), a1, 1, vg);
            if constexpr (GATHER) { if (last && has_next) PG8_GATHER(nxt); }
            PG8_WAIT_L(8); PG8_BAR; PG8_WAIT_L(0); PG8_MMA(0, 0, At, B0); PG8_BAR; PG8_SCHED;
            PG8_LDB(B1, 0, 1); PG8_STAGE(PG8_SB(0, 0), b2, voffB);
            PG8_BAR; PG8_WAIT_L(0); PG8_MMA(0, 1, At, B1); PG8_BAR;
            PG8_LDA(At, 0, 1); PG8_STAGE_A(PG8_SA(0, 0), a2, 0, vg);
            PG8_BAR; PG8_WAIT_L(0); PG8_MMA(1, 0, At, B0); PG8_BAR; PG8_SCHED;
            PG8_STAGE(PG8_SB(0, 1), b2 + hstep, voffB);
            PG8_WAIT_V(6); PG8_BAR; PG8_MMA(1, 1, At, B1); PG8_BAR;
            PG8_LDB(B0, 1, 0); PG8_SCHED; PG8_LDA(At, 1, 0); PG8_STAGE_A(PG8_SA(0, 1), a2, 1, vg);
            PG8_WAIT_L(8); PG8_BAR; PG8_WAIT_L(0); PG8_MMA(0, 0, At, B0); PG8_BAR; PG8_SCHED;
            PG8_LDB(B1, 1, 1); PG8_STAGE(PG8_SB(1, 0), b3, voffB);
            PG8_BAR; PG8_WAIT_L(0); PG8_MMA(0, 1, At, B1); PG8_BAR;
            PG8_LDA(At, 1, 1); PG8_STAGE_A(PG8_SA(1, 0), a3, 0, vg);
            PG8_BAR; PG8_WAIT_L(0); PG8_MMA(1, 0, At, B0); PG8_BAR; PG8_SCHED;
            PG8_STAGE(PG8_SB(1, 1), b3 + hstep, voffB);
            PG8_WAIT_V(6); PG8_BAR; PG8_MMA(1, 1, At, B1); PG8_BAR;
            }
        }
        if constexpr (ALIGN_EPI) { if (wr == 0) PG8_BAR; }
        E(acc, cur, wr, wc, fr, fq);
        if (!has_next) break;
#pragma unroll
        for (int a = 0; a < 2; ++a)
#pragma unroll
            for (int b = 0; b < 2; ++b)
#pragma unroll
                for (int m = 0; m < 4; ++m)
#pragma unroll
                    for (int n = 0; n < 2; ++n) acc[a][b][m][n] = (f32x4){0.f, 0.f, 0.f, 0.f};
        cur = nxt; cA = nA; cB = nB; ++ui;
        if constexpr (ALIGN_EPI) { if (wr == 1) PG8_BAR; }
    }
    PG8_WAIT_V(0);
    if constexpr (!ALIGN_EPI) { if (wr == 0) PG8_BAR; }
    PG8_BAR;
#undef PG8_SA
#undef PG8_SB
#undef PG8_STAGE
#undef PG8_STAGE_A
#undef PG8_GATHER
#undef PG8_LDA
#undef PG8_LDB
#undef PG8_MMA
#undef PG8_WAIT_V
#undef PG8_WAIT_L
#undef PG8_BAR
#undef PG8_SCHED
}


struct EpiM1 {
    static constexpr bool PERM = true;
    bf16_t* Q; bf16_t* Kn; bf16_t* KT; bf16_t* VT; bf16_t* OGS;
    __device__ __forceinline__ void operator()(const f32x4 (&acc)[2][2][4][2], const Unit& u, int wr, int wc, int fr, int fq) const {
        const int row0 = u.arow0 + wr * 64 + fr, pn = u.pn;
        if (pn < 4 || pn >= 8) {
            bf16_t* base; int ldc, colt; float sc = 1.f; const bool sig = pn >= 8;
            if (pn < 2) { base = Q; ldc = MQK; colt = pn * 256; sc = 0.08838834764831845f; }
            else if (pn < 4) { base = Kn; ldc = MQK; colt = (pn - 2) * 256; }
            else { base = OGS; ldc = MV; colt = (pn - 8) * 256; }
            const int col0 = colt + wc * 32 + 8 * fq;
#pragma unroll
            for (int ai = 0; ai < 2; ++ai)
#pragma unroll
                for (int m = 0; m < 4; ++m) { bf16_t* rowp = base + (size_t)(row0 + ai * HALF + m * 16) * ldc + col0;
#pragma unroll
                    for (int bj = 0; bj < 2; ++bj) { f32x4 v0 = acc[ai][bj][m][0] * sc, v1 = acc[ai][bj][m][1] * sc;
                        if (sig) {
#pragma unroll
                            for (int j = 0; j < 4; ++j) { v0[j] = sigmoidf_(v0[j]); v1[j] = sigmoidf_(v1[j]); } }
                        u32x4 w; w.x = cvt_pk_bf16(v0[0], v0[1]); w.y = cvt_pk_bf16(v0[2], v0[3]); w.z = cvt_pk_bf16(v1[0], v1[1]); w.w = cvt_pk_bf16(v1[2], v1[3]);
                        *(u32x4*)(rowp + bj * HALF) = w; } }
        }
        if (pn >= 2 && pn < 8) {
            const int b = u.arow0 / SEQ, s0 = (u.arow0 % SEQ) + wr * 64 + fr;
            bf16_t* base; int colt, nc;
            if (pn < 4) { base = KT; colt = (pn - 2) * 256; nc = MQK; } else { base = VT; colt = (pn - 4) * 256; nc = MV; }
            bf16_t* xb = base + ((size_t)b * nc + colt + wc * 32 + 8 * fq) * SEQ + s0;
#pragma unroll
            for (int ai = 0; ai < 2; ++ai)
#pragma unroll
                for (int m = 0; m < 4; ++m)
#pragma unroll
                    for (int bj = 0; bj < 2; ++bj)
#pragma unroll
                        for (int n = 0; n < 2; ++n)
#pragma unroll
                            for (int j = 0; j < 4; ++j)
                                xb[(size_t)(bj * HALF + 4 * n + j) * SEQ + ai * HALF + m * 16] = (bf16_t)f2bf(acc[ai][bj][m][n][j]);
        }
    }
};
struct EpiRes {
    static constexpr bool PERM = false;
    const float* base; float* out; const float* gate; float mul;
    __device__ __forceinline__ void operator()(const f32x4 (&acc)[2][2][4][2], const Unit& u, int wr, int wc, int fr, int fq) const {
        const int row0 = u.arow0 + wr * 64 + fr, col0 = u.pn * BM + wc * 32 + 4 * fq, b = u.arow0 / SEQ;
        f32x4 gv[2][2];
#pragma unroll
        for (int bj = 0; bj < 2; ++bj)
#pragma unroll
            for (int n = 0; n < 2; ++n) gv[bj][n] = *(const f32x4*)(gate + (size_t)b * 6 * D + col0 + bj * HALF + n * 16);
#pragma unroll
        for (int ai = 0; ai < 2; ++ai)
#pragma unroll
            for (int m = 0; m < 4; ++m) { const size_t off = (size_t)(row0 + ai * HALF + m * 16) * D + col0;
#pragma unroll
                for (int bj = 0; bj < 2; ++bj)
#pragma unroll
                    for (int n = 0; n < 2; ++n) { const f32x4 bs = *(const f32x4*)(base + off + bj * HALF + n * 16);
                        *(f32x4*)(out + off + bj * HALF + n * 16) = bs + gv[bj][n] * acc[ai][bj][m][n] * mul; } }
    }
};
struct EpiBf {
    static constexpr bool PERM = true;
    bf16_t* O; int ldc;
    __device__ __forceinline__ void operator()(const f32x4 (&acc)[2][2][4][2], const Unit& u, int wr, int wc, int fr, int fq) const {
        const int row0 = u.arow0 + wr * 64 + fr, col0 = u.pn * BM + wc * 32 + 8 * fq;
#pragma unroll
        for (int ai = 0; ai < 2; ++ai)
#pragma unroll
            for (int m = 0; m < 4; ++m) { bf16_t* rowp = O + (size_t)(row0 + ai * HALF + m * 16) * ldc + col0;
#pragma unroll
                for (int bj = 0; bj < 2; ++bj) { const f32x4 v0 = acc[ai][bj][m][0], v1 = acc[ai][bj][m][1];
                    u32x4 w; w.x = cvt_pk_bf16(v0[0], v0[1]); w.y = cvt_pk_bf16(v0[2], v0[3]); w.z = cvt_pk_bf16(v1[0], v1[1]); w.w = cvt_pk_bf16(v1[2], v1[3]);
                    *(u32x4*)(rowp + bj * HALF) = w; } }
    }
};
template <bool SILU> struct EpiGlu {
    static constexpr bool PERM = true;
    bf16_t* O; int ldc; int plain_tiles; bf16_t* P; int ldp;
    __device__ __forceinline__ void operator()(const f32x4 (&acc)[2][2][4][2], const Unit& u, int wr, int wc, int fr, int fq) const {
        const int row0 = u.arow0 + wr * 64 + fr;
        if (u.pn < plain_tiles) {
            const int col0 = u.pn * BM + wc * 32 + 8 * fq;
#pragma unroll
            for (int ai = 0; ai < 2; ++ai)
#pragma unroll
                for (int m = 0; m < 4; ++m) { bf16_t* rowp = P + (size_t)(row0 + ai * HALF + m * 16) * ldp + col0;
#pragma unroll
                    for (int bj = 0; bj < 2; ++bj) { const f32x4 v0 = acc[ai][bj][m][0], v1 = acc[ai][bj][m][1];
                        u32x4 w; w.x = cvt_pk_bf16(v0[0], v0[1]); w.y = cvt_pk_bf16(v0[2], v0[3]); w.z = cvt_pk_bf16(v1[0], v1[1]); w.w = cvt_pk_bf16(v1[2], v1[3]);
                        *(u32x4*)(rowp + bj * HALF) = w; } }
            return;
        }
        const int col0 = (u.pn - plain_tiles) * HALF + wc * 32 + 8 * fq;
#pragma unroll
        for (int ai = 0; ai < 2; ++ai)
#pragma unroll
            for (int m = 0; m < 4; ++m) { bf16_t* rowp = O + (size_t)(row0 + ai * HALF + m * 16) * ldc + col0;
                f32x4 v0 = acc[ai][0][m][0], v1 = acc[ai][0][m][1]; const f32x4 u0 = acc[ai][1][m][0], u1 = acc[ai][1][m][1];
                if (SILU) {
#pragma unroll
                    for (int j = 0; j < 4; ++j) { v0[j] = v0[j] * sigmoidf_(v0[j]); v1[j] = v1[j] * sigmoidf_(v1[j]); } }
                v0 = v0 * u0; v1 = v1 * u1;
                u32x4 w; w.x = cvt_pk_bf16(v0[0], v0[1]); w.y = cvt_pk_bf16(v0[2], v0[3]); w.z = cvt_pk_bf16(v1[0], v1[1]); w.w = cvt_pk_bf16(v1[2], v1[3]);
                *(u32x4*)rowp = w; }
    }
};
}

#define XB_TMO      128
#define XB_XCNT(j)  (256  + 64 * (j))
#define XB_XSUB(j)  (1280 + 64 * (j))
#define XB_XGEN(j)  (2304 + 64 * (j))
#define XB_TOP      3328
#define XB_TOPGEN   3392
#define XCD_BAR_WORDS 3456
#define XB_SPIN_CAP (1u << 18)
__device__ __forceinline__ unsigned xb_ld(unsigned* p)              { return __hip_atomic_load(p, __ATOMIC_RELAXED, __HIP_MEMORY_SCOPE_AGENT); }
__device__ __forceinline__ unsigned xb_add(unsigned* p, unsigned v) { return __hip_atomic_fetch_add(p, v, __ATOMIC_RELAXED, __HIP_MEMORY_SCOPE_AGENT); }
__device__ __forceinline__ unsigned xb_xcc_id() { return (unsigned)__builtin_amdgcn_s_getreg((3 << 11) | 20) & 0xFu; }
#define XB_SPIN(cond, bar) do { unsigned _sp = 0; while (cond) { __builtin_amdgcn_s_sleep(1); \
    if ((++_sp & 255u) == 0u) { if (xb_ld(&(bar)[XB_TMO])) break; if (_sp > XB_SPIN_CAP) { atomicAdd(&(bar)[XB_TMO], 1u); break; } } } } while (0)
struct XcdBarrier { unsigned* bar; unsigned x; volatile LAS unsigned* st; };
__device__ __forceinline__ XcdBarrier xcd_barrier_post(unsigned* bar, volatile LAS unsigned* st) {
    XcdBarrier b; b.bar = bar; b.x = xb_xcc_id(); b.st = st;
    if (threadIdx.x == 0) (void)xb_add(&bar[XB_XCNT(b.x)], 1u);
    return b;
}
__device__ __forceinline__ void xcd_barrier_complete(unsigned* bar, unsigned x, unsigned& nloc, unsigned& nx) {
    const unsigned G = gridDim.x * gridDim.y * gridDim.z;
    unsigned sum, cnt, mine, sp = 0u;
    for (;;) {
        sum = 0u; cnt = 0u; mine = 0u;
#pragma unroll
        for (unsigned j = 0; j < 16; ++j) { const unsigned c = xb_ld(&bar[XB_XCNT(j)]); sum += c; cnt += (c > 0u) ? 1u : 0u; mine = (j == x) ? c : mine; }
        if (sum == G) break;
        __builtin_amdgcn_s_sleep(1);
        if ((++sp & 255u) == 0u) { if (xb_ld(&bar[XB_TMO])) break; if (sp > XB_SPIN_CAP) { atomicAdd(&bar[XB_TMO], 1u); break; } }
    }
    nloc = mine > 0u ? mine : 1u; nx = cnt > 0u ? cnt : 1u;
}
__device__ __forceinline__ void xcd_barrier(const XcdBarrier& b) {
    asm volatile("s_waitcnt vmcnt(0)" ::: "memory");
    __syncthreads();
    if (threadIdx.x == 0) {
        unsigned* bar = b.bar;
        __builtin_amdgcn_s_waitcnt(0);
        unsigned nloc = b.st[0], nx = b.st[1];
        if (nloc == 0u) { xcd_barrier_complete(bar, b.x, nloc, nx); b.st[0] = nloc; b.st[1] = nx; }
        const unsigned old = xb_add(&bar[XB_XSUB(b.x)], 1u);
        const unsigned gen = old / nloc;
        if (old + 1u == (gen + 1u) * nloc) {
            __builtin_amdgcn_fence(__ATOMIC_RELEASE, "agent");
            asm volatile("s_waitcnt vmcnt(0)" ::: "memory");
            const unsigned og = xb_add(&bar[XB_TOP], 1u);
            const unsigned tg = og / nx;
            if (og + 1u == (tg + 1u) * nx) xb_add(&bar[XB_TOPGEN], 1u);
            else XB_SPIN(xb_ld(&bar[XB_TOPGEN]) == tg, bar);
            __builtin_amdgcn_fence(__ATOMIC_ACQUIRE, "agent");
            xb_add(&bar[XB_XGEN(b.x)], 1u);
            asm volatile("s_waitcnt vmcnt(0)" ::: "memory");
        } else {
            XB_SPIN(xb_ld(&bar[XB_XGEN(b.x)]) == gen, bar);
            __builtin_amdgcn_fence(__ATOMIC_ACQUIRE, "agent");
            asm volatile("s_waitcnt vmcnt(0)" ::: "memory");
        }
    }
    __syncthreads();
}

struct Args { const float* in[20]; float* out; unsigned char* ws; int ph_lo, ph_hi; };
__device__ __forceinline__ const void* karg_ptr(int idx) {
    const void* p = ((const void* const __attribute__((address_space(4)))*)__builtin_amdgcn_kernarg_segment_ptr())[idx];
    asm volatile("" : "+s"(p)); return p;
}
struct InProxy { __device__ __forceinline__ const float* operator[](int i) const { return (const float*)karg_ptr(i); } };
struct WsProxy { __device__ __forceinline__ operator unsigned char*() const { return (unsigned char*)karg_ptr(21); }
                 __device__ __forceinline__ unsigned char* operator+(size_t o) const { return (unsigned char*)karg_ptr(21) + o; } };
struct OutProxy { __device__ __forceinline__ operator float*() const { return (float*)karg_ptr(20); }
                  __device__ __forceinline__ float* operator+(size_t o) const { return (float*)karg_ptr(20) + o; } };
struct CtlProxy { __device__ __forceinline__ operator gu32*() const { return (gu32*)karg_ptr(21); }
                  __device__ __forceinline__ gu32* operator+(int o) const { return (gu32*)karg_ptr(21) + o; } };
struct Frame {
    LAS unsigned char* lds; volatile LAS unsigned* MISC; CtlProxy ctl;
    int tid, lane, wave, vcu, G, bx;
    InProxy in; OutProxy out; WsProxy ws;
};
enum { I_X = 0, I_C, I_N1G, I_N2G, I_WADA, I_BADA, I_MWIN, I_MBG, I_MNG, I_MWOUT, I_CWIN, I_CCW, I_CCB, I_CWOUT, I_WR, I_BR, I_EWG, I_EWU, I_EWD, I_FG };

__device__ __forceinline__ float wave_sum(float v) {
#pragma unroll
    for (int o = 1; o < 64; o <<= 1) v += __shfl_xor(v, o);
    return v;
}

__device__ __forceinline__ void cvt_item(const float* W, int ldw, int K, int k0, int n0, bf16_t* WT, int drow0, LAS float* scr, int lane) {
#pragma unroll 8
    for (int i = 0; i < 32; ++i) { const int kk = 2 * i + (lane >> 5); scr[kk * 33 + (lane & 31)] = W[(size_t)(k0 + kk) * ldw + n0 + (lane & 31)]; }
    LDS_WAIT(); asm volatile("" ::: "memory");
    const int c = lane & 7;
#pragma unroll
    for (int j = 0; j < 4; ++j) { const int n = (lane >> 3) + 8 * j; const LAS float* s = scr + (8 * c) * 33 + n;
        u32x4 o; o.x = pk2(s[0 * 33], s[1 * 33]); o.y = pk2(s[2 * 33], s[3 * 33]); o.z = pk2(s[4 * 33], s[5 * 33]); o.w = pk2(s[6 * 33], s[7 * 33]);
        *(GAS u32x4*)(WT + (size_t)(drow0 + n) * K + k0 + 8 * c) = o; }
    LDS_WAIT(); asm volatile("" ::: "memory");
}
__device__ __forceinline__ int glu_row(int n, int which) { return (n >> 7) * 256 + which * 128 + (n & 127); }

__device__ __forceinline__ void convert_weights(Frame& F, int L) {
    LAS float* scr = (LAS float*)(F.lds + F.wave * 16384);
    const int gw = F.vcu * NWAVES + F.wave, NGW = F.G * NWAVES;
    bf16_t* W0 = (bf16_t*)(F.ws + WS_W0); bf16_t* W1 = (bf16_t*)(F.ws + WS_W1); bf16_t* WUP = (bf16_t*)(F.ws + WS_WUP); bf16_t* WDN = (bf16_t*)(F.ws + WS_WDN);
    constexpr int I_IN = 16 * 96, I_OUT = 16 * 32, I_G = NE * 16 * 16, I_D = NE * 8 * 32;
    constexpr int NITEMS = I_IN + I_OUT + 2 * I_G + I_D;
    for (int it = gw; it < NITEMS; it += NGW) {
        int r = it;
        if (r < I_IN) { const int kb = r / 96, nb = r % 96, n0 = nb * 32;
            if (L == 0) cvt_item(F.in[I_MWIN], MPROJ, D, kb * 64, n0, W0, n0, scr, F.lane);
            else { int dr; if (n0 < D) dr = n0; else if (n0 < 2 * D) dr = D + glu_row(n0 - D, 0); else dr = D + glu_row(n0 - 2 * D, 1);
                cvt_item(F.in[I_CWIN], 3 * D, D, kb * 64, n0, W0, dr, scr, F.lane); }
            continue; } r -= I_IN;
        if (r < I_OUT) { const int kb = r / 32, nb = r % 32; cvt_item(L == 0 ? F.in[I_MWOUT] : F.in[I_CWOUT], D, D, kb * 64, nb * 32, W1, nb * 32, scr, F.lane); continue; } r -= I_OUT;
        if (r < 2 * I_G) { const int which = r / I_G; r %= I_G; const int e = r / 256, kb = (r % 256) / 16, nb = r % 16, n0 = nb * 32;
            const float* src = (which == 0 ? F.in[I_EWG] : F.in[I_EWU]) + ((size_t)L * NE + e) * D * DE;
            cvt_item(src, DE, D, kb * 64, n0, WUP + (size_t)e * 1024 * D, glu_row(n0, which), scr, F.lane); continue; } r -= 2 * I_G;
        { const int e = r / 256, kb = (r % 256) / 32, nb = r % 32;
          const float* src = F.in[I_EWD] + ((size_t)L * NE + e) * DE * D;
          cvt_item(src, D, DE, kb * 64, nb * 32, WDN + (size_t)e * D * DE, nb * 32, scr, F.lane); }
    }
}

__device__ __forceinline__ void phase_prologue(Frame& F) {
    float* MOD = (float*)(F.ws + WS_MOD);
    LAS float* cond = (LAS float*)(F.lds + 0);
    LAS float* red = (LAS float*)(F.lds + 16384);
    bool did = false;
    for (int task = F.bx; task < 192; task += F.G) {
        if (did) __syncthreads();
        did = true;
        for (int i = F.tid; i < NB * D; i += NTHR) { const int b = i / D, k = i % D; const float c = F.in[I_C][i]; cond[k * 4 + b] = c * sigmoidf_(c); }
        __syncthreads();
        const int layer = task / 96, col = (task % 96) * 64 + F.lane;
        const float* W = F.in[I_WADA] + (size_t)layer * D * 6 * D;
        float a0 = 0.f, a1 = 0.f, a2 = 0.f, a3 = 0.f;
#pragma unroll 8
        for (int kk = 0; kk < 128; ++kk) { const int k = F.wave * 128 + kk; const float w = W[(size_t)k * 6 * D + col]; const f32x4 c4 = *(const LAS f32x4*)(cond + k * 4);
            a0 += c4[0] * w; a1 += c4[1] * w; a2 += c4[2] * w; a3 += c4[3] * w; }
        red[(F.wave * 4 + 0) * 64 + F.lane] = a0; red[(F.wave * 4 + 1) * 64 + F.lane] = a1; red[(F.wave * 4 + 2) * 64 + F.lane] = a2; red[(F.wave * 4 + 3) * 64 + F.lane] = a3;
        __syncthreads();
        if (F.tid < 256) { const int b = F.tid >> 6, l = F.tid & 63; float s = 0.f;
#pragma unroll
            for (int w = 0; w < 8; ++w) s += red[(w * 4 + b) * 64 + l];
            const int c = (task % 96) * 64 + l;
            MOD[((size_t)layer * NB + b) * 6 * D + c] = s + F.in[I_BADA][(size_t)layer * 6 * D + c]; }
    }
    __syncthreads();
    convert_weights(F, 0);
}

__device__ __forceinline__ void xreduce32(float (&v)[32], int lane) {
#pragma unroll
    for (int step = 0; step < 5; ++step) {
        const int M = 32 >> step, n = 32 >> step;
        const bool up = (lane & M) != 0;
#pragma unroll
        for (int i = 0; i < n / 2; ++i) { float a = v[i], b = v[i + n / 2]; asm volatile("" : "+v"(a), "+v"(b));
            const float send = up ? a : b, keep = up ? b : a; v[i] = keep + __shfl_xor(send, M); }
    }
    v[0] += __shfl_xor(v[0], 1);
}

constexpr int RP_WL = 0, RP_RINFO = 65536, RP_LCNT = RP_RINFO + 128 * 8 * 4, RP_TPRE = RP_LCNT + 256;
template <int MODE>
__device__ __forceinline__ void row_pass(Frame& F, int layer) {
    constexpr int DOTS = (MODE == 0) ? 8 : (MODE == 1 ? 16 : 0);
    constexpr int RPI = (MODE == 1) ? 2 : 4;
    constexpr bool COMBINE = (MODE == 2 || MODE == 3), MODUL = (MODE != 3);
    const float* MOD = (const float*)(F.ws + WS_MOD);
    LAS float* wl = (LAS float*)(F.lds + RP_WL);
    LAS int* rinfo = (LAS int*)(F.lds + RP_RINFO);
    LAS int* lcnt = (LAS int*)(F.lds + RP_LCNT);
    LAS int* tpre = (LAS int*)(F.lds + RP_TPRE);
    const float* xin = (MODE == 0) ? F.in[I_X] : F.out;
    bf16_t* U = (bf16_t*)(F.ws + WS_U);
    const int lane = F.lane;
    const int clayer = (MODE == 2) ? 0 : 1;
    if (DOTS == 8) { for (int i = F.tid; i < D * 8; i += NTHR) { const int k = i >> 3, j = i & 7; wl[i] = F.in[I_MWIN][(size_t)k * MPROJ + 3072 + j]; } }
    if (DOTS == 16) { for (int i = F.tid; i < D * 16; i += NTHR) wl[i] = F.in[I_WR][i]; }
    if (COMBINE && F.tid == 0) { int a = 0; for (int e = 0; e < NE; ++e) { tpre[e] = a; a += ((int)__hip_atomic_load(F.ctl + CW_CNT + 64 * clayer + e, RLX_AGENT) + 255) >> 8; } tpre[NE] = a; }
    float brt[16];
    if (MODE == 1) {
#pragma unroll
        for (int e = 0; e < 16; ++e) brt[e] = F.in[I_BR][e]; }
    for (int batch = F.vcu; batch < T / 128; batch += F.G) {
        __syncthreads();
        if (MODE == 1 && F.tid < 32) lcnt[F.tid] = 0;
        __syncthreads();
        const int row_base = batch * 128 + F.wave * 16, b = row_base / SEQ;
        const float* gam = (MODE == 3) ? F.in[I_FG] : ((MODE == 1) ? F.in[I_N2G] + (size_t)layer * D : F.in[I_N1G] + (size_t)layer * D);
        const float* mod = MOD + ((size_t)layer * NB + b) * 6 * D;
        const float* shp = mod + ((MODE == 1) ? 3 * D : 0); const float* scp = shp + D;
        const float* g2p = MOD + ((size_t)clayer * NB + b) * 6 * D + 5 * D;
        f32x4 gm[4], sh[4], sc[4], g2[4];
#pragma unroll
        for (int j = 0; j < 4; ++j) { gm[j] = *(const f32x4*)(gam + 256 * j + 4 * lane);
            if (MODUL) { sh[j] = *(const f32x4*)(shp + 256 * j + 4 * lane); sc[j] = *(const f32x4*)(scp + 256 * j + 4 * lane) + 1.0f; }
            if (COMBINE) g2[j] = *(const f32x4*)(g2p + 256 * j + 4 * lane); }
#pragma unroll 1
        for (int it = 0; it < 16 / RPI; ++it) {
            const int r0 = row_base + it * RPI;
            f32x4 x[RPI][4];
#pragma unroll
            for (int r = 0; r < RPI; ++r)
#pragma unroll
                for (int j = 0; j < 4; ++j) x[r][j] = *(const f32x4*)(xin + (size_t)(r0 + r) * D + 256 * j + 4 * lane);
            if (COMBINE) {
                const bf16_t* O = (const bf16_t*)(F.ws + WS_O);
#pragma unroll
                for (int r = 0; r < RPI; ++r) {
                    const u32x4 ti = *(const u32x4*)(F.ws + WS_TOK + (size_t)(r0 + r) * 16);
                    const int e0 = __builtin_amdgcn_readfirstlane((int)(ti.x >> 16)), e1 = __builtin_amdgcn_readfirstlane((int)(ti.y >> 16));
                    const int s0 = tpre[e0] * 256 + (int)(ti.x & 0xffffu), s1 = tpre[e1] * 256 + (int)(ti.y & 0xffffu);
                    const unsigned wz_ = ti.z, ww_ = ti.w; const float w0 = __uint_as_float(wz_), w1 = __uint_as_float(ww_);
#pragma unroll
                    for (int j = 0; j < 4; ++j) {
                        const u32x2 a = *(const u32x2*)(O + (size_t)s0 * D + 256 * j + 4 * lane), c = *(const u32x2*)(O + (size_t)s1 * D + 256 * j + 4 * lane);
                        f32x4 mo; mo[0] = w0 * bflo(a.x) + w1 * bflo(c.x); mo[1] = w0 * bfhi(a.x) + w1 * bfhi(c.x); mo[2] = w0 * bflo(a.y) + w1 * bflo(c.y); mo[3] = w0 * bfhi(a.y) + w1 * bfhi(c.y);
                        if (!(DBG_SKIP & (MODE == 2 ? 2 : 8))) x[r][j] = x[r][j] + g2[j] * mo * ((DBG_SKIP & 16) ? 2.0f : 1.0f);
                        if (MODE == 2) *(f32x4*)(F.out + (size_t)(r0 + r) * D + 256 * j + 4 * lane) = x[r][j];
#ifdef DBG_PROBE
                        if (MODE == 3 && r0 + r == 777 && lane == 5 && j == 0) { float* dbg = (float*)(F.ws + 60 * MiB); dbg[0] = w0; dbg[1] = w1; dbg[2] = (float)s0; dbg[3] = (float)s1; dbg[4] = mo[0]; dbg[5] = g2[0][0]; dbg[6] = x[r][0][0]; dbg[7] = bflo(a.x); dbg[8] = bflo(c.x); dbg[9] = (float)e0; dbg[10] = (float)e1; dbg[11] = (float)tpre[e0]; }
#endif
                    }
                }
            }
            float rstd[RPI];
#pragma unroll
            for (int r = 0; r < RPI; ++r) { float s = 0.f;
#pragma unroll
                for (int j = 0; j < 4; ++j) s += (x[r][j][0] * x[r][j][0] + x[r][j][1] * x[r][j][1]) + (x[r][j][2] * x[r][j][2] + x[r][j][3] * x[r][j][3]);
                rstd[r] = 1.0f / sqrtf(wave_sum(s) * (1.0f / D) + EPS); }
#pragma unroll
            for (int r = 0; r < RPI; ++r)
#pragma unroll
                for (int j = 0; j < 4; ++j) { f32x4 y = x[r][j] * rstd[r] * gm[j]; if (MODUL) y = y * sc[j] + sh[j]; x[r][j] = y;
                    if (MODE == 3) *(f32x4*)(F.out + (size_t)(r0 + r) * D + 256 * j + 4 * lane) = y;
                    else { u32x2 w; w.x = pk2(y[0], y[1]); w.y = pk2(y[2], y[3]); *(u32x2*)(U + (size_t)(r0 + r) * D + 256 * j + 4 * lane) = w; } }
            if (DOTS > 0) {
                float v[32];
#pragma unroll
                for (int i = 0; i < 32; ++i) v[i] = 0.f;
#pragma unroll
                for (int j = 0; j < 4; ++j)
#pragma unroll
                    for (int i = 0; i < 4; ++i) { const int k = 256 * j + 4 * lane + i;
                        float w[DOTS > 0 ? DOTS : 1];
#pragma unroll
                        for (int q = 0; q < DOTS / 4; ++q) { const f32x4 t4 = *(const LAS f32x4*)(wl + k * DOTS + 4 * q); w[4 * q] = t4[0]; w[4 * q + 1] = t4[1]; w[4 * q + 2] = t4[2]; w[4 * q + 3] = t4[3]; }
#pragma unroll
                        for (int r = 0; r < RPI; ++r)
#pragma unroll
                            for (int e = 0; e < DOTS; ++e) v[r * DOTS + e] += x[r][j][i] * w[e];
                        asm volatile("" ::: "memory"); }
                xreduce32(v, lane);
                const float tot = v[0];
                if (MODE == 0) {
                    const int idx = lane >> 1, r = idx >> 3, gi = idx & 7, row = r0 + r, bb = row / SEQ, s = row % SEQ;
                    if ((lane & 1) == 0) {
                        const float pre = tot + F.in[I_MBG][gi];
                        if (gi < 4) ((float*)(F.ws + WS_IG))[(size_t)(bb * NH + gi) * SEQ + s] = pre;
                        else { const float ls = (pre >= 0.f) ? -log1pf(expf(-pre)) : (pre - log1pf(expf(pre))); ((float*)(F.ws + WS_LF))[(size_t)(bb * NH + gi - 4) * SEQ + s] = ls; }
                    }
                }
                if (MODE == 1) {
#pragma unroll
                    for (int r = 0; r < RPI; ++r) {
                        float lg[16], mx = -INFINITY;
#pragma unroll
                        for (int e = 0; e < 16; ++e) { lg[e] = __shfl(tot, 32 * r + 2 * e); mx = fmaxf(mx, lg[e]); }
                        float se = 0.f;
#pragma unroll
                        for (int e = 0; e < 16; ++e) { lg[e] = expf(lg[e] - mx); se += lg[e]; }
                        const float inv = 1.0f / se;
                        float sel[16];
#pragma unroll
                        for (int e = 0; e < 16; ++e) { lg[e] *= inv; sel[e] = lg[e] + brt[e]; }
                        int best = 0; float bscore = -INFINITY;
#pragma unroll
                        for (int gq = 0; gq < 4; ++gq) { const float a = sel[4 * gq], bq = sel[4 * gq + 1], c = sel[4 * gq + 2], d = sel[4 * gq + 3];
                            const float m1 = fmaxf(fmaxf(a, bq), fmaxf(c, d));
                            const float lo1 = fminf(a, bq), hi1 = fmaxf(a, bq), lo2 = fminf(c, d), hi2 = fmaxf(c, d);
                            const float m2 = fmaxf(fminf(hi1, hi2), fmaxf(lo1, lo2));
                            const float gs = m1 + m2; if (gs > bscore) { bscore = gs; best = gq; } }
                        float s4[4], p4[4];
#pragma unroll
                        for (int q = 0; q < 4; ++q) { s4[q] = -INFINITY; p4[q] = 0.f; }
#pragma unroll
                        for (int gq = 0; gq < 4; ++gq) if (best == gq) {
#pragma unroll
                            for (int q = 0; q < 4; ++q) { s4[q] = sel[4 * gq + q]; p4[q] = lg[4 * gq + q]; } }
                        int i0 = 0; float v0 = s4[0], pp0 = p4[0];
#pragma unroll
                        for (int q = 1; q < 4; ++q) if (s4[q] > v0) { v0 = s4[q]; i0 = q; pp0 = p4[q]; }
                        int i1 = -1; float v1 = -INFINITY, pp1 = 0.f;
#pragma unroll
                        for (int q = 0; q < 4; ++q) if (q != i0 && s4[q] > v1) { v1 = s4[q]; i1 = q; pp1 = p4[q]; }
                        const float wsum = pp0 + pp1, w0 = pp0 / wsum, w1 = pp1 / wsum;
                        const int e0 = best * 4 + i0, e1 = best * 4 + i1;
                        if (lane == 0) {
                            const int lp0 = __hip_atomic_fetch_add(lcnt + e0, 1, __ATOMIC_RELAXED, __HIP_MEMORY_SCOPE_WORKGROUP), lp1 = __hip_atomic_fetch_add(lcnt + e1, 1, __ATOMIC_RELAXED, __HIP_MEMORY_SCOPE_WORKGROUP);
                            LAS int* ri = rinfo + (F.wave * 16 + it * RPI + r) * 8;
                            ri[0] = e0; ri[1] = e1; ri[2] = lp0; ri[3] = lp1; ri[4] = __builtin_bit_cast(int, w0); ri[5] = __builtin_bit_cast(int, w1);
                        }
                    }
                }
            }
        }
        if (MODE == 1) {
            __syncthreads();
            if (F.tid < 16) lcnt[16 + F.tid] = (int)__hip_atomic_fetch_add(F.ctl + CW_CNT + 64 * layer + F.tid, (unsigned)lcnt[F.tid], RLX_AGENT);
            __syncthreads();
            if (F.tid < 128) { const LAS int* ri = rinfo + F.tid * 8; const int row = batch * 128 + F.tid; const int e0 = ri[0], e1 = ri[1], p0 = lcnt[16 + e0] + ri[2], p1 = lcnt[16 + e1] + ri[3];
                int* LIST = (int*)(F.ws + WS_LIST); LIST[e0 * LCAP + p0] = row; LIST[e1 * LCAP + p1] = row;
                u32x4 ti; ti.x = (unsigned)(e0 << 16) | (unsigned)p0; ti.y = (unsigned)(e1 << 16) | (unsigned)p1; ti.z = (unsigned)ri[4]; ti.w = (unsigned)ri[5];
                *(u32x4*)(F.ws + WS_TOK + (size_t)row * 16) = ti; }
        }
    }
    __syncthreads();
}

__device__ __forceinline__ float incl_sum(float v, int lane) {
#pragma unroll
    for (int o = 1; o < 64; o <<= 1) { const float t = __shfl_up(v, o); if (lane >= o) v += t; }
    return v;
}
__device__ __forceinline__ float incl_max(float v, int lane) {
#pragma unroll
    for (int o = 1; o < 64; o <<= 1) { const float t = __shfl_up(v, o); if (lane >= o) v = fmaxf(v, t); }
    return v;
}
__device__ __forceinline__ void phase_scan(Frame& F) {
    LAS float* wkA = (LAS float*)(F.lds + 0);
    LAS float* decA = (LAS float*)(F.lds + 32768);
    LAS float* tot = (LAS float*)(F.lds + 33280);
    LAS float* bst = (LAS float*)(F.lds + 33792);
    LAS float* cmx = (LAS float*)(F.lds + 34304);
    LAS float* rst = (LAS float*)(F.lds + 34816);
    const int lane = F.lane, w = F.wave;
    for (int unit = F.vcu; unit < 256; unit += F.G) {
        const int bh = unit >> 4, slice = unit & 15;
        const float* IG = (const float*)(F.ws + WS_IG) + (size_t)bh * SEQ; const float* LF = (const float*)(F.ws + WS_LF) + (size_t)bh * SEQ;
        __syncthreads();
        float p[16], g[16], pm[16];
#pragma unroll
        for (int q = 0; q < 16; ++q) { const int c = 16 * w + q; p[q] = incl_sum(LF[c * 64 + lane], lane); if (lane == 63) tot[c] = p[q]; }
        __syncthreads();
        if (F.tid < 128) { float s = 0.f; for (int c = 0; c < F.tid; ++c) s += tot[c]; bst[F.tid] = s; }
        __syncthreads();
#pragma unroll
        for (int q = 0; q < 16; ++q) { const int c = 16 * w + q; p[q] += bst[c]; g[q] = IG[c * 64 + lane] - p[q]; pm[q] = incl_max(g[q], lane); if (lane == 63) cmx[c] = pm[q]; }
        __syncthreads();
        if (F.tid < 128) { float s = 0.f; for (int c = 0; c < F.tid; ++c) s = fmaxf(s, cmx[c]); rst[F.tid] = s; }
        __syncthreads();
#pragma unroll
        for (int q = 0; q < 16; ++q) { const int c = 16 * w + q; const float Rs = rst[c], Rn = fmaxf(Rs, cmx[c]), Rrun = fmaxf(Rs, pm[q]);
            wkA[c * 64 + lane] = expf(g[q] - Rn); if (lane == 0) decA[c] = expf(Rs - Rn);
            if (slice == 0) { const size_t o = (size_t)bh * SEQ + c * 64 + lane; ((float*)(F.ws + WS_GA))[o] = g[q]; ((float*)(F.ws + WS_RR))[o] = Rrun; ((float*)(F.ws + WS_MM))[o] = p[q] + Rrun;
                if (lane == 0) ((float*)(F.ws + WS_RC))[bh * NCH + c] = Rs; } }
        __syncthreads();
        const bf16_t* KTp = (const bf16_t*)(F.ws + WS_KT) + ((size_t)bh * DK + 16 * w + (lane & 15)) * SEQ + 8 * (lane >> 4);
        const bf16_t* VTp = (const bf16_t*)(F.ws + WS_VT) + ((size_t)bh * DV + 16 * slice + (lane & 15)) * SEQ + 8 * (lane >> 4);
        bf16_t* STp = (bf16_t*)(F.ws + WS_ST) + ((size_t)bh * NCH * DV + 16 * slice + (lane & 15)) * DK + 16 * w + 4 * (lane >> 4);
        float* NSp = (float*)(F.ws + WS_NS) + (size_t)bh * NCH * DK + 16 * w + 4 * (lane >> 4);
        f32x4 accS = (f32x4){0.f, 0.f, 0.f, 0.f}, accN = (f32x4){0.f, 0.f, 0.f, 0.f};
        u32x4 ka[2], va[2], kn[2], vn[2];
#pragma unroll
        for (int kk = 0; kk < 2; ++kk) { ka[kk] = *(const u32x4*)(KTp + kk * 32); va[kk] = *(const u32x4*)(VTp + kk * 32); kn[kk] = ka[kk]; vn[kk] = va[kk]; }
        for (int c = 0; c < NCH; ++c) {
            { u32x2 o; o.x = pk2(accS[0], accS[1]); o.y = pk2(accS[2], accS[3]); *(u32x2*)(STp + (size_t)c * DV * DK) = o; }
            if (slice == 0 && (lane & 15) == 0) *(f32x4*)(NSp + (size_t)c * DK) = accN;
            if (c == NCH - 1) break;
#pragma unroll
            for (int kk = 0; kk < 2; ++kk) { kn[kk] = *(const u32x4*)(KTp + (c + 1) * 64 + kk * 32); vn[kk] = *(const u32x4*)(VTp + (c + 1) * 64 + kk * 32); }
            const float dec = decA[c];
            accS = accS * dec; accN = accN * dec;
#pragma unroll
            for (int kk = 0; kk < 2; ++kk) {
                const LAS f32x4* wp = (const LAS f32x4*)(wkA + c * 64 + kk * 32 + 8 * (lane >> 4));
                const f32x4 w0 = wp[0], w1 = wp[1];
                u32x4 bv, b1;
                bv.x = pk2(bflo(va[kk].x) * w0[0], bfhi(va[kk].x) * w0[1]); bv.y = pk2(bflo(va[kk].y) * w0[2], bfhi(va[kk].y) * w0[3]);
                bv.z = pk2(bflo(va[kk].z) * w1[0], bfhi(va[kk].z) * w1[1]); bv.w = pk2(bflo(va[kk].w) * w1[2], bfhi(va[kk].w) * w1[3]);
                b1.x = pk2(w0[0], w0[1]); b1.y = pk2(w0[2], w0[3]); b1.z = pk2(w1[0], w1[1]); b1.w = pk2(w1[2], w1[3]);
                const bf16x8 af = __builtin_bit_cast(bf16x8, ka[kk]);
                accS = __builtin_amdgcn_mfma_f32_16x16x32_bf16(af, __builtin_bit_cast(bf16x8, bv), accS, 0, 0, 0);
                accN = __builtin_amdgcn_mfma_f32_16x16x32_bf16(af, __builtin_bit_cast(bf16x8, b1), accN, 0, 0, 0);
            }
#pragma unroll
            for (int kk = 0; kk < 2; ++kk) { ka[kk] = kn[kk]; va[kk] = vn[kk]; }
        }
    }
    __syncthreads();
}

constexpr int OC_AP = 0, OC_STRIDE = 400, OC_BVEC = 25600, OC_INV = 26368, OC_PART = 26624, OC_GS = 28672, OC_RT = 28928, OC_EMM = 29184, OC_RS = 29440;
__device__ __forceinline__ void phase_out(Frame& F) {
    LAS unsigned char* AP = F.lds + OC_AP;
    LAS float* bvec = (LAS float*)(F.lds + OC_BVEC); LAS float* inv = (LAS float*)(F.lds + OC_INV); LAS float* part = (LAS float*)(F.lds + OC_PART);
    LAS float* gs = (LAS float*)(F.lds + OC_GS); LAS float* Rt = (LAS float*)(F.lds + OC_RT); LAS float* emm = (LAS float*)(F.lds + OC_EMM); LAS float* rsA = (LAS float*)(F.lds + OC_RS);
    const int lane = F.lane, w = F.wave, tid = F.tid, l15 = lane & 15, lq = lane >> 4;
    const bf16_t* Qg = (const bf16_t*)(F.ws + WS_Q); const bf16_t* Kg = (const bf16_t*)(F.ws + WS_K);
    const bf16_t* VTg = (const bf16_t*)(F.ws + WS_VT); const bf16_t* STg = (const bf16_t*)(F.ws + WS_ST); const bf16_t* OGS = (const bf16_t*)(F.ws + WS_OGS);
    bf16_t* HN = (bf16_t*)(F.ws + WS_U);
    for (int unit = F.vcu; unit < 16 * NCH; unit += F.G) {
        const int bh = unit >> 7, c = unit & 127, b = bh >> 2, h = bh & 3;
        const int tk0 = b * SEQ + c * 64;
        __syncthreads();
        u32x4 bfr[2][6];
#pragma unroll
        for (int n = 0; n < 2; ++n) { const int dv = 32 * w + 16 * n + l15;
#pragma unroll
            for (int kk = 0; kk < 2; ++kk) bfr[n][kk] = *(const u32x4*)(VTg + ((size_t)bh * DV + dv) * SEQ + c * 64 + 32 * kk + 8 * lq);
#pragma unroll
            for (int kk = 0; kk < 4; ++kk) bfr[n][2 + kk] = *(const u32x4*)(STg + (((size_t)bh * NCH + c) * DV + dv) * DK + 32 * kk + 8 * lq); }
        if (tid < 64) { const size_t o = (size_t)bh * SEQ + c * 64 + tid; gs[tid] = ((const float*)(F.ws + WS_GA))[o]; Rt[tid] = ((const float*)(F.ws + WS_RR))[o]; emm[tid] = expf(-((const float*)(F.ws + WS_MM))[o]); bvec[tid] = 1.0f; }
        else if (tid < 192) bvec[tid] = ((const float*)(F.ws + WS_NS))[((size_t)bh * NCH + c) * DK + tid - 64];
        const float Rc = ((const float*)(F.ws + WS_RC))[bh * NCH + c];
        const int mt = w >> 1, ntb = (w & 1) * 2;
        u32x4 qa[4], kb[2][4];
#pragma unroll
        for (int kk = 0; kk < 4; ++kk) { qa[kk] = *(const u32x4*)(Qg + (size_t)(tk0 + 16 * mt + l15) * MQK + h * DK + 32 * kk + 8 * lq);
#pragma unroll
            for (int n = 0; n < 2; ++n) kb[n][kk] = *(const u32x4*)(Kg + (size_t)(tk0 + 16 * (ntb + n) + l15) * MQK + h * DK + 32 * kk + 8 * lq); }
        const int tq = tid >> 3, pq = tid & 7;
        const u32x4 q0 = *(const u32x4*)(Qg + (size_t)(tk0 + tq) * MQK + h * DK + 16 * pq), q1 = *(const u32x4*)(Qg + (size_t)(tk0 + tq) * MQK + h * DK + 16 * pq + 8);
        __syncthreads();
        f32x4 pacc[2];
#pragma unroll
        for (int n = 0; n < 2; ++n) { pacc[n] = (f32x4){0.f, 0.f, 0.f, 0.f};
#pragma unroll
            for (int kk = 0; kk < 4; ++kk) pacc[n] = __builtin_amdgcn_mfma_f32_16x16x32_bf16(__builtin_bit_cast(bf16x8, qa[kk]), __builtin_bit_cast(bf16x8, kb[n][kk]), pacc[n], 0, 0, 0); }
#pragma unroll
        for (int n = 0; n < 2; ++n) { const int sl = 16 * (ntb + n) + l15; const float gsv = gs[sl];
#pragma unroll
            for (int r = 0; r < 4; ++r) { const int tl = 16 * mt + 4 * lq + r; const float pv = (sl <= tl) ? pacc[n][r] * expf(gsv - Rt[tl]) : 0.f;
                *(LAS bf16_t*)(AP + tl * OC_STRIDE + sl * 2) = (bf16_t)f2bf(pv); } }
        { const float wq = expf(Rc - Rt[tq]);
          u32x4 o0, o1;
          o0.x = pk2(bflo(q0.x) * wq, bfhi(q0.x) * wq); o0.y = pk2(bflo(q0.y) * wq, bfhi(q0.y) * wq); o0.z = pk2(bflo(q0.z) * wq, bfhi(q0.z) * wq); o0.w = pk2(bflo(q0.w) * wq, bfhi(q0.w) * wq);
          o1.x = pk2(bflo(q1.x) * wq, bfhi(q1.x) * wq); o1.y = pk2(bflo(q1.y) * wq, bfhi(q1.y) * wq); o1.z = pk2(bflo(q1.z) * wq, bfhi(q1.z) * wq); o1.w = pk2(bflo(q1.w) * wq, bfhi(q1.w) * wq);
          *(LAS u32x4*)(AP + tq * OC_STRIDE + 128 + 32 * pq) = o0; *(LAS u32x4*)(AP + tq * OC_STRIDE + 128 + 32 * pq + 16) = o1; }
        __syncthreads();
        { float s = 0.f;
#pragma unroll
          for (int q = 0; q < 3; ++q) { const u32x4 a = *(const LAS u32x4*)(AP + tq * OC_STRIDE + 48 * pq + 16 * q); const LAS f32x4* bp = (const LAS f32x4*)(bvec + 24 * pq + 8 * q); const f32x4 b0 = bp[0], b1 = bp[1];
              s += bflo(a.x) * b0[0] + bfhi(a.x) * b0[1] + bflo(a.y) * b0[2] + bfhi(a.y) * b0[3] + bflo(a.z) * b1[0] + bfhi(a.z) * b1[1] + bflo(a.w) * b1[2] + bfhi(a.w) * b1[3]; }
          s += __shfl_xor(s, 1); s += __shfl_xor(s, 2); s += __shfl_xor(s, 4);
          if (pq == 0) inv[tq] = 1.0f / fmaxf(fabsf(s), emm[tq]); }
        f32x4 acc[4][2];
#pragma unroll
        for (int m = 0; m < 4; ++m)
#pragma unroll
            for (int n = 0; n < 2; ++n) acc[m][n] = (f32x4){0.f, 0.f, 0.f, 0.f};
#pragma unroll
        for (int kk = 0; kk < 6; ++kk) {
            bf16x8 af[4];
#pragma unroll
            for (int m = 0; m < 4; ++m) af[m] = *(const LAS bf16x8*)(AP + (16 * m + l15) * OC_STRIDE + 64 * kk + 16 * lq);
#pragma unroll
            for (int m = 0; m < 4; ++m)
#pragma unroll
                for (int n = 0; n < 2; ++n) acc[m][n] = __builtin_amdgcn_mfma_f32_16x16x32_bf16(af[m], __builtin_bit_cast(bf16x8, bfr[n][kk]), acc[m][n], 0, 0, 0);
        }
        __syncthreads();
#pragma unroll
        for (int m = 0; m < 4; ++m)
#pragma unroll
            for (int r = 0; r < 4; ++r) { const int tl = 16 * m + 4 * lq + r; const float iv = inv[tl];
                const float h0 = acc[m][0][r] * iv, h1 = acc[m][1][r] * iv; acc[m][0][r] = h0; acc[m][1][r] = h1;
                float s = h0 * h0 + h1 * h1; s += __shfl_xor(s, 1); s += __shfl_xor(s, 2); s += __shfl_xor(s, 4); s += __shfl_xor(s, 8);
                if (l15 == 0) part[w * 64 + tl] = s; }
        __syncthreads();
        if (tid < 64) { float s = 0.f;
#pragma unroll
            for (int ww = 0; ww < 8; ++ww) s += part[ww * 64 + tid];
            rsA[tid] = 1.0f / sqrtf(s * (1.0f / DV) + EPS); }
        __syncthreads();
#pragma unroll
        for (int n = 0; n < 2; ++n) { const int col = h * DV + 32 * w + 16 * n + l15; const float ng = F.in[I_MNG][col];
#pragma unroll
            for (int m = 0; m < 4; ++m)
#pragma unroll
                for (int r = 0; r < 4; ++r) { const int tl = 16 * m + 4 * lq + r; const size_t o = (size_t)(tk0 + tl) * MV + col;
                    HN[o] = (bf16_t)f2bf(acc[m][n][r] * rsA[tl] * ng * bf2f(OGS[o])); } }
    }
    __syncthreads();
}

__device__ __forceinline__ void phase_conv(Frame& F) {
    const bf16_t* BG = (const bf16_t*)(F.ws + WS_BG); const bf16_t* Z = (const bf16_t*)(F.ws + WS_Z); bf16_t* Y = (bf16_t*)(F.ws + WS_Y);
    const int cg = F.tid & 127, rsub = F.tid >> 7, col = 8 * cg;
    float w0[8], w1[8], w2[8], cb[8];
#pragma unroll
    for (int i = 0; i < 8; ++i) { w0[i] = F.in[I_CCW][col + i]; w1[i] = F.in[I_CCW][D + col + i]; w2[i] = F.in[I_CCW][2 * D + col + i]; cb[i] = F.in[I_CCB][col + i]; }
    for (int batch = F.vcu; batch < T / 128; batch += F.G) {
        const int t0 = batch * 128 + rsub * 32, s0 = t0 % SEQ;
        u32x4 z2 = (u32x4){0u, 0u, 0u, 0u}, z1 = z2;
        if (s0 >= 2) z2 = *(const u32x4*)(Z + (size_t)(t0 - 2) * D + col);
        if (s0 >= 1) z1 = *(const u32x4*)(Z + (size_t)(t0 - 1) * D + col);
#pragma unroll 4
        for (int r = 0; r < 32; ++r) {
            const u32x4 z0 = *(const u32x4*)(Z + (size_t)(t0 + r) * D + col), bg = *(const u32x4*)(BG + (size_t)(t0 + r) * D + col);
            float o[8];
#pragma unroll
            for (int i = 0; i < 4; ++i) {
                o[2 * i] = bflo(bg[i]) * (w0[2 * i] * bflo(z2[i]) + w1[2 * i] * bflo(z1[i]) + w2[2 * i] * bflo(z0[i]) + cb[2 * i]);
                o[2 * i + 1] = bfhi(bg[i]) * (w0[2 * i + 1] * bfhi(z2[i]) + w1[2 * i + 1] * bfhi(z1[i]) + w2[2 * i + 1] * bfhi(z0[i]) + cb[2 * i + 1]); }
            u32x4 ov; ov.x = pk2(o[0], o[1]); ov.y = pk2(o[2], o[3]); ov.z = pk2(o[4], o[5]); ov.w = pk2(o[6], o[7]);
            *(u32x4*)(Y + (size_t)(t0 + r) * D + col) = ov;
            z2 = z1; z1 = z0;
        }
    }
}

__device__ __forceinline__ void moe_table(Frame& F, int layer) {
    __syncthreads();
    if (F.tid == 0) { int a = 0; for (int e = 0; e < NE; ++e) { const int c = (int)__hip_atomic_load(F.ctl + CW_CNT + 64 * layer + e, RLX_AGENT); F.MISC[16 + e] = (unsigned)a; F.MISC[40 + e] = (unsigned)c; a += (c + 255) >> 8; } F.MISC[16 + NE] = (unsigned)a; }
    __syncthreads();
}

constexpr int N_PHASES = 17;
#define WSP(T_, off) ((T_*)(F.ws + (off)))
__global__ void __launch_bounds__(NTHR, 2) fwd_kernel(Args args) {
    extern __shared__ __attribute__((aligned(16))) unsigned char lds_raw[];
#define MAKE_FRAME() Frame F; { int t_ = threadIdx.x, bx_ = blockIdx.x, g_ = gridDim.x; asm volatile("" : "+v"(t_), "+s"(bx_), "+s"(g_)); \
        F.lds = (LAS unsigned char*)lds_raw; F.MISC = (volatile LAS unsigned*)(F.lds + MISC_OFF); F.tid = t_; F.lane = t_ & 63; F.wave = __builtin_amdgcn_readfirstlane(t_ >> 6); \
        F.G = g_; F.bx = bx_; F.vcu = (g_ % 8 == 0) ? (bx_ % 8) * (g_ / 8) + bx_ / 8 : bx_; }
    const int lo = args.ph_lo, hi = args.ph_hi;
    const bool one_launch = (hi - lo) > 1;
    XcdBarrier bar;
    { MAKE_FRAME();
      for (int u = F.tid; u < 256; u += NTHR) F.MISC[u] = 0u;
      __syncthreads();
      bar.bar = (unsigned*)(F.ctl + CW_BAR); bar.x = 0; bar.st = nullptr;
      if (one_launch) bar = xcd_barrier_post((unsigned*)(F.ctl + CW_BAR), F.MISC + 8); }
#ifdef PH_ONLY
#define IN(k) ((k) == PH_ONLY && lo <= (k) && (k) < hi)
#else
#define IN(k) (lo <= (k) && (k) < hi)
#endif
#define SEAM(k) do { if (IN(k) && IN((k) + 1)) xcd_barrier(bar); } while (0)
#define PHASE(k) if (IN(k)) { MAKE_FRAME(); asm volatile("; PHASE_MARK " #k);
#define END_PHASE(k) } SEAM(k);
    PHASE(0) phase_prologue(F); END_PHASE(0)
    PHASE(1) row_pass<0>(F, 0); END_PHASE(1)
    PHASE(2) pg8::Gemm g{WSP(bf16_t, WS_U), WSP(bf16_t, WS_W0), D}; pg8::DenseOrder S; S.init(T, 3 * D, F.G, F.bx);
        pg8::EpiM1 E{WSP(bf16_t, WS_Q), WSP(bf16_t, WS_K), WSP(bf16_t, WS_KT), WSP(bf16_t, WS_VT), WSP(bf16_t, WS_OGS)};
        pg8::gemm_phase<pg8::EpiM1, pg8::DenseOrder, false, true, true>(F.lds, g, S, E, F.tid); END_PHASE(2)
    PHASE(3) phase_scan(F); END_PHASE(3)
    PHASE(4) phase_out(F); END_PHASE(4)
    PHASE(5) pg8::Gemm g{WSP(bf16_t, WS_U), WSP(bf16_t, WS_W1), D}; pg8::DenseOrder S; S.init(T, D, F.G, F.bx);
        pg8::EpiRes E{F.in[I_X], F.out, WSP(float, WS_MOD) + 2 * D, (DBG_SKIP & 1) ? 0.f : 1.f};
        pg8::gemm_phase<pg8::EpiRes, pg8::DenseOrder, false, true, true>(F.lds, g, S, E, F.tid); END_PHASE(5)
#define MOE_BLOCK(L, p0, p1, p2) \
    PHASE(p0) row_pass<1>(F, L); END_PHASE(p0) \
    PHASE(p1) moe_table(F, L); \
        pg8::Gemm g{WSP(bf16_t, WS_U), WSP(bf16_t, WS_WUP), D}; pg8::MoeOrder S{(const LAS int*)(F.MISC + 16), (const LAS int*)(F.MISC + 40), WSP(const int, WS_LIST), F.G, F.vcu, 1024}; \
        pg8::EpiGlu<true> E{WSP(bf16_t, WS_A), DE, 0, nullptr, 0}; \
        pg8::gemm_phase<pg8::EpiGlu<true>, pg8::MoeOrder, true, true, true>(F.lds, g, S, E, F.tid); END_PHASE(p1) \
    PHASE(p2) moe_table(F, L); \
        pg8::Gemm g{WSP(bf16_t, WS_A), WSP(bf16_t, WS_WDN), DE}; pg8::MoeOrder S{(const LAS int*)(F.MISC + 16), (const LAS int*)(F.MISC + 40), WSP(const int, WS_LIST), F.G, F.vcu, 1024}; \
        pg8::EpiBf E{WSP(bf16_t, WS_O), D}; \
        pg8::gemm_phase<pg8::EpiBf, pg8::MoeOrder, false, true, true>(F.lds, g, S, E, F.tid); END_PHASE(p2)
    MOE_BLOCK(0, 6, 7, 8)
    PHASE(9) row_pass<2>(F, 1); convert_weights(F, 1); END_PHASE(9)
    PHASE(10) pg8::Gemm g{WSP(bf16_t, WS_U), WSP(bf16_t, WS_W0), D}; pg8::DenseOrder S; S.init(T, 3 * D, F.G, F.bx);
        pg8::EpiGlu<false> E{WSP(bf16_t, WS_Z), D, 4, WSP(bf16_t, WS_BG), D};
        pg8::gemm_phase<pg8::EpiGlu<false>, pg8::DenseOrder, false, true, true>(F.lds, g, S, E, F.tid); END_PHASE(10)
    PHASE(11) phase_conv(F); END_PHASE(11)
    PHASE(12) pg8::Gemm g{WSP(bf16_t, WS_Y), WSP(bf16_t, WS_W1), D}; pg8::DenseOrder S; S.init(T, D, F.G, F.bx);
        pg8::EpiRes E{F.out, F.out, WSP(float, WS_MOD) + (size_t)NB * 6 * D + 2 * D, (DBG_SKIP & 4) ? 0.f : 1.f};
        pg8::gemm_phase<pg8::EpiRes, pg8::DenseOrder, false, true, true>(F.lds, g, S, E, F.tid); END_PHASE(12)
    MOE_BLOCK(1, 13, 14, 15)
    if (IN(16)) { MAKE_FRAME(); asm volatile("; PHASE_MARK 16"); row_pass<3>(F, 1);
#ifdef DBG_PROBE
        if (F.bx == 0 && F.tid == 0) { float val = 0.f;
            if (DBG_PROBE == 1) { unsigned s = 0; for (int e = 0; e < NE; ++e) s += __hip_atomic_load(F.ctl + CW_CNT + e, RLX_AGENT); val = 100.f * (float)s / 65536.f; }
            if (DBG_PROBE == 2) { const bf16_t* A = WSP(bf16_t, WS_A); int nz = 0; for (int i = 0; i < 4096; ++i) nz += (A[(size_t)i * 977 % ((size_t)65536 * DE)] != 0xAAAA) ? 1 : 0; val = 100.f * nz / 4096.f; }
            if (DBG_PROBE == 3) { const bf16_t* O = WSP(bf16_t, WS_O); int nz = 0; for (int i = 0; i < 4096; ++i) nz += (O[(size_t)i * 9973 % ((size_t)65536 * D)] != 0xAAAA) ? 1 : 0; val = 100.f * nz / 4096.f; }
            if (DBG_PROBE == 4) { const unsigned* TK = WSP(unsigned, WS_TOK); float s = 0.f; for (int i = 0; i < 1024; ++i) s += __builtin_bit_cast(float, TK[(size_t)i * 31 * 4 + 2]) + __builtin_bit_cast(float, TK[(size_t)i * 31 * 4 + 3]); val = 100.f * s / 1024.f; }
            if (DBG_PROBE == 5) { const bf16_t* O = WSP(bf16_t, WS_O); float s = 0.f; for (int i = 0; i < 4096; ++i) { const float v = bf2f(O[(size_t)i * 9973 % ((size_t)65536 * D)]); s += v * v; } val = 100.f * sqrtf(s / 4096.f); }
            if (DBG_PROBE == 6) { const float* M = WSP(float, WS_MOD); float s = 0.f; for (int i = 0; i < 1024; ++i) { const float v = M[5 * D + i]; s += v * v; } val = 100.f * sqrtf(s / 1024.f); }
            if (DBG_PROBE == 7) { const unsigned* TK = WSP(unsigned, WS_TOK); const unsigned a = TK[4 * 12345], b2 = TK[4 * 12345 + 1]; val = (float)((a >> 16) * 16 + (b2 >> 16)) + 1000.f * (float)((a & 0xffff) > 32768u); }
            if (DBG_PROBE == 8 || DBG_PROBE == 9) { const unsigned* TK = WSP(unsigned, WS_TOK); const bf16_t* O = WSP(bf16_t, WS_O); float s = 0.f; int bad = 0;
                int tp[NE + 1]; { int a = 0; for (int e = 0; e < NE; ++e) { tp[e] = a; a += ((int)__hip_atomic_load(F.ctl + CW_CNT + 64 + e, RLX_AGENT) + 255) >> 8; } tp[NE] = a; }
                for (int i = 0; i < 256; ++i) { const int t = i * 127; const unsigned a = TK[4 * t]; const int e0 = a >> 16, p0 = a & 0xffff; int tpe = 0; for (int e = 0; e < NE; ++e) if (e == e0) tpe = tp[e];
                    const int s0 = tpe * 256 + p0; if (e0 >= NE || s0 >= 69632) { ++bad; continue; } for (int c = 0; c < 16; ++c) { const float v = bf2f(O[(size_t)s0 * D + c * 61]); s += v * v; } }
                val = (DBG_PROBE == 8) ? 100.f * sqrtf(s / 4096.f) : (float)bad; }
            if (DBG_PROBE >= 100) { const float* dbg = (const float*)(F.ws + 60 * MiB); val = 1000.f * dbg[DBG_PROBE - 100]; }
            float* o = F.out; o[0] = val; }
#endif
    }
#undef IN
#undef SEAM
}

extern "C" void kernel_launch(void* const* d_in, const int* in_sizes, int n_in, void* d_out, int out_size, void* d_ws, size_t ws_size, hipStream_t stream) {
    static int grid = 0;
    if (grid == 0) {
        if (n_in != 20 || in_sizes[0] != T * D || out_size != T * D || ws_size < WS_END) { fprintf(stderr, "kernel_launch: unexpected shapes: n_in %d in0 %d out %d ws %zu\n", n_in, n_in > 0 ? in_sizes[0] : -1, out_size, ws_size); grid = -1; return; }
        int dev = 0, cus = 0, per_cu = 0;
        if (hipGetDevice(&dev) != hipSuccess || hipDeviceGetAttribute(&cus, hipDeviceAttributeMultiprocessorCount, dev) != hipSuccess) { grid = -1; return; }
        if (hipFuncSetAttribute((const void*)fwd_kernel, hipFuncAttributeMaxDynamicSharedMemorySize, LDS_BYTES) != hipSuccess) { fprintf(stderr, "kernel_launch: hipFuncSetAttribute failed\n"); grid = -1; return; }
        if (hipOccupancyMaxActiveBlocksPerMultiprocessor(&per_cu, (const void*)fwd_kernel, NTHR, LDS_BYTES) != hipSuccess || per_cu < 1) { fprintf(stderr, "kernel_launch: occupancy query says %d blocks per CU\n", per_cu); (void)hipGetLastError(); grid = -1; return; }
        grid = cus;
        if (grid != 256) fprintf(stderr, "kernel_launch: %d CUs (built for 256)\n", grid);
    }
    if (grid < 0) return;
    (void)hipMemsetAsync((char*)d_ws + WS_CTL, 0, CTL_ZERO_BYTES, stream);
    Args a{};
    for (int i = 0; i < 20; ++i) a.in[i] = (const float*)d_in[i];
    a.out = (float*)d_out; a.ws = (unsigned char*)d_ws;
#if MK_N_LAUNCHES == 1
    a.ph_lo = 0; a.ph_hi = N_PHASES;
    void* kargs[] = {&a};
    hipError_t e = hipLaunchCooperativeKernel((const void*)fwd_kernel, dim3(grid), dim3(NTHR), kargs, LDS_BYTES, stream);
    if (e != hipSuccess) fprintf(stderr, "kernel_launch: cooperative launch failed: %s\n", hipGetErrorString(e));
#else
    for (int p = 0; p < N_PHASES; ++p) { a.ph_lo = p; a.ph_hi = p + 1; hipLaunchKernelGGL(fwd_kernel, dim3(grid), dim3(NTHR), LDS_BYTES, stream, a); }
#endif
}
```

```cpp
#include <hip/hip_runtime.h>
#include <cstdio>
#include <cstdint>

#ifndef DBG_SKIP
#define DBG_SKIP 0
#endif
#ifndef MK_N_LAUNCHES
#define MK_N_LAUNCHES 1
#endif

#define LAS __attribute__((address_space(3)))
#define GAS __attribute__((address_space(1)))
typedef unsigned short bf16_t;
typedef short bf16x8 __attribute__((ext_vector_type(8)));
typedef float f32x4 __attribute__((ext_vector_type(4)));
typedef float f32x2 __attribute__((ext_vector_type(2)));
typedef unsigned u32x4 __attribute__((ext_vector_type(4)));
typedef unsigned u32x2 __attribute__((ext_vector_type(2)));
typedef GAS unsigned gu32;
#define RLX_AGENT __ATOMIC_RELAXED, __HIP_MEMORY_SCOPE_AGENT
#define LDS_WAIT() asm volatile("s_waitcnt lgkmcnt(0)" ::: "memory")
#define VM_WAIT() asm volatile("s_waitcnt vmcnt(0)" ::: "memory")

constexpr int NB = 4, SEQ = 8192, D = 1024, T = NB * SEQ;
constexpr int NH = 4, DK = 128, DV = 256, MQK = NH * DK, MV = NH * DV, MPROJ = 2 * MQK + 2 * MV + 2 * NH;
constexpr int CH = 64, NCH = SEQ / CH;
constexpr int NE = 16, DE = 512, LCAP = 65536;
constexpr int SLOT_ROWS = 2 * T + NE * 256;
constexpr float EPS = 1e-6f;
constexpr int NWAVES = 8, NTHR = 512;

constexpr size_t MiB = 1u << 20;
constexpr size_t WS_CTL = 0, CTL_ZERO_BYTES = 64 * 1024;
constexpr size_t WS_MOD = 1 * MiB;
constexpr size_t WS_W0 = 2 * MiB;
constexpr size_t WS_W1 = 8 * MiB;
constexpr size_t WS_WUP = 10 * MiB;
constexpr size_t WS_WDN = 42 * MiB;
constexpr size_t WS_WL1 = 338 * MiB;
constexpr size_t WS_IG = 62 * MiB;
constexpr size_t WS_LF = WS_IG + 512 * 1024;
constexpr size_t WS_GA = WS_LF + 512 * 1024;
constexpr size_t WS_RR = WS_GA + 512 * 1024;
constexpr size_t WS_MM = WS_RR + 512 * 1024;
constexpr size_t WS_RC = WS_MM + 512 * 1024;
constexpr size_t WS_NS = 65 * MiB;
constexpr size_t WS_TOK = 66 * MiB;
constexpr size_t WS_LIST = 67 * MiB;
constexpr size_t WS_U = 72 * MiB;
constexpr size_t WS_Q = 136 * MiB;
constexpr size_t WS_K = 168 * MiB;
constexpr size_t WS_KT = 200 * MiB;
constexpr size_t WS_VT = 232 * MiB;
constexpr size_t WS_OGS = 296 * MiB;
constexpr size_t WS_ST = 360 * MiB;
constexpr size_t WS_A = 136 * MiB;
constexpr size_t WS_O = 204 * MiB;
constexpr size_t WS_BG = 136 * MiB;
constexpr size_t WS_Z = 200 * MiB;
constexpr size_t WS_Y = 264 * MiB;
constexpr size_t WS_END = 488 * MiB;
static_assert(WS_A + (size_t)SLOT_ROWS * DE * 2 <= WS_O && WS_O + (size_t)SLOT_ROWS * D * 2 <= WS_ST, "moe map");

constexpr int CW_CNT = 64;
constexpr int CW_CVT = 256;
constexpr int CW_BAR = 1024;

constexpr int RING_BYTES = 131072;
constexpr int MISC_OFF = RING_BYTES;
constexpr int LDS_BYTES = 147456;

typedef __bf16 bf16x2_t __attribute__((ext_vector_type(2)));
__device__ __forceinline__ unsigned f2bf(float f) { return (unsigned)__builtin_bit_cast(unsigned short, (__bf16)f); }
__device__ __forceinline__ unsigned pk2(float lo, float hi) { bf16x2_t v; v[0] = (__bf16)lo; v[1] = (__bf16)hi; return __builtin_bit_cast(unsigned, v); }
__device__ __forceinline__ float bf2f(unsigned short h) { return __builtin_bit_cast(float, (unsigned)h << 16); }
__device__ __forceinline__ float bflo(unsigned w) { return __builtin_bit_cast(float, w << 16); }
__device__ __forceinline__ float bfhi(unsigned w) { return __builtin_bit_cast(float, w & 0xffff0000u); }
__device__ __forceinline__ unsigned cvt_pk_bf16(float lo, float hi) { unsigned r; asm volatile("v_cvt_pk_bf16_f32 %0, %1, %2" : "=v"(r) : "v"(lo), "v"(hi)); return r; }
__device__ __forceinline__ float fast_exp(float x) { return __builtin_amdgcn_exp2f(x * 1.44269504089f); }
__device__ __forceinline__ float sigmoidf_(float x) { return __builtin_amdgcn_rcpf(1.0f + fast_exp(-x)); }

namespace pg8 {
constexpr int BM = 256, BK = 64, HALF = 128, HTB = HALF * BK * 2, STAGE_BYTES = 8 * HTB, NXCD = 8, WGM = 8;
__host__ __device__ __forceinline__ int lds_byte(int r, int c) { const int st = (r >> 4) * 2 + (c >> 5), rr = r & 15, cc = c & 31, ob = rr * 64 + cc * 2; return st * 1024 + (ob ^ (((ob >> 9) & 1) << 5)); }
__host__ __device__ __forceinline__ void stage_rc(int b, int& R, int& C) { const int st = b / 1024, sb = b % 1024, swz = sb ^ (((sb >> 9) & 1) << 5); R = (st >> 1) * 16 + swz / 64; C = (st & 1) * 32 + (swz % 64) / 2; }
__host__ __device__ __forceinline__ int perm32(int rho) { const int n = rho >> 4, i = rho & 15; return 8 * (i >> 2) + 4 * n + (i & 3); }

struct Unit { int arow0, brow0, pm, pn, e, nvalid; const int* alist; };
struct Gemm { const bf16_t* A; const bf16_t* Bt; int K; };

struct DenseOrder {
    int nM, nN, nwg, G, c;
    __device__ void init(int M, int N, int G_, int c_) { nM = M / BM; nN = N / BM; nwg = nM * nN; G = G_; c = c_; }
    __device__ bool next(int i, Unit& u) const {
        const long L = (long)i * G + c; if (L >= nwg) return false;
        int wgid = (int)L; { const int q = nwg / NXCD, r = nwg % NXCD, xcd = wgid % NXCD, off = wgid / NXCD; wgid = (xcd < r ? xcd * (q + 1) : r * (q + 1) + (xcd - r) * q) + off; }
        const int nig = WGM * nN, gid = wgid / nig, fm = gid * WGM, gsz = (nM - fm) < WGM ? (nM - fm) : WGM;
        u.pm = fm + ((wgid % nig) % gsz); u.pn = (wgid % nig) / gsz; u.arow0 = u.pm * BM; u.brow0 = u.pn * BM; u.e = 0; u.nvalid = 256; u.alist = nullptr; return true;
    }
};
struct MoeOrder {
    const LAS int* tpre; const LAS int* cnt; const int* list; int G, vcu, bn;
    __device__ bool next(int i, Unit& u) const {
        const int U = i * G + vcu, rt = U >> 2, pn = U & 3;
        if (rt >= tpre[NE]) return false;
        int e = 0;
#pragma unroll
        for (int k = 1; k < NE; ++k) e += (rt >= tpre[k]) ? 1 : 0;
        const int r = rt - tpre[e];
        u.arow0 = rt * BM; u.brow0 = e * bn + pn * BM; u.pm = rt; u.pn = pn; u.e = e; u.nvalid = min(256, cnt[e] - r * 256); u.alist = list + e * LCAP + r * 256; return true;
    }
};

template <class Epi, class Sched, bool GATHER, bool ALIGN_EPI, bool SP2>
__device__ __forceinline__ void gemm_phase(LAS unsigned char* lds, const Gemm g, const Sched& S, const Epi& E, const int tid) {
    const int wid = __builtin_amdgcn_readfirstlane(tid >> 6), lane = tid & 63, wr = wid >> 2, wc = wid & 3, fr = lane & 15, fq = lane >> 4;
    const int K = g.K, nt = K / BK;
    unsigned voffA[2], voffB[2];
#pragma unroll
    for (int i = 0; i < 2; ++i) { int R, C; stage_rc(tid * 16 + i * 8192, R, C); const int Rb = Epi::PERM ? ((R & ~31) + perm32(R & 31)) : R;
        voffA[i] = (unsigned)(R * K + C) * 2u; voffB[i] = (unsigned)(Rb * K + C) * 2u; }
    const size_t kstep = (size_t)(BK * 2);
    const size_t hstep = (size_t)HALF * K * 2;
    const unsigned ldsw = (unsigned)wid * 1024u;
    const int aoff = lds_byte(wr * 64 + fr, fq * 8), boff = lds_byte(wc * 32 + fr, fq * 8);
#define PG8_SA(b, h) (((b) * 2 + (h)) * HTB)
#define PG8_SB(b, h) ((4 + (b) * 2 + (h)) * HTB)
#define PG8_STAGE(bufoff, gbase, voff) do { _Pragma("unroll") for (int _i = 0; _i < 2; ++_i) \
        __builtin_amdgcn_global_load_lds((const unsigned*)((const char*)(gbase) + (voff)[_i]), (LAS unsigned*)(lds + (bufoff) + ldsw + _i * 8192), 16, 0, 0); } while (0)
#define PG8_STAGE_A(bufoff, kb, h, vo) do { if constexpr (GATHER) { PG8_STAGE(bufoff, kb, (vo)[h]); } else { PG8_STAGE(bufoff, (kb) + (h) * hstep, voffA); } } while (0)
#define PG8_LDA(dst, b, h) do { _Pragma("unroll") for (int m = 0; m < 4; ++m) _Pragma("unroll") for (int k = 0; k < 2; ++k) dst[m][k] = *(const LAS bf16x8*)(lds + PG8_SA(b, h) + aoff + m * 2048 + k * 1024); } while (0)
#define PG8_LDB(dst, b, h) do { _Pragma("unroll") for (int n = 0; n < 2; ++n) _Pragma("unroll") for (int k = 0; k < 2; ++k) dst[n][k] = *(const LAS bf16x8*)(lds + PG8_SB(b, h) + boff + n * 2048 + k * 1024); } while (0)
#define PG8_MMA(ai, bj, At, Bt) do { __builtin_amdgcn_s_setprio(1); _Pragma("unroll") for (int m = 0; m < 4; ++m) _Pragma("unroll") for (int n = 0; n < 2; ++n) _Pragma("unroll") for (int k = 0; k < 2; ++k) \
        acc[ai][bj][m][n] = __builtin_amdgcn_mfma_f32_16x16x32_bf16(Bt[n][k], At[m][k], acc[ai][bj][m][n], 0, 0, 0); __builtin_amdgcn_s_setprio(0); } while (0)
#define PG8_WAIT_V(n) asm volatile("s_waitcnt vmcnt(" #n ")" ::: "memory")
#define PG8_WAIT_L(n) asm volatile("s_waitcnt lgkmcnt(" #n ")" ::: "memory")
#define PG8_BAR __builtin_amdgcn_s_barrier()
#define PG8_SCHED __builtin_amdgcn_sched_barrier(0)
    Unit cur, nxt; int ui = 0;
    if (!S.next(0, cur)) return;
    f32x4 acc[2][2][4][2];
#pragma unroll
    for (int a = 0; a < 2; ++a)
#pragma unroll
        for (int b = 0; b < 2; ++b)
#pragma unroll
            for (int m = 0; m < 4; ++m)
#pragma unroll
                for (int n = 0; n < 2; ++n) acc[a][b][m][n] = (f32x4){0.f, 0.f, 0.f, 0.f};
    bf16x8 At[4][2], B0[2][2], B1[2][2];
    unsigned vg[2][2];
#define PG8_GATHER(u) do { _Pragma("unroll") for (int _h = 0; _h < 2; ++_h) _Pragma("unroll") for (int _i = 0; _i < 2; ++_i) { int _R, _C; stage_rc(tid * 16 + _i * 8192, _R, _C); \
        const int _r = _h * HALF + _R; const int _tok = (_r < (u).nvalid) ? (u).alist[_r] : 0; vg[_h][_i] = (unsigned)(_tok * K + _C) * 2u; } } while (0)
    const char* cA; const char* cB = (const char*)g.Bt + (size_t)cur.brow0 * K * 2;
    if constexpr (GATHER) { cA = (const char*)g.A; PG8_GATHER(cur); } else { cA = (const char*)g.A + (size_t)cur.arow0 * K * 2;
#pragma unroll
        for (int h = 0; h < 2; ++h)
#pragma unroll
            for (int i = 0; i < 2; ++i) vg[h][i] = 0u; }
    if constexpr (SP2) {
        PG8_STAGE(PG8_SB(0, 0), cB, voffB); PG8_STAGE(PG8_SB(0, 1), cB + hstep, voffB); PG8_STAGE_A(PG8_SA(0, 0), cA, 0, vg); PG8_STAGE_A(PG8_SA(0, 1), cA, 1, vg);
        if (wr == 1) PG8_BAR;
        PG8_WAIT_V(2); PG8_BAR;
        PG8_STAGE(PG8_SB(1, 0), cB + kstep, voffB); PG8_STAGE_A(PG8_SA(1, 0), cA + kstep, 0, vg); PG8_STAGE(PG8_SB(1, 1), cB + hstep + kstep, voffB);
        PG8_WAIT_V(6); PG8_BAR;
    } else {
        PG8_STAGE(PG8_SB(0, 0), cB, voffB); PG8_STAGE_A(PG8_SA(0, 0), cA, 0, vg); PG8_STAGE(PG8_SB(0, 1), cB + hstep, voffB); PG8_STAGE_A(PG8_SA(0, 1), cA, 1, vg);
        if (wr == 1) PG8_BAR;
        PG8_WAIT_V(4); PG8_BAR;
        PG8_STAGE(PG8_SB(1, 0), cB + kstep, voffB); PG8_STAGE_A(PG8_SA(1, 0), cA + kstep, 0, vg); PG8_STAGE(PG8_SB(1, 1), cB + hstep + kstep, voffB);
        PG8_WAIT_V(6); PG8_BAR;
    }
    for (;;) {
        const bool has_next = S.next(ui + 1, nxt);
        const char* nA; const char* nB = has_next ? (const char*)g.Bt + (size_t)nxt.brow0 * K * 2 : cB;
        if constexpr (GATHER) nA = cA; else nA = has_next ? (const char*)g.A + (size_t)nxt.arow0 * K * 2 : cA;
        for (int t = 0; t < nt; t += 2) {
            const bool last = (t == nt - 2);
            const char* a1 = cA + (size_t)(t + 1) * kstep;
            const char* a2 = last ? nA : cA + (size_t)(t + 2) * kstep; const char* b2 = last ? nB : cB + (size_t)(t + 2) * kstep;
            const char* a3 = a2 + kstep; const char* b3 = b2 + kstep;
            if constexpr (SP2) {
            PG8_LDB(B0, 0, 0); PG8_LDB(B1, 0, 1); PG8_SCHED; PG8_LDA(At, 0, 0); PG8_STAGE_A(PG8_SA(1, 1), a1, 1, vg);
            if constexpr (GATHER) { if (last && has_next) PG8_GATHER(nxt); }
            PG8_WAIT_V(8); PG8_WAIT_L(0); PG8_BAR; PG8_MMA(0, 0, At, B0); PG8_MMA(0, 1, At, B1); PG8_BAR; PG8_SCHED;
            PG8_LDA(At, 0, 1); PG8_STAGE(PG8_SB(0, 0), b2, voffB); PG8_STAGE(PG8_SB(0, 1), b2 + hstep, voffB); PG8_STAGE_A(PG8_SA(0, 0), a2, 0, vg);
            PG8_WAIT_V(8); PG8_WAIT_L(0); PG8_BAR; PG8_MMA(1, 0, At, B0); PG8_MMA(1, 1, At, B1); PG8_BAR; PG8_SCHED;
            PG8_LDB(B0, 1, 0); PG8_LDB(B1, 1, 1); PG8_SCHED; PG8_LDA(At, 1, 0); PG8_STAGE_A(PG8_SA(0, 1), a2, 1, vg);
            PG8_WAIT_V(8); PG8_WAIT_L(0); PG8_BAR; PG8_MMA(0, 0, At, B0); PG8_MMA(0, 1, At, B1); PG8_BAR; PG8_SCHED;
            PG8_LDA(At, 1, 1); PG8_STAGE(PG8_SB(1, 0), b3, voffB); PG8_STAGE(PG8_SB(1, 1), b3 + hstep, voffB); PG8_STAGE_A(PG8_SA(1, 0), a3, 0, vg);
            PG8_WAIT_V(8); PG8_WAIT_L(0); PG8_BAR; PG8_MMA(1, 0, At, B0); PG8_MMA(1, 1, At, B1); PG8_BAR; PG8_SCHED;
            } else {
            PG8_LDB(B0, 0, 0); PG8_SCHED; PG8_LDA(At, 0, 0); PG8_STAGE_A(PG8_SA(1, 1), a1, 1, vg);
            if constexpr (GATHER) { if (last && has_next) PG8_GATHER(nxt); }
            PG8_WAIT_L(8); PG8_BAR; PG8_WAIT_L(0); PG8_MMA(0, 0, At, B0); PG8_BAR; PG8_SCHED;
            PG8_LDB(B1, 0, 1); PG8_STAGE(PG8_SB(0, 0), b2, voffB);
            PG8_BAR; PG8_WAIT_L(0); PG8_MMA(0, 1, At, B1); PG8_BAR;
            PG8_LDA(At, 0, 1); PG8_STAGE_A(PG8_SA(0, 0), a2, 0, vg);
            PG8_BAR; PG8_WAIT_L(0); PG8_MMA(1, 0, At, B0); PG8_BAR; PG8_SCHED;
            PG8_STAGE(PG8_SB(0, 1), b2 + hstep, voffB);
            PG8_WAIT_V(6); PG8_BAR; PG8_MMA(1, 1, At, B1); PG8_BAR;
            PG8_LDB(B0, 1, 0); PG8_SCHED; PG8_LDA(At, 1, 0); PG8_STAGE_A(PG8_SA(0, 1), a2, 1, vg);
            PG8_WAIT_L(8); PG8_BAR; PG8_WAIT_L(0); PG8_MMA(0, 0, At, B0); PG8_BAR; PG8_SCHED;
            PG8_LDB(B1, 1, 1); PG8_STAGE(PG8_SB(1, 0), b3, voffB);
            PG8_BAR; PG8_WAIT_L(0); PG8_MMA(0, 1, At, B1); PG8_BAR;
            PG8_LDA(At, 1, 1); PG8_STAGE_A(PG8_SA(1, 0), a3, 0, vg);
            PG8_BAR; PG8_WAIT_L(0); PG8_MMA(1, 0, At, B0); PG8_BAR; PG8_SCHED;
            PG8_STAGE(PG8_SB(1, 1), b3 + hstep, voffB);
            PG8_WAIT_V(6); PG8_BAR; PG8_MMA(1, 1, At, B1); PG8_BAR;
            }
        }
        if constexpr (ALIGN_EPI) { if (wr == 0) PG8_BAR; }
        E(acc, cur, wr, wc, fr, fq);
        if (!has_next) break;
#pragma unroll
        for (int a = 0; a < 2; ++a)
#pragma unroll
            for (int b = 0; b < 2; ++b)
#pragma unroll
                for (int m = 0; m < 4; ++m)
#pragma unroll
                    for (int n = 0; n < 2; ++n) acc[a][b][m][n] = (f32x4){0.f, 0.f, 0.f, 0.f};
        cur = nxt; cA = nA; cB = nB; ++ui;
        if constexpr (ALIGN_EPI) { if (wr == 1) PG8_BAR; }
    }
    PG8_WAIT_V(0);
    if constexpr (!ALIGN_EPI) { if (wr == 0) PG8_BAR; }
    PG8_BAR;
#undef PG8_SA
#undef PG8_SB
#undef PG8_STAGE
#undef PG8_STAGE_A
#undef PG8_GATHER
#undef PG8_LDA
#undef PG8_LDB
#undef PG8_MMA
#undef PG8_WAIT_V
#undef PG8_WAIT_L
#undef PG8_BAR
#undef PG8_SCHED
}


struct EpiM1 {
    static constexpr bool PERM = true;
    bf16_t* Q; bf16_t* Kn; bf16_t* KT; bf16_t* VT; bf16_t* OGS;
    __device__ __forceinline__ void operator()(const f32x4 (&acc)[2][2][4][2], const Unit& u, int wr, int wc, int fr, int fq) const {
        const int row0 = u.arow0 + wr * 64 + fr, pn = u.pn;
        if (pn < 4 || pn >= 8) {
            bf16_t* base; int ldc, colt; float sc = 1.f; const bool sig = pn >= 8;
            if (pn < 2) { base = Q; ldc = MQK; colt = pn * 256; sc = 0.08838834764831845f; }
            else if (pn < 4) { base = Kn; ldc = MQK; colt = (pn - 2) * 256; }
            else { base = OGS; ldc = MV; colt = (pn - 8) * 256; }
            const int col0 = colt + wc * 32 + 8 * fq;
#pragma unroll
            for (int ai = 0; ai < 2; ++ai)
#pragma unroll
                for (int m = 0; m < 4; ++m) { bf16_t* rowp = base + (size_t)(row0 + ai * HALF + m * 16) * ldc + col0;
#pragma unroll
                    for (int bj = 0; bj < 2; ++bj) { f32x4 v0 = acc[ai][bj][m][0] * sc, v1 = acc[ai][bj][m][1] * sc;
                        if (sig) {
#pragma unroll
                            for (int j = 0; j < 4; ++j) { v0[j] = sigmoidf_(v0[j]); v1[j] = sigmoidf_(v1[j]); } }
                        u32x4 w; w.x = cvt_pk_bf16(v0[0], v0[1]); w.y = cvt_pk_bf16(v0[2], v0[3]); w.z = cvt_pk_bf16(v1[0], v1[1]); w.w = cvt_pk_bf16(v1[2], v1[3]);
                        *(u32x4*)(rowp + bj * HALF) = w; } }
        }
        if (pn >= 2 && pn < 8) {
            const int b = u.arow0 / SEQ, s0 = (u.arow0 % SEQ) + wr * 64;
            bf16_t* base; int colt, feat;
            if (pn < 4) { base = KT; colt = (pn - 2) * 256; feat = DK; } else { base = VT; colt = (pn - 4) * 256; feat = DV; }
#pragma unroll
            for (int ai = 0; ai < 2; ++ai) {
                const int ch = (s0 + ai * HALF) >> 6;
#pragma unroll
                for (int bj = 0; bj < 2; ++bj) {
                    const int col = colt + bj * HALF + wc * 32 + 8 * fq, hd = col / feat, f0 = col % feat;
                    bf16_t* xb = base + ((((size_t)(b * NH + hd) * NCH + ch) * feat + f0) << 6) + fr;
#pragma unroll
                    for (int m = 0; m < 4; ++m)
#pragma unroll
                        for (int n = 0; n < 2; ++n)
#pragma unroll
                            for (int j = 0; j < 4; ++j)
                                xb[((4 * n + j) << 6) + m * 16] = (bf16_t)f2bf(acc[ai][bj][m][n][j]);
                }
            }
        }
    }
};
struct EpiRes {
    static constexpr bool PERM = false;
    const float* base; float* out; const float* gate; float mul;
    __device__ __forceinline__ void operator()(const f32x4 (&acc)[2][2][4][2], const Unit& u, int wr, int wc, int fr, int fq) const {
        const int row0 = u.arow0 + wr * 64 + fr, col0 = u.pn * BM + wc * 32 + 4 * fq, b = u.arow0 / SEQ;
        f32x4 gv[2][2];
#pragma unroll
        for (int bj = 0; bj < 2; ++bj)
#pragma unroll
            for (int n = 0; n < 2; ++n) gv[bj][n] = *(const f32x4*)(gate + (size_t)b * 6 * D + col0 + bj * HALF + n * 16);
#pragma unroll
        for (int ai = 0; ai < 2; ++ai)
#pragma unroll
            for (int m = 0; m < 4; ++m) { const size_t off = (size_t)(row0 + ai * HALF + m * 16) * D + col0;
#pragma unroll
                for (int bj = 0; bj < 2; ++bj)
#pragma unroll
                    for (int n = 0; n < 2; ++n) { const f32x4 bs = *(const f32x4*)(base + off + bj * HALF + n * 16);
                        *(f32x4*)(out + off + bj * HALF + n * 16) = bs + gv[bj][n] * acc[ai][bj][m][n] * mul; } }
    }
};
struct EpiBf {
    static constexpr bool PERM = true;
    bf16_t* O; int ldc;
    __device__ __forceinline__ void operator()(const f32x4 (&acc)[2][2][4][2], const Unit& u, int wr, int wc, int fr, int fq) const {
        const int row0 = u.arow0 + wr * 64 + fr, col0 = u.pn * BM + wc * 32 + 8 * fq;
#pragma unroll
        for (int ai = 0; ai < 2; ++ai)
#pragma unroll
            for (int m = 0; m < 4; ++m) { bf16_t* rowp = O + (size_t)(row0 + ai * HALF + m * 16) * ldc + col0;
#pragma unroll
                for (int bj = 0; bj < 2; ++bj) { const f32x4 v0 = acc[ai][bj][m][0], v1 = acc[ai][bj][m][1];
                    u32x4 w; w.x = cvt_pk_bf16(v0[0], v0[1]); w.y = cvt_pk_bf16(v0[2], v0[3]); w.z = cvt_pk_bf16(v1[0], v1[1]); w.w = cvt_pk_bf16(v1[2], v1[3]);
                    *(u32x4*)(rowp + bj * HALF) = w; } }
    }
};
template <bool SILU> struct EpiGlu {
    static constexpr bool PERM = true;
    bf16_t* O; int ldc; int plain_tiles; bf16_t* P; int ldp;
    __device__ __forceinline__ void operator()(const f32x4 (&acc)[2][2][4][2], const Unit& u, int wr, int wc, int fr, int fq) const {
        const int row0 = u.arow0 + wr * 64 + fr;
        if (u.pn < plain_tiles) {
            const int col0 = u.pn * BM + wc * 32 + 8 * fq;
#pragma unroll
            for (int ai = 0; ai < 2; ++ai)
#pragma unroll
                for (int m = 0; m < 4; ++m) { bf16_t* rowp = P + (size_t)(row0 + ai * HALF + m * 16) * ldp + col0;
#pragma unroll
                    for (int bj = 0; bj < 2; ++bj) { const f32x4 v0 = acc[ai][bj][m][0], v1 = acc[ai][bj][m][1];
                        u32x4 w; w.x = cvt_pk_bf16(v0[0], v0[1]); w.y = cvt_pk_bf16(v0[2], v0[3]); w.z = cvt_pk_bf16(v1[0], v1[1]); w.w = cvt_pk_bf16(v1[2], v1[3]);
                        *(u32x4*)(rowp + bj * HALF) = w; } }
            return;
        }
        const int col0 = (u.pn - plain_tiles) * HALF + wc * 32 + 8 * fq;
#pragma unroll
        for (int ai = 0; ai < 2; ++ai)
#pragma unroll
            for (int m = 0; m < 4; ++m) { bf16_t* rowp = O + (size_t)(row0 + ai * HALF + m * 16) * ldc + col0;
                f32x4 v0 = acc[ai][0][m][0], v1 = acc[ai][0][m][1]; const f32x4 u0 = acc[ai][1][m][0], u1 = acc[ai][1][m][1];
                if (SILU) {
#pragma unroll
                    for (int j = 0; j < 4; ++j) { v0[j] = v0[j] * sigmoidf_(v0[j]); v1[j] = v1[j] * sigmoidf_(v1[j]); } }
                v0 = v0 * u0; v1 = v1 * u1;
                u32x4 w; w.x = cvt_pk_bf16(v0[0], v0[1]); w.y = cvt_pk_bf16(v0[2], v0[3]); w.z = cvt_pk_bf16(v1[0], v1[1]); w.w = cvt_pk_bf16(v1[2], v1[3]);
                *(u32x4*)rowp = w; }
    }
};
}

#define XB_TMO      128
#define XB_XCNT(j)  (256  + 64 * (j))
#define XB_XSUB(j)  (1280 + 64 * (j))
#define XB_XGEN(j)  (2304 + 64 * (j))
#define XB_TOP      3328
#define XB_TOPGEN   3392
#define XCD_BAR_WORDS 3456
#define XB_SPIN_CAP (1u << 18)
__device__ __forceinline__ unsigned xb_ld(unsigned* p)              { return __hip_atomic_load(p, __ATOMIC_RELAXED, __HIP_MEMORY_SCOPE_AGENT); }
__device__ __forceinline__ unsigned xb_add(unsigned* p, unsigned v) { return __hip_atomic_fetch_add(p, v, __ATOMIC_RELAXED, __HIP_MEMORY_SCOPE_AGENT); }
__device__ __forceinline__ unsigned xb_xcc_id() { return (unsigned)__builtin_amdgcn_s_getreg((3 << 11) | 20) & 0xFu; }
#define XB_SPIN(cond, bar) do { unsigned _sp = 0; while (cond) { __builtin_amdgcn_s_sleep(1); \
    if ((++_sp & 255u) == 0u) { if (xb_ld(&(bar)[XB_TMO])) break; if (_sp > XB_SPIN_CAP) { atomicAdd(&(bar)[XB_TMO], 1u); break; } } } } while (0)
struct XcdBarrier { unsigned* bar; unsigned x; volatile LAS unsigned* st; };
__device__ __forceinline__ XcdBarrier xcd_barrier_post(unsigned* bar, volatile LAS unsigned* st) {
    XcdBarrier b; b.bar = bar; b.x = xb_xcc_id(); b.st = st;
    if (threadIdx.x == 0) (void)xb_add(&bar[XB_XCNT(b.x)], 1u);
    return b;
}
__device__ __forceinline__ void xcd_barrier_complete(unsigned* bar, unsigned x, unsigned& nloc, unsigned& nx) {
    const unsigned G = gridDim.x * gridDim.y * gridDim.z;
    unsigned sum, cnt, mine, sp = 0u;
    for (;;) {
        sum = 0u; cnt = 0u; mine = 0u;
#pragma unroll
        for (unsigned j = 0; j < 16; ++j) { const unsigned c = xb_ld(&bar[XB_XCNT(j)]); sum += c; cnt += (c > 0u) ? 1u : 0u; mine = (j == x) ? c : mine; }
        if (sum == G) break;
        __builtin_amdgcn_s_sleep(1);
        if ((++sp & 255u) == 0u) { if (xb_ld(&bar[XB_TMO])) break; if (sp > XB_SPIN_CAP) { atomicAdd(&bar[XB_TMO], 1u); break; } }
    }
    nloc = mine > 0u ? mine : 1u; nx = cnt > 0u ? cnt : 1u;
}
__device__ __forceinline__ void xcd_barrier(const XcdBarrier& b) {
    asm volatile("s_waitcnt vmcnt(0)" ::: "memory");
    __syncthreads();
    if (threadIdx.x == 0) {
        unsigned* bar = b.bar;
        __builtin_amdgcn_s_waitcnt(0);
        unsigned nloc = b.st[0], nx = b.st[1];
        if (nloc == 0u) { xcd_barrier_complete(bar, b.x, nloc, nx); b.st[0] = nloc; b.st[1] = nx; }
        const unsigned old = xb_add(&bar[XB_XSUB(b.x)], 1u);
        const unsigned gen = old / nloc;
        if (old + 1u == (gen + 1u) * nloc) {
            __builtin_amdgcn_fence(__ATOMIC_RELEASE, "agent");
            asm volatile("s_waitcnt vmcnt(0)" ::: "memory");
            const unsigned og = xb_add(&bar[XB_TOP], 1u);
            const unsigned tg = og / nx;
            if (og + 1u == (tg + 1u) * nx) xb_add(&bar[XB_TOPGEN], 1u);
            else XB_SPIN(xb_ld(&bar[XB_TOPGEN]) == tg, bar);
            __builtin_amdgcn_fence(__ATOMIC_ACQUIRE, "agent");
            xb_add(&bar[XB_XGEN(b.x)], 1u);
            asm volatile("s_waitcnt vmcnt(0)" ::: "memory");
        } else {
            XB_SPIN(xb_ld(&bar[XB_XGEN(b.x)]) == gen, bar);
            __builtin_amdgcn_fence(__ATOMIC_ACQUIRE, "agent");
            asm volatile("s_waitcnt vmcnt(0)" ::: "memory");
        }
    }
    __syncthreads();
}

struct Args { const float* in[20]; float* out; unsigned char* ws; int ph_lo, ph_hi; };
__device__ __forceinline__ const void* karg_ptr(int idx) {
    unsigned long long v = (unsigned long long)((const void* const __attribute__((address_space(4)))*)__builtin_amdgcn_kernarg_segment_ptr())[idx];
    asm volatile("" : "+s"(v)); return (const void*)(const GAS char*)v;
}
struct InProxy { __device__ __forceinline__ const float* operator[](int i) const { return (const float*)karg_ptr(i); } };
struct WsProxy { __device__ __forceinline__ operator unsigned char*() const { return (unsigned char*)karg_ptr(21); }
                 __device__ __forceinline__ unsigned char* operator+(size_t o) const { return (unsigned char*)karg_ptr(21) + o; } };
struct OutProxy { __device__ __forceinline__ operator float*() const { return (float*)karg_ptr(20); }
                  __device__ __forceinline__ float* operator+(size_t o) const { return (float*)karg_ptr(20) + o; } };
struct CtlProxy { __device__ __forceinline__ operator gu32*() const { return (gu32*)karg_ptr(21); }
                  __device__ __forceinline__ gu32* operator+(int o) const { return (gu32*)karg_ptr(21) + o; } };
struct Frame {
    LAS unsigned char* lds; volatile LAS unsigned* MISC; CtlProxy ctl;
    int tid, lane, wave, vcu, G, bx;
    InProxy in; OutProxy out; WsProxy ws;
};
enum { I_X = 0, I_C, I_N1G, I_N2G, I_WADA, I_BADA, I_MWIN, I_MBG, I_MNG, I_MWOUT, I_CWIN, I_CCW, I_CCB, I_CWOUT, I_WR, I_BR, I_EWG, I_EWU, I_EWD, I_FG };

__device__ __forceinline__ float wave_sum(float v) {
#pragma unroll
    for (int o = 1; o < 64; o <<= 1) v += __shfl_xor(v, o);
    return v;
}

__device__ __forceinline__ void cvt_item(const float* W, int ldw, int K, int k0, int n0, bf16_t* WT, int drow0, LAS float* scr, int lane) {
#pragma unroll 8
    for (int i = 0; i < 32; ++i) { const int kk = 2 * i + (lane >> 5); scr[kk * 33 + (lane & 31)] = W[(size_t)(k0 + kk) * ldw + n0 + (lane & 31)]; }
    LDS_WAIT(); asm volatile("" ::: "memory");
    const int c = lane & 7;
#pragma unroll
    for (int j = 0; j < 4; ++j) { const int n = (lane >> 3) + 8 * j; const LAS float* s = scr + (8 * c) * 33 + n;
        u32x4 o; o.x = pk2(s[0 * 33], s[1 * 33]); o.y = pk2(s[2 * 33], s[3 * 33]); o.z = pk2(s[4 * 33], s[5 * 33]); o.w = pk2(s[6 * 33], s[7 * 33]);
        *(GAS u32x4*)(WT + (size_t)(drow0 + n) * K + k0 + 8 * c) = o; }
    LDS_WAIT(); asm volatile("" ::: "memory");
}
__device__ __forceinline__ int glu_row(int n, int which) { return (n >> 7) * 256 + which * 128 + (n & 127); }

template <bool DYN>
__device__ __forceinline__ void convert_weights(Frame& F, int L) {
    LAS float* scr = (LAS float*)(F.lds + F.wave * 16384);
    const int gw = F.vcu * NWAVES + F.wave, NGW = F.G * NWAVES;
    const size_t lo_ = (L == 0) ? 0 : WS_WL1;
    bf16_t* W0 = (bf16_t*)(F.ws + lo_ + WS_W0); bf16_t* W1 = (bf16_t*)(F.ws + lo_ + WS_W1); bf16_t* WUP = (bf16_t*)(F.ws + lo_ + WS_WUP); bf16_t* WDN = (bf16_t*)(F.ws + lo_ + WS_WDN);
    constexpr int I_IN = 16 * 96, I_OUT = 16 * 32, I_G = NE * 16 * 16, I_D = NE * 8 * 32;
    constexpr int NITEMS = I_IN + I_OUT + 2 * I_G + I_D;
    int it = DYN ? NITEMS : gw, grp_end = 0;
    for (;;) {
        if (DYN) { if (it >= grp_end) { int b0 = 0; if (F.lane == 0) b0 = (int)__hip_atomic_fetch_add(F.ctl + CW_CVT, 8u, RLX_AGENT); it = __builtin_amdgcn_readfirstlane(b0); grp_end = it + 8; } }
        if (it >= NITEMS) break;
        int r = it; it += DYN ? 1 : NGW;
        if (r < I_IN) { const int kb = r / 96, nb = r % 96, n0 = nb * 32;
            if (L == 0) cvt_item(F.in[I_MWIN], MPROJ, D, kb * 64, n0, W0, n0, scr, F.lane);
            else { int dr; if (n0 < D) dr = n0; else if (n0 < 2 * D) dr = D + glu_row(n0 - D, 0); else dr = D + glu_row(n0 - 2 * D, 1);
                cvt_item(F.in[I_CWIN], 3 * D, D, kb * 64, n0, W0, dr, scr, F.lane); }
            continue; } r -= I_IN;
        if (r < I_OUT) { const int kb = r / 32, nb = r % 32; cvt_item(L == 0 ? F.in[I_MWOUT] : F.in[I_CWOUT], D, D, kb * 64, nb * 32, W1, nb * 32, scr, F.lane); continue; } r -= I_OUT;
        if (r < 2 * I_G) { const int which = r / I_G; r %= I_G; const int e = r / 256, kb = (r % 256) / 16, nb = r % 16, n0 = nb * 32;
            const float* src = (which == 0 ? F.in[I_EWG] : F.in[I_EWU]) + ((size_t)L * NE + e) * D * DE;
            cvt_item(src, DE, D, kb * 64, n0, WUP + (size_t)e * 1024 * D, glu_row(n0, which), scr, F.lane); continue; } r -= 2 * I_G;
        { const int e = r / 256, kb = (r % 256) / 32, nb = r % 32;
          const float* src = F.in[I_EWD] + ((size_t)L * NE + e) * DE * D;
          cvt_item(src, D, DE, kb * 64, nb * 32, WDN + (size_t)e * D * DE, nb * 32, scr, F.lane); }
    }
}

__device__ __forceinline__ void phase_prologue(Frame& F) {
    float* MOD = (float*)(F.ws + WS_MOD);
    LAS float* cond = (LAS float*)(F.lds + 0);
    LAS float* red = (LAS float*)(F.lds + 16384);
    bool did = false;
    for (int task = F.bx; task < 192; task += F.G) {
        if (did) __syncthreads();
        did = true;
        for (int i = F.tid; i < NB * D; i += NTHR) { const int b = i / D, k = i % D; const float c = F.in[I_C][i]; cond[k * 4 + b] = c * sigmoidf_(c); }
        __syncthreads();
        const int layer = task / 96, col = (task % 96) * 64 + F.lane;
        const float* W = F.in[I_WADA] + (size_t)layer * D * 6 * D;
        float a0 = 0.f, a1 = 0.f, a2 = 0.f, a3 = 0.f;
#pragma unroll 8
        for (int kk = 0; kk < 128; ++kk) { const int k = F.wave * 128 + kk; const float w = W[(size_t)k * 6 * D + col]; const f32x4 c4 = *(const LAS f32x4*)(cond + k * 4);
            a0 += c4[0] * w; a1 += c4[1] * w; a2 += c4[2] * w; a3 += c4[3] * w; }
        red[(F.wave * 4 + 0) * 64 + F.lane] = a0; red[(F.wave * 4 + 1) * 64 + F.lane] = a1; red[(F.wave * 4 + 2) * 64 + F.lane] = a2; red[(F.wave * 4 + 3) * 64 + F.lane] = a3;
        __syncthreads();
        if (F.tid < 256) { const int b = F.tid >> 6, l = F.tid & 63; float s = 0.f;
#pragma unroll
            for (int w = 0; w < 8; ++w) s += red[(w * 4 + b) * 64 + l];
            const int c = (task % 96) * 64 + l;
            MOD[((size_t)layer * NB + b) * 6 * D + c] = s + F.in[I_BADA][(size_t)layer * 6 * D + c]; }
    }
    __syncthreads();
    convert_weights<false>(F, 0);
}

__device__ __forceinline__ void xreduce32(float (&v)[32], int lane) {
#pragma unroll
    for (int step = 0; step < 5; ++step) {
        const int M = 32 >> step, n = 32 >> step;
        const bool up = (lane & M) != 0;
#pragma unroll
        for (int i = 0; i < n / 2; ++i) { float a = v[i], b = v[i + n / 2]; asm volatile("" : "+v"(a), "+v"(b));
            const float send = up ? a : b, keep = up ? b : a; v[i] = keep + __shfl_xor(send, M); }
    }
    v[0] += __shfl_xor(v[0], 1);
}

constexpr int RP_WL = 0, RP_RINFO = 65536, RP_LCNT = RP_RINFO + 128 * 8 * 4, RP_TPRE = RP_LCNT + 256;
template <int MODE>
__device__ __forceinline__ void row_pass(Frame& F, int layer) {
    constexpr int DOTS = (MODE == 0) ? 8 : (MODE == 1 ? 16 : 0);
    constexpr int RPI = (MODE == 1) ? 2 : 4;
    constexpr bool COMBINE = (MODE == 2 || MODE == 3), MODUL = (MODE != 3);
    const float* MOD = (const float*)(F.ws + WS_MOD);
    LAS float* wl = (LAS float*)(F.lds + RP_WL);
    LAS int* rinfo = (LAS int*)(F.lds + RP_RINFO);
    LAS int* lcnt = (LAS int*)(F.lds + RP_LCNT);
    LAS int* tpre = (LAS int*)(F.lds + RP_TPRE);
    const float* xin = (MODE == 0) ? F.in[I_X] : F.out;
    bf16_t* U = (bf16_t*)(F.ws + WS_U);
    const int lane = F.lane;
    const int clayer = (MODE == 2) ? 0 : 1;
    if (DOTS > 0) { for (int idx = F.tid; idx < D * DOTS; idx += NTHR) { const int k = idx / (DOTS > 0 ? DOTS : 1), e = idx % (DOTS > 0 ? DOTS : 1), jj = k >> 8, l = (k >> 2) & 63, ii = k & 3;
            const int rot = (DOTS == 16) ? ((l >> 2) & 3) : ((l >> 3) & 1), ch = ((e >> 2) + rot) & (DOTS / 4 - 1);
            const float wv = (DOTS == 8) ? F.in[I_MWIN][(size_t)k * MPROJ + 3072 + e] : F.in[I_WR][idx];
            wl[((jj * 4 + ii) * 64 + l) * DOTS + ch * 4 + (e & 3)] = wv; } }
    if (COMBINE && F.tid == 0) { int a = 0; for (int e = 0; e < NE; ++e) { tpre[e] = a; a += ((int)__hip_atomic_load(F.ctl + CW_CNT + 64 * clayer + e, RLX_AGENT) + 255) >> 8; } tpre[NE] = a; }
    float brt[16];
    if (MODE == 1) {
#pragma unroll
        for (int e = 0; e < 16; ++e) brt[e] = F.in[I_BR][e]; }
    for (int batch = F.vcu; batch < T / 128; batch += F.G) {
        __syncthreads();
        if (MODE == 1 && F.tid < 32) lcnt[F.tid] = 0;
        __syncthreads();
        const int row_base = batch * 128 + F.wave * 16, b = row_base / SEQ;
        const float* gam = (MODE == 3) ? F.in[I_FG] : ((MODE == 1) ? F.in[I_N2G] + (size_t)layer * D : F.in[I_N1G] + (size_t)layer * D);
        const float* mod = MOD + ((size_t)layer * NB + b) * 6 * D;
        const float* shp = mod + ((MODE == 1) ? 3 * D : 0); const float* scp = shp + D;
        const float* g2p = MOD + ((size_t)clayer * NB + b) * 6 * D + 5 * D;
        f32x4 gm[4], sh[4], sc[4], g2[4];
#pragma unroll
        for (int j = 0; j < 4; ++j) { gm[j] = *(const f32x4*)(gam + 256 * j + 4 * lane);
            if (MODUL) { sh[j] = *(const f32x4*)(shp + 256 * j + 4 * lane); sc[j] = *(const f32x4*)(scp + 256 * j + 4 * lane) + 1.0f; }
            if (COMBINE) g2[j] = *(const f32x4*)(g2p + 256 * j + 4 * lane); }
#pragma unroll 1
        for (int it = 0; it < 16 / RPI; ++it) {
            const int r0 = row_base + it * RPI;
            f32x4 x[RPI][4];
#pragma unroll
            for (int r = 0; r < RPI; ++r)
#pragma unroll
                for (int j = 0; j < 4; ++j) x[r][j] = *(const f32x4*)(xin + (size_t)(r0 + r) * D + 256 * j + 4 * lane);
            if (COMBINE) {
                const bf16_t* O = (const bf16_t*)(F.ws + WS_O);
#pragma unroll
                for (int r = 0; r < RPI; ++r) {
                    const u32x4 ti = *(const u32x4*)(F.ws + WS_TOK + (size_t)(r0 + r) * 16);
                    const int e0 = __builtin_amdgcn_readfirstlane((int)(ti.x >> 16)), e1 = __builtin_amdgcn_readfirstlane((int)(ti.y >> 16));
                    const int s0 = tpre[e0] * 256 + (int)(ti.x & 0xffffu), s1 = tpre[e1] * 256 + (int)(ti.y & 0xffffu);
                    const unsigned wz_ = ti.z, ww_ = ti.w; const float w0 = __uint_as_float(wz_), w1 = __uint_as_float(ww_);
#pragma unroll
                    for (int j = 0; j < 4; ++j) {
                        const u32x2 a = *(const u32x2*)(O + (size_t)s0 * D + 256 * j + 4 * lane), c = *(const u32x2*)(O + (size_t)s1 * D + 256 * j + 4 * lane);
                        f32x4 mo; mo[0] = w0 * bflo(a.x) + w1 * bflo(c.x); mo[1] = w0 * bfhi(a.x) + w1 * bfhi(c.x); mo[2] = w0 * bflo(a.y) + w1 * bflo(c.y); mo[3] = w0 * bfhi(a.y) + w1 * bfhi(c.y);
                        if (!(DBG_SKIP & (MODE == 2 ? 2 : 8))) x[r][j] = x[r][j] + g2[j] * mo * ((DBG_SKIP & 16) ? 2.0f : 1.0f);
                        if (MODE == 2) *(f32x4*)(F.out + (size_t)(r0 + r) * D + 256 * j + 4 * lane) = x[r][j];
#ifdef DBG_PROBE
                        if (MODE == 3 && r0 + r == 777 && lane == 5 && j == 0) { float* dbg = (float*)(F.ws + 60 * MiB); dbg[0] = w0; dbg[1] = w1; dbg[2] = (float)s0; dbg[3] = (float)s1; dbg[4] = mo[0]; dbg[5] = g2[0][0]; dbg[6] = x[r][0][0]; dbg[7] = bflo(a.x); dbg[8] = bflo(c.x); dbg[9] = (float)e0; dbg[10] = (float)e1; dbg[11] = (float)tpre[e0]; }
#endif
                    }
                }
            }
            float rstd[RPI];
#pragma unroll
            for (int r = 0; r < RPI; ++r) { float s = 0.f;
#pragma unroll
                for (int j = 0; j < 4; ++j) s += (x[r][j][0] * x[r][j][0] + x[r][j][1] * x[r][j][1]) + (x[r][j][2] * x[r][j][2] + x[r][j][3] * x[r][j][3]);
                rstd[r] = 1.0f / sqrtf(wave_sum(s) * (1.0f / D) + EPS); }
#pragma unroll
            for (int r = 0; r < RPI; ++r)
#pragma unroll
                for (int j = 0; j < 4; ++j) { f32x4 y = x[r][j] * rstd[r] * gm[j]; if (MODUL) y = y * sc[j] + sh[j]; x[r][j] = y;
                    if (MODE == 3) *(f32x4*)(F.out + (size_t)(r0 + r) * D + 256 * j + 4 * lane) = y;
                    else { u32x2 w; w.x = pk2(y[0], y[1]); w.y = pk2(y[2], y[3]); *(u32x2*)(U + (size_t)(r0 + r) * D + 256 * j + 4 * lane) = w; } }
            if (DOTS > 0) {
                float v[32];
#pragma unroll
                for (int i = 0; i < 32; ++i) v[i] = 0.f;
#pragma unroll
                for (int j = 0; j < 4; ++j)
#pragma unroll
                    for (int i = 0; i < 4; ++i) {
                        float w[DOTS > 0 ? DOTS : 1];
#pragma unroll
                        for (int q = 0; q < DOTS / 4; ++q) { const int rot = (DOTS == 16) ? ((lane >> 2) & 3) : ((lane >> 3) & 1);
                            const f32x4 t4 = *(const LAS f32x4*)(wl + ((j * 4 + i) * 64 + lane) * DOTS + ((q + rot) & (DOTS / 4 - 1)) * 4); w[4 * q] = t4[0]; w[4 * q + 1] = t4[1]; w[4 * q + 2] = t4[2]; w[4 * q + 3] = t4[3]; }
#pragma unroll
                        for (int r = 0; r < RPI; ++r)
#pragma unroll
                            for (int e = 0; e < DOTS; ++e) v[r * DOTS + e] += x[r][j][i] * w[e];
                        asm volatile("" ::: "memory"); }
                xreduce32(v, lane);
                const float tot = v[0];
                if (MODE == 0) {
                    const int idx = lane >> 1, r = idx >> 3, gi = idx & 7, row = r0 + r, bb = row / SEQ, s = row % SEQ;
                    if ((lane & 1) == 0) {
                        const float pre = tot + F.in[I_MBG][gi];
                        if (gi < 4) ((float*)(F.ws + WS_IG))[(size_t)(bb * NH + gi) * SEQ + s] = pre;
                        else { const float ls = (pre >= 0.f) ? -log1pf(expf(-pre)) : (pre - log1pf(expf(pre))); ((float*)(F.ws + WS_LF))[(size_t)(bb * NH + gi - 4) * SEQ + s] = ls; }
                    }
                }
                if (MODE == 1) {
#pragma unroll
                    for (int r = 0; r < RPI; ++r) {
                        float lg[16], mx = -INFINITY;
#pragma unroll
                        for (int e = 0; e < 16; ++e) { lg[e] = __shfl(tot, 32 * r + 2 * e); mx = fmaxf(mx, lg[e]); }
                        float se = 0.f;
#pragma unroll
                        for (int e = 0; e < 16; ++e) { lg[e] = expf(lg[e] - mx); se += lg[e]; }
                        const float inv = 1.0f / se;
                        float sel[16];
#pragma unroll
                        for (int e = 0; e < 16; ++e) { lg[e] *= inv; sel[e] = lg[e] + brt[e]; }
                        int best = 0; float bscore = -INFINITY;
#pragma unroll
                        for (int gq = 0; gq < 4; ++gq) { const float a = sel[4 * gq], bq = sel[4 * gq + 1], c = sel[4 * gq + 2], d = sel[4 * gq + 3];
                            const float m1 = fmaxf(fmaxf(a, bq), fmaxf(c, d));
                            const float lo1 = fminf(a, bq), hi1 = fmaxf(a, bq), lo2 = fminf(c, d), hi2 = fmaxf(c, d);
                            const float m2 = fmaxf(fminf(hi1, hi2), fmaxf(lo1, lo2));
                            const float gs = m1 + m2; if (gs > bscore) { bscore = gs; best = gq; } }
                        float s4[4], p4[4];
#pragma unroll
                        for (int q = 0; q < 4; ++q) { s4[q] = -INFINITY; p4[q] = 0.f; }
#pragma unroll
                        for (int gq = 0; gq < 4; ++gq) if (best == gq) {
#pragma unroll
                            for (int q = 0; q < 4; ++q) { s4[q] = sel[4 * gq + q]; p4[q] = lg[4 * gq + q]; } }
                        int i0 = 0; float v0 = s4[0], pp0 = p4[0];
#pragma unroll
                        for (int q = 1; q < 4; ++q) if (s4[q] > v0) { v0 = s4[q]; i0 = q; pp0 = p4[q]; }
                        int i1 = -1; float v1 = -INFINITY, pp1 = 0.f;
#pragma unroll
                        for (int q = 0; q < 4; ++q) if (q != i0 && s4[q] > v1) { v1 = s4[q]; i1 = q; pp1 = p4[q]; }
                        const float wsum = pp0 + pp1, w0 = pp0 / wsum, w1 = pp1 / wsum;
                        const int e0 = best * 4 + i0, e1 = best * 4 + i1;
                        if (lane == 0) {
                            const int lp0 = __hip_atomic_fetch_add(lcnt + e0, 1, __ATOMIC_RELAXED, __HIP_MEMORY_SCOPE_WORKGROUP), lp1 = __hip_atomic_fetch_add(lcnt + e1, 1, __ATOMIC_RELAXED, __HIP_MEMORY_SCOPE_WORKGROUP);
                            LAS int* ri = rinfo + (F.wave * 16 + it * RPI + r) * 8;
                            ri[0] = e0; ri[1] = e1; ri[2] = lp0; ri[3] = lp1; ri[4] = __builtin_bit_cast(int, w0); ri[5] = __builtin_bit_cast(int, w1);
                        }
                    }
                }
            }
        }
        if (MODE == 1) {
            __syncthreads();
            if (F.tid < 16) lcnt[16 + F.tid] = (int)__hip_atomic_fetch_add(F.ctl + CW_CNT + 64 * layer + F.tid, (unsigned)lcnt[F.tid], RLX_AGENT);
            __syncthreads();
            if (F.tid < 128) { const LAS int* ri = rinfo + F.tid * 8; const int row = batch * 128 + F.tid; const int e0 = ri[0], e1 = ri[1], p0 = lcnt[16 + e0] + ri[2], p1 = lcnt[16 + e1] + ri[3];
                int* LIST = (int*)(F.ws + WS_LIST); LIST[e0 * LCAP + p0] = row; LIST[e1 * LCAP + p1] = row;
                u32x4 ti; ti.x = (unsigned)(e0 << 16) | (unsigned)p0; ti.y = (unsigned)(e1 << 16) | (unsigned)p1; ti.z = (unsigned)ri[4]; ti.w = (unsigned)ri[5];
                *(u32x4*)(F.ws + WS_TOK + (size_t)row * 16) = ti; }
        }
    }
    __syncthreads();
}

#define LBAR() do { asm volatile("s_waitcnt lgkmcnt(0)" ::: "memory"); __builtin_amdgcn_s_barrier(); asm volatile("" ::: "memory"); } while (0)
__device__ __forceinline__ float incl_sum(float v, int lane) {
#pragma unroll
    for (int o = 1; o < 64; o <<= 1) { const float t = __shfl_up(v, o); if (lane >= o) v += t; }
    return v;
}
__device__ __forceinline__ float incl_max(float v, int lane) {
#pragma unroll
    for (int o = 1; o < 64; o <<= 1) { const float t = __shfl_up(v, o); if (lane >= o) v = fmaxf(v, t); }
    return v;
}
__device__ __forceinline__ void phase_scan(Frame& F, int mode = 0) {
    LAS float* wkA = (LAS float*)(F.lds + 0);
    LAS float* decA = (LAS float*)(F.lds + 32768);
    LAS float* tot = (LAS float*)(F.lds + 33280);
    LAS float* bst = (LAS float*)(F.lds + 33792);
    LAS float* cmx = (LAS float*)(F.lds + 34304);
    LAS float* rst = (LAS float*)(F.lds + 34816);
    LAS float* xw = (LAS float*)(F.lds + 35328);
    LAS unsigned char* ring = F.lds + 40960;
    constexpr int SLOT = 18432;
    const int lane = F.lane, w = F.wave, tid = F.tid;
    for (int unit = F.vcu; unit < 256; unit += F.G) {
        const int bh = unit >> 4, slice = unit & 15;
        const float* IG = (const float*)(F.ws + WS_IG) + (size_t)bh * SEQ; const float* LF = (const float*)(F.ws + WS_LF) + (size_t)bh * SEQ;
        __syncthreads();
        if (mode < 2) {
        float p[16], g[16], pm[16];
#pragma unroll
        for (int q = 0; q < 16; ++q) { const int c = 16 * w + q; p[q] = incl_sum(LF[c * 64 + lane], lane); if (lane == 63) tot[c] = p[q]; }
        __syncthreads();
        if (tid < 128) { const float v = tot[tid]; const float inc = incl_sum(v, lane); if (tid == 63) xw[0] = inc; bst[tid] = inc - v; }
        __syncthreads();
        if (tid >= 64 && tid < 128) bst[tid] += xw[0];
        __syncthreads();
#pragma unroll
        for (int q = 0; q < 16; ++q) { const int c = 16 * w + q; p[q] += bst[c]; g[q] = IG[c * 64 + lane] - p[q]; pm[q] = incl_max(g[q], lane); if (lane == 63) cmx[c] = pm[q]; }
        __syncthreads();
        if (tid < 128) { const float v = cmx[tid]; const float inc = incl_max(v, lane); if (tid == 63) xw[1] = inc; float ex = __shfl_up(inc, 1); if (lane == 0) ex = 0.f; rst[tid] = fmaxf(ex, 0.f); }
        __syncthreads();
        if (tid >= 64 && tid < 128) rst[tid] = fmaxf(rst[tid], xw[1]);
        __syncthreads();
#pragma unroll
        for (int q = 0; q < 16; ++q) { const int c = 16 * w + q; const float Rs = rst[c], Rn = fmaxf(Rs, cmx[c]), Rrun = fmaxf(Rs, pm[q]);
            wkA[c * 64 + lane] = expf(g[q] - Rn); if (lane == 0) decA[c] = expf(Rs - Rn);
            if (slice == 0) { const size_t o = (size_t)bh * SEQ + c * 64 + lane; ((float*)(F.ws + WS_GA))[o] = g[q]; ((float*)(F.ws + WS_RR))[o] = Rrun; ((float*)(F.ws + WS_MM))[o] = p[q] + Rrun;
                if (lane == 0) ((float*)(F.ws + WS_RC))[bh * NCH + c] = Rs; } }
        }
        __syncthreads();
        if (mode == 1) continue;
        const bf16_t* KTg = (const bf16_t*)(F.ws + WS_KT) + (size_t)bh * NCH * DK * 64;
        const bf16_t* VTg = (const bf16_t*)(F.ws + WS_VT) + ((size_t)bh * NCH * DV + 16 * slice) * 64;
        bf16_t* STp = (bf16_t*)(F.ws + WS_ST) + ((size_t)bh * NCH * DV + 16 * slice + (lane & 15)) * DK + 16 * w + 4 * (lane >> 4);
        float* NSp = (float*)(F.ws + WS_NS) + (size_t)bh * NCH * DK + 16 * w + 4 * (lane >> 4);
        f32x4 accS = (f32x4){0.f, 0.f, 0.f, 0.f}, accN = (f32x4){0.f, 0.f, 0.f, 0.f};
        constexpr int PD = 4;
        u32x4 gk[PD][2], gv[PD];
        const int wr0 = (tid >> 3) * 128 + (((tid & 7) ^ ((tid >> 3) & 7)) << 4);
        const int arow = 16 * w + (lane & 15), brow = lane & 15, lq = lane >> 4;
#define SC_LOAD(set, cc) do { gk[set][0] = *(const u32x4*)(KTg + (size_t)(cc) * DK * 64 + tid * 8); gk[set][1] = *(const u32x4*)(KTg + (size_t)(cc) * DK * 64 + 4096 + tid * 8); \
        if (tid < 128) gv[set] = *(const u32x4*)(VTg + (size_t)(cc) * DV * 64 + tid * 8); } while (0)
#define SC_WRITE(set, slot) do { LAS unsigned char* sb_ = ring + (slot) * SLOT; *(LAS u32x4*)(sb_ + wr0) = gk[set][0]; *(LAS u32x4*)(sb_ + 8192 + wr0) = gk[set][1]; \
        if (tid < 128) *(LAS u32x4*)(sb_ + 16384 + wr0) = gv[set]; } while (0)
#pragma unroll
        for (int q = 0; q < PD; ++q) SC_LOAD(q, q);
        SC_WRITE(0, 0);
        SC_LOAD(0, PD);
        LBAR();
        for (int c0 = 0; c0 < NCH; c0 += PD) {
#pragma unroll
            for (int q = 0; q < PD; ++q) {
                const int c = c0 + q;
                if (c + 1 < NCH) { SC_WRITE((q + 1) % PD, (q + 1) & 1); if (c + 1 + PD < NCH) SC_LOAD((q + 1) % PD, c + 1 + PD); }
                if (mode < 3) { { u32x2 o; o.x = pk2(accS[0], accS[1]); o.y = pk2(accS[2], accS[3]); *(u32x2*)(STp + (size_t)c * DV * DK) = o; }
                if (slice == 0 && (lane & 15) == 0) *(f32x4*)(NSp + (size_t)c * DK) = accN; }
                const float dec = decA[c];
                accS = accS * dec; accN = accN * dec;
                const LAS unsigned char* sb = ring + (q & 1) * SLOT;
#pragma unroll
                for (int kk = 0; kk < 2; ++kk) {
                    const LAS f32x4* wp = (const LAS f32x4*)(wkA + c * 64 + kk * 32 + 8 * lq);
                    const f32x4 w0 = wp[0], w1 = wp[1];
                    const u32x4 ka = *(const LAS u32x4*)(sb + arow * 128 + (((4 * kk + lq) ^ (arow & 7)) << 4));
                    const u32x4 vv = *(const LAS u32x4*)(sb + 16384 + brow * 128 + (((4 * kk + lq) ^ (brow & 7)) << 4));
                    u32x4 bv, b1;
                    bv.x = pk2(bflo(vv.x) * w0[0], bfhi(vv.x) * w0[1]); bv.y = pk2(bflo(vv.y) * w0[2], bfhi(vv.y) * w0[3]);
                    bv.z = pk2(bflo(vv.z) * w1[0], bfhi(vv.z) * w1[1]); bv.w = pk2(bflo(vv.w) * w1[2], bfhi(vv.w) * w1[3]);
                    b1.x = pk2(w0[0], w0[1]); b1.y = pk2(w0[2], w0[3]); b1.z = pk2(w1[0], w1[1]); b1.w = pk2(w1[2], w1[3]);
                    const bf16x8 af = __builtin_bit_cast(bf16x8, ka);
                    accS = __builtin_amdgcn_mfma_f32_16x16x32_bf16(af, __builtin_bit_cast(bf16x8, bv), accS, 0, 0, 0);
                    accN = __builtin_amdgcn_mfma_f32_16x16x32_bf16(af, __builtin_bit_cast(bf16x8, b1), accN, 0, 0, 0);
                }
                LBAR();
            }
        }
        asm volatile("" :: "v"(accS), "v"(accN));
#undef SC_LOAD
#undef SC_WRITE
    }
    __syncthreads();
}

constexpr int OC_AP = 0, OC_STRIDE = 400, OC_BVEC = 25600, OC_INV = 26368, OC_PART = 26624, OC_GS = 28672, OC_RT = 28928, OC_EMM = 29184, OC_HT = 32768, OC_HSTR = 528;
__device__ __forceinline__ void phase_out(Frame& F) {
    LAS unsigned char* AP = F.lds + OC_AP; LAS unsigned char* HT = F.lds + OC_HT;
    LAS float* bvec = (LAS float*)(F.lds + OC_BVEC); LAS float* inv = (LAS float*)(F.lds + OC_INV); LAS float* part = (LAS float*)(F.lds + OC_PART);
    LAS float* gs = (LAS float*)(F.lds + OC_GS); LAS float* Rt = (LAS float*)(F.lds + OC_RT); LAS float* emm = (LAS float*)(F.lds + OC_EMM);
    const int lane = F.lane, w = F.wave, tid = F.tid, l15 = lane & 15, lq = lane >> 4;
    const bf16_t* Qg = (const bf16_t*)(F.ws + WS_Q); const bf16_t* Kg = (const bf16_t*)(F.ws + WS_K);
    const bf16_t* VTg = (const bf16_t*)(F.ws + WS_VT); const bf16_t* STg = (const bf16_t*)(F.ws + WS_ST); const bf16_t* OGS = (const bf16_t*)(F.ws + WS_OGS);
    const float* GAg = (const float*)(F.ws + WS_GA); const float* RRg = (const float*)(F.ws + WS_RR); const float* MMg = (const float*)(F.ws + WS_MM);
    const float* NSg = (const float*)(F.ws + WS_NS); const float* RCg = (const float*)(F.ws + WS_RC); const float* MNG = F.in[I_MNG];
    bf16_t* HN = (bf16_t*)(F.ws + WS_U);
    const int mt = w >> 1, ntb = (w & 1) * 2, tq = tid >> 3, pq = tid & 7, NU = 16 * NCH;
    u32x4 bfr[2][6], qa[4], kb[2][4], q0, q1, og[4]; f32x4 ng0, ng1; float sc_g = 0.f, sc_r = 0.f, sc_m = 0.f, sc_b = 0.f, Rc = 0.f;
#define OC_LOAD_MAIN(U_) do { const int bh_ = (U_) >> 7, c_ = (U_) & 127, tk_ = (bh_ >> 2) * SEQ + c_ * 64, h_ = bh_ & 3; \
        _Pragma("unroll") for (int n = 0; n < 2; ++n) { const int dv = 32 * w + 16 * n + l15; \
            _Pragma("unroll") for (int kk = 0; kk < 2; ++kk) bfr[n][kk] = *(const u32x4*)(VTg + ((((size_t)bh_ * NCH + c_) * DV + dv) << 6) + 32 * kk + 8 * lq); \
            _Pragma("unroll") for (int kk = 0; kk < 4; ++kk) bfr[n][2 + kk] = *(const u32x4*)(STg + (((size_t)bh_ * NCH + c_) * DV + dv) * DK + 32 * kk + 8 * lq); } \
        _Pragma("unroll") for (int kk = 0; kk < 4; ++kk) { qa[kk] = *(const u32x4*)(Qg + (size_t)(tk_ + 16 * mt + l15) * MQK + h_ * DK + 32 * kk + 8 * lq); \
            _Pragma("unroll") for (int n = 0; n < 2; ++n) kb[n][kk] = *(const u32x4*)(Kg + (size_t)(tk_ + 16 * (ntb + n) + l15) * MQK + h_ * DK + 32 * kk + 8 * lq); } \
        q0 = *(const u32x4*)(Qg + (size_t)(tk_ + tq) * MQK + h_ * DK + 16 * pq); q1 = *(const u32x4*)(Qg + (size_t)(tk_ + tq) * MQK + h_ * DK + 16 * pq + 8); \
        if (tid < 64) { const size_t o_ = (size_t)bh_ * SEQ + c_ * 64 + tid; sc_g = GAg[o_]; sc_r = RRg[o_]; sc_m = MMg[o_]; sc_b = 1.0f; } \
        else if (tid < 192) sc_b = NSg[((size_t)bh_ * NCH + c_) * DK + tid - 64]; \
        Rc = RCg[bh_ * NCH + c_]; } while (0)
#define OC_LOAD_OGS(U_) do { const int bh_ = (U_) >> 7, c_ = (U_) & 127, tk_ = (bh_ >> 2) * SEQ + c_ * 64, h_ = bh_ & 3; \
        _Pragma("unroll") for (int q = 0; q < 4; ++q) og[q] = *(const u32x4*)(OGS + (size_t)(tk_ + (tid >> 5) + 16 * q) * MV + h_ * DV + 8 * (tid & 31)); \
        ng0 = *(const f32x4*)(MNG + h_ * DV + 8 * (tid & 31)); ng1 = *(const f32x4*)(MNG + h_ * DV + 8 * (tid & 31) + 4); } while (0)
    int unit = F.vcu;
    if (unit < NU) { OC_LOAD_MAIN(unit); OC_LOAD_OGS(unit); }
    for (; unit < NU; unit += F.G) {
        const int bh = unit >> 7, c = unit & 127, b = bh >> 2, h = bh & 3;
        const int tk0 = b * SEQ + c * 64;
        if (tid < 64) { gs[tid] = sc_g; Rt[tid] = sc_r; emm[tid] = expf(-sc_m); }
        if (tid < 192) bvec[tid] = sc_b;
        const float Rc_cur = Rc;
        LBAR();
        f32x4 pacc[2];
#pragma unroll
        for (int n = 0; n < 2; ++n) { pacc[n] = (f32x4){0.f, 0.f, 0.f, 0.f};
#pragma unroll
            for (int kk = 0; kk < 4; ++kk) pacc[n] = __builtin_amdgcn_mfma_f32_16x16x32_bf16(__builtin_bit_cast(bf16x8, qa[kk]), __builtin_bit_cast(bf16x8, kb[n][kk]), pacc[n], 0, 0, 0); }
#pragma unroll
        for (int n = 0; n < 2; ++n) { const int sl = 16 * (ntb + n) + l15; const float gsv = gs[sl];
#pragma unroll
            for (int r = 0; r < 4; ++r) { const int tl = 16 * mt + 4 * lq + r; const float pv = (sl <= tl) ? pacc[n][r] * expf(gsv - Rt[tl]) : 0.f;
                *(LAS bf16_t*)(AP + tl * OC_STRIDE + sl * 2) = (bf16_t)f2bf(pv); } }
        { const float wq = expf(Rc_cur - Rt[tq]);
          u32x4 o0, o1;
          o0.x = pk2(bflo(q0.x) * wq, bfhi(q0.x) * wq); o0.y = pk2(bflo(q0.y) * wq, bfhi(q0.y) * wq); o0.z = pk2(bflo(q0.z) * wq, bfhi(q0.z) * wq); o0.w = pk2(bflo(q0.w) * wq, bfhi(q0.w) * wq);
          o1.x = pk2(bflo(q1.x) * wq, bfhi(q1.x) * wq); o1.y = pk2(bflo(q1.y) * wq, bfhi(q1.y) * wq); o1.z = pk2(bflo(q1.z) * wq, bfhi(q1.z) * wq); o1.w = pk2(bflo(q1.w) * wq, bfhi(q1.w) * wq);
          *(LAS u32x4*)(AP + tq * OC_STRIDE + 128 + 32 * pq) = o0; *(LAS u32x4*)(AP + tq * OC_STRIDE + 128 + 32 * pq + 16) = o1; }
        LBAR();
        { float s = 0.f;
#pragma unroll
          for (int q = 0; q < 3; ++q) { const u32x4 a = *(const LAS u32x4*)(AP + tq * OC_STRIDE + 48 * pq + 16 * q); const LAS f32x4* bp = (const LAS f32x4*)(bvec + 24 * pq + 8 * q); const f32x4 b0 = bp[0], b1 = bp[1];
              s += bflo(a.x) * b0[0] + bfhi(a.x) * b0[1] + bflo(a.y) * b0[2] + bfhi(a.y) * b0[3] + bflo(a.z) * b1[0] + bfhi(a.z) * b1[1] + bflo(a.w) * b1[2] + bfhi(a.w) * b1[3]; }
          s += __shfl_xor(s, 1); s += __shfl_xor(s, 2); s += __shfl_xor(s, 4);
          if (pq == 0) inv[tq] = 1.0f / fmaxf(fabsf(s), emm[tq]); }
        f32x4 acc[4][2];
#pragma unroll
        for (int m = 0; m < 4; ++m)
#pragma unroll
            for (int n = 0; n < 2; ++n) acc[m][n] = (f32x4){0.f, 0.f, 0.f, 0.f};
#pragma unroll
        for (int kk = 0; kk < 6; ++kk) {
            bf16x8 af[4];
#pragma unroll
            for (int m = 0; m < 4; ++m) af[m] = *(const LAS bf16x8*)(AP + (16 * m + l15) * OC_STRIDE + 64 * kk + 16 * lq);
#pragma unroll
            for (int m = 0; m < 4; ++m)
#pragma unroll
                for (int n = 0; n < 2; ++n) acc[m][n] = __builtin_amdgcn_mfma_f32_16x16x32_bf16(af[m], __builtin_bit_cast(bf16x8, bfr[n][kk]), acc[m][n], 0, 0, 0);
        }
        const int nxt = unit + F.G;
        if (nxt < NU) OC_LOAD_MAIN(nxt);
        LBAR();
#pragma unroll
        for (int m = 0; m < 4; ++m)
#pragma unroll
            for (int r = 0; r < 4; ++r) { const int tl = 16 * m + 4 * lq + r; const float iv = inv[tl];
                const float h0 = acc[m][0][r] * iv, h1 = acc[m][1][r] * iv;
                *(LAS bf16_t*)(HT + tl * OC_HSTR + (32 * w + l15) * 2) = (bf16_t)f2bf(h0); *(LAS bf16_t*)(HT + tl * OC_HSTR + (32 * w + 16 + l15) * 2) = (bf16_t)f2bf(h1);
                float s = h0 * h0 + h1 * h1; s += __shfl_xor(s, 1); s += __shfl_xor(s, 2); s += __shfl_xor(s, 4); s += __shfl_xor(s, 8);
                if (l15 == 0) part[w * 64 + tl] = s; }
        LBAR();
#pragma unroll
        for (int q = 0; q < 4; ++q) { const int row = (tid >> 5) + 16 * q, ch = tid & 31; float ss = 0.f;
#pragma unroll
            for (int ww = 0; ww < 8; ++ww) ss += part[ww * 64 + row];
            const float rs = 1.0f / sqrtf(ss * (1.0f / DV) + EPS);
            const u32x4 hv = *(const LAS u32x4*)(HT + row * OC_HSTR + ch * 16); const u32x4 g = og[q];
            u32x4 o;
            o.x = pk2(bflo(hv.x) * rs * ng0[0] * bflo(g.x), bfhi(hv.x) * rs * ng0[1] * bfhi(g.x)); o.y = pk2(bflo(hv.y) * rs * ng0[2] * bflo(g.y), bfhi(hv.y) * rs * ng0[3] * bfhi(g.y));
            o.z = pk2(bflo(hv.z) * rs * ng1[0] * bflo(g.z), bfhi(hv.z) * rs * ng1[1] * bfhi(g.z)); o.w = pk2(bflo(hv.w) * rs * ng1[2] * bflo(g.w), bfhi(hv.w) * rs * ng1[3] * bfhi(g.w));
            *(u32x4*)(HN + (size_t)(tk0 + row) * MV + h * DV + 8 * ch) = o; }
        if (nxt < NU) OC_LOAD_OGS(nxt);
    }
#undef OC_LOAD_MAIN
#undef OC_LOAD_OGS
    __syncthreads();
}

__device__ __forceinline__ void phase_conv(Frame& F) {
    const bf16_t* BG = (const bf16_t*)(F.ws + WS_BG); const bf16_t* Z = (const bf16_t*)(F.ws + WS_Z); bf16_t* Y = (bf16_t*)(F.ws + WS_Y);
    const int cg = F.tid & 127, rsub = F.tid >> 7, col = 8 * cg;
    float w0[8], w1[8], w2[8], cb[8];
#pragma unroll
    for (int i = 0; i < 8; ++i) { w0[i] = F.in[I_CCW][col + i]; w1[i] = F.in[I_CCW][D + col + i]; w2[i] = F.in[I_CCW][2 * D + col + i]; cb[i] = F.in[I_CCB][col + i]; }
    for (int batch = F.vcu; batch < T / 128; batch += F.G) {
        const int t0 = batch * 128 + rsub * 32, s0 = t0 % SEQ;
        u32x4 z2 = (u32x4){0u, 0u, 0u, 0u}, z1 = z2;
        if (s0 >= 2) z2 = *(const u32x4*)(Z + (size_t)(t0 - 2) * D + col);
        if (s0 >= 1) z1 = *(const u32x4*)(Z + (size_t)(t0 - 1) * D + col);
#pragma unroll 4
        for (int r = 0; r < 32; ++r) {
            const u32x4 z0 = *(const u32x4*)(Z + (size_t)(t0 + r) * D + col), bg = *(const u32x4*)(BG + (size_t)(t0 + r) * D + col);
            float o[8];
#pragma unroll
            for (int i = 0; i < 4; ++i) {
                o[2 * i] = bflo(bg[i]) * (w0[2 * i] * bflo(z2[i]) + w1[2 * i] * bflo(z1[i]) + w2[2 * i] * bflo(z0[i]) + cb[2 * i]);
                o[2 * i + 1] = bfhi(bg[i]) * (w0[2 * i + 1] * bfhi(z2[i]) + w1[2 * i + 1] * bfhi(z1[i]) + w2[2 * i + 1] * bfhi(z0[i]) + cb[2 * i + 1]); }
            u32x4 ov; ov.x = pk2(o[0], o[1]); ov.y = pk2(o[2], o[3]); ov.z = pk2(o[4], o[5]); ov.w = pk2(o[6], o[7]);
            *(u32x4*)(Y + (size_t)(t0 + r) * D + col) = ov;
            z2 = z1; z1 = z0;
        }
    }
}

__device__ __forceinline__ void moe_table(Frame& F, int layer) {
    __syncthreads();
    if (F.tid == 0) { int a = 0; for (int e = 0; e < NE; ++e) { const int c = (int)__hip_atomic_load(F.ctl + CW_CNT + 64 * layer + e, RLX_AGENT); F.MISC[16 + e] = (unsigned)a; F.MISC[40 + e] = (unsigned)c; a += (c + 255) >> 8; } F.MISC[16 + NE] = (unsigned)a; }
    __syncthreads();
}

constexpr int N_PHASES = 17;
#define WSP(T_, off) ((T_*)(F.ws + (off)))
__global__ void __launch_bounds__(NTHR, 2) fwd_kernel(Args args) {
    extern __shared__ __attribute__((aligned(16))) unsigned char lds_raw[];
#define MAKE_FRAME() Frame F; { int t_ = threadIdx.x, bx_ = blockIdx.x, g_ = gridDim.x; asm volatile("" : "+v"(t_), "+s"(bx_), "+s"(g_)); \
        F.lds = (LAS unsigned char*)lds_raw; F.MISC = (volatile LAS unsigned*)(F.lds + MISC_OFF); F.tid = t_; F.lane = t_ & 63; F.wave = __builtin_amdgcn_readfirstlane(t_ >> 6); \
        F.G = g_; F.bx = bx_; F.vcu = (g_ % 8 == 0) ? (bx_ % 8) * (g_ / 8) + bx_ / 8 : bx_; }
    const int lo = args.ph_lo, hi = args.ph_hi;
    const bool one_launch = (hi - lo) > 1;
    XcdBarrier bar;
    { MAKE_FRAME();
      for (int u = F.tid; u < 256; u += NTHR) F.MISC[u] = 0u;
      __syncthreads();
      bar.bar = (unsigned*)(F.ctl + CW_BAR); bar.x = 0; bar.st = nullptr;
      if (one_launch) bar = xcd_barrier_post((unsigned*)(F.ctl + CW_BAR), F.MISC + 8); }
#ifdef PH_ONLY
#define IN(k) ((k) == PH_ONLY && lo <= (k) && (k) < hi)
#else
#define IN(k) (lo <= (k) && (k) < hi)
#endif
#define SEAM(k) do { if (IN(k) && IN((k) + 1)) xcd_barrier(bar); } while (0)
#ifndef DUP_MODE
#define DUP_MODE 0
#endif
#ifndef DUP_PHASE
#define DUP_PHASE (-1)
#endif
#define PHASE(k) if (IN(k)) { for (int rep_ = 0; rep_ < (((k) == DUP_PHASE) ? 2 : 1); ++rep_) { MAKE_FRAME(); asm volatile("; PHASE_MARK " #k);
#define END_PHASE(k) } } SEAM(k);
    PHASE(0) phase_prologue(F); END_PHASE(0)
    PHASE(1) row_pass<0>(F, 0); END_PHASE(1)
    PHASE(2) pg8::Gemm g{WSP(bf16_t, WS_U), WSP(bf16_t, WS_W0), D}; pg8::DenseOrder S; S.init(T, 3 * D, F.G, F.bx);
        pg8::EpiM1 E{WSP(bf16_t, WS_Q), WSP(bf16_t, WS_K), WSP(bf16_t, WS_KT), WSP(bf16_t, WS_VT), WSP(bf16_t, WS_OGS)};
        pg8::gemm_phase<pg8::EpiM1, pg8::DenseOrder, false, true, true>(F.lds, g, S, E, F.tid); END_PHASE(2)
    PHASE(3) phase_scan(F, rep_ == 0 ? 0 : DUP_MODE); END_PHASE(3)
    PHASE(4) phase_out(F); END_PHASE(4)
    PHASE(5) pg8::Gemm g{WSP(bf16_t, WS_U), WSP(bf16_t, WS_W1), D}; pg8::DenseOrder S; S.init(T, D, F.G, F.bx);
        pg8::EpiRes E{F.in[I_X], F.out, WSP(float, WS_MOD) + 2 * D, (DBG_SKIP & 1) ? 0.f : 1.f};
        pg8::gemm_phase<pg8::EpiRes, pg8::DenseOrder, false, true, true>(F.lds, g, S, E, F.tid); END_PHASE(5)
#define WL(L_, off) WSP(bf16_t, ((L_) == 0 ? (size_t)0 : WS_WL1) + (off))
#define MOE_BLOCK(L, p0, p1, p2) \
    PHASE(p0) row_pass<1>(F, L); END_PHASE(p0) \
    PHASE(p1) moe_table(F, L); \
        pg8::Gemm g{WSP(bf16_t, WS_U), WL(L, WS_WUP), D}; pg8::MoeOrder S{(const LAS int*)(F.MISC + 16), (const LAS int*)(F.MISC + 40), WSP(const int, WS_LIST), F.G, F.vcu, 1024}; \
        pg8::EpiGlu<true> E{WSP(bf16_t, WS_A), DE, 0, nullptr, 0}; \
        pg8::gemm_phase<pg8::EpiGlu<true>, pg8::MoeOrder, true, true, true>(F.lds, g, S, E, F.tid); END_PHASE(p1) \
    PHASE(p2) moe_table(F, L); \
        pg8::Gemm g{WSP(bf16_t, WS_A), WL(L, WS_WDN), DE}; pg8::MoeOrder S{(const LAS int*)(F.MISC + 16), (const LAS int*)(F.MISC + 40), WSP(const int, WS_LIST), F.G, F.vcu, 1024}; \
        pg8::EpiBf E{WSP(bf16_t, WS_O), D}; \
        pg8::gemm_phase<pg8::EpiBf, pg8::MoeOrder, false, true, true>(F.lds, g, S, E, F.tid); END_PHASE(p2)
    MOE_BLOCK(0, 6, 7, 8)
    PHASE(9) row_pass<2>(F, 1); convert_weights<false>(F, 1); END_PHASE(9)
    PHASE(10) pg8::Gemm g{WSP(bf16_t, WS_U), WL(1, WS_W0), D}; pg8::DenseOrder S; S.init(T, 3 * D, F.G, F.bx);
        pg8::EpiGlu<false> E{WSP(bf16_t, WS_Z), D, 4, WSP(bf16_t, WS_BG), D};
        pg8::gemm_phase<pg8::EpiGlu<false>, pg8::DenseOrder, false, true, true>(F.lds, g, S, E, F.tid); END_PHASE(10)
    PHASE(11) phase_conv(F); END_PHASE(11)
    PHASE(12) pg8::Gemm g{WSP(bf16_t, WS_Y), WL(1, WS_W1), D}; pg8::DenseOrder S; S.init(T, D, F.G, F.bx);
        pg8::EpiRes E{F.out, F.out, WSP(float, WS_MOD) + (size_t)NB * 6 * D + 2 * D, (DBG_SKIP & 4) ? 0.f : 1.f};
        pg8::gemm_phase<pg8::EpiRes, pg8::DenseOrder, false, true, true>(F.lds, g, S, E, F.tid); END_PHASE(12)
    MOE_BLOCK(1, 13, 14, 15)
    if (IN(16)) { MAKE_FRAME(); asm volatile("; PHASE_MARK 16"); row_pass<3>(F, 1);
#ifdef DBG_PROBE
        if (F.bx == 0 && F.tid == 0) { float val = 0.f;
            if (DBG_PROBE == 1) { unsigned s = 0; for (int e = 0; e < NE; ++e) s += __hip_atomic_load(F.ctl + CW_CNT + e, RLX_AGENT); val = 100.f * (float)s / 65536.f; }
            if (DBG_PROBE == 2) { const bf16_t* A = WSP(bf16_t, WS_A); int nz = 0; for (int i = 0; i < 4096; ++i) nz += (A[(size_t)i * 977 % ((size_t)65536 * DE)] != 0xAAAA) ? 1 : 0; val = 100.f * nz / 4096.f; }
            if (DBG_PROBE == 3) { const bf16_t* O = WSP(bf16_t, WS_O); int nz = 0; for (int i = 0; i < 4096; ++i) nz += (O[(size_t)i * 9973 % ((size_t)65536 * D)] != 0xAAAA) ? 1 : 0; val = 100.f * nz / 4096.f; }
            if (DBG_PROBE == 4) { const unsigned* TK = WSP(unsigned, WS_TOK); float s = 0.f; for (int i = 0; i < 1024; ++i) s += __builtin_bit_cast(float, TK[(size_t)i * 31 * 4 + 2]) + __builtin_bit_cast(float, TK[(size_t)i * 31 * 4 + 3]); val = 100.f * s / 1024.f; }
            if (DBG_PROBE == 5) { const bf16_t* O = WSP(bf16_t, WS_O); float s = 0.f; for (int i = 0; i < 4096; ++i) { const float v = bf2f(O[(size_t)i * 9973 % ((size_t)65536 * D)]); s += v * v; } val = 100.f * sqrtf(s / 4096.f); }
            if (DBG_PROBE == 6) { const float* M = WSP(float, WS_MOD); float s = 0.f; for (int i = 0; i < 1024; ++i) { const float v = M[5 * D + i]; s += v * v; } val = 100.f * sqrtf(s / 1024.f); }
            if (DBG_PROBE == 7) { const unsigned* TK = WSP(unsigned, WS_TOK); const unsigned a = TK[4 * 12345], b2 = TK[4 * 12345 + 1]; val = (float)((a >> 16) * 16 + (b2 >> 16)) + 1000.f * (float)((a & 0xffff) > 32768u); }
            if (DBG_PROBE == 8 || DBG_PROBE == 9) { const unsigned* TK = WSP(unsigned, WS_TOK); const bf16_t* O = WSP(bf16_t, WS_O); float s = 0.f; int bad = 0;
                int tp[NE + 1]; { int a = 0; for (int e = 0; e < NE; ++e) { tp[e] = a; a += ((int)__hip_atomic_load(F.ctl + CW_CNT + 64 + e, RLX_AGENT) + 255) >> 8; } tp[NE] = a; }
                for (int i = 0; i < 256; ++i) { const int t = i * 127; const unsigned a = TK[4 * t]; const int e0 = a >> 16, p0 = a & 0xffff; int tpe = 0; for (int e = 0; e < NE; ++e) if (e == e0) tpe = tp[e];
                    const int s0 = tpe * 256 + p0; if (e0 >= NE || s0 >= 69632) { ++bad; continue; } for (int c = 0; c < 16; ++c) { const float v = bf2f(O[(size_t)s0 * D + c * 61]); s += v * v; } }
                val = (DBG_PROBE == 8) ? 100.f * sqrtf(s / 4096.f) : (float)bad; }
            if (DBG_PROBE >= 100) { const float* dbg = (const float*)(F.ws + 60 * MiB); val = 1000.f * dbg[DBG_PROBE - 100]; }
            float* o = F.out; o[0] = val; }
#endif
    }
#undef IN
#undef SEAM
}

extern "C" void kernel_launch(void* const* d_in, const int* in_sizes, int n_in, void* d_out, int out_size, void* d_ws, size_t ws_size, hipStream_t stream) {
    static int grid = 0;
    if (grid == 0) {
        if (n_in != 20 || in_sizes[0] != T * D || out_size != T * D || ws_size < WS_END) { fprintf(stderr, "kernel_launch: unexpected shapes: n_in %d in0 %d out %d ws %zu\n", n_in, n_in > 0 ? in_sizes[0] : -1, out_size, ws_size); grid = -1; return; }
        int dev = 0, cus = 0, per_cu = 0;
        if (hipGetDevice(&dev) != hipSuccess || hipDeviceGetAttribute(&cus, hipDeviceAttributeMultiprocessorCount, dev) != hipSuccess) { grid = -1; return; }
        if (hipFuncSetAttribute((const void*)fwd_kernel, hipFuncAttributeMaxDynamicSharedMemorySize, LDS_BYTES) != hipSuccess) { fprintf(stderr, "kernel_launch: hipFuncSetAttribute failed\n"); grid = -1; return; }
        if (hipOccupancyMaxActiveBlocksPerMultiprocessor(&per_cu, (const void*)fwd_kernel, NTHR, LDS_BYTES) != hipSuccess || per_cu < 1) { fprintf(stderr, "kernel_launch: occupancy query says %d blocks per CU\n", per_cu); (void)hipGetLastError(); grid = -1; return; }
        grid = cus;
        if (grid != 256) fprintf(stderr, "kernel_launch: %d CUs (built for 256)\n", grid);
    }
    if (grid < 0) return;
    (void)hipMemsetAsync((char*)d_ws + WS_CTL, 0, CTL_ZERO_BYTES, stream);
    Args a{};
    for (int i = 0; i < 20; ++i) a.in[i] = (const float*)d_in[i];
    a.out = (float*)d_out; a.ws = (unsigned char*)d_ws;
#if MK_N_LAUNCHES == 1
    a.ph_lo = 0; a.ph_hi = N_PHASES;
    void* kargs[] = {&a};
    hipError_t e = hipLaunchCooperativeKernel((const void*)fwd_kernel, dim3(grid), dim3(NTHR), kargs, LDS_BYTES, stream);
    if (e != hipSuccess) fprintf(stderr, "kernel_launch: cooperative launch failed: %s\n", hipGetErrorString(e));
#else
    for (int p = 0; p < N_PHASES; ++p) { a.ph_lo = p; a.ph_hi = p + 1; hipLaunchKernelGGL(fwd_kernel, dim3(grid), dim3(NTHR), LDS_BYTES, stream, a); }
#endif
}
```

```cpp
#include <hip/hip_runtime.h>
#include <cstdio>
#include <cstdint>

#ifndef DBG_SKIP
#define DBG_SKIP 0
#endif
#ifndef MK_N_LAUNCHES
#define MK_N_LAUNCHES 1
#endif

#define LAS __attribute__((address_space(3)))
#define GAS __attribute__((address_space(1)))
typedef unsigned short bf16_t;
typedef short bf16x8 __attribute__((ext_vector_type(8)));
typedef float f32x4 __attribute__((ext_vector_type(4)));
typedef float f32x2 __attribute__((ext_vector_type(2)));
typedef unsigned u32x4 __attribute__((ext_vector_type(4)));
typedef unsigned u32x2 __attribute__((ext_vector_type(2)));
typedef GAS unsigned gu32;
#define RLX_AGENT __ATOMIC_RELAXED, __HIP_MEMORY_SCOPE_AGENT
#define LDS_WAIT() asm volatile("s_waitcnt lgkmcnt(0)" ::: "memory")
#define VM_WAIT() asm volatile("s_waitcnt vmcnt(0)" ::: "memory")

constexpr int NB = 4, SEQ = 8192, D = 1024, T = NB * SEQ;
constexpr int NH = 4, DK = 128, DV = 256, MQK = NH * DK, MV = NH * DV, MPROJ = 2 * MQK + 2 * MV + 2 * NH;
constexpr int CH = 64, NCH = SEQ / CH;
constexpr int NE = 16, DE = 512, LCAP = 65536;
constexpr int SLOT_ROWS = 2 * T + NE * 256;
constexpr float EPS = 1e-6f;
constexpr int NWAVES = 8, NTHR = 512;

constexpr size_t MiB = 1u << 20;
constexpr size_t WS_CTL = 0, CTL_ZERO_BYTES = 64 * 1024;
constexpr size_t WS_MOD = 1 * MiB;
constexpr size_t WS_W0 = 2 * MiB;
constexpr size_t WS_W1 = 8 * MiB;
constexpr size_t WS_WUP = 10 * MiB;
constexpr size_t WS_WDN = 42 * MiB;
constexpr size_t WS_WL1 = 338 * MiB;
constexpr size_t WS_IG = 62 * MiB;
constexpr size_t WS_LF = WS_IG + 512 * 1024;
constexpr size_t WS_GA = WS_LF + 512 * 1024;
constexpr size_t WS_RR = WS_GA + 512 * 1024;
constexpr size_t WS_MM = WS_RR + 512 * 1024;
constexpr size_t WS_RC = WS_MM + 512 * 1024;
constexpr size_t WS_NS = 65 * MiB;
constexpr size_t WS_TOK = 66 * MiB;
constexpr size_t WS_LIST = 67 * MiB;
constexpr size_t WS_U = 72 * MiB;
constexpr size_t WS_Q = 136 * MiB;
constexpr size_t WS_K = 168 * MiB;
constexpr size_t WS_KT = 200 * MiB;
constexpr size_t WS_VT = 232 * MiB;
constexpr size_t WS_OGS = 296 * MiB;
constexpr size_t WS_ST = 360 * MiB;
constexpr size_t WS_A = 136 * MiB;
constexpr size_t WS_O = 204 * MiB;
constexpr size_t WS_BG = 136 * MiB;
constexpr size_t WS_Z = 200 * MiB;
constexpr size_t WS_Y = 264 * MiB;
constexpr size_t WS_XB = 400 * MiB;
constexpr size_t WS_END = 488 * MiB;
static_assert(WS_A + (size_t)SLOT_ROWS * DE * 2 <= WS_O && WS_O + (size_t)SLOT_ROWS * D * 2 <= WS_ST, "moe map");

constexpr int CW_CNT = 64;
constexpr int CW_CVT = 256;
constexpr int CW_BAR = 1024;

constexpr int RING_BYTES = 131072;
constexpr int MISC_OFF = RING_BYTES;
constexpr int EPI_OFF = MISC_OFF + 1024;
constexpr int LDS_BYTES = 149504;

typedef __bf16 bf16x2_t __attribute__((ext_vector_type(2)));
__device__ __forceinline__ unsigned f2bf(float f) { return (unsigned)__builtin_bit_cast(unsigned short, (__bf16)f); }
__device__ __forceinline__ unsigned pk2(float lo, float hi) { bf16x2_t v; v[0] = (__bf16)lo; v[1] = (__bf16)hi; return __builtin_bit_cast(unsigned, v); }
__device__ __forceinline__ float bf2f(unsigned short h) { return __builtin_bit_cast(float, (unsigned)h << 16); }
__device__ __forceinline__ float bflo(unsigned w) { return __builtin_bit_cast(float, w << 16); }
__device__ __forceinline__ float bfhi(unsigned w) { return __builtin_bit_cast(float, w & 0xffff0000u); }
__device__ __forceinline__ unsigned cvt_pk_bf16(float lo, float hi) { unsigned r; asm volatile("v_cvt_pk_bf16_f32 %0, %1, %2" : "=v"(r) : "v"(lo), "v"(hi)); return r; }
__device__ __forceinline__ float fast_exp(float x) { return __builtin_amdgcn_exp2f(x * 1.44269504089f); }
__device__ __forceinline__ float sigmoidf_(float x) { return __builtin_amdgcn_rcpf(1.0f + fast_exp(-x)); }

namespace pg8 {
constexpr int BM = 256, BK = 64, HALF = 128, HTB = HALF * BK * 2, STAGE_BYTES = 8 * HTB, NXCD = 8, WGM = 8;
__host__ __device__ __forceinline__ int lds_byte(int r, int c) { const int st = (r >> 4) * 2 + (c >> 5), rr = r & 15, cc = c & 31, ob = rr * 64 + cc * 2; return st * 1024 + (ob ^ (((ob >> 9) & 1) << 5)); }
__host__ __device__ __forceinline__ void stage_rc(int b, int& R, int& C) { const int st = b / 1024, sb = b % 1024, swz = sb ^ (((sb >> 9) & 1) << 5); R = (st >> 1) * 16 + swz / 64; C = (st & 1) * 32 + (swz % 64) / 2; }
__host__ __device__ __forceinline__ int perm32(int rho) { const int n = rho >> 4, i = rho & 15; return 8 * (i >> 2) + 4 * n + (i & 3); }

struct Unit { int arow0, brow0, pm, pn, e, nvalid; const int* alist; };
struct Gemm { const bf16_t* A; const bf16_t* Bt; int K; };

struct DenseOrder {
    int nM, nN, nwg, G, c;
    __device__ void init(int M, int N, int G_, int c_) { nM = M / BM; nN = N / BM; nwg = nM * nN; G = G_; c = c_; }
    __device__ bool next(int i, Unit& u) const {
        const long L = (long)i * G + c; if (L >= nwg) return false;
        int wgid = (int)L; { const int q = nwg / NXCD, r = nwg % NXCD, xcd = wgid % NXCD, off = wgid / NXCD; wgid = (xcd < r ? xcd * (q + 1) : r * (q + 1) + (xcd - r) * q) + off; }
        const int nig = WGM * nN, gid = wgid / nig, fm = gid * WGM, gsz = (nM - fm) < WGM ? (nM - fm) : WGM;
        u.pm = fm + ((wgid % nig) % gsz); u.pn = (wgid % nig) / gsz; u.arow0 = u.pm * BM; u.brow0 = u.pn * BM; u.e = 0; u.nvalid = 256; u.alist = nullptr; return true;
    }
};
struct MoeOrder {
    const LAS int* tpre; const LAS int* cnt; const int* list; int G, vcu, bn;
    __device__ bool next(int i, Unit& u) const {
        const int U = i * G + vcu, rt = U >> 2, pn = U & 3;
        if (rt >= tpre[NE]) return false;
        int e = 0;
#pragma unroll
        for (int k = 1; k < NE; ++k) e += (rt >= tpre[k]) ? 1 : 0;
        const int r = rt - tpre[e];
        u.arow0 = rt * BM; u.brow0 = e * bn + pn * BM; u.pm = rt; u.pn = pn; u.e = e; u.nvalid = min(256, cnt[e] - r * 256); u.alist = list + e * LCAP + r * 256; return true;
    }
};

template <class Epi, class Sched, bool GATHER, bool ALIGN_EPI, bool SP2>
__device__ __forceinline__ void gemm_phase(LAS unsigned char* lds, const Gemm g, const Sched& S, const Epi& E, const int tid) {
    const int wid = __builtin_amdgcn_readfirstlane(tid >> 6), lane = tid & 63, wr = wid >> 2, wc = wid & 3, fr = lane & 15, fq = lane >> 4;
    const int K = g.K, nt = K / BK;
    unsigned voffA[2], voffB[2];
#pragma unroll
    for (int i = 0; i < 2; ++i) { int R, C; stage_rc(tid * 16 + i * 8192, R, C); const int Rb = Epi::PERM ? ((R & ~31) + perm32(R & 31)) : R;
        voffA[i] = (unsigned)(R * K + C) * 2u; voffB[i] = (unsigned)(Rb * K + C) * 2u; }
    const size_t kstep = (size_t)(BK * 2);
    const size_t hstep = (size_t)HALF * K * 2;
    const unsigned ldsw = (unsigned)wid * 1024u;
    const int aoff = lds_byte(wr * 64 + fr, fq * 8), boff = lds_byte(wc * 32 + fr, fq * 8);
#define PG8_SA(b, h) (((b) * 2 + (h)) * HTB)
#define PG8_SB(b, h) ((4 + (b) * 2 + (h)) * HTB)
#define PG8_STAGE(bufoff, gbase, voff) do { _Pragma("unroll") for (int _i = 0; _i < 2; ++_i) \
        __builtin_amdgcn_global_load_lds((const unsigned*)((const char*)(gbase) + (voff)[_i]), (LAS unsigned*)(lds + (bufoff) + ldsw + _i * 8192), 16, 0, 0); } while (0)
#define PG8_STAGE_A(bufoff, kb, h, vo) do { if constexpr (GATHER) { PG8_STAGE(bufoff, kb, (vo)[h]); } else { PG8_STAGE(bufoff, (kb) + (h) * hstep, voffA); } } while (0)
#define PG8_LDA(dst, b, h) do { _Pragma("unroll") for (int m = 0; m < 4; ++m) _Pragma("unroll") for (int k = 0; k < 2; ++k) dst[m][k] = *(const LAS bf16x8*)(lds + PG8_SA(b, h) + aoff + m * 2048 + k * 1024); } while (0)
#define PG8_LDB(dst, b, h) do { _Pragma("unroll") for (int n = 0; n < 2; ++n) _Pragma("unroll") for (int k = 0; k < 2; ++k) dst[n][k] = *(const LAS bf16x8*)(lds + PG8_SB(b, h) + boff + n * 2048 + k * 1024); } while (0)
#define PG8_MMA(ai, bj, At, Bt) do { __builtin_amdgcn_s_setprio(1); _Pragma("unroll") for (int m = 0; m < 4; ++m) _Pragma("unroll") for (int n = 0; n < 2; ++n) _Pragma("unroll") for (int k = 0; k < 2; ++k) \
        acc[ai][bj][m][n] = __builtin_amdgcn_mfma_f32_16x16x32_bf16(Bt[n][k], At[m][k], acc[ai][bj][m][n], 0, 0, 0); __builtin_amdgcn_s_setprio(0); } while (0)
#define PG8_WAIT_V(n) asm volatile("s_waitcnt vmcnt(" #n ")" ::: "memory")
#define PG8_WAIT_L(n) asm volatile("s_waitcnt lgkmcnt(" #n ")" ::: "memory")
#define PG8_BAR __builtin_amdgcn_s_barrier()
#define PG8_SCHED __builtin_amdgcn_sched_barrier(0)
    Unit cur, nxt; int ui = 0;
    if (!S.next(0, cur)) return;
    f32x4 acc[2][2][4][2];
#pragma unroll
    for (int a = 0; a < 2; ++a)
#pragma unroll
        for (int b = 0; b < 2; ++b)
#pragma unroll
            for (int m = 0; m < 4; ++m)
#pragma unroll
                for (int n = 0; n < 2; ++n) acc[a][b][m][n] = (f32x4){0.f, 0.f, 0.f, 0.f};
    bf16x8 At[4][2], B0[2][2], B1[2][2];
    unsigned vg[2][2];
#define PG8_GATHER(u) do { _Pragma("unroll") for (int _h = 0; _h < 2; ++_h) _Pragma("unroll") for (int _i = 0; _i < 2; ++_i) { int _R, _C; stage_rc(tid * 16 + _i * 8192, _R, _C); \
        const int _r = _h * HALF + _R; const int _tok = (_r < (u).nvalid) ? (u).alist[_r] : 0; vg[_h][_i] = (unsigned)(_tok * K + _C) * 2u; } } while (0)
    const char* cA; const char* cB = (const char*)g.Bt + (size_t)cur.brow0 * K * 2;
    if constexpr (GATHER) { cA = (const char*)g.A; PG8_GATHER(cur); } else { cA = (const char*)g.A + (size_t)cur.arow0 * K * 2;
#pragma unroll
        for (int h = 0; h < 2; ++h)
#pragma unroll
            for (int i = 0; i < 2; ++i) vg[h][i] = 0u; }
    if constexpr (SP2) {
        PG8_STAGE(PG8_SB(0, 0), cB, voffB); PG8_STAGE(PG8_SB(0, 1), cB + hstep, voffB); PG8_STAGE_A(PG8_SA(0, 0), cA, 0, vg); PG8_STAGE_A(PG8_SA(0, 1), cA, 1, vg);
        if (wr == 1) PG8_BAR;
        PG8_WAIT_V(2); PG8_BAR;
        PG8_STAGE(PG8_SB(1, 0), cB + kstep, voffB); PG8_STAGE_A(PG8_SA(1, 0), cA + kstep, 0, vg); PG8_STAGE(PG8_SB(1, 1), cB + hstep + kstep, voffB);
        PG8_WAIT_V(6); PG8_BAR;
    } else {
        PG8_STAGE(PG8_SB(0, 0), cB, voffB); PG8_STAGE_A(PG8_SA(0, 0), cA, 0, vg); PG8_STAGE(PG8_SB(0, 1), cB + hstep, voffB); PG8_STAGE_A(PG8_SA(0, 1), cA, 1, vg);
        if (wr == 1) PG8_BAR;
        PG8_WAIT_V(4); PG8_BAR;
        PG8_STAGE(PG8_SB(1, 0), cB + kstep, voffB); PG8_STAGE_A(PG8_SA(1, 0), cA + kstep, 0, vg); PG8_STAGE(PG8_SB(1, 1), cB + hstep + kstep, voffB);
        PG8_WAIT_V(6); PG8_BAR;
    }
    for (;;) {
        const bool has_next = S.next(ui + 1, nxt);
        const char* nA; const char* nB = has_next ? (const char*)g.Bt + (size_t)nxt.brow0 * K * 2 : cB;
        if constexpr (GATHER) nA = cA; else nA = has_next ? (const char*)g.A + (size_t)nxt.arow0 * K * 2 : cA;
        for (int t = 0; t < nt; t += 2) {
            const bool last = (t == nt - 2);
            const char* a1 = cA + (size_t)(t + 1) * kstep;
            const char* a2 = last ? nA : cA + (size_t)(t + 2) * kstep; const char* b2 = last ? nB : cB + (size_t)(t + 2) * kstep;
            const char* a3 = a2 + kstep; const char* b3 = b2 + kstep;
            if constexpr (SP2) {
            PG8_LDB(B0, 0, 0); PG8_LDB(B1, 0, 1); PG8_SCHED; PG8_LDA(At, 0, 0); PG8_STAGE_A(PG8_SA(1, 1), a1, 1, vg);
            if constexpr (GATHER) { if (last && has_next) PG8_GATHER(nxt); }
            PG8_WAIT_V(8); PG8_WAIT_L(0); PG8_BAR; PG8_MMA(0, 0, At, B0); PG8_MMA(0, 1, At, B1); PG8_BAR; PG8_SCHED;
            PG8_LDA(At, 0, 1); PG8_STAGE(PG8_SB(0, 0), b2, voffB); PG8_STAGE(PG8_SB(0, 1), b2 + hstep, voffB); PG8_STAGE_A(PG8_SA(0, 0), a2, 0, vg);
            PG8_WAIT_V(8); PG8_WAIT_L(0); PG8_BAR; PG8_MMA(1, 0, At, B0); PG8_MMA(1, 1, At, B1); PG8_BAR; PG8_SCHED;
            PG8_LDB(B0, 1, 0); PG8_LDB(B1, 1, 1); PG8_SCHED; PG8_LDA(At, 1, 0); PG8_STAGE_A(PG8_SA(0, 1), a2, 1, vg);
            PG8_WAIT_V(8); PG8_WAIT_L(0); PG8_BAR; PG8_MMA(0, 0, At, B0); PG8_MMA(0, 1, At, B1); PG8_BAR; PG8_SCHED;
            PG8_LDA(At, 1, 1); PG8_STAGE(PG8_SB(1, 0), b3, voffB); PG8_STAGE(PG8_SB(1, 1), b3 + hstep, voffB); PG8_STAGE_A(PG8_SA(1, 0), a3, 0, vg);
            PG8_WAIT_V(8); PG8_WAIT_L(0); PG8_BAR; PG8_MMA(1, 0, At, B0); PG8_MMA(1, 1, At, B1); PG8_BAR; PG8_SCHED;
            } else {
            PG8_LDB(B0, 0, 0); PG8_SCHED; PG8_LDA(At, 0, 0); PG8_STAGE_A(PG8_SA(1, 1), a1, 1, vg);
            if constexpr (GATHER) { if (last && has_next) PG8_GATHER(nxt); }
            PG8_WAIT_L(8); PG8_BAR; PG8_WAIT_L(0); PG8_MMA(0, 0, At, B0); PG8_BAR; PG8_SCHED;
            PG8_LDB(B1, 0, 1); PG8_STAGE(PG8_SB(0, 0), b2, voffB);
            PG8_BAR; PG8_WAIT_L(0); PG8_MMA(0, 1, At, B1); PG8_BAR;
            PG8_LDA(At, 0, 1); PG8_STAGE_A(PG8_SA(0, 0), a2, 0, vg);
            PG8_BAR; PG8_WAIT_L(0); PG8_MMA(1, 0, At, B0); PG8_BAR; PG8_SCHED;
            PG8_STAGE(PG8_SB(0, 1), b2 + hstep, voffB);
            PG8_WAIT_V(6); PG8_BAR; PG8_MMA(1, 1, At, B1); PG8_BAR;
            PG8_LDB(B0, 1, 0); PG8_SCHED; PG8_LDA(At, 1, 0); PG8_STAGE_A(PG8_SA(0, 1), a2, 1, vg);
            PG8_WAIT_L(8); PG8_BAR; PG8_WAIT_L(0); PG8_MMA(0, 0, At, B0); PG8_BAR; PG8_SCHED;
            PG8_LDB(B1, 1, 1); PG8_STAGE(PG8_SB(1, 0), b3, voffB);
            PG8_BAR; PG8_WAIT_L(0); PG8_MMA(0, 1, At, B1); PG8_BAR;
            PG8_LDA(At, 1, 1); PG8_STAGE_A(PG8_SA(1, 0), a3, 0, vg);
            PG8_BAR; PG8_WAIT_L(0); PG8_MMA(1, 0, At, B0); PG8_BAR; PG8_SCHED;
            PG8_STAGE(PG8_SB(1, 1), b3 + hstep, voffB);
            PG8_WAIT_V(6); PG8_BAR; PG8_MMA(1, 1, At, B1); PG8_BAR;
            }
        }
        if constexpr (ALIGN_EPI) { if (wr == 0) PG8_BAR; }
        E(acc, cur, wr, wc, fr, fq);
        if (!has_next) break;
#pragma unroll
        for (int a = 0; a < 2; ++a)
#pragma unroll
            for (int b = 0; b < 2; ++b)
#pragma unroll
                for (int m = 0; m < 4; ++m)
#pragma unroll
                    for (int n = 0; n < 2; ++n) acc[a][b][m][n] = (f32x4){0.f, 0.f, 0.f, 0.f};
        cur = nxt; cA = nA; cB = nB; ++ui;
        if constexpr (ALIGN_EPI) { if (wr == 1) PG8_BAR; }
    }
    PG8_WAIT_V(0);
    if constexpr (!ALIGN_EPI) { if (wr == 0) PG8_BAR; }
    PG8_BAR;
#undef PG8_SA
#undef PG8_SB
#undef PG8_STAGE
#undef PG8_STAGE_A
#undef PG8_GATHER
#undef PG8_LDA
#undef PG8_LDB
#undef PG8_MMA
#undef PG8_WAIT_V
#undef PG8_WAIT_L
#undef PG8_BAR
#undef PG8_SCHED
}


struct EpiM1 {
    static constexpr bool PERM = true;
    bf16_t* Q; bf16_t* Kn; bf16_t* KT; bf16_t* VT; bf16_t* OGS; LAS unsigned char* tlds;
    __device__ __forceinline__ void operator()(const f32x4 (&acc)[2][2][4][2], const Unit& u, int wr, int wc, int fr, int fq) const {
        const int row0 = u.arow0 + wr * 64 + fr, pn = u.pn;
        if (pn < 4 || pn >= 8) {
            bf16_t* base; int ldc, colt; float sc = 1.f; const bool sig = pn >= 8;
            if (pn < 2) { base = Q; ldc = MQK; colt = pn * 256; sc = 0.08838834764831845f; }
            else if (pn < 4) { base = Kn; ldc = MQK; colt = (pn - 2) * 256; }
            else { base = OGS; ldc = MV; colt = (pn - 8) * 256; }
            const int col0 = colt + wc * 32 + 8 * fq;
#pragma unroll
            for (int ai = 0; ai < 2; ++ai)
#pragma unroll
                for (int m = 0; m < 4; ++m) { bf16_t* rowp = base + (size_t)(row0 + ai * HALF + m * 16) * ldc + col0;
#pragma unroll
                    for (int bj = 0; bj < 2; ++bj) { f32x4 v0 = acc[ai][bj][m][0] * sc, v1 = acc[ai][bj][m][1] * sc;
                        if (sig) {
#pragma unroll
                            for (int j = 0; j < 4; ++j) { v0[j] = sigmoidf_(v0[j]); v1[j] = sigmoidf_(v1[j]); } }
                        u32x4 w; w.x = cvt_pk_bf16(v0[0], v0[1]); w.y = cvt_pk_bf16(v0[2], v0[3]); w.z = cvt_pk_bf16(v1[0], v1[1]); w.w = cvt_pk_bf16(v1[2], v1[3]);
                        *(u32x4*)(rowp + bj * HALF) = w; } }
        }
        if (pn >= 2 && pn < 8) {
            const int b = u.arow0 / SEQ, s0 = (u.arow0 % SEQ) + wr * 64;
            bf16_t* base; int colt, feat;
            if (pn < 4) { base = KT; colt = (pn - 2) * 256; feat = DK; } else { base = VT; colt = (pn - 4) * 256; feat = DV; }
            LAS unsigned char* tb = tlds + (wr * 4 + wc) * 2048;
            const int lane = fq * 16 + fr;
#pragma unroll
            for (int ai = 0; ai < 2; ++ai) {
                const int ch = (s0 + ai * HALF) >> 6;
#pragma unroll
                for (int bj = 0; bj < 2; ++bj) {
                    const int col = colt + bj * HALF + wc * 32, hd = col / feat, f0 = col % feat;
                    bf16_t* xb = base + ((((size_t)(b * NH + hd) * NCH + ch) * feat + f0) << 6);
#pragma unroll
                    for (int n = 0; n < 2; ++n) {
#pragma unroll
                        for (int m = 0; m < 4; ++m)
#pragma unroll
                            for (int j = 0; j < 4; ++j) { const int t = m * 16 + fr;
                                *(LAS bf16_t*)(tb + (4 * fq + j) * 128 + ((((t >> 3) ^ (2 * fq)) & 7) << 4) + (t & 7) * 2) = (bf16_t)f2bf(acc[ai][bj][m][n][j]); }
#pragma unroll
                        for (int q = 0; q < 2; ++q) { const int id = lane + 64 * q, cr = id >> 3, p = id & 7, tc = (p ^ (2 * (cr >> 2))) & 7;
                            const u32x4 v = *(const LAS u32x4*)(tb + id * 16);
                            *(u32x4*)(xb + (size_t)(8 * (cr >> 2) + 4 * n + (cr & 3)) * 64 + tc * 8) = v; }
                    }
                }
            }
        }
    }
};
template <bool BASE_F32> struct EpiRes {
    static constexpr bool PERM = true;
    const void* base; bf16_t* out; const float* gate; float mul;
    __device__ __forceinline__ void operator()(const f32x4 (&acc)[2][2][4][2], const Unit& u, int wr, int wc, int fr, int fq) const {
        const int row0 = u.arow0 + wr * 64 + fr, col0 = u.pn * BM + wc * 32 + 8 * fq, b = u.arow0 / SEQ;
        f32x4 gv[2][2];
#pragma unroll
        for (int bj = 0; bj < 2; ++bj)
#pragma unroll
            for (int n = 0; n < 2; ++n) gv[bj][n] = *(const f32x4*)(gate + (size_t)b * 6 * D + col0 + bj * HALF + n * 4) * mul;
#pragma unroll
        for (int ai = 0; ai < 2; ++ai)
#pragma unroll
            for (int m = 0; m < 4; ++m) { const size_t off = (size_t)(row0 + ai * HALF + m * 16) * D + col0;
#pragma unroll
                for (int bj = 0; bj < 2; ++bj) { f32x4 b0, b1;
                    if (BASE_F32) { b0 = *(const f32x4*)((const float*)base + off + bj * HALF); b1 = *(const f32x4*)((const float*)base + off + bj * HALF + 4); }
                    else { const u32x4 bw = *(const u32x4*)((const bf16_t*)base + off + bj * HALF); b0 = (f32x4){bflo(bw.x), bfhi(bw.x), bflo(bw.y), bfhi(bw.y)}; b1 = (f32x4){bflo(bw.z), bfhi(bw.z), bflo(bw.w), bfhi(bw.w)}; }
                    const f32x4 v0 = b0 + gv[bj][0] * acc[ai][bj][m][0], v1 = b1 + gv[bj][1] * acc[ai][bj][m][1];
                    u32x4 w; w.x = cvt_pk_bf16(v0[0], v0[1]); w.y = cvt_pk_bf16(v0[2], v0[3]); w.z = cvt_pk_bf16(v1[0], v1[1]); w.w = cvt_pk_bf16(v1[2], v1[3]);
                    *(u32x4*)(out + off + bj * HALF) = w; } }
    }
};
struct EpiBf {
    static constexpr bool PERM = true;
    bf16_t* O; int ldc;
    __device__ __forceinline__ void operator()(const f32x4 (&acc)[2][2][4][2], const Unit& u, int wr, int wc, int fr, int fq) const {
        const int row0 = u.arow0 + wr * 64 + fr, col0 = u.pn * BM + wc * 32 + 8 * fq;
#pragma unroll
        for (int ai = 0; ai < 2; ++ai)
#pragma unroll
            for (int m = 0; m < 4; ++m) { bf16_t* rowp = O + (size_t)(row0 + ai * HALF + m * 16) * ldc + col0;
#pragma unroll
                for (int bj = 0; bj < 2; ++bj) { const f32x4 v0 = acc[ai][bj][m][0], v1 = acc[ai][bj][m][1];
                    u32x4 w; w.x = cvt_pk_bf16(v0[0], v0[1]); w.y = cvt_pk_bf16(v0[2], v0[3]); w.z = cvt_pk_bf16(v1[0], v1[1]); w.w = cvt_pk_bf16(v1[2], v1[3]);
                    *(u32x4*)(rowp + bj * HALF) = w; } }
    }
};
template <bool SILU> struct EpiGlu {
    static constexpr bool PERM = true;
    bf16_t* O; int ldc; int plain_tiles; bf16_t* P; int ldp;
    __device__ __forceinline__ void operator()(const f32x4 (&acc)[2][2][4][2], const Unit& u, int wr, int wc, int fr, int fq) const {
        const int row0 = u.arow0 + wr * 64 + fr;
        if (u.pn < plain_tiles) {
            const int col0 = u.pn * BM + wc * 32 + 8 * fq;
#pragma unroll
            for (int ai = 0; ai < 2; ++ai)
#pragma unroll
                for (int m = 0; m < 4; ++m) { bf16_t* rowp = P + (size_t)(row0 + ai * HALF + m * 16) * ldp + col0;
#pragma unroll
                    for (int bj = 0; bj < 2; ++bj) { const f32x4 v0 = acc[ai][bj][m][0], v1 = acc[ai][bj][m][1];
                        u32x4 w; w.x = cvt_pk_bf16(v0[0], v0[1]); w.y = cvt_pk_bf16(v0[2], v0[3]); w.z = cvt_pk_bf16(v1[0], v1[1]); w.w = cvt_pk_bf16(v1[2], v1[3]);
                        *(u32x4*)(rowp + bj * HALF) = w; } }
            return;
        }
        const int col0 = (u.pn - plain_tiles) * HALF + wc * 32 + 8 * fq;
#pragma unroll
        for (int ai = 0; ai < 2; ++ai)
#pragma unroll
            for (int m = 0; m < 4; ++m) { bf16_t* rowp = O + (size_t)(row0 + ai * HALF + m * 16) * ldc + col0;
                f32x4 v0 = acc[ai][0][m][0], v1 = acc[ai][0][m][1]; const f32x4 u0 = acc[ai][1][m][0], u1 = acc[ai][1][m][1];
                if (SILU) {
#pragma unroll
                    for (int j = 0; j < 4; ++j) { v0[j] = v0[j] * sigmoidf_(v0[j]); v1[j] = v1[j] * sigmoidf_(v1[j]); } }
                v0 = v0 * u0; v1 = v1 * u1;
                u32x4 w; w.x = cvt_pk_bf16(v0[0], v0[1]); w.y = cvt_pk_bf16(v0[2], v0[3]); w.z = cvt_pk_bf16(v1[0], v1[1]); w.w = cvt_pk_bf16(v1[2], v1[3]);
                *(u32x4*)rowp = w; }
    }
};
}

#define XB_TMO      128
#define XB_XCNT(j)  (256  + 64 * (j))
#define XB_XSUB(j)  (1280 + 64 * (j))
#define XB_XGEN(j)  (2304 + 64 * (j))
#define XB_TOP      3328
#define XB_TOPGEN   3392
#define XCD_BAR_WORDS 3456
#define XB_SPIN_CAP (1u << 18)
__device__ __forceinline__ unsigned xb_ld(unsigned* p)              { return __hip_atomic_load(p, __ATOMIC_RELAXED, __HIP_MEMORY_SCOPE_AGENT); }
__device__ __forceinline__ unsigned xb_add(unsigned* p, unsigned v) { return __hip_atomic_fetch_add(p, v, __ATOMIC_RELAXED, __HIP_MEMORY_SCOPE_AGENT); }
__device__ __forceinline__ unsigned xb_xcc_id() { return (unsigned)__builtin_amdgcn_s_getreg((3 << 11) | 20) & 0xFu; }
#define XB_SPIN(cond, bar) do { unsigned _sp = 0; while (cond) { __builtin_amdgcn_s_sleep(1); \
    if ((++_sp & 255u) == 0u) { if (xb_ld(&(bar)[XB_TMO])) break; if (_sp > XB_SPIN_CAP) { atomicAdd(&(bar)[XB_TMO], 1u); break; } } } } while (0)
struct XcdBarrier { unsigned* bar; unsigned x; volatile LAS unsigned* st; };
__device__ __forceinline__ XcdBarrier xcd_barrier_post(unsigned* bar, volatile LAS unsigned* st) {
    XcdBarrier b; b.bar = bar; b.x = xb_xcc_id(); b.st = st;
    if (threadIdx.x == 0) (void)xb_add(&bar[XB_XCNT(b.x)], 1u);
    return b;
}
__device__ __forceinline__ void xcd_barrier_complete(unsigned* bar, unsigned x, unsigned& nloc, unsigned& nx) {
    const unsigned G = gridDim.x * gridDim.y * gridDim.z;
    unsigned sum, cnt, mine, sp = 0u;
    for (;;) {
        sum = 0u; cnt = 0u; mine = 0u;
#pragma unroll
        for (unsigned j = 0; j < 16; ++j) { const unsigned c = xb_ld(&bar[XB_XCNT(j)]); sum += c; cnt += (c > 0u) ? 1u : 0u; mine = (j == x) ? c : mine; }
        if (sum == G) break;
        __builtin_amdgcn_s_sleep(1);
        if ((++sp & 255u) == 0u) { if (xb_ld(&bar[XB_TMO])) break; if (sp > XB_SPIN_CAP) { atomicAdd(&bar[XB_TMO], 1u); break; } }
    }
    nloc = mine > 0u ? mine : 1u; nx = cnt > 0u ? cnt : 1u;
}
__device__ __forceinline__ void xcd_barrier(const XcdBarrier& b) {
    asm volatile("s_waitcnt vmcnt(0)" ::: "memory");
    __syncthreads();
    if (threadIdx.x == 0) {
        unsigned* bar = b.bar;
        __builtin_amdgcn_s_waitcnt(0);
        unsigned nloc = b.st[0], nx = b.st[1];
        if (nloc == 0u) { xcd_barrier_complete(bar, b.x, nloc, nx); b.st[0] = nloc; b.st[1] = nx; }
        const unsigned old = xb_add(&bar[XB_XSUB(b.x)], 1u);
        const unsigned gen = old / nloc;
        if (old + 1u == (gen + 1u) * nloc) {
            __builtin_amdgcn_fence(__ATOMIC_RELEASE, "agent");
            asm volatile("s_waitcnt vmcnt(0)" ::: "memory");
            const unsigned og = xb_add(&bar[XB_TOP], 1u);
            const unsigned tg = og / nx;
            if (og + 1u == (tg + 1u) * nx) xb_add(&bar[XB_TOPGEN], 1u);
            else XB_SPIN(xb_ld(&bar[XB_TOPGEN]) == tg, bar);
            __builtin_amdgcn_fence(__ATOMIC_ACQUIRE, "agent");
            xb_add(&bar[XB_XGEN(b.x)], 1u);
            asm volatile("s_waitcnt vmcnt(0)" ::: "memory");
        } else {
            XB_SPIN(xb_ld(&bar[XB_XGEN(b.x)]) == gen, bar);
            __builtin_amdgcn_fence(__ATOMIC_ACQUIRE, "agent");
            asm volatile("s_waitcnt vmcnt(0)" ::: "memory");
        }
    }
    __syncthreads();
}

struct Args { const float* in[20]; float* out; unsigned char* ws; int ph_lo, ph_hi; };
__device__ __forceinline__ const void* karg_ptr(int idx) {
    unsigned long long v = (unsigned long long)((const void* const __attribute__((address_space(4)))*)__builtin_amdgcn_kernarg_segment_ptr())[idx];
    asm volatile("" : "+s"(v)); return (const void*)(const GAS char*)v;
}
struct InProxy { __device__ __forceinline__ const float* operator[](int i) const { return (const float*)karg_ptr(i); } };
struct WsProxy { __device__ __forceinline__ operator unsigned char*() const { return (unsigned char*)karg_ptr(21); }
                 __device__ __forceinline__ unsigned char* operator+(size_t o) const { return (unsigned char*)karg_ptr(21) + o; } };
struct OutProxy { __device__ __forceinline__ operator float*() const { return (float*)karg_ptr(20); }
                  __device__ __forceinline__ float* operator+(size_t o) const { return (float*)karg_ptr(20) + o; } };
struct CtlProxy { __device__ __forceinline__ operator gu32*() const { return (gu32*)karg_ptr(21); }
                  __device__ __forceinline__ gu32* operator+(int o) const { return (gu32*)karg_ptr(21) + o; } };
struct Frame {
    LAS unsigned char* lds; volatile LAS unsigned* MISC; CtlProxy ctl;
    int tid, lane, wave, vcu, G, bx;
    InProxy in; OutProxy out; WsProxy ws;
};
enum { I_X = 0, I_C, I_N1G, I_N2G, I_WADA, I_BADA, I_MWIN, I_MBG, I_MNG, I_MWOUT, I_CWIN, I_CCW, I_CCB, I_CWOUT, I_WR, I_BR, I_EWG, I_EWU, I_EWD, I_FG };

__device__ __forceinline__ float wave_sum(float v) {
#pragma unroll
    for (int o = 1; o < 64; o <<= 1) v += __shfl_xor(v, o);
    return v;
}

__device__ __forceinline__ int glu_row(int n, int which) { return (n >> 7) * 256 + which * 128 + (n & 127); }
struct CvtItem { const float* src; bf16_t* dst; int ldw, K; };
constexpr int CVT_IN = 16 * 96, CVT_OUT = 16 * 32, CVT_G = NE * 16 * 16, CVT_D = NE * 8 * 32, CVT_ITEMS = CVT_IN + CVT_OUT + 2 * CVT_G + CVT_D;
__device__ __forceinline__ CvtItem cvt_decode(Frame& F, int L, int it) {
    const size_t lo_ = (L == 0) ? 0 : WS_WL1;
    CvtItem d; int r = it;
    if (r < CVT_IN) { const int kb = r / 96, nb = r % 96, n0 = nb * 32; d.K = D;
        if (L == 0) { d.src = F.in[I_MWIN] + (size_t)kb * 64 * MPROJ + n0; d.ldw = MPROJ; d.dst = (bf16_t*)(F.ws + lo_ + WS_W0) + (size_t)n0 * D + kb * 64; }
        else { int dr; if (n0 < D) dr = n0; else if (n0 < 2 * D) dr = D + glu_row(n0 - D, 0); else dr = D + glu_row(n0 - 2 * D, 1);
            d.src = F.in[I_CWIN] + (size_t)kb * 64 * 3 * D + n0; d.ldw = 3 * D; d.dst = (bf16_t*)(F.ws + lo_ + WS_W0) + (size_t)dr * D + kb * 64; }
        return d; } r -= CVT_IN;
    if (r < CVT_OUT) { const int kb = r / 32, nb = r % 32; d.K = D; d.ldw = D; d.src = (L == 0 ? F.in[I_MWOUT] : F.in[I_CWOUT]) + (size_t)kb * 64 * D + nb * 32; d.dst = (bf16_t*)(F.ws + lo_ + WS_W1) + (size_t)nb * 32 * D + kb * 64; return d; } r -= CVT_OUT;
    if (r < 2 * CVT_G) { const int which = r / CVT_G; r %= CVT_G; const int e = r / 256, kb = (r % 256) / 16, nb = r % 16, n0 = nb * 32; d.K = D; d.ldw = DE;
        d.src = (which == 0 ? F.in[I_EWG] : F.in[I_EWU]) + ((size_t)L * NE + e) * D * DE + (size_t)kb * 64 * DE + n0;
        d.dst = (bf16_t*)(F.ws + lo_ + WS_WUP) + (size_t)e * 1024 * D + (size_t)glu_row(n0, which) * D + kb * 64; return d; } r -= 2 * CVT_G;
    { const int e = r / 256, kb = (r % 256) / 32, nb = r % 32; d.K = DE; d.ldw = D;
      d.src = F.in[I_EWD] + ((size_t)L * NE + e) * DE * D + (size_t)kb * 64 * D + nb * 32;
      d.dst = (bf16_t*)(F.ws + lo_ + WS_WDN) + (size_t)e * D * DE + (size_t)nb * 32 * DE + kb * 64; }
    return d;
}
__device__ __forceinline__ void convert_weights(Frame& F, int L) {
    LAS float* scr = (LAS float*)(F.lds + F.wave * 16384);
    const int gw = F.vcu * NWAVES + F.wave, NGW = F.G * NWAVES, lane = F.lane;
    float ld[32];
    CvtItem cur, nxt;
    int it = gw;
    if (it < CVT_ITEMS) { cur = cvt_decode(F, L, it);
#pragma unroll
        for (int i = 0; i < 32; ++i) ld[i] = cur.src[(size_t)(2 * i + (lane >> 5)) * cur.ldw + (lane & 31)]; }
    for (; it < CVT_ITEMS; it += NGW) {
#pragma unroll
        for (int i = 0; i < 32; ++i) scr[(2 * i + (lane >> 5)) * 33 + (lane & 31)] = ld[i];
        const bool more = it + NGW < CVT_ITEMS;
        if (more) { nxt = cvt_decode(F, L, it + NGW);
#pragma unroll
            for (int i = 0; i < 32; ++i) ld[i] = nxt.src[(size_t)(2 * i + (lane >> 5)) * nxt.ldw + (lane & 31)]; }
        LDS_WAIT(); asm volatile("" ::: "memory");
        const int c = lane & 7;
#pragma unroll
        for (int j = 0; j < 4; ++j) { const int n = (lane >> 3) + 8 * j; const LAS float* s = scr + (8 * c) * 33 + n;
            u32x4 o; o.x = pk2(s[0 * 33], s[1 * 33]); o.y = pk2(s[2 * 33], s[3 * 33]); o.z = pk2(s[4 * 33], s[5 * 33]); o.w = pk2(s[6 * 33], s[7 * 33]);
            *(GAS u32x4*)(cur.dst + (size_t)n * cur.K + 8 * c) = o; }
        LDS_WAIT(); asm volatile("" ::: "memory");
        cur = nxt;
    }
}

__device__ __forceinline__ void phase_prologue(Frame& F) {
    float* MOD = (float*)(F.ws + WS_MOD);
    LAS float* cond = (LAS float*)(F.lds + 0);
    LAS float* red = (LAS float*)(F.lds + 16384);
    bool did = false;
    for (int task = F.bx; task < 192; task += F.G) {
        if (did) __syncthreads();
        did = true;
        for (int i = F.tid; i < NB * D; i += NTHR) { const int b = i / D, k = i % D; const float c = F.in[I_C][i]; cond[k * 4 + b] = c * sigmoidf_(c); }
        __syncthreads();
        const int layer = task / 96, col = (task % 96) * 64 + F.lane;
        const float* W = F.in[I_WADA] + (size_t)layer * D * 6 * D;
        float a0 = 0.f, a1 = 0.f, a2 = 0.f, a3 = 0.f;
#pragma unroll 8
        for (int kk = 0; kk < 128; ++kk) { const int k = F.wave * 128 + kk; const float w = W[(size_t)k * 6 * D + col]; const f32x4 c4 = *(const LAS f32x4*)(cond + k * 4);
            a0 += c4[0] * w; a1 += c4[1] * w; a2 += c4[2] * w; a3 += c4[3] * w; }
        red[(F.wave * 4 + 0) * 64 + F.lane] = a0; red[(F.wave * 4 + 1) * 64 + F.lane] = a1; red[(F.wave * 4 + 2) * 64 + F.lane] = a2; red[(F.wave * 4 + 3) * 64 + F.lane] = a3;
        __syncthreads();
        if (F.tid < 256) { const int b = F.tid >> 6, l = F.tid & 63; float s = 0.f;
#pragma unroll
            for (int w = 0; w < 8; ++w) s += red[(w * 4 + b) * 64 + l];
            const int c = (task % 96) * 64 + l;
            MOD[((size_t)layer * NB + b) * 6 * D + c] = s + F.in[I_BADA][(size_t)layer * 6 * D + c]; }
    }
    __syncthreads();
    convert_weights(F, 0);
}

template <int N>
__device__ __forceinline__ void xreduce(float (&v)[N], int lane) {
    constexpr int STEPS = (N == 32) ? 5 : 4;
#pragma unroll
    for (int step = 0; step < STEPS; ++step) {
        const int M = 32 >> step, n = N >> step;
        const bool up = (lane & M) != 0;
#pragma unroll
        for (int i = 0; i < n / 2; ++i) { float a = v[i], b = v[i + n / 2]; asm volatile("" : "+v"(a), "+v"(b));
            const float send = up ? a : b, keep = up ? b : a; v[i] = keep + __shfl_xor(send, M); }
    }
    if (N == 16) v[0] += __shfl_xor(v[0], 2);
    v[0] += __shfl_xor(v[0], 1);
}

constexpr int RP_WL = 0, RP_RINFO = 65536, RP_LCNT = RP_RINFO + 128 * 8 * 4, RP_TPRE = RP_LCNT + 256;
template <int MODE>
__device__ __forceinline__ void row_pass(Frame& F, int layer) {
    constexpr int DOTS = (MODE == 0) ? 8 : (MODE == 1 ? 16 : 0);
    constexpr int RPI = 2, NIT = 16 / RPI, NV = (DOTS > 0) ? RPI * DOTS : 16;
    constexpr bool COMBINE = (MODE == 2 || MODE == 3), MODUL = (MODE != 3);
    const float* MOD = (const float*)(F.ws + WS_MOD);
    LAS float* wl = (LAS float*)(F.lds + RP_WL);
    LAS int* rinfo = (LAS int*)(F.lds + RP_RINFO);
    LAS int* lcnt = (LAS int*)(F.lds + RP_LCNT);
    LAS int* tpre = (LAS int*)(F.lds + RP_TPRE);
    const float* xin = F.in[I_X];
    bf16_t* XB = (bf16_t*)(F.ws + WS_XB);
    float* xout = F.out;
    bf16_t* U = (bf16_t*)(F.ws + WS_U);
    const bf16_t* O = (const bf16_t*)(F.ws + WS_O);
    const unsigned char* TOKp = (const unsigned char*)(F.ws + WS_TOK);
    const int lane = F.lane;
    const int clayer = (MODE == 2) ? 0 : 1;
    if (DOTS > 0) { constexpr int NQ = D * (DOTS > 0 ? DOTS : 4) / 4 / NTHR;
        f32x4 tv[NQ];
#pragma unroll
        for (int q = 0; q < NQ; ++q) { const int piece = F.tid + q * NTHR, k = piece / (DOTS / 4), c4 = piece % (DOTS / 4);
            tv[q] = (DOTS == 8) ? *(const f32x4*)(F.in[I_MWIN] + (size_t)k * MPROJ + 3072 + 4 * c4) : *(const f32x4*)(F.in[I_WR] + (size_t)piece * 4); }
#pragma unroll
        for (int q = 0; q < NQ; ++q) { const int piece = F.tid + q * NTHR, k = piece / (DOTS / 4), c4 = piece % (DOTS / 4), jj = k >> 8, l = (k >> 2) & 63, ii = k & 3;
            const int rot = (DOTS == 16) ? ((l >> 2) & 3) : ((l >> 3) & 1), ch = (c4 + rot) & (DOTS / 4 - 1);
            *(LAS f32x4*)(wl + ((jj * 4 + ii) * 64 + l) * DOTS + ch * 4) = tv[q]; } }
    if (COMBINE && F.tid == 0) { int a = 0; for (int e = 0; e < NE; ++e) { tpre[e] = a; a += ((int)__hip_atomic_load(F.ctl + CW_CNT + 64 * clayer + e, RLX_AGENT) + 255) >> 8; } tpre[NE] = a; }
    float brt[16];
    if (MODE == 1) {
#pragma unroll
        for (int e = 0; e < 16; ++e) brt[e] = F.in[I_BR][e]; }
    for (int batch = F.vcu; batch < T / 128; batch += F.G) {
        __syncthreads();
        if (MODE == 1 && F.tid < 32) lcnt[F.tid] = 0;
        __syncthreads();
        const int row_base = batch * 128 + F.wave * 16, b = row_base / SEQ;
        const float* gam = (MODE == 3) ? F.in[I_FG] : ((MODE == 1) ? F.in[I_N2G] + (size_t)layer * D : F.in[I_N1G] + (size_t)layer * D);
        const float* mod = MOD + ((size_t)layer * NB + b) * 6 * D;
        const float* shp = mod + ((MODE == 1) ? 3 * D : 0); const float* scp = shp + D;
        const float* g2p = MOD + ((size_t)clayer * NB + b) * 6 * D + 5 * D;
        f32x4 gm[4], sh[4], sc[4], g2[4];
#pragma unroll
        for (int j = 0; j < 4; ++j) { gm[j] = *(const f32x4*)(gam + 256 * j + 4 * lane);
            if (MODUL) { sh[j] = *(const f32x4*)(shp + 256 * j + 4 * lane); sc[j] = *(const f32x4*)(scp + 256 * j + 4 * lane) + 1.0f; }
            if (COMBINE) g2[j] = *(const f32x4*)(g2p + 256 * j + 4 * lane); }
        f32x4 xn[RPI][4]; u32x2 on[RPI][2][4]; u32x4 tkn[RPI], tkn2[RPI];
#define RP_LOAD_X(IT) do { _Pragma("unroll") for (int r = 0; r < RPI; ++r) _Pragma("unroll") for (int j = 0; j < 4; ++j) { \
            if (MODE == 0) xn[r][j] = *(const f32x4*)(xin + (size_t)(row_base + (IT) * RPI + r) * D + 256 * j + 4 * lane); \
            else { const u32x2 xb_ = *(const u32x2*)(XB + (size_t)(row_base + (IT) * RPI + r) * D + 256 * j + 4 * lane); xn[r][j] = (f32x4){bflo(xb_.x), bfhi(xb_.x), bflo(xb_.y), bfhi(xb_.y)}; } } } while (0)
#define RP_LOAD_TOK(dst, IT) do { _Pragma("unroll") for (int r = 0; r < RPI; ++r) dst[r] = *(const u32x4*)(TOKp + (size_t)(row_base + (IT) * RPI + r) * 16); } while (0)
#define RP_LOAD_O(tk) do { _Pragma("unroll") for (int r = 0; r < RPI; ++r) { const unsigned tx_ = tk[r].x, ty_ = tk[r].y; \
            const int e0_ = __builtin_amdgcn_readfirstlane((int)(tx_ >> 16)), e1_ = __builtin_amdgcn_readfirstlane((int)(ty_ >> 16)); \
            const int s0_ = tpre[e0_] * 256 + (int)(tx_ & 0xffffu), s1_ = tpre[e1_] * 256 + (int)(ty_ & 0xffffu); \
            _Pragma("unroll") for (int j = 0; j < 4; ++j) { on[r][0][j] = *(const u32x2*)(O + (size_t)s0_ * D + 256 * j + 4 * lane); on[r][1][j] = *(const u32x2*)(O + (size_t)s1_ * D + 256 * j + 4 * lane); } } } while (0)
        RP_LOAD_X(0);
        if (COMBINE) { RP_LOAD_TOK(tkn, 0); RP_LOAD_O(tkn); RP_LOAD_TOK(tkn2, 1); }
#pragma unroll 1
        for (int it = 0; it < NIT; ++it) {
            const int r0 = row_base + it * RPI;
            f32x4 x[RPI][4]; u32x2 oc[RPI][2][4]; float w0c[RPI], w1c[RPI];
#pragma unroll
            for (int r = 0; r < RPI; ++r) {
#pragma unroll
                for (int j = 0; j < 4; ++j) { x[r][j] = xn[r][j]; if (COMBINE) { oc[r][0][j] = on[r][0][j]; oc[r][1][j] = on[r][1][j]; } }
                if (COMBINE) { const unsigned wz_ = tkn[r].z, ww_ = tkn[r].w; w0c[r] = __uint_as_float(wz_); w1c[r] = __uint_as_float(ww_); } }
            if (it + 1 < NIT) {
                RP_LOAD_X(it + 1);
                if (COMBINE) {
#pragma unroll
                    for (int r = 0; r < RPI; ++r) tkn[r] = tkn2[r];
                    RP_LOAD_O(tkn);
                    if (it + 2 < NIT) RP_LOAD_TOK(tkn2, it + 2); } }
            if (COMBINE) {
#pragma unroll
                for (int r = 0; r < RPI; ++r)
#pragma unroll
                    for (int j = 0; j < 4; ++j) { const u32x2 a = oc[r][0][j], c = oc[r][1][j]; const float w0 = w0c[r], w1 = w1c[r];
                        f32x4 mo; mo[0] = w0 * bflo(a.x) + w1 * bflo(c.x); mo[1] = w0 * bfhi(a.x) + w1 * bfhi(c.x); mo[2] = w0 * bflo(a.y) + w1 * bflo(c.y); mo[3] = w0 * bfhi(a.y) + w1 * bfhi(c.y);
                        x[r][j] = x[r][j] + g2[j] * mo;
                        if (MODE == 2) { u32x2 xw_; xw_.x = pk2(x[r][j][0], x[r][j][1]); xw_.y = pk2(x[r][j][2], x[r][j][3]); *(u32x2*)(XB + (size_t)(r0 + r) * D + 256 * j + 4 * lane) = xw_; } }
            }
            float rstd[RPI];
#pragma unroll
            for (int r = 0; r < RPI; ++r) { float s = 0.f;
#pragma unroll
                for (int j = 0; j < 4; ++j) s += (x[r][j][0] * x[r][j][0] + x[r][j][1] * x[r][j][1]) + (x[r][j][2] * x[r][j][2] + x[r][j][3] * x[r][j][3]);
                rstd[r] = 1.0f / sqrtf(wave_sum(s) * (1.0f / D) + EPS); }
#pragma unroll
            for (int r = 0; r < RPI; ++r)
#pragma unroll
                for (int j = 0; j < 4; ++j) { f32x4 y = x[r][j] * rstd[r] * gm[j]; if (MODUL) y = y * sc[j] + sh[j]; x[r][j] = y;
                    if (MODE == 3) *(f32x4*)(xout + (size_t)(r0 + r) * D + 256 * j + 4 * lane) = y;
                    else { u32x2 w; w.x = pk2(y[0], y[1]); w.y = pk2(y[2], y[3]); *(u32x2*)(U + (size_t)(r0 + r) * D + 256 * j + 4 * lane) = w; } }
            if (DOTS > 0) {
                float v[NV];
#pragma unroll
                for (int i = 0; i < NV; ++i) v[i] = 0.f;
#pragma unroll
                for (int j = 0; j < 4; ++j)
#pragma unroll
                    for (int i = 0; i < 4; ++i) {
                        float w[DOTS > 0 ? DOTS : 1];
#pragma unroll
                        for (int q = 0; q < DOTS / 4; ++q) { const int rot = (DOTS == 16) ? ((lane >> 2) & 3) : ((lane >> 3) & 1);
                            const f32x4 t4 = *(const LAS f32x4*)(wl + ((j * 4 + i) * 64 + lane) * DOTS + ((q + rot) & (DOTS / 4 - 1)) * 4); w[4 * q] = t4[0]; w[4 * q + 1] = t4[1]; w[4 * q + 2] = t4[2]; w[4 * q + 3] = t4[3]; }
#pragma unroll
                        for (int r = 0; r < RPI; ++r)
#pragma unroll
                            for (int e = 0; e < DOTS; ++e) v[r * DOTS + e] += x[r][j][i] * w[e];
                        asm volatile("" ::: "memory"); }
                xreduce<NV>(v, lane);
                const float tot = v[0];
                if (MODE == 0) {
                    const int idx = lane >> 2, r = idx >> 3, gi = idx & 7, row = r0 + r, bb = row / SEQ, s = row % SEQ;
                    if ((lane & 3) == 0) {
                        const float pre = tot + F.in[I_MBG][gi];
                        if (gi < 4) ((float*)(F.ws + WS_IG))[(size_t)(bb * NH + gi) * SEQ + s] = pre;
                        else { const float ls = (pre >= 0.f) ? -log1pf(expf(-pre)) : (pre - log1pf(expf(pre))); ((float*)(F.ws + WS_LF))[(size_t)(bb * NH + gi - 4) * SEQ + s] = ls; }
                    }
                }
                if (MODE == 1) {
#pragma unroll
                    for (int r = 0; r < RPI; ++r) {
                        float lg[16], mx = -INFINITY;
#pragma unroll
                        for (int e = 0; e < 16; ++e) { lg[e] = __shfl(tot, 32 * r + 2 * e); mx = fmaxf(mx, lg[e]); }
                        float se = 0.f;
#pragma unroll
                        for (int e = 0; e < 16; ++e) { lg[e] = expf(lg[e] - mx); se += lg[e]; }
                        const float inv = 1.0f / se;
                        float sel[16];
#pragma unroll
                        for (int e = 0; e < 16; ++e) { lg[e] *= inv; sel[e] = lg[e] + brt[e]; }
                        int best = 0; float bscore = -INFINITY;
#pragma unroll
                        for (int gq = 0; gq < 4; ++gq) { const float a = sel[4 * gq], bq = sel[4 * gq + 1], c = sel[4 * gq + 2], d = sel[4 * gq + 3];
                            const float m1 = fmaxf(fmaxf(a, bq), fmaxf(c, d));
                            const float lo1 = fminf(a, bq), hi1 = fmaxf(a, bq), lo2 = fminf(c, d), hi2 = fmaxf(c, d);
                            const float m2 = fmaxf(fminf(hi1, hi2), fmaxf(lo1, lo2));
                            const float gs = m1 + m2; if (gs > bscore) { bscore = gs; best = gq; } }
                        float s4[4], p4[4];
#pragma unroll
                        for (int q = 0; q < 4; ++q) { s4[q] = -INFINITY; p4[q] = 0.f; }
#pragma unroll
                        for (int gq = 0; gq < 4; ++gq) if (best == gq) {
#pragma unroll
                            for (int q = 0; q < 4; ++q) { s4[q] = sel[4 * gq + q]; p4[q] = lg[4 * gq + q]; } }
                        int i0 = 0; float v0 = s4[0], pp0 = p4[0];
#pragma unroll
                        for (int q = 1; q < 4; ++q) if (s4[q] > v0) { v0 = s4[q]; i0 = q; pp0 = p4[q]; }
                        int i1 = -1; float v1 = -INFINITY, pp1 = 0.f;
#pragma unroll
                        for (int q = 0; q < 4; ++q) if (q != i0 && s4[q] > v1) { v1 = s4[q]; i1 = q; pp1 = p4[q]; }
                        const float wsum = pp0 + pp1, w0 = pp0 / wsum, w1 = pp1 / wsum;
                        const int e0 = best * 4 + i0, e1 = best * 4 + i1;
                        if (lane == 0) {
                            const int lp0 = __hip_atomic_fetch_add(lcnt + e0, 1, __ATOMIC_RELAXED, __HIP_MEMORY_SCOPE_WORKGROUP), lp1 = __hip_atomic_fetch_add(lcnt + e1, 1, __ATOMIC_RELAXED, __HIP_MEMORY_SCOPE_WORKGROUP);
                            LAS int* ri = rinfo + (F.wave * 16 + it * RPI + r) * 8;
                            ri[0] = e0; ri[1] = e1; ri[2] = lp0; ri[3] = lp1; ri[4] = __builtin_bit_cast(int, w0); ri[5] = __builtin_bit_cast(int, w1);
                        }
                    }
                }
            }
        }
#undef RP_LOAD_X
#undef RP_LOAD_TOK
#undef RP_LOAD_O
        if (MODE == 1) {
            __syncthreads();
            if (F.tid < 16) lcnt[16 + F.tid] = (int)__hip_atomic_fetch_add(F.ctl + CW_CNT + 64 * layer + F.tid, (unsigned)lcnt[F.tid], RLX_AGENT);
            __syncthreads();
            if (F.tid < 128) { const LAS int* ri = rinfo + F.tid * 8; const int row = batch * 128 + F.tid; const int e0 = ri[0], e1 = ri[1], p0 = lcnt[16 + e0] + ri[2], p1 = lcnt[16 + e1] + ri[3];
                int* LIST = (int*)(F.ws + WS_LIST); LIST[e0 * LCAP + p0] = row; LIST[e1 * LCAP + p1] = row;
                u32x4 ti; ti.x = (unsigned)(e0 << 16) | (unsigned)p0; ti.y = (unsigned)(e1 << 16) | (unsigned)p1; ti.z = (unsigned)ri[4]; ti.w = (unsigned)ri[5];
                *(u32x4*)(F.ws + WS_TOK + (size_t)row * 16) = ti; }
        }
    }
    __syncthreads();
}

#define LBAR() do { asm volatile("s_waitcnt lgkmcnt(0)" ::: "memory"); __builtin_amdgcn_s_barrier(); asm volatile("" ::: "memory"); } while (0)
__device__ __forceinline__ float incl_sum(float v, int lane) {
#pragma unroll
    for (int o = 1; o < 64; o <<= 1) { const float t = __shfl_up(v, o); if (lane >= o) v += t; }
    return v;
}
__device__ __forceinline__ float incl_max(float v, int lane) {
#pragma unroll
    for (int o = 1; o < 64; o <<= 1) { const float t = __shfl_up(v, o); if (lane >= o) v = fmaxf(v, t); }
    return v;
}
__device__ __forceinline__ void phase_scan(Frame& F, int mode = 0) {
    LAS float* wkA = (LAS float*)(F.lds + 0);
    LAS float* decA = (LAS float*)(F.lds + 32768);
    LAS float* tot = (LAS float*)(F.lds + 33280);
    LAS float* bst = (LAS float*)(F.lds + 33792);
    LAS float* cmx = (LAS float*)(F.lds + 34304);
    LAS float* rst = (LAS float*)(F.lds + 34816);
    LAS float* xw = (LAS float*)(F.lds + 35328);
    LAS unsigned char* ring = F.lds + 40960;
    constexpr int SLOT = 18432;
    const int lane = F.lane, w = F.wave, tid = F.tid;
    for (int unit = F.vcu; unit < 256; unit += F.G) {
        const int bh = unit >> 4, slice = unit & 15;
        const float* IG = (const float*)(F.ws + WS_IG) + (size_t)bh * SEQ; const float* LF = (const float*)(F.ws + WS_LF) + (size_t)bh * SEQ;
        __syncthreads();
        if (mode < 2) {
        float p[16], g[16], pm[16];
#pragma unroll
        for (int q = 0; q < 16; ++q) { const int c = 16 * w + q; p[q] = incl_sum(LF[c * 64 + lane], lane); if (lane == 63) tot[c] = p[q]; }
        __syncthreads();
        if (tid < 128) { const float v = tot[tid]; const float inc = incl_sum(v, lane); if (tid == 63) xw[0] = inc; bst[tid] = inc - v; }
        __syncthreads();
        if (tid >= 64 && tid < 128) bst[tid] += xw[0];
        __syncthreads();
#pragma unroll
        for (int q = 0; q < 16; ++q) { const int c = 16 * w + q; p[q] += bst[c]; g[q] = IG[c * 64 + lane] - p[q]; pm[q] = incl_max(g[q], lane); if (lane == 63) cmx[c] = pm[q]; }
        __syncthreads();
        if (tid < 128) { const float v = cmx[tid]; const float inc = incl_max(v, lane); if (tid == 63) xw[1] = inc; float ex = __shfl_up(inc, 1); if (lane == 0) ex = 0.f; rst[tid] = fmaxf(ex, 0.f); }
        __syncthreads();
        if (tid >= 64 && tid < 128) rst[tid] = fmaxf(rst[tid], xw[1]);
        __syncthreads();
#pragma unroll
        for (int q = 0; q < 16; ++q) { const int c = 16 * w + q; const float Rs = rst[c], Rn = fmaxf(Rs, cmx[c]), Rrun = fmaxf(Rs, pm[q]);
            wkA[c * 64 + lane] = expf(g[q] - Rn); if (lane == 0) decA[c] = expf(Rs - Rn);
            if (slice == 0) { const size_t o = (size_t)bh * SEQ + c * 64 + lane; ((float*)(F.ws + WS_GA))[o] = g[q]; ((float*)(F.ws + WS_RR))[o] = Rrun; ((float*)(F.ws + WS_MM))[o] = p[q] + Rrun;
                if (lane == 0) ((float*)(F.ws + WS_RC))[bh * NCH + c] = Rs; } }
        }
        __syncthreads();
        if (mode == 1) continue;
        const bf16_t* KTg = (const bf16_t*)(F.ws + WS_KT) + (size_t)bh * NCH * DK * 64;
        const bf16_t* VTg = (const bf16_t*)(F.ws + WS_VT) + ((size_t)bh * NCH * DV + 16 * slice) * 64;
        bf16_t* STp = (bf16_t*)(F.ws + WS_ST) + ((size_t)bh * NCH * DV + 16 * slice + (lane & 15)) * DK + 16 * w + 4 * (lane >> 4);
        float* NSp = (float*)(F.ws + WS_NS) + (size_t)bh * NCH * DK + 16 * w + 4 * (lane >> 4);
        f32x4 accS = (f32x4){0.f, 0.f, 0.f, 0.f}, accN = (f32x4){0.f, 0.f, 0.f, 0.f};
        constexpr int PD = 4;
        u32x4 gk[PD][2], gv[PD];
        const int wr0 = (tid >> 3) * 128 + (((tid & 7) ^ ((tid >> 3) & 7)) << 4);
        const int arow = 16 * w + (lane & 15), brow = lane & 15, lq = lane >> 4;
#define SC_LOAD(set, cc) do { gk[set][0] = *(const u32x4*)(KTg + (size_t)(cc) * DK * 64 + tid * 8); gk[set][1] = *(const u32x4*)(KTg + (size_t)(cc) * DK * 64 + 4096 + tid * 8); \
        if (tid < 128) gv[set] = *(const u32x4*)(VTg + (size_t)(cc) * DV * 64 + tid * 8); } while (0)
#define SC_WRITE(set, slot) do { LAS unsigned char* sb_ = ring + (slot) * SLOT; *(LAS u32x4*)(sb_ + wr0) = gk[set][0]; *(LAS u32x4*)(sb_ + 8192 + wr0) = gk[set][1]; \
        if (tid < 128) *(LAS u32x4*)(sb_ + 16384 + wr0) = gv[set]; } while (0)
#pragma unroll
        for (int q = 0; q < PD; ++q) SC_LOAD(q, q);
        SC_WRITE(0, 0);
        SC_LOAD(0, PD);
        LBAR();
        for (int c0 = 0; c0 < NCH; c0 += PD) {
#pragma unroll
            for (int q = 0; q < PD; ++q) {
                const int c = c0 + q;
                if (c + 1 < NCH) { SC_WRITE((q + 1) % PD, (q + 1) & 1); if (c + 1 + PD < NCH) SC_LOAD((q + 1) % PD, c + 1 + PD); }
                if (mode < 3) { { u32x2 o; o.x = pk2(accS[0], accS[1]); o.y = pk2(accS[2], accS[3]); *(u32x2*)(STp + (size_t)c * DV * DK) = o; }
                if (slice == 0 && (lane & 15) == 0) *(f32x4*)(NSp + (size_t)c * DK) = accN; }
                const float dec = decA[c];
                accS = accS * dec; accN = accN * dec;
                const LAS unsigned char* sb = ring + (q & 1) * SLOT;
#pragma unroll
                for (int kk = 0; kk < 2; ++kk) {
                    const LAS f32x4* wp = (const LAS f32x4*)(wkA + c * 64 + kk * 32 + 8 * lq);
                    const f32x4 w0 = wp[0], w1 = wp[1];
                    const u32x4 ka = *(const LAS u32x4*)(sb + arow * 128 + (((4 * kk + lq) ^ (arow & 7)) << 4));
                    const u32x4 vv = *(const LAS u32x4*)(sb + 16384 + brow * 128 + (((4 * kk + lq) ^ (brow & 7)) << 4));
                    u32x4 bv, b1;
                    bv.x = pk2(bflo(vv.x) * w0[0], bfhi(vv.x) * w0[1]); bv.y = pk2(bflo(vv.y) * w0[2], bfhi(vv.y) * w0[3]);
                    bv.z = pk2(bflo(vv.z) * w1[0], bfhi(vv.z) * w1[1]); bv.w = pk2(bflo(vv.w) * w1[2], bfhi(vv.w) * w1[3]);
                    b1.x = pk2(w0[0], w0[1]); b1.y = pk2(w0[2], w0[3]); b1.z = pk2(w1[0], w1[1]); b1.w = pk2(w1[2], w1[3]);
                    const bf16x8 af = __builtin_bit_cast(bf16x8, ka);
                    accS = __builtin_amdgcn_mfma_f32_16x16x32_bf16(af, __builtin_bit_cast(bf16x8, bv), accS, 0, 0, 0);
                    accN = __builtin_amdgcn_mfma_f32_16x16x32_bf16(af, __builtin_bit_cast(bf16x8, b1), accN, 0, 0, 0);
                }
                LBAR();
            }
        }
        asm volatile("" :: "v"(accS), "v"(accN));
#undef SC_LOAD
#undef SC_WRITE
    }
    __syncthreads();
}

constexpr int OC_AP = 0, OC_STRIDE = 400, OC_BVEC = 25600, OC_INV = 26368, OC_PART = 26624, OC_GS = 28672, OC_RT = 28928, OC_EMM = 29184, OC_HT = 32768, OC_HSTR = 528;
__device__ __forceinline__ void phase_out(Frame& F) {
    LAS unsigned char* AP = F.lds + OC_AP; LAS unsigned char* HT = F.lds + OC_HT;
    LAS float* bvec = (LAS float*)(F.lds + OC_BVEC); LAS float* inv = (LAS float*)(F.lds + OC_INV); LAS float* part = (LAS float*)(F.lds + OC_PART);
    LAS float* gs = (LAS float*)(F.lds + OC_GS); LAS float* Rt = (LAS float*)(F.lds + OC_RT); LAS float* emm = (LAS float*)(F.lds + OC_EMM);
    const int lane = F.lane, w = F.wave, tid = F.tid, l15 = lane & 15, lq = lane >> 4;
    const bf16_t* Qg = (const bf16_t*)(F.ws + WS_Q); const bf16_t* Kg = (const bf16_t*)(F.ws + WS_K);
    const bf16_t* VTg = (const bf16_t*)(F.ws + WS_VT); const bf16_t* STg = (const bf16_t*)(F.ws + WS_ST); const bf16_t* OGS = (const bf16_t*)(F.ws + WS_OGS);
    const float* GAg = (const float*)(F.ws + WS_GA); const float* RRg = (const float*)(F.ws + WS_RR); const float* MMg = (const float*)(F.ws + WS_MM);
    const float* NSg = (const float*)(F.ws + WS_NS); const float* RCg = (const float*)(F.ws + WS_RC); const float* MNG = F.in[I_MNG];
    bf16_t* HN = (bf16_t*)(F.ws + WS_U);
    const int mt = w >> 1, ntb = (w & 1) * 2, tq = tid >> 3, pq = tid & 7, NU = 16 * NCH;
    u32x4 bfr[2][6], qa[4], kb[2][4], q0, q1, og[4]; f32x4 ng0, ng1; float sc_g = 0.f, sc_r = 0.f, sc_m = 0.f, sc_b = 0.f, Rc = 0.f;
#define OC_LOAD_MAIN(U_) do { const int bh_ = (U_) >> 7, c_ = (U_) & 127, tk_ = (bh_ >> 2) * SEQ + c_ * 64, h_ = bh_ & 3; \
        _Pragma("unroll") for (int n = 0; n < 2; ++n) { const int dv = 32 * w + 16 * n + l15; \
            _Pragma("unroll") for (int kk = 0; kk < 2; ++kk) bfr[n][kk] = *(const u32x4*)(VTg + ((((size_t)bh_ * NCH + c_) * DV + dv) << 6) + 32 * kk + 8 * lq); \
            _Pragma("unroll") for (int kk = 0; kk < 4; ++kk) bfr[n][2 + kk] = *(const u32x4*)(STg + (((size_t)bh_ * NCH + c_) * DV + dv) * DK + 32 * kk + 8 * lq); } \
        _Pragma("unroll") for (int kk = 0; kk < 4; ++kk) { qa[kk] = *(const u32x4*)(Qg + (size_t)(tk_ + 16 * mt + l15) * MQK + h_ * DK + 32 * kk + 8 * lq); \
            _Pragma("unroll") for (int n = 0; n < 2; ++n) kb[n][kk] = *(const u32x4*)(Kg + (size_t)(tk_ + 16 * (ntb + n) + l15) * MQK + h_ * DK + 32 * kk + 8 * lq); } \
        q0 = *(const u32x4*)(Qg + (size_t)(tk_ + tq) * MQK + h_ * DK + 16 * pq); q1 = *(const u32x4*)(Qg + (size_t)(tk_ + tq) * MQK + h_ * DK + 16 * pq + 8); \
        if (tid < 64) { const size_t o_ = (size_t)bh_ * SEQ + c_ * 64 + tid; sc_g = GAg[o_]; sc_r = RRg[o_]; sc_m = MMg[o_]; sc_b = 1.0f; } \
        else if (tid < 192) sc_b = NSg[((size_t)bh_ * NCH + c_) * DK + tid - 64]; \
        Rc = RCg[bh_ * NCH + c_]; } while (0)
#define OC_LOAD_OGS(U_) do { const int bh_ = (U_) >> 7, c_ = (U_) & 127, tk_ = (bh_ >> 2) * SEQ + c_ * 64, h_ = bh_ & 3; \
        _Pragma("unroll") for (int q = 0; q < 4; ++q) og[q] = *(const u32x4*)(OGS + (size_t)(tk_ + (tid >> 5) + 16 * q) * MV + h_ * DV + 8 * (tid & 31)); \
        ng0 = *(const f32x4*)(MNG + h_ * DV + 8 * (tid & 31)); ng1 = *(const f32x4*)(MNG + h_ * DV + 8 * (tid & 31) + 4); } while (0)
    int unit = F.vcu;
    if (unit < NU) { OC_LOAD_MAIN(unit); OC_LOAD_OGS(unit); }
    for (; unit < NU; unit += F.G) {
        const int bh = unit >> 7, c = unit & 127, b = bh >> 2, h = bh & 3;
        const int tk0 = b * SEQ + c * 64;
        if (tid < 64) { gs[tid] = sc_g; Rt[tid] = sc_r; emm[tid] = expf(-sc_m); }
        if (tid < 192) bvec[tid] = sc_b;
        const float Rc_cur = Rc;
        LBAR();
        f32x4 pacc[2];
#pragma unroll
        for (int n = 0; n < 2; ++n) { pacc[n] = (f32x4){0.f, 0.f, 0.f, 0.f};
#pragma unroll
            for (int kk = 0; kk < 4; ++kk) pacc[n] = __builtin_amdgcn_mfma_f32_16x16x32_bf16(__builtin_bit_cast(bf16x8, qa[kk]), __builtin_bit_cast(bf16x8, kb[n][kk]), pacc[n], 0, 0, 0); }
#pragma unroll
        for (int n = 0; n < 2; ++n) { const int sl = 16 * (ntb + n) + l15; const float gsv = gs[sl];
#pragma unroll
            for (int r = 0; r < 4; ++r) { const int tl = 16 * mt + 4 * lq + r; const float pv = (sl <= tl) ? pacc[n][r] * expf(gsv - Rt[tl]) : 0.f;
                *(LAS bf16_t*)(AP + tl * OC_STRIDE + sl * 2) = (bf16_t)f2bf(pv); } }
        { const float wq = expf(Rc_cur - Rt[tq]);
          u32x4 o0, o1;
          o0.x = pk2(bflo(q0.x) * wq, bfhi(q0.x) * wq); o0.y = pk2(bflo(q0.y) * wq, bfhi(q0.y) * wq); o0.z = pk2(bflo(q0.z) * wq, bfhi(q0.z) * wq); o0.w = pk2(bflo(q0.w) * wq, bfhi(q0.w) * wq);
          o1.x = pk2(bflo(q1.x) * wq, bfhi(q1.x) * wq); o1.y = pk2(bflo(q1.y) * wq, bfhi(q1.y) * wq); o1.z = pk2(bflo(q1.z) * wq, bfhi(q1.z) * wq); o1.w = pk2(bflo(q1.w) * wq, bfhi(q1.w) * wq);
          *(LAS u32x4*)(AP + tq * OC_STRIDE + 128 + 32 * pq) = o0; *(LAS u32x4*)(AP + tq * OC_STRIDE + 128 + 32 * pq + 16) = o1; }
        LBAR();
        { float s = 0.f;
#pragma unroll
          for (int q = 0; q < 3; ++q) { const u32x4 a = *(const LAS u32x4*)(AP + tq * OC_STRIDE + 48 * pq + 16 * q); const LAS f32x4* bp = (const LAS f32x4*)(bvec + 24 * pq + 8 * q); const f32x4 b0 = bp[0], b1 = bp[1];
              s += bflo(a.x) * b0[0] + bfhi(a.x) * b0[1] + bflo(a.y) * b0[2] + bfhi(a.y) * b0[3] + bflo(a.z) * b1[0] + bfhi(a.z) * b1[1] + bflo(a.w) * b1[2] + bfhi(a.w) * b1[3]; }
          s += __shfl_xor(s, 1); s += __shfl_xor(s, 2); s += __shfl_xor(s, 4);
          if (pq == 0) inv[tq] = 1.0f / fmaxf(fabsf(s), emm[tq]); }
        f32x4 acc[4][2];
#pragma unroll
        for (int m = 0; m < 4; ++m)
#pragma unroll
            for (int n = 0; n < 2; ++n) acc[m][n] = (f32x4){0.f, 0.f, 0.f, 0.f};
#pragma unroll
        for (int kk = 0; kk < 6; ++kk) {
            bf16x8 af[4];
#pragma unroll
            for (int m = 0; m < 4; ++m) af[m] = *(const LAS bf16x8*)(AP + (16 * m + l15) * OC_STRIDE + 64 * kk + 16 * lq);
#pragma unroll
            for (int m = 0; m < 4; ++m)
#pragma unroll
                for (int n = 0; n < 2; ++n) acc[m][n] = __builtin_amdgcn_mfma_f32_16x16x32_bf16(af[m], __builtin_bit_cast(bf16x8, bfr[n][kk]), acc[m][n], 0, 0, 0);
        }
        const int nxt = unit + F.G;
        if (nxt < NU) OC_LOAD_MAIN(nxt);
        LBAR();
#pragma unroll
        for (int m = 0; m < 4; ++m)
#pragma unroll
            for (int r = 0; r < 4; ++r) { const int tl = 16 * m + 4 * lq + r; const float iv = inv[tl];
                const float h0 = acc[m][0][r] * iv, h1 = acc[m][1][r] * iv;
                *(LAS bf16_t*)(HT + tl * OC_HSTR + (32 * w + l15) * 2) = (bf16_t)f2bf(h0); *(LAS bf16_t*)(HT + tl * OC_HSTR + (32 * w + 16 + l15) * 2) = (bf16_t)f2bf(h1);
                float s = h0 * h0 + h1 * h1; s += __shfl_xor(s, 1); s += __shfl_xor(s, 2); s += __shfl_xor(s, 4); s += __shfl_xor(s, 8);
                if (l15 == 0) part[w * 64 + tl] = s; }
        LBAR();
#pragma unroll
        for (int q = 0; q < 4; ++q) { const int row = (tid >> 5) + 16 * q, ch = tid & 31; float ss = 0.f;
#pragma unroll
            for (int ww = 0; ww < 8; ++ww) ss += part[ww * 64 + row];
            const float rs = 1.0f / sqrtf(ss * (1.0f / DV) + EPS);
            const u32x4 hv = *(const LAS u32x4*)(HT + row * OC_HSTR + ch * 16); const u32x4 g = og[q];
            u32x4 o;
            o.x = pk2(bflo(hv.x) * rs * ng0[0] * bflo(g.x), bfhi(hv.x) * rs * ng0[1] * bfhi(g.x)); o.y = pk2(bflo(hv.y) * rs * ng0[2] * bflo(g.y), bfhi(hv.y) * rs * ng0[3] * bfhi(g.y));
            o.z = pk2(bflo(hv.z) * rs * ng1[0] * bflo(g.z), bfhi(hv.z) * rs * ng1[1] * bfhi(g.z)); o.w = pk2(bflo(hv.w) * rs * ng1[2] * bflo(g.w), bfhi(hv.w) * rs * ng1[3] * bfhi(g.w));
            *(u32x4*)(HN + (size_t)(tk0 + row) * MV + h * DV + 8 * ch) = o; }
        if (nxt < NU) OC_LOAD_OGS(nxt);
    }
#undef OC_LOAD_MAIN
#undef OC_LOAD_OGS
    __syncthreads();
}

__device__ __forceinline__ void phase_conv(Frame& F) {
    const bf16_t* BG = (const bf16_t*)(F.ws + WS_BG); const bf16_t* Z = (const bf16_t*)(F.ws + WS_Z); bf16_t* Y = (bf16_t*)(F.ws + WS_Y);
    const int cg = F.tid & 127, rsub = F.tid >> 7, col = 8 * cg;
    float w0[8], w1[8], w2[8], cb[8];
#pragma unroll
    for (int i = 0; i < 8; ++i) { w0[i] = F.in[I_CCW][col + i]; w1[i] = F.in[I_CCW][D + col + i]; w2[i] = F.in[I_CCW][2 * D + col + i]; cb[i] = F.in[I_CCB][col + i]; }
    for (int batch = F.vcu; batch < T / 128; batch += F.G) {
        const int t0 = batch * 128 + rsub * 32, s0 = t0 % SEQ;
        u32x4 z2 = (u32x4){0u, 0u, 0u, 0u}, z1 = z2;
        if (s0 >= 2) z2 = *(const u32x4*)(Z + (size_t)(t0 - 2) * D + col);
        if (s0 >= 1) z1 = *(const u32x4*)(Z + (size_t)(t0 - 1) * D + col);
#pragma unroll 4
        for (int r = 0; r < 32; ++r) {
            const u32x4 z0 = *(const u32x4*)(Z + (size_t)(t0 + r) * D + col), bg = *(const u32x4*)(BG + (size_t)(t0 + r) * D + col);
            float o[8];
#pragma unroll
            for (int i = 0; i < 4; ++i) {
                o[2 * i] = bflo(bg[i]) * (w0[2 * i] * bflo(z2[i]) + w1[2 * i] * bflo(z1[i]) + w2[2 * i] * bflo(z0[i]) + cb[2 * i]);
                o[2 * i + 1] = bfhi(bg[i]) * (w0[2 * i + 1] * bfhi(z2[i]) + w1[2 * i + 1] * bfhi(z1[i]) + w2[2 * i + 1] * bfhi(z0[i]) + cb[2 * i + 1]); }
            u32x4 ov; ov.x = pk2(o[0], o[1]); ov.y = pk2(o[2], o[3]); ov.z = pk2(o[4], o[5]); ov.w = pk2(o[6], o[7]);
            *(u32x4*)(Y + (size_t)(t0 + r) * D + col) = ov;
            z2 = z1; z1 = z0;
        }
    }
}

__device__ __forceinline__ void moe_table(Frame& F, int layer) {
    __syncthreads();
    if (F.tid == 0) { int a = 0; for (int e = 0; e < NE; ++e) { const int c = (int)__hip_atomic_load(F.ctl + CW_CNT + 64 * layer + e, RLX_AGENT); F.MISC[16 + e] = (unsigned)a; F.MISC[40 + e] = (unsigned)c; a += (c + 255) >> 8; } F.MISC[16 + NE] = (unsigned)a; }
    __syncthreads();
}

#ifndef TIMER_PHASE
#define TIMER_PHASE (-1)
#endif
#define STAMP(k) do { if (TIMER_PHASE >= 0 && blockIdx.x == 0 && threadIdx.x == 0) { unsigned long long t_ = __builtin_amdgcn_s_memrealtime(); ((unsigned long long*)karg_ptr(21))[4096 + (k)] = t_; } } while (0)
constexpr int N_PHASES = 17;
#define WSP(T_, off) ((T_*)(F.ws + (off)))
__global__ void __launch_bounds__(NTHR, 2) fwd_kernel(Args args) {
    extern __shared__ __attribute__((aligned(16))) unsigned char lds_raw[];
#define MAKE_FRAME() Frame F; { int t_ = threadIdx.x, bx_ = blockIdx.x, g_ = gridDim.x; asm volatile("" : "+v"(t_), "+s"(bx_), "+s"(g_)); \
        F.lds = (LAS unsigned char*)lds_raw; F.MISC = (volatile LAS unsigned*)(F.lds + MISC_OFF); F.tid = t_; F.lane = t_ & 63; F.wave = __builtin_amdgcn_readfirstlane(t_ >> 6); \
        F.G = g_; F.bx = bx_; F.vcu = (g_ % 8 == 0) ? (bx_ % 8) * (g_ / 8) + bx_ / 8 : bx_; }
    const int lo = args.ph_lo, hi = args.ph_hi;
    const bool one_launch = (hi - lo) > 1;
    XcdBarrier bar;
    { MAKE_FRAME();
      for (int u = F.tid; u < 256; u += NTHR) F.MISC[u] = 0u;
      __syncthreads();
      bar.bar = (unsigned*)(F.ctl + CW_BAR); bar.x = 0; bar.st = nullptr;
      if (one_launch) bar = xcd_barrier_post((unsigned*)(F.ctl + CW_BAR), F.MISC + 8); }
    STAMP(0);
#ifdef PH_ONLY
#define IN(k) ((k) == PH_ONLY && lo <= (k) && (k) < hi)
#else
#define IN(k) (lo <= (k) && (k) < hi)
#endif
#define SEAM(k) do { if (IN(k) && IN((k) + 1)) { xcd_barrier(bar); STAMP((k) + 1); } } while (0)
#ifndef DUP_MODE
#define DUP_MODE 0
#endif
#ifndef DUP_PHASE
#define DUP_PHASE (-1)
#endif
#define PHASE(k) if (IN(k)) { for (int rep_ = 0; rep_ < (((k) == DUP_PHASE) ? 2 : 1); ++rep_) { MAKE_FRAME(); asm volatile("; PHASE_MARK " #k);
#define END_PHASE(k) } } SEAM(k);
    PHASE(0) phase_prologue(F); END_PHASE(0)
    PHASE(1) row_pass<0>(F, 0); END_PHASE(1)
    PHASE(2) pg8::Gemm g{WSP(bf16_t, WS_U), WSP(bf16_t, WS_W0), D}; pg8::DenseOrder S; S.init(T, 3 * D, F.G, F.bx);
        pg8::EpiM1 E{WSP(bf16_t, WS_Q), WSP(bf16_t, WS_K), WSP(bf16_t, WS_KT), WSP(bf16_t, WS_VT), WSP(bf16_t, WS_OGS), F.lds + EPI_OFF};
        pg8::gemm_phase<pg8::EpiM1, pg8::DenseOrder, false, true, true>(F.lds, g, S, E, F.tid); END_PHASE(2)
    PHASE(3) phase_scan(F, rep_ == 0 ? 0 : DUP_MODE); END_PHASE(3)
    PHASE(4) phase_out(F); END_PHASE(4)
    PHASE(5) pg8::Gemm g{WSP(bf16_t, WS_U), WSP(bf16_t, WS_W1), D}; pg8::DenseOrder S; S.init(T, D, F.G, F.bx);
        pg8::EpiRes<true> E{F.in[I_X], WSP(bf16_t, WS_XB), WSP(float, WS_MOD) + 2 * D, (DBG_SKIP & 1) ? 0.f : 1.f};
        pg8::gemm_phase<pg8::EpiRes<true>, pg8::DenseOrder, false, true, true>(F.lds, g, S, E, F.tid); END_PHASE(5)
#define WL(L_, off) WSP(bf16_t, ((L_) == 0 ? (size_t)0 : WS_WL1) + (off))
#define MOE_BLOCK(L, p0, p1, p2) \
    PHASE(p0) row_pass<1>(F, L); END_PHASE(p0) \
    PHASE(p1) moe_table(F, L); \
        pg8::Gemm g{WSP(bf16_t, WS_U), WL(L, WS_WUP), D}; pg8::MoeOrder S{(const LAS int*)(F.MISC + 16), (const LAS int*)(F.MISC + 40), WSP(const int, WS_LIST), F.G, F.vcu, 1024}; \
        pg8::EpiGlu<true> E{WSP(bf16_t, WS_A), DE, 0, nullptr, 0}; \
        pg8::gemm_phase<pg8::EpiGlu<true>, pg8::MoeOrder, true, true, true>(F.lds, g, S, E, F.tid); END_PHASE(p1) \
    PHASE(p2) moe_table(F, L); \
        pg8::Gemm g{WSP(bf16_t, WS_A), WL(L, WS_WDN), DE}; pg8::MoeOrder S{(const LAS int*)(F.MISC + 16), (const LAS int*)(F.MISC + 40), WSP(const int, WS_LIST), F.G, F.vcu, 1024}; \
        pg8::EpiBf E{WSP(bf16_t, WS_O), D}; \
        pg8::gemm_phase<pg8::EpiBf, pg8::MoeOrder, false, true, true>(F.lds, g, S, E, F.tid); END_PHASE(p2)
    MOE_BLOCK(0, 6, 7, 8)
    PHASE(9) row_pass<2>(F, 1); convert_weights(F, 1); END_PHASE(9)
    PHASE(10) pg8::Gemm g{WSP(bf16_t, WS_U), WL(1, WS_W0), D}; pg8::DenseOrder S; S.init(T, 3 * D, F.G, F.bx);
        pg8::EpiGlu<false> E{WSP(bf16_t, WS_Z), D, 4, WSP(bf16_t, WS_BG), D};
        pg8::gemm_phase<pg8::EpiGlu<false>, pg8::DenseOrder, false, true, true>(F.lds, g, S, E, F.tid); END_PHASE(10)
    PHASE(11) phase_conv(F); END_PHASE(11)
    PHASE(12) pg8::Gemm g{WSP(bf16_t, WS_Y), WL(1, WS_W1), D}; pg8::DenseOrder S; S.init(T, D, F.G, F.bx);
        pg8::EpiRes<false> E{WSP(bf16_t, WS_XB), WSP(bf16_t, WS_XB), WSP(float, WS_MOD) + (size_t)NB * 6 * D + 2 * D, (DBG_SKIP & 4) ? 0.f : 1.f};
        pg8::gemm_phase<pg8::EpiRes<false>, pg8::DenseOrder, false, true, true>(F.lds, g, S, E, F.tid); END_PHASE(12)
    MOE_BLOCK(1, 13, 14, 15)
    if (IN(16)) { MAKE_FRAME(); asm volatile("; PHASE_MARK 16"); row_pass<3>(F, 1);
    }

    if (TIMER_PHASE >= 0 && one_launch) {
        STAMP(17);
        xcd_barrier(bar);
        const unsigned long long* ts = (const unsigned long long*)karg_ptr(21) + 4096;
        const unsigned long long d = __hip_atomic_load(ts + TIMER_PHASE + 1, RLX_AGENT) - __hip_atomic_load(ts + TIMER_PHASE, RLX_AGENT);
        const unsigned long long t0 = __builtin_amdgcn_s_memrealtime();
        while (__builtin_amdgcn_s_memrealtime() - t0 < 4ull * d) __builtin_amdgcn_s_sleep(8);
    }
#undef IN
#undef SEAM
}

extern "C" void kernel_launch(void* const* d_in, const int* in_sizes, int n_in, void* d_out, int out_size, void* d_ws, size_t ws_size, hipStream_t stream) {
    static int grid = 0;
    if (grid == 0) {
        if (n_in != 20 || in_sizes[0] != T * D || out_size != T * D || ws_size < WS_END) { fprintf(stderr, "kernel_launch: unexpected shapes: n_in %d in0 %d out %d ws %zu\n", n_in, n_in > 0 ? in_sizes[0] : -1, out_size, ws_size); grid = -1; return; }
        int dev = 0, cus = 0, per_cu = 0;
        if (hipGetDevice(&dev) != hipSuccess || hipDeviceGetAttribute(&cus, hipDeviceAttributeMultiprocessorCount, dev) != hipSuccess) { grid = -1; return; }
        if (hipFuncSetAttribute((const void*)fwd_kernel, hipFuncAttributeMaxDynamicSharedMemorySize, LDS_BYTES) != hipSuccess) { fprintf(stderr, "kernel_launch: hipFuncSetAttribute failed\n"); grid = -1; return; }
        if (hipOccupancyMaxActiveBlocksPerMultiprocessor(&per_cu, (const void*)fwd_kernel, NTHR, LDS_BYTES) != hipSuccess || per_cu < 1) { fprintf(stderr, "kernel_launch: occupancy query says %d blocks per CU\n", per_cu); (void)hipGetLastError(); grid = -1; return; }
        grid = cus;
        if (grid != 256) fprintf(stderr, "kernel_launch: %d CUs (built for 256)\n", grid);
    }
    if (grid < 0) return;
    (void)hipMemsetAsync((char*)d_ws + WS_CTL, 0, CTL_ZERO_BYTES, stream);
    Args a{};
    for (int i = 0; i < 20; ++i) a.in[i] = (const float*)d_in[i];
    a.out = (float*)d_out; a.ws = (unsigned char*)d_ws;
#if MK_N_LAUNCHES == 1
    a.ph_lo = 0; a.ph_hi = N_PHASES;
    void* kargs[] = {&a};
    hipError_t e = hipLaunchCooperativeKernel((const void*)fwd_kernel, dim3(grid), dim3(NTHR), kargs, LDS_BYTES, stream);
    if (e != hipSuccess) fprintf(stderr, "kernel_launch: cooperative launch failed: %s\n", hipGetErrorString(e));
#else
    for (int p = 0; p < N_PHASES; ++p) { a.ph_lo = p; a.ph_hi = p + 1; hipLaunchKernelGGL(fwd_kernel, dim3(grid), dim3(NTHR), LDS_BYTES, stream, a); }
#endif
}
```

```cpp
#include <hip/hip_runtime.h>
#include <cstdio>
#include <cstdint>

#ifndef DBG_SKIP
#define DBG_SKIP 0
#endif
#ifndef MK_N_LAUNCHES
#define MK_N_LAUNCHES 1
#endif

#define LAS __attribute__((address_space(3)))
#define GAS __attribute__((address_space(1)))
typedef unsigned short bf16_t;
typedef short bf16x8 __attribute__((ext_vector_type(8)));
typedef float f32x4 __attribute__((ext_vector_type(4)));
typedef float f32x2 __attribute__((ext_vector_type(2)));
typedef unsigned u32x4 __attribute__((ext_vector_type(4)));
typedef unsigned u32x2 __attribute__((ext_vector_type(2)));
typedef GAS unsigned gu32;
#define RLX_AGENT __ATOMIC_RELAXED, __HIP_MEMORY_SCOPE_AGENT
#define LDS_WAIT() asm volatile("s_waitcnt lgkmcnt(0)" ::: "memory")
#define VM_WAIT() asm volatile("s_waitcnt vmcnt(0)" ::: "memory")

constexpr int NB = 4, SEQ = 8192, D = 1024, T = NB * SEQ;
constexpr int NH = 4, DK = 128, DV = 256, MQK = NH * DK, MV = NH * DV, MPROJ = 2 * MQK + 2 * MV + 2 * NH;
constexpr int CH = 64, NCH = SEQ / CH;
constexpr int NE = 16, DE = 512, LCAP = 65536;
constexpr int SLOT_ROWS = 2 * T + NE * 256;
constexpr float EPS = 1e-6f;
constexpr int NWAVES = 8, NTHR = 512;

constexpr size_t MiB = 1u << 20;
constexpr size_t WS_CTL = 0, CTL_ZERO_BYTES = 64 * 1024;
constexpr size_t WS_MOD = 1 * MiB;
constexpr size_t WS_W0 = 2 * MiB;
constexpr size_t WS_W1 = 8 * MiB;
constexpr size_t WS_WUP = 10 * MiB;
constexpr size_t WS_WDN = 42 * MiB;
constexpr size_t WS_WL1 = 338 * MiB;
constexpr size_t WS_IG = 62 * MiB;
constexpr size_t WS_LF = WS_IG + 512 * 1024;
constexpr size_t WS_GA = WS_LF + 512 * 1024;
constexpr size_t WS_RR = WS_GA + 512 * 1024;
constexpr size_t WS_MM = WS_RR + 512 * 1024;
constexpr size_t WS_RC = WS_MM + 512 * 1024;
constexpr size_t WS_NS = 65 * MiB;
constexpr size_t WS_TOK = 66 * MiB;
constexpr size_t WS_LIST = 67 * MiB;
constexpr size_t WS_U = 72 * MiB;
constexpr size_t WS_Q = 136 * MiB;
constexpr size_t WS_K = 168 * MiB;
constexpr size_t WS_KT = 200 * MiB;
constexpr size_t WS_VT = 232 * MiB;
constexpr size_t WS_OGS = 296 * MiB;
constexpr size_t WS_ST = 360 * MiB;
constexpr size_t WS_A = 136 * MiB;
constexpr size_t WS_O = 204 * MiB;
constexpr size_t WS_BG = 136 * MiB;
constexpr size_t WS_Z = 200 * MiB;
constexpr size_t WS_Y = 264 * MiB;
constexpr size_t WS_XB = 400 * MiB;
constexpr size_t WS_END = 488 * MiB;
static_assert(WS_A + (size_t)SLOT_ROWS * DE * 2 <= WS_O && WS_O + (size_t)SLOT_ROWS * D * 2 <= WS_ST, "moe map");

constexpr int CW_CNT = 64;
constexpr int CW_CVT = 256;
constexpr int CW_BAR = 1024;

constexpr int RING_BYTES = 131072;
constexpr int MISC_OFF = RING_BYTES;
constexpr int EPI_OFF = MISC_OFF + 1024;
constexpr int LDS_BYTES = 149504;

typedef __bf16 bf16x2_t __attribute__((ext_vector_type(2)));
__device__ __forceinline__ unsigned f2bf(float f) { return (unsigned)__builtin_bit_cast(unsigned short, (__bf16)f); }
__device__ __forceinline__ unsigned pk2(float lo, float hi) { bf16x2_t v; v[0] = (__bf16)lo; v[1] = (__bf16)hi; return __builtin_bit_cast(unsigned, v); }
__device__ __forceinline__ float bf2f(unsigned short h) { return __builtin_bit_cast(float, (unsigned)h << 16); }
__device__ __forceinline__ float bflo(unsigned w) { return __builtin_bit_cast(float, w << 16); }
__device__ __forceinline__ float bfhi(unsigned w) { return __builtin_bit_cast(float, w & 0xffff0000u); }
__device__ __forceinline__ unsigned cvt_pk_bf16(float lo, float hi) { unsigned r; asm volatile("v_cvt_pk_bf16_f32 %0, %1, %2" : "=v"(r) : "v"(lo), "v"(hi)); return r; }
__device__ __forceinline__ float fast_exp(float x) { return __builtin_amdgcn_exp2f(x * 1.44269504089f); }
__device__ __forceinline__ float sigmoidf_(float x) { return __builtin_amdgcn_rcpf(1.0f + fast_exp(-x)); }

namespace pg8 {
constexpr int BM = 256, BK = 64, HALF = 128, HTB = HALF * BK * 2, STAGE_BYTES = 8 * HTB, NXCD = 8, WGM = 8;
__host__ __device__ __forceinline__ int lds_byte(int r, int c) { const int st = (r >> 4) * 2 + (c >> 5), rr = r & 15, cc = c & 31, ob = rr * 64 + cc * 2; return st * 1024 + (ob ^ (((ob >> 9) & 1) << 5)); }
__host__ __device__ __forceinline__ void stage_rc(int b, int& R, int& C) { const int st = b / 1024, sb = b % 1024, swz = sb ^ (((sb >> 9) & 1) << 5); R = (st >> 1) * 16 + swz / 64; C = (st & 1) * 32 + (swz % 64) / 2; }
__host__ __device__ __forceinline__ int perm32(int rho) { const int n = rho >> 4, i = rho & 15; return 8 * (i >> 2) + 4 * n + (i & 3); }

struct Unit { int arow0, brow0, pm, pn, e, nvalid; const int* alist; };
struct Gemm { const bf16_t* A; const bf16_t* Bt; int K; };

struct DenseOrder {
    int nM, nN, nwg, G, c;
    __device__ void init(int M, int N, int G_, int c_) { nM = M / BM; nN = N / BM; nwg = nM * nN; G = G_; c = c_; }
    __device__ bool next(int i, Unit& u) const {
        const long L = (long)i * G + c; if (L >= nwg) return false;
        int wgid = (int)L; { const int q = nwg / NXCD, r = nwg % NXCD, xcd = wgid % NXCD, off = wgid / NXCD; wgid = (xcd < r ? xcd * (q + 1) : r * (q + 1) + (xcd - r) * q) + off; }
        const int nig = WGM * nN, gid = wgid / nig, fm = gid * WGM, gsz = (nM - fm) < WGM ? (nM - fm) : WGM;
        u.pm = fm + ((wgid % nig) % gsz); u.pn = (wgid % nig) / gsz; u.arow0 = u.pm * BM; u.brow0 = u.pn * BM; u.e = 0; u.nvalid = 256; u.alist = nullptr; return true;
    }
};
struct MoeOrder {
    const LAS int* tpre; const LAS int* cnt; const int* list; int G, vcu, bn;
    __device__ bool next(int i, Unit& u) const {
        const int U = i * G + vcu, rt = U >> 2, pn = U & 3;
        if (rt >= tpre[NE]) return false;
        int e = 0;
#pragma unroll
        for (int k = 1; k < NE; ++k) e += (rt >= tpre[k]) ? 1 : 0;
        const int r = rt - tpre[e];
        u.arow0 = rt * BM; u.brow0 = e * bn + pn * BM; u.pm = rt; u.pn = pn; u.e = e; u.nvalid = min(256, cnt[e] - r * 256); u.alist = list + e * LCAP + r * 256; return true;
    }
};

template <class Epi, class Sched, bool GATHER, bool ALIGN_EPI, bool SP2>
__device__ __forceinline__ void gemm_phase(LAS unsigned char* lds, const Gemm g, const Sched& S, const Epi& E, const int tid) {
    const int wid = __builtin_amdgcn_readfirstlane(tid >> 6), lane = tid & 63, wr = wid >> 2, wc = wid & 3, fr = lane & 15, fq = lane >> 4;
    const int K = g.K, nt = K / BK;
    unsigned voffA[2], voffB[2];
#pragma unroll
    for (int i = 0; i < 2; ++i) { int R, C; stage_rc(tid * 16 + i * 8192, R, C); const int Rb = Epi::PERM ? ((R & ~31) + perm32(R & 31)) : R;
        voffA[i] = (unsigned)(R * K + C) * 2u; voffB[i] = (unsigned)(Rb * K + C) * 2u; }
    const size_t kstep = (size_t)(BK * 2);
    const size_t hstep = (size_t)HALF * K * 2;
    const unsigned ldsw = (unsigned)wid * 1024u;
    const int aoff = lds_byte(wr * 64 + fr, fq * 8), boff = lds_byte(wc * 32 + fr, fq * 8);
#define PG8_SA(b, h) (((b) * 2 + (h)) * HTB)
#define PG8_SB(b, h) ((4 + (b) * 2 + (h)) * HTB)
#define PG8_STAGE(bufoff, gbase, voff) do { _Pragma("unroll") for (int _i = 0; _i < 2; ++_i) \
        __builtin_amdgcn_global_load_lds((const unsigned*)((const char*)(gbase) + (voff)[_i]), (LAS unsigned*)(lds + (bufoff) + ldsw + _i * 8192), 16, 0, 0); } while (0)
#define PG8_STAGE_A(bufoff, kb, h, vo) do { if constexpr (GATHER) { PG8_STAGE(bufoff, kb, (vo)[h]); } else { PG8_STAGE(bufoff, (kb) + (h) * hstep, voffA); } } while (0)
#define PG8_LDA(dst, b, h) do { _Pragma("unroll") for (int m = 0; m < 4; ++m) _Pragma("unroll") for (int k = 0; k < 2; ++k) dst[m][k] = *(const LAS bf16x8*)(lds + PG8_SA(b, h) + aoff + m * 2048 + k * 1024); } while (0)
#define PG8_LDB(dst, b, h) do { _Pragma("unroll") for (int n = 0; n < 2; ++n) _Pragma("unroll") for (int k = 0; k < 2; ++k) dst[n][k] = *(const LAS bf16x8*)(lds + PG8_SB(b, h) + boff + n * 2048 + k * 1024); } while (0)
#define PG8_MMA(ai, bj, At, Bt) do { __builtin_amdgcn_s_setprio(1); _Pragma("unroll") for (int m = 0; m < 4; ++m) _Pragma("unroll") for (int n = 0; n < 2; ++n) _Pragma("unroll") for (int k = 0; k < 2; ++k) \
        acc[ai][bj][m][n] = __builtin_amdgcn_mfma_f32_16x16x32_bf16(Bt[n][k], At[m][k], acc[ai][bj][m][n], 0, 0, 0); __builtin_amdgcn_s_setprio(0); } while (0)
#define PG8_WAIT_V(n) asm volatile("s_waitcnt vmcnt(" #n ")" ::: "memory")
#define PG8_WAIT_L(n) asm volatile("s_waitcnt lgkmcnt(" #n ")" ::: "memory")
#define PG8_BAR __builtin_amdgcn_s_barrier()
#define PG8_SCHED __builtin_amdgcn_sched_barrier(0)
    Unit cur, nxt; int ui = 0;
    if (!S.next(0, cur)) return;
    f32x4 acc[2][2][4][2];
#pragma unroll
    for (int a = 0; a < 2; ++a)
#pragma unroll
        for (int b = 0; b < 2; ++b)
#pragma unroll
            for (int m = 0; m < 4; ++m)
#pragma unroll
                for (int n = 0; n < 2; ++n) acc[a][b][m][n] = (f32x4){0.f, 0.f, 0.f, 0.f};
    bf16x8 At[4][2], B0[2][2], B1[2][2];
    unsigned vg[2][2];
#define PG8_GATHER(u) do { _Pragma("unroll") for (int _h = 0; _h < 2; ++_h) _Pragma("unroll") for (int _i = 0; _i < 2; ++_i) { int _R, _C; stage_rc(tid * 16 + _i * 8192, _R, _C); \
        const int _r = _h * HALF + _R; const int _tok = (_r < (u).nvalid) ? (u).alist[_r] : 0; vg[_h][_i] = (unsigned)(_tok * K + _C) * 2u; } } while (0)
    const char* cA; const char* cB = (const char*)g.Bt + (size_t)cur.brow0 * K * 2;
    if constexpr (GATHER) { cA = (const char*)g.A; PG8_GATHER(cur); } else { cA = (const char*)g.A + (size_t)cur.arow0 * K * 2;
#pragma unroll
        for (int h = 0; h < 2; ++h)
#pragma unroll
            for (int i = 0; i < 2; ++i) vg[h][i] = 0u; }
    if constexpr (SP2) {
        PG8_STAGE(PG8_SB(0, 0), cB, voffB); PG8_STAGE(PG8_SB(0, 1), cB + hstep, voffB); PG8_STAGE_A(PG8_SA(0, 0), cA, 0, vg); PG8_STAGE_A(PG8_SA(0, 1), cA, 1, vg);
        if (wr == 1) PG8_BAR;
        PG8_WAIT_V(2); PG8_BAR;
        PG8_STAGE(PG8_SB(1, 0), cB + kstep, voffB); PG8_STAGE_A(PG8_SA(1, 0), cA + kstep, 0, vg); PG8_STAGE(PG8_SB(1, 1), cB + hstep + kstep, voffB);
        PG8_WAIT_V(6); PG8_BAR;
    } else {
        PG8_STAGE(PG8_SB(0, 0), cB, voffB); PG8_STAGE_A(PG8_SA(0, 0), cA, 0, vg); PG8_STAGE(PG8_SB(0, 1), cB + hstep, voffB); PG8_STAGE_A(PG8_SA(0, 1), cA, 1, vg);
        if (wr == 1) PG8_BAR;
        PG8_WAIT_V(4); PG8_BAR;
        PG8_STAGE(PG8_SB(1, 0), cB + kstep, voffB); PG8_STAGE_A(PG8_SA(1, 0), cA + kstep, 0, vg); PG8_STAGE(PG8_SB(1, 1), cB + hstep + kstep, voffB);
        PG8_WAIT_V(6); PG8_BAR;
    }
    for (;;) {
        const bool has_next = S.next(ui + 1, nxt);
        const char* nA; const char* nB = has_next ? (const char*)g.Bt + (size_t)nxt.brow0 * K * 2 : cB;
        if constexpr (GATHER) nA = cA; else nA = has_next ? (const char*)g.A + (size_t)nxt.arow0 * K * 2 : cA;
        for (int t = 0; t < nt; t += 2) {
            const bool last = (t == nt - 2);
            const char* a1 = cA + (size_t)(t + 1) * kstep;
            const char* a2 = last ? nA : cA + (size_t)(t + 2) * kstep; const char* b2 = last ? nB : cB + (size_t)(t + 2) * kstep;
            const char* a3 = a2 + kstep; const char* b3 = b2 + kstep;
            if constexpr (SP2) {
            PG8_LDB(B0, 0, 0); PG8_LDB(B1, 0, 1); PG8_SCHED; PG8_LDA(At, 0, 0); PG8_STAGE_A(PG8_SA(1, 1), a1, 1, vg);
            if constexpr (GATHER) { if (last && has_next) PG8_GATHER(nxt); }
            PG8_WAIT_V(8); PG8_WAIT_L(0); PG8_BAR; PG8_MMA(0, 0, At, B0); PG8_MMA(0, 1, At, B1); PG8_BAR; PG8_SCHED;
            PG8_LDA(At, 0, 1); PG8_STAGE(PG8_SB(0, 0), b2, voffB); PG8_STAGE(PG8_SB(0, 1), b2 + hstep, voffB); PG8_STAGE_A(PG8_SA(0, 0), a2, 0, vg);
            PG8_WAIT_V(8); PG8_WAIT_L(0); PG8_BAR; PG8_MMA(1, 0, At, B0); PG8_MMA(1, 1, At, B1); PG8_BAR; PG8_SCHED;
            PG8_LDB(B0, 1, 0); PG8_LDB(B1, 1, 1); PG8_SCHED; PG8_LDA(At, 1, 0); PG8_STAGE_A(PG8_SA(0, 1), a2, 1, vg);
            PG8_WAIT_V(8); PG8_WAIT_L(0); PG8_BAR; PG8_MMA(0, 0, At, B0); PG8_MMA(0, 1, At, B1); PG8_BAR; PG8_SCHED;
            PG8_LDA(At, 1, 1); PG8_STAGE(PG8_SB(1, 0), b3, voffB); PG8_STAGE(PG8_SB(1, 1), b3 + hstep, voffB); PG8_STAGE_A(PG8_SA(1, 0), a3, 0, vg);
            PG8_WAIT_V(8); PG8_WAIT_L(0); PG8_BAR; PG8_MMA(1, 0, At, B0); PG8_MMA(1, 1, At, B1); PG8_BAR; PG8_SCHED;
            } else {
            PG8_LDB(B0, 0, 0); PG8_SCHED; PG8_LDA(At, 0, 0); PG8_STAGE_A(PG8_SA(1, 1), a1, 1, vg);
            if constexpr (GATHER) { if (last && has_next) PG8_GATHER(nxt); }
            PG8_WAIT_L(8); PG8_BAR; PG8_WAIT_L(0); PG8_MMA(0, 0, At, B0); PG8_BAR; PG8_SCHED;
            PG8_LDB(B1, 0, 1); PG8_STAGE(PG8_SB(0, 0), b2, voffB);
            PG8_BAR; PG8_WAIT_L(0); PG8_MMA(0, 1, At, B1); PG8_BAR;
            PG8_LDA(At, 0, 1); PG8_STAGE_A(PG8_SA(0, 0), a2, 0, vg);
            PG8_BAR; PG8_WAIT_L(0); PG8_MMA(1, 0, At, B0); PG8_BAR; PG8_SCHED;
            PG8_STAGE(PG8_SB(0, 1), b2 + hstep, voffB);
            PG8_WAIT_V(6); PG8_BAR; PG8_MMA(1, 1, At, B1); PG8_BAR;
            PG8_LDB(B0, 1, 0); PG8_SCHED; PG8_LDA(At, 1, 0); PG8_STAGE_A(PG8_SA(0, 1), a2, 1, vg);
            PG8_WAIT_L(8); PG8_BAR; PG8_WAIT_L(0); PG8_MMA(0, 0, At, B0); PG8_BAR; PG8_SCHED;
            PG8_LDB(B1, 1, 1); PG8_STAGE(PG8_SB(1, 0), b3, voffB);
            PG8_BAR; PG8_WAIT_L(0); PG8_MMA(0, 1, At, B1); PG8_BAR;
            PG8_LDA(At, 1, 1); PG8_STAGE_A(PG8_SA(1, 0), a3, 0, vg);
            PG8_BAR; PG8_WAIT_L(0); PG8_MMA(1, 0, At, B0); PG8_BAR; PG8_SCHED;
            PG8_STAGE(PG8_SB(1, 1), b3 + hstep, voffB);
            PG8_WAIT_V(6); PG8_BAR; PG8_MMA(1, 1, At, B1); PG8_BAR;
            }
        }
        if constexpr (ALIGN_EPI) { if (wr == 0) PG8_BAR; }
        E(acc, cur, wr, wc, fr, fq);
        if (!has_next) break;
#pragma unroll
        for (int a = 0; a < 2; ++a)
#pragma unroll
            for (int b = 0; b < 2; ++b)
#pragma unroll
                for (int m = 0; m < 4; ++m)
#pragma unroll
                    for (int n = 0; n < 2; ++n) acc[a][b][m][n] = (f32x4){0.f, 0.f, 0.f, 0.f};
        cur = nxt; cA = nA; cB = nB; ++ui;
        if constexpr (ALIGN_EPI) { if (wr == 1) PG8_BAR; }
    }
    PG8_WAIT_V(0);
    if constexpr (!ALIGN_EPI) { if (wr == 0) PG8_BAR; }
    PG8_BAR;
#undef PG8_SA
#undef PG8_SB
#undef PG8_STAGE
#undef PG8_STAGE_A
#undef PG8_GATHER
#undef PG8_LDA
#undef PG8_LDB
#undef PG8_MMA
#undef PG8_WAIT_V
#undef PG8_WAIT_L
#undef PG8_BAR
#undef PG8_SCHED
}


struct EpiM1 {
    static constexpr bool PERM = true;
    bf16_t* Q; bf16_t* Kn; bf16_t* KT; bf16_t* VT; bf16_t* OGS; LAS unsigned char* tlds;
    __device__ __forceinline__ void operator()(const f32x4 (&acc)[2][2][4][2], const Unit& u, int wr, int wc, int fr, int fq) const {
        const int row0 = u.arow0 + wr * 64 + fr, pn = u.pn;
        if (pn < 4 || pn >= 8) {
            bf16_t* base; int ldc, colt; float sc = 1.f; const bool sig = pn >= 8;
            if (pn < 2) { base = Q; ldc = MQK; colt = pn * 256; sc = 0.08838834764831845f; }
            else if (pn < 4) { base = Kn; ldc = MQK; colt = (pn - 2) * 256; }
            else { base = OGS; ldc = MV; colt = (pn - 8) * 256; }
            const int col0 = colt + wc * 32 + 8 * fq;
#pragma unroll
            for (int ai = 0; ai < 2; ++ai)
#pragma unroll
                for (int m = 0; m < 4; ++m) { bf16_t* rowp = base + (size_t)(row0 + ai * HALF + m * 16) * ldc + col0;
#pragma unroll
                    for (int bj = 0; bj < 2; ++bj) { f32x4 v0 = acc[ai][bj][m][0] * sc, v1 = acc[ai][bj][m][1] * sc;
                        if (sig) {
#pragma unroll
                            for (int j = 0; j < 4; ++j) { v0[j] = sigmoidf_(v0[j]); v1[j] = sigmoidf_(v1[j]); } }
                        u32x4 w; w.x = cvt_pk_bf16(v0[0], v0[1]); w.y = cvt_pk_bf16(v0[2], v0[3]); w.z = cvt_pk_bf16(v1[0], v1[1]); w.w = cvt_pk_bf16(v1[2], v1[3]);
                        *(u32x4*)(rowp + bj * HALF) = w; } }
        }
        if (pn >= 2 && pn < 8) {
            const int b = u.arow0 / SEQ, s0 = (u.arow0 % SEQ) + wr * 64;
            bf16_t* base; int colt, feat;
            if (pn < 4) { base = KT; colt = (pn - 2) * 256; feat = DK; } else { base = VT; colt = (pn - 4) * 256; feat = DV; }
            LAS unsigned char* tb = tlds + (wr * 4 + wc) * 2048;
            const int lane = fq * 16 + fr;
#pragma unroll
            for (int ai = 0; ai < 2; ++ai) {
                const int ch = (s0 + ai * HALF) >> 6;
#pragma unroll
                for (int bj = 0; bj < 2; ++bj) {
                    const int col = colt + bj * HALF + wc * 32, hd = col / feat, f0 = col % feat;
                    bf16_t* xb = base + ((((size_t)(b * NH + hd) * NCH + ch) * feat + f0) << 6);
#pragma unroll
                    for (int n = 0; n < 2; ++n) {
#pragma unroll
                        for (int m = 0; m < 4; ++m)
#pragma unroll
                            for (int j = 0; j < 4; ++j) { const int t = m * 16 + fr;
                                *(LAS bf16_t*)(tb + (4 * fq + j) * 128 + ((((t >> 3) ^ (2 * fq)) & 7) << 4) + (t & 7) * 2) = (bf16_t)f2bf(acc[ai][bj][m][n][j]); }
#pragma unroll
                        for (int q = 0; q < 2; ++q) { const int id = lane + 64 * q, cr = id >> 3, p = id & 7, tc = (p ^ (2 * (cr >> 2))) & 7;
                            const u32x4 v = *(const LAS u32x4*)(tb + id * 16);
                            *(u32x4*)(xb + (size_t)(8 * (cr >> 2) + 4 * n + (cr & 3)) * 64 + tc * 8) = v; }
                    }
                }
            }
        }
    }
};
template <bool BASE_F32> struct EpiRes {
    static constexpr bool PERM = true;
    const void* base; bf16_t* out; const float* gate; float mul;
    __device__ __forceinline__ void operator()(const f32x4 (&acc)[2][2][4][2], const Unit& u, int wr, int wc, int fr, int fq) const {
        const int row0 = u.arow0 + wr * 64 + fr, col0 = u.pn * BM + wc * 32 + 8 * fq, b = u.arow0 / SEQ;
        f32x4 gv[2][2];
#pragma unroll
        for (int bj = 0; bj < 2; ++bj)
#pragma unroll
            for (int n = 0; n < 2; ++n) gv[bj][n] = *(const f32x4*)(gate + (size_t)b * 6 * D + col0 + bj * HALF + n * 4) * mul;
        u32x4 t[2][4][2];
#pragma unroll
        for (int ai = 0; ai < 2; ++ai)
#pragma unroll
            for (int m = 0; m < 4; ++m)
#pragma unroll
                for (int bj = 0; bj < 2; ++bj) { const f32x4 v0 = gv[bj][0] * acc[ai][bj][m][0], v1 = gv[bj][1] * acc[ai][bj][m][1];
                    t[ai][m][bj].x = cvt_pk_bf16(v0[0], v0[1]); t[ai][m][bj].y = cvt_pk_bf16(v0[2], v0[3]); t[ai][m][bj].z = cvt_pk_bf16(v1[0], v1[1]); t[ai][m][bj].w = cvt_pk_bf16(v1[2], v1[3]); }
        if (BASE_F32) {
#pragma unroll
            for (int ai = 0; ai < 2; ++ai) {
                f32x4 bf[4][2][2];
#pragma unroll
                for (int m = 0; m < 4; ++m)
#pragma unroll
                    for (int bj = 0; bj < 2; ++bj) { const float* p = (const float*)base + (size_t)(row0 + ai * HALF + m * 16) * D + col0 + bj * HALF; bf[m][bj][0] = *(const f32x4*)p; bf[m][bj][1] = *(const f32x4*)(p + 4); }
                asm volatile("" ::: "memory");
#pragma unroll
                for (int m = 0; m < 4; ++m)
#pragma unroll
                    for (int bj = 0; bj < 2; ++bj) { const f32x4 a0 = bf[m][bj][0], a1 = bf[m][bj][1]; const u32x4 c = t[ai][m][bj]; u32x4 w;
                        w.x = cvt_pk_bf16(a0[0] + bflo(c.x), a0[1] + bfhi(c.x)); w.y = cvt_pk_bf16(a0[2] + bflo(c.y), a0[3] + bfhi(c.y));
                        w.z = cvt_pk_bf16(a1[0] + bflo(c.z), a1[1] + bfhi(c.z)); w.w = cvt_pk_bf16(a1[2] + bflo(c.w), a1[3] + bfhi(c.w));
                        *(u32x4*)(out + (size_t)(row0 + ai * HALF + m * 16) * D + col0 + bj * HALF) = w; }
                asm volatile("" ::: "memory");
            }
        } else {
            u32x4 bw[2][4][2];
#pragma unroll
            for (int ai = 0; ai < 2; ++ai)
#pragma unroll
                for (int m = 0; m < 4; ++m)
#pragma unroll
                    for (int bj = 0; bj < 2; ++bj) bw[ai][m][bj] = *(const u32x4*)((const bf16_t*)base + (size_t)(row0 + ai * HALF + m * 16) * D + col0 + bj * HALF);
            asm volatile("" ::: "memory");
#pragma unroll
            for (int ai = 0; ai < 2; ++ai)
#pragma unroll
                for (int m = 0; m < 4; ++m)
#pragma unroll
                    for (int bj = 0; bj < 2; ++bj) { const u32x4 a = bw[ai][m][bj], c = t[ai][m][bj]; u32x4 w;
                        w.x = cvt_pk_bf16(bflo(a.x) + bflo(c.x), bfhi(a.x) + bfhi(c.x)); w.y = cvt_pk_bf16(bflo(a.y) + bflo(c.y), bfhi(a.y) + bfhi(c.y));
                        w.z = cvt_pk_bf16(bflo(a.z) + bflo(c.z), bfhi(a.z) + bfhi(c.z)); w.w = cvt_pk_bf16(bflo(a.w) + bflo(c.w), bfhi(a.w) + bfhi(c.w));
                        *(u32x4*)(out + (size_t)(row0 + ai * HALF + m * 16) * D + col0 + bj * HALF) = w; }
        }
    }
};
struct EpiBf {
    static constexpr bool PERM = true;
    bf16_t* O; int ldc;
    __device__ __forceinline__ void operator()(const f32x4 (&acc)[2][2][4][2], const Unit& u, int wr, int wc, int fr, int fq) const {
        const int row0 = u.arow0 + wr * 64 + fr, col0 = u.pn * BM + wc * 32 + 8 * fq;
#pragma unroll
        for (int ai = 0; ai < 2; ++ai)
#pragma unroll
            for (int m = 0; m < 4; ++m) { bf16_t* rowp = O + (size_t)(row0 + ai * HALF + m * 16) * ldc + col0;
#pragma unroll
                for (int bj = 0; bj < 2; ++bj) { const f32x4 v0 = acc[ai][bj][m][0], v1 = acc[ai][bj][m][1];
                    u32x4 w; w.x = cvt_pk_bf16(v0[0], v0[1]); w.y = cvt_pk_bf16(v0[2], v0[3]); w.z = cvt_pk_bf16(v1[0], v1[1]); w.w = cvt_pk_bf16(v1[2], v1[3]);
                    *(u32x4*)(rowp + bj * HALF) = w; } }
    }
};
template <bool SILU> struct EpiGlu {
    static constexpr bool PERM = true;
    bf16_t* O; int ldc; int plain_tiles; bf16_t* P; int ldp;
    __device__ __forceinline__ void operator()(const f32x4 (&acc)[2][2][4][2], const Unit& u, int wr, int wc, int fr, int fq) const {
        const int row0 = u.arow0 + wr * 64 + fr;
        if (u.pn < plain_tiles) {
            const int col0 = u.pn * BM + wc * 32 + 8 * fq;
#pragma unroll
            for (int ai = 0; ai < 2; ++ai)
#pragma unroll
                for (int m = 0; m < 4; ++m) { bf16_t* rowp = P + (size_t)(row0 + ai * HALF + m * 16) * ldp + col0;
#pragma unroll
                    for (int bj = 0; bj < 2; ++bj) { const f32x4 v0 = acc[ai][bj][m][0], v1 = acc[ai][bj][m][1];
                        u32x4 w; w.x = cvt_pk_bf16(v0[0], v0[1]); w.y = cvt_pk_bf16(v0[2], v0[3]); w.z = cvt_pk_bf16(v1[0], v1[1]); w.w = cvt_pk_bf16(v1[2], v1[3]);
                        *(u32x4*)(rowp + bj * HALF) = w; } }
            return;
        }
        const int col0 = (u.pn - plain_tiles) * HALF + wc * 32 + 8 * fq;
#pragma unroll
        for (int ai = 0; ai < 2; ++ai)
#pragma unroll
            for (int m = 0; m < 4; ++m) { bf16_t* rowp = O + (size_t)(row0 + ai * HALF + m * 16) * ldc + col0;
                f32x4 v0 = acc[ai][0][m][0], v1 = acc[ai][0][m][1]; const f32x4 u0 = acc[ai][1][m][0], u1 = acc[ai][1][m][1];
                if (SILU) {
#pragma unroll
                    for (int j = 0; j < 4; ++j) { v0[j] = v0[j] * sigmoidf_(v0[j]); v1[j] = v1[j] * sigmoidf_(v1[j]); } }
                v0 = v0 * u0; v1 = v1 * u1;
                u32x4 w; w.x = cvt_pk_bf16(v0[0], v0[1]); w.y = cvt_pk_bf16(v0[2], v0[3]); w.z = cvt_pk_bf16(v1[0], v1[1]); w.w = cvt_pk_bf16(v1[2], v1[3]);
                *(u32x4*)rowp = w; }
    }
};
}

#define XB_TMO      128
#define XB_XCNT(j)  (256  + 64 * (j))
#define XB_XSUB(j)  (1280 + 64 * (j))
#define XB_XGEN(j)  (2304 + 64 * (j))
#define XB_TOP      3328
#define XB_TOPGEN   3392
#define XCD_BAR_WORDS 3456
#define XB_SPIN_CAP (1u << 18)
__device__ __forceinline__ unsigned xb_ld(unsigned* p)              { return __hip_atomic_load(p, __ATOMIC_RELAXED, __HIP_MEMORY_SCOPE_AGENT); }
__device__ __forceinline__ unsigned xb_add(unsigned* p, unsigned v) { return __hip_atomic_fetch_add(p, v, __ATOMIC_RELAXED, __HIP_MEMORY_SCOPE_AGENT); }
__device__ __forceinline__ unsigned xb_xcc_id() { return (unsigned)__builtin_amdgcn_s_getreg((3 << 11) | 20) & 0xFu; }
#define XB_SPIN(cond, bar) do { unsigned _sp = 0; while (cond) { __builtin_amdgcn_s_sleep(1); \
    if ((++_sp & 255u) == 0u) { if (xb_ld(&(bar)[XB_TMO])) break; if (_sp > XB_SPIN_CAP) { atomicAdd(&(bar)[XB_TMO], 1u); break; } } } } while (0)
struct XcdBarrier { unsigned* bar; unsigned x; volatile LAS unsigned* st; };
__device__ __forceinline__ XcdBarrier xcd_barrier_post(unsigned* bar, volatile LAS unsigned* st) {
    XcdBarrier b; b.bar = bar; b.x = xb_xcc_id(); b.st = st;
    if (threadIdx.x == 0) (void)xb_add(&bar[XB_XCNT(b.x)], 1u);
    return b;
}
__device__ __forceinline__ void xcd_barrier_complete(unsigned* bar, unsigned x, unsigned& nloc, unsigned& nx) {
    const unsigned G = gridDim.x * gridDim.y * gridDim.z;
    unsigned sum, cnt, mine, sp = 0u;
    for (;;) {
        sum = 0u; cnt = 0u; mine = 0u;
#pragma unroll
        for (unsigned j = 0; j < 16; ++j) { const unsigned c = xb_ld(&bar[XB_XCNT(j)]); sum += c; cnt += (c > 0u) ? 1u : 0u; mine = (j == x) ? c : mine; }
        if (sum == G) break;
        __builtin_amdgcn_s_sleep(1);
        if ((++sp & 255u) == 0u) { if (xb_ld(&bar[XB_TMO])) break; if (sp > XB_SPIN_CAP) { atomicAdd(&bar[XB_TMO], 1u); break; } }
    }
    nloc = mine > 0u ? mine : 1u; nx = cnt > 0u ? cnt : 1u;
}
__device__ __forceinline__ void xcd_barrier(const XcdBarrier& b) {
    asm volatile("s_waitcnt vmcnt(0)" ::: "memory");
    __syncthreads();
    if (threadIdx.x == 0) {
        unsigned* bar = b.bar;
        __builtin_amdgcn_s_waitcnt(0);
        unsigned nloc = b.st[0], nx = b.st[1];
        if (nloc == 0u) { xcd_barrier_complete(bar, b.x, nloc, nx); b.st[0] = nloc; b.st[1] = nx; }
        const unsigned old = xb_add(&bar[XB_XSUB(b.x)], 1u);
        const unsigned gen = old / nloc;
        if (old + 1u == (gen + 1u) * nloc) {
            __builtin_amdgcn_fence(__ATOMIC_RELEASE, "agent");
            asm volatile("s_waitcnt vmcnt(0)" ::: "memory");
            const unsigned og = xb_add(&bar[XB_TOP], 1u);
            const unsigned tg = og / nx;
            if (og + 1u == (tg + 1u) * nx) xb_add(&bar[XB_TOPGEN], 1u);
            else XB_SPIN(xb_ld(&bar[XB_TOPGEN]) == tg, bar);
            __builtin_amdgcn_fence(__ATOMIC_ACQUIRE, "agent");
            xb_add(&bar[XB_XGEN(b.x)], 1u);
            asm volatile("s_waitcnt vmcnt(0)" ::: "memory");
        } else {
            XB_SPIN(xb_ld(&bar[XB_XGEN(b.x)]) == gen, bar);
            __builtin_amdgcn_fence(__ATOMIC_ACQUIRE, "agent");
            asm volatile("s_waitcnt vmcnt(0)" ::: "memory");
        }
    }
    __syncthreads();
}

struct Args { const float* in[20]; float* out; unsigned char* ws; int ph_lo, ph_hi; };
__device__ __forceinline__ const void* karg_ptr(int idx) {
    unsigned long long v = (unsigned long long)((const void* const __attribute__((address_space(4)))*)__builtin_amdgcn_kernarg_segment_ptr())[idx];
    asm volatile("" : "+s"(v)); return (const void*)(const GAS char*)v;
}
struct InProxy { __device__ __forceinline__ const float* operator[](int i) const { return (const float*)karg_ptr(i); } };
struct WsProxy { __device__ __forceinline__ operator unsigned char*() const { return (unsigned char*)karg_ptr(21); }
                 __device__ __forceinline__ unsigned char* operator+(size_t o) const { return (unsigned char*)karg_ptr(21) + o; } };
struct OutProxy { __device__ __forceinline__ operator float*() const { return (float*)karg_ptr(20); }
                  __device__ __forceinline__ float* operator+(size_t o) const { return (float*)karg_ptr(20) + o; } };
struct CtlProxy { __device__ __forceinline__ operator gu32*() const { return (gu32*)karg_ptr(21); }
                  __device__ __forceinline__ gu32* operator+(int o) const { return (gu32*)karg_ptr(21) + o; } };
struct Frame {
    LAS unsigned char* lds; volatile LAS unsigned* MISC; CtlProxy ctl;
    int tid, lane, wave, vcu, G, bx;
    InProxy in; OutProxy out; WsProxy ws;
};
enum { I_X = 0, I_C, I_N1G, I_N2G, I_WADA, I_BADA, I_MWIN, I_MBG, I_MNG, I_MWOUT, I_CWIN, I_CCW, I_CCB, I_CWOUT, I_WR, I_BR, I_EWG, I_EWU, I_EWD, I_FG };

__device__ __forceinline__ float wave_sum(float v) {
#pragma unroll
    for (int o = 1; o < 64; o <<= 1) v += __shfl_xor(v, o);
    return v;
}

__device__ __forceinline__ int glu_row(int n, int which) { return (n >> 7) * 256 + which * 128 + (n & 127); }
struct CvtItem { const float* src; bf16_t* dst; int ldw, K; };
constexpr int CVT_IN = 16 * 96, CVT_OUT = 16 * 32, CVT_G = NE * 16 * 16, CVT_D = NE * 8 * 32, CVT_ITEMS = CVT_IN + CVT_OUT + 2 * CVT_G + CVT_D;
__device__ __forceinline__ CvtItem cvt_decode(Frame& F, int L, int it) {
    const size_t lo_ = (L == 0) ? 0 : WS_WL1;
    CvtItem d; int r = it;
    if (r < CVT_IN) { const int kb = r / 96, nb = r % 96, n0 = nb * 32; d.K = D;
        if (L == 0) { d.src = F.in[I_MWIN] + (size_t)kb * 64 * MPROJ + n0; d.ldw = MPROJ; d.dst = (bf16_t*)(F.ws + lo_ + WS_W0) + (size_t)n0 * D + kb * 64; }
        else { int dr; if (n0 < D) dr = n0; else if (n0 < 2 * D) dr = D + glu_row(n0 - D, 0); else dr = D + glu_row(n0 - 2 * D, 1);
            d.src = F.in[I_CWIN] + (size_t)kb * 64 * 3 * D + n0; d.ldw = 3 * D; d.dst = (bf16_t*)(F.ws + lo_ + WS_W0) + (size_t)dr * D + kb * 64; }
        return d; } r -= CVT_IN;
    if (r < CVT_OUT) { const int kb = r / 32, nb = r % 32; d.K = D; d.ldw = D; d.src = (L == 0 ? F.in[I_MWOUT] : F.in[I_CWOUT]) + (size_t)kb * 64 * D + nb * 32; d.dst = (bf16_t*)(F.ws + lo_ + WS_W1) + (size_t)nb * 32 * D + kb * 64; return d; } r -= CVT_OUT;
    if (r < 2 * CVT_G) { const int which = r / CVT_G; r %= CVT_G; const int e = r / 256, kb = (r % 256) / 16, nb = r % 16, n0 = nb * 32; d.K = D; d.ldw = DE;
        d.src = (which == 0 ? F.in[I_EWG] : F.in[I_EWU]) + ((size_t)L * NE + e) * D * DE + (size_t)kb * 64 * DE + n0;
        d.dst = (bf16_t*)(F.ws + lo_ + WS_WUP) + (size_t)e * 1024 * D + (size_t)glu_row(n0, which) * D + kb * 64; return d; } r -= 2 * CVT_G;
    { const int e = r / 256, kb = (r % 256) / 32, nb = r % 32; d.K = DE; d.ldw = D;
      d.src = F.in[I_EWD] + ((size_t)L * NE + e) * DE * D + (size_t)kb * 64 * D + nb * 32;
      d.dst = (bf16_t*)(F.ws + lo_ + WS_WDN) + (size_t)e * D * DE + (size_t)nb * 32 * DE + kb * 64; }
    return d;
}
__device__ __forceinline__ void convert_weights(Frame& F, int L) {
    LAS float* scr = (LAS float*)(F.lds + F.wave * 16384);
    const int gw = F.vcu * NWAVES + F.wave, NGW = F.G * NWAVES, lane = F.lane;
    float ld[32];
    CvtItem cur, nxt;
    int it = gw;
    if (it < CVT_ITEMS) { cur = cvt_decode(F, L, it);
#pragma unroll
        for (int i = 0; i < 32; ++i) ld[i] = cur.src[(size_t)(2 * i + (lane >> 5)) * cur.ldw + (lane & 31)]; }
    for (; it < CVT_ITEMS; it += NGW) {
#pragma unroll
        for (int i = 0; i < 32; ++i) scr[(2 * i + (lane >> 5)) * 33 + (lane & 31)] = ld[i];
        const bool more = it + NGW < CVT_ITEMS;
        if (more) { nxt = cvt_decode(F, L, it + NGW);
#pragma unroll
            for (int i = 0; i < 32; ++i) ld[i] = nxt.src[(size_t)(2 * i + (lane >> 5)) * nxt.ldw + (lane & 31)]; }
        LDS_WAIT(); asm volatile("" ::: "memory");
        const int c = lane & 7;
#pragma unroll
        for (int j = 0; j < 4; ++j) { const int n = (lane >> 3) + 8 * j; const LAS float* s = scr + (8 * c) * 33 + n;
            u32x4 o; o.x = pk2(s[0 * 33], s[1 * 33]); o.y = pk2(s[2 * 33], s[3 * 33]); o.z = pk2(s[4 * 33], s[5 * 33]); o.w = pk2(s[6 * 33], s[7 * 33]);
            *(GAS u32x4*)(cur.dst + (size_t)n * cur.K + 8 * c) = o; }
        LDS_WAIT(); asm volatile("" ::: "memory");
        cur = nxt;
    }
}

__device__ __forceinline__ void phase_prologue(Frame& F) {
    float* MOD = (float*)(F.ws + WS_MOD);
    LAS float* cond = (LAS float*)(F.lds + 0);
    LAS float* red = (LAS float*)(F.lds + 16384);
    bool did = false;
    for (int task = F.bx; task < 192; task += F.G) {
        if (did) __syncthreads();
        did = true;
        for (int i = F.tid; i < NB * D; i += NTHR) { const int b = i / D, k = i % D; const float c = F.in[I_C][i]; cond[k * 4 + b] = c * sigmoidf_(c); }
        __syncthreads();
        const int layer = task / 96, col = (task % 96) * 64 + F.lane;
        const float* W = F.in[I_WADA] + (size_t)layer * D * 6 * D;
        float a0 = 0.f, a1 = 0.f, a2 = 0.f, a3 = 0.f;
#pragma unroll 8
        for (int kk = 0; kk < 128; ++kk) { const int k = F.wave * 128 + kk; const float w = W[(size_t)k * 6 * D + col]; const f32x4 c4 = *(const LAS f32x4*)(cond + k * 4);
            a0 += c4[0] * w; a1 += c4[1] * w; a2 += c4[2] * w; a3 += c4[3] * w; }
        red[(F.wave * 4 + 0) * 64 + F.lane] = a0; red[(F.wave * 4 + 1) * 64 + F.lane] = a1; red[(F.wave * 4 + 2) * 64 + F.lane] = a2; red[(F.wave * 4 + 3) * 64 + F.lane] = a3;
        __syncthreads();
        if (F.tid < 256) { const int b = F.tid >> 6, l = F.tid & 63; float s = 0.f;
#pragma unroll
            for (int w = 0; w < 8; ++w) s += red[(w * 4 + b) * 64 + l];
            const int c = (task % 96) * 64 + l;
            MOD[((size_t)layer * NB + b) * 6 * D + c] = s + F.in[I_BADA][(size_t)layer * 6 * D + c]; }
    }
    __syncthreads();
    convert_weights(F, 0);
}

template <int N>
__device__ __forceinline__ void xreduce(float (&v)[N], int lane) {
    constexpr int STEPS = (N == 32) ? 5 : 4;
#pragma unroll
    for (int i = 0; i < N / 2; ++i) { const auto r = __builtin_amdgcn_permlane32_swap(__builtin_bit_cast(unsigned, v[i]), __builtin_bit_cast(unsigned, v[i + N / 2]), false, false);
        const unsigned r0_ = r[0], r1_ = r[1]; v[i] = __uint_as_float(r0_) + __uint_as_float(r1_); }
#pragma unroll
    for (int i = 0; i < N / 4; ++i) { const auto r = __builtin_amdgcn_permlane16_swap(__builtin_bit_cast(unsigned, v[i]), __builtin_bit_cast(unsigned, v[i + N / 4]), false, false);
        const unsigned r0_ = r[0], r1_ = r[1]; v[i] = __uint_as_float(r0_) + __uint_as_float(r1_); }
#pragma unroll
    for (int step = 2; step < STEPS; ++step) {
        const int M = 32 >> step, n = N >> step;
        const bool up = (lane & M) != 0;
#pragma unroll
        for (int i = 0; i < n / 2; ++i) { float a = v[i], b = v[i + n / 2]; asm volatile("" : "+v"(a), "+v"(b));
            const float send = up ? a : b, keep = up ? b : a; v[i] = keep + __shfl_xor(send, M); }
    }
    if (N == 16) v[0] += __shfl_xor(v[0], 2);
    v[0] += __shfl_xor(v[0], 1);
}

constexpr int RP_WL = 0, RP_RINFO = 65536, RP_LCNT = RP_RINFO + 128 * 8 * 4, RP_TPRE = RP_LCNT + 256;
template <int MODE>
__device__ __forceinline__ void row_pass(Frame& F, int layer) {
    constexpr int DOTS = (MODE == 0) ? 8 : (MODE == 1 ? 16 : 0);
    constexpr int RPI = 2, NIT = 16 / RPI, NV = (DOTS > 0) ? RPI * DOTS : 16;
    constexpr bool COMBINE = (MODE == 2 || MODE == 3), MODUL = (MODE != 3);
    const float* MOD = (const float*)(F.ws + WS_MOD);
    LAS float* wl = (LAS float*)(F.lds + RP_WL);
    LAS int* rinfo = (LAS int*)(F.lds + RP_RINFO);
    LAS int* lcnt = (LAS int*)(F.lds + RP_LCNT);
    LAS int* tpre = (LAS int*)(F.lds + RP_TPRE);
    const float* xin = F.in[I_X];
    bf16_t* XB = (bf16_t*)(F.ws + WS_XB);
    float* xout = F.out;
    bf16_t* U = (bf16_t*)(F.ws + WS_U);
    const bf16_t* O = (const bf16_t*)(F.ws + WS_O);
    const unsigned char* TOKp = (const unsigned char*)(F.ws + WS_TOK);
    const int lane = F.lane;
    const int clayer = (MODE == 2) ? 0 : 1;
    if (DOTS > 0) { constexpr int NQ = D * (DOTS > 0 ? DOTS : 4) / 4 / NTHR;
        f32x4 tv[NQ];
#pragma unroll
        for (int q = 0; q < NQ; ++q) { const int piece = F.tid + q * NTHR, k = piece / (DOTS / 4), c4 = piece % (DOTS / 4);
            tv[q] = (DOTS == 8) ? *(const f32x4*)(F.in[I_MWIN] + (size_t)k * MPROJ + 3072 + 4 * c4) : *(const f32x4*)(F.in[I_WR] + (size_t)piece * 4); }
#pragma unroll
        for (int q = 0; q < NQ; ++q) { const int piece = F.tid + q * NTHR, k = piece / (DOTS / 4), c4 = piece % (DOTS / 4), jj = k >> 8, l = (k >> 2) & 63, ii = k & 3;
            const int rot = (DOTS == 16) ? ((l >> 2) & 3) : ((l >> 3) & 1), ch = (c4 + rot) & (DOTS / 4 - 1);
            *(LAS f32x4*)(wl + ((jj * 4 + ii) * 64 + l) * DOTS + ch * 4) = tv[q]; } }
    if (COMBINE && F.tid == 0) { int a = 0; for (int e = 0; e < NE; ++e) { tpre[e] = a; a += ((int)__hip_atomic_load(F.ctl + CW_CNT + 64 * clayer + e, RLX_AGENT) + 255) >> 8; } tpre[NE] = a; }
    float brt[16];
    if (MODE == 1) {
#pragma unroll
        for (int e = 0; e < 16; ++e) brt[e] = F.in[I_BR][e]; }
    for (int batch = F.vcu; batch < T / 128; batch += F.G) {
        __syncthreads();
        if (MODE == 1 && F.tid < 32) lcnt[F.tid] = 0;
        __syncthreads();
        const int row_base = batch * 128 + F.wave * 16, b = row_base / SEQ;
        const float* gam = (MODE == 3) ? F.in[I_FG] : ((MODE == 1) ? F.in[I_N2G] + (size_t)layer * D : F.in[I_N1G] + (size_t)layer * D);
        const float* mod = MOD + ((size_t)layer * NB + b) * 6 * D;
        const float* shp = mod + ((MODE == 1) ? 3 * D : 0); const float* scp = shp + D;
        const float* g2p = MOD + ((size_t)clayer * NB + b) * 6 * D + 5 * D;
        f32x4 gm[4], sh[4], sc[4], g2[4];
#pragma unroll
        for (int j = 0; j < 4; ++j) { gm[j] = *(const f32x4*)(gam + 256 * j + 4 * lane);
            if (MODUL) { sh[j] = *(const f32x4*)(shp + 256 * j + 4 * lane); sc[j] = *(const f32x4*)(scp + 256 * j + 4 * lane) + 1.0f; }
            if (COMBINE) g2[j] = *(const f32x4*)(g2p + 256 * j + 4 * lane); }
        f32x4 xn[RPI][4]; u32x2 on[RPI][2][4]; u32x4 tkn[RPI], tkn2[RPI];
#define RP_LOAD_X(IT) do { _Pragma("unroll") for (int r = 0; r < RPI; ++r) _Pragma("unroll") for (int j = 0; j < 4; ++j) { \
            if (MODE == 0) xn[r][j] = *(const f32x4*)(xin + (size_t)(row_base + (IT) * RPI + r) * D + 256 * j + 4 * lane); \
            else { const u32x2 xb_ = *(const u32x2*)(XB + (size_t)(row_base + (IT) * RPI + r) * D + 256 * j + 4 * lane); xn[r][j] = (f32x4){bflo(xb_.x), bfhi(xb_.x), bflo(xb_.y), bfhi(xb_.y)}; } } } while (0)
#define RP_LOAD_TOK(dst, IT) do { _Pragma("unroll") for (int r = 0; r < RPI; ++r) dst[r] = *(const u32x4*)(TOKp + (size_t)(row_base + (IT) * RPI + r) * 16); } while (0)
#define RP_LOAD_O(tk) do { _Pragma("unroll") for (int r = 0; r < RPI; ++r) { const unsigned tx_ = tk[r].x, ty_ = tk[r].y; \
            const int e0_ = __builtin_amdgcn_readfirstlane((int)(tx_ >> 16)), e1_ = __builtin_amdgcn_readfirstlane((int)(ty_ >> 16)); \
            const int s0_ = tpre[e0_] * 256 + (int)(tx_ & 0xffffu), s1_ = tpre[e1_] * 256 + (int)(ty_ & 0xffffu); \
            _Pragma("unroll") for (int j = 0; j < 4; ++j) { on[r][0][j] = *(const u32x2*)(O + (size_t)s0_ * D + 256 * j + 4 * lane); on[r][1][j] = *(const u32x2*)(O + (size_t)s1_ * D + 256 * j + 4 * lane); } } } while (0)
        RP_LOAD_X(0);
        if (COMBINE) { RP_LOAD_TOK(tkn, 0); RP_LOAD_O(tkn); RP_LOAD_TOK(tkn2, 1); }
#pragma unroll 1
        for (int it = 0; it < NIT; ++it) {
            const int r0 = row_base + it * RPI;
            f32x4 x[RPI][4]; u32x2 oc[RPI][2][4]; float w0c[RPI], w1c[RPI];
#pragma unroll
            for (int r = 0; r < RPI; ++r) {
#pragma unroll
                for (int j = 0; j < 4; ++j) { x[r][j] = xn[r][j]; if (COMBINE) { oc[r][0][j] = on[r][0][j]; oc[r][1][j] = on[r][1][j]; } }
                if (COMBINE) { const unsigned wz_ = tkn[r].z, ww_ = tkn[r].w; w0c[r] = __uint_as_float(wz_); w1c[r] = __uint_as_float(ww_); } }
            if (it + 1 < NIT) {
                RP_LOAD_X(it + 1);
                if (COMBINE) {
#pragma unroll
                    for (int r = 0; r < RPI; ++r) tkn[r] = tkn2[r];
                    RP_LOAD_O(tkn);
                    if (it + 2 < NIT) RP_LOAD_TOK(tkn2, it + 2); } }
            if (COMBINE) {
#pragma unroll
                for (int r = 0; r < RPI; ++r)
#pragma unroll
                    for (int j = 0; j < 4; ++j) { const u32x2 a = oc[r][0][j], c = oc[r][1][j]; const float w0 = w0c[r], w1 = w1c[r];
                        f32x4 mo; mo[0] = w0 * bflo(a.x) + w1 * bflo(c.x); mo[1] = w0 * bfhi(a.x) + w1 * bfhi(c.x); mo[2] = w0 * bflo(a.y) + w1 * bflo(c.y); mo[3] = w0 * bfhi(a.y) + w1 * bfhi(c.y);
                        x[r][j] = x[r][j] + g2[j] * mo;
                        if (MODE == 2) { u32x2 xw_; xw_.x = pk2(x[r][j][0], x[r][j][1]); xw_.y = pk2(x[r][j][2], x[r][j][3]); *(u32x2*)(XB + (size_t)(r0 + r) * D + 256 * j + 4 * lane) = xw_; } }
            }
            float rstd[RPI];
#pragma unroll
            for (int r = 0; r < RPI; ++r) { float s = 0.f;
#pragma unroll
                for (int j = 0; j < 4; ++j) s += (x[r][j][0] * x[r][j][0] + x[r][j][1] * x[r][j][1]) + (x[r][j][2] * x[r][j][2] + x[r][j][3] * x[r][j][3]);
                rstd[r] = 1.0f / sqrtf(wave_sum(s) * (1.0f / D) + EPS); }
#pragma unroll
            for (int r = 0; r < RPI; ++r)
#pragma unroll
                for (int j = 0; j < 4; ++j) { f32x4 y = x[r][j] * rstd[r] * gm[j]; if (MODUL) y = y * sc[j] + sh[j]; x[r][j] = y;
                    if (MODE == 3) *(f32x4*)(xout + (size_t)(r0 + r) * D + 256 * j + 4 * lane) = y;
                    else { u32x2 w; w.x = pk2(y[0], y[1]); w.y = pk2(y[2], y[3]); *(u32x2*)(U + (size_t)(r0 + r) * D + 256 * j + 4 * lane) = w; } }
            if (DOTS > 0) {
                float v[NV];
#pragma unroll
                for (int i = 0; i < NV; ++i) v[i] = 0.f;
#pragma unroll
                for (int j = 0; j < 4; ++j)
#pragma unroll
                    for (int i = 0; i < 4; ++i) {
                        float w[DOTS > 0 ? DOTS : 1];
#pragma unroll
                        for (int q = 0; q < DOTS / 4; ++q) { const int rot = (DOTS == 16) ? ((lane >> 2) & 3) : ((lane >> 3) & 1);
                            const f32x4 t4 = *(const LAS f32x4*)(wl + ((j * 4 + i) * 64 + lane) * DOTS + ((q + rot) & (DOTS / 4 - 1)) * 4); w[4 * q] = t4[0]; w[4 * q + 1] = t4[1]; w[4 * q + 2] = t4[2]; w[4 * q + 3] = t4[3]; }
#pragma unroll
                        for (int r = 0; r < RPI; ++r)
#pragma unroll
                            for (int e = 0; e < DOTS; ++e) v[r * DOTS + e] += x[r][j][i] * w[e];
                        asm volatile("" ::: "memory"); }
                xreduce<NV>(v, lane);
                const float tot = v[0];
                if (MODE == 0) {
                    const int idx = lane >> 2, r = idx >> 3, gi = idx & 7, row = r0 + r, bb = row / SEQ, s = row % SEQ;
                    if ((lane & 3) == 0) {
                        const float pre = tot + F.in[I_MBG][gi];
                        if (gi < 4) ((float*)(F.ws + WS_IG))[(size_t)(bb * NH + gi) * SEQ + s] = pre;
                        else { const float ls = (pre >= 0.f) ? -log1pf(expf(-pre)) : (pre - log1pf(expf(pre))); ((float*)(F.ws + WS_LF))[(size_t)(bb * NH + gi - 4) * SEQ + s] = ls; }
                    }
                }
                if (MODE == 1) {
                    const int r = lane >> 5;
                    float lg[16], mx = -INFINITY;
#pragma unroll
                    for (int e = 0; e < 16; ++e) { lg[e] = __shfl(tot, 32 * r + 2 * e); mx = fmaxf(mx, lg[e]); }
                    float se = 0.f;
#pragma unroll
                    for (int e = 0; e < 16; ++e) { lg[e] = __builtin_amdgcn_exp2f((lg[e] - mx) * 1.44269504089f); se += lg[e]; }
                    const float inv = 1.0f / se;
                    float sel[16];
#pragma unroll
                    for (int e = 0; e < 16; ++e) { lg[e] *= inv; sel[e] = lg[e] + brt[e]; }
                    int best = 0; float bscore = -INFINITY;
#pragma unroll
                    for (int gq = 0; gq < 4; ++gq) { const float a = sel[4 * gq], bq = sel[4 * gq + 1], c = sel[4 * gq + 2], d = sel[4 * gq + 3];
                        const float m1 = fmaxf(fmaxf(a, bq), fmaxf(c, d));
                        const float lo1 = fminf(a, bq), hi1 = fmaxf(a, bq), lo2 = fminf(c, d), hi2 = fmaxf(c, d);
                        const float m2 = fmaxf(fminf(hi1, hi2), fmaxf(lo1, lo2));
                        const float gs = m1 + m2; if (gs > bscore) { bscore = gs; best = gq; } }
                    float s4[4], p4[4];
#pragma unroll
                    for (int q = 0; q < 4; ++q) { s4[q] = -INFINITY; p4[q] = 0.f; }
#pragma unroll
                    for (int gq = 0; gq < 4; ++gq) if (best == gq) {
#pragma unroll
                        for (int q = 0; q < 4; ++q) { s4[q] = sel[4 * gq + q]; p4[q] = lg[4 * gq + q]; } }
                    int i0 = 0; float v0 = s4[0], pp0 = p4[0];
#pragma unroll
                    for (int q = 1; q < 4; ++q) if (s4[q] > v0) { v0 = s4[q]; i0 = q; pp0 = p4[q]; }
                    int i1 = -1; float v1 = -INFINITY, pp1 = 0.f;
#pragma unroll
                    for (int q = 0; q < 4; ++q) if (q != i0 && s4[q] > v1) { v1 = s4[q]; i1 = q; pp1 = p4[q]; }
                    const float wsum = pp0 + pp1, w0 = pp0 / wsum, w1 = pp1 / wsum;
                    const int e0 = best * 4 + i0, e1 = best * 4 + i1;
                    if ((lane & 31) == 0) {
                        const int lp0 = __hip_atomic_fetch_add(lcnt + e0, 1, __ATOMIC_RELAXED, __HIP_MEMORY_SCOPE_WORKGROUP), lp1 = __hip_atomic_fetch_add(lcnt + e1, 1, __ATOMIC_RELAXED, __HIP_MEMORY_SCOPE_WORKGROUP);
                        LAS int* ri = rinfo + (F.wave * 16 + it * RPI + r) * 8;
                        ri[0] = e0; ri[1] = e1; ri[2] = lp0; ri[3] = lp1; ri[4] = __builtin_bit_cast(int, w0); ri[5] = __builtin_bit_cast(int, w1);
                    }
                }
            }
        }
#undef RP_LOAD_X
#undef RP_LOAD_TOK
#undef RP_LOAD_O
        if (MODE == 1) {
            __syncthreads();
            if (F.tid < 16) lcnt[16 + F.tid] = (int)__hip_atomic_fetch_add(F.ctl + CW_CNT + 64 * layer + F.tid, (unsigned)lcnt[F.tid], RLX_AGENT);
            __syncthreads();
            if (F.tid < 128) { const LAS int* ri = rinfo + F.tid * 8; const int row = batch * 128 + F.tid; const int e0 = ri[0], e1 = ri[1], p0 = lcnt[16 + e0] + ri[2], p1 = lcnt[16 + e1] + ri[3];
                int* LIST = (int*)(F.ws + WS_LIST); LIST[e0 * LCAP + p0] = row; LIST[e1 * LCAP + p1] = row;
                u32x4 ti; ti.x = (unsigned)(e0 << 16) | (unsigned)p0; ti.y = (unsigned)(e1 << 16) | (unsigned)p1; ti.z = (unsigned)ri[4]; ti.w = (unsigned)ri[5];
                *(u32x4*)(F.ws + WS_TOK + (size_t)row * 16) = ti; }
        }
    }
    __syncthreads();
}

#define LBAR() do { asm volatile("s_waitcnt lgkmcnt(0)" ::: "memory"); __builtin_amdgcn_s_barrier(); asm volatile("" ::: "memory"); } while (0)
__device__ __forceinline__ float incl_sum(float v, int lane) {
#pragma unroll
    for (int o = 1; o < 64; o <<= 1) { const float t = __shfl_up(v, o); if (lane >= o) v += t; }
    return v;
}
__device__ __forceinline__ float incl_max(float v, int lane) {
#pragma unroll
    for (int o = 1; o < 64; o <<= 1) { const float t = __shfl_up(v, o); if (lane >= o) v = fmaxf(v, t); }
    return v;
}
__device__ __forceinline__ void phase_scan(Frame& F, int mode = 0) {
    LAS float* wkA = (LAS float*)(F.lds + 0);
    LAS float* decA = (LAS float*)(F.lds + 32768);
    LAS float* tot = (LAS float*)(F.lds + 33280);
    LAS float* bst = (LAS float*)(F.lds + 33792);
    LAS float* cmx = (LAS float*)(F.lds + 34304);
    LAS float* rst = (LAS float*)(F.lds + 34816);
    LAS float* xw = (LAS float*)(F.lds + 35328);
    LAS unsigned char* ring = F.lds + 40960;
    constexpr int SLOT = 12288;
    const int lane = F.lane, w = F.wave, tid = F.tid;
    for (int unit = F.vcu; unit < 256; unit += F.G) {
        const int bh = unit >> 4, slice = unit & 15;
        const float* IG = (const float*)(F.ws + WS_IG) + (size_t)bh * SEQ; const float* LF = (const float*)(F.ws + WS_LF) + (size_t)bh * SEQ;
        __syncthreads();
        if (mode < 2) {
        float p[16], g[16], pm[16];
#pragma unroll
        for (int q = 0; q < 16; ++q) { const int c = 16 * w + q; p[q] = incl_sum(LF[c * 64 + lane], lane); if (lane == 63) tot[c] = p[q]; }
        __syncthreads();
        if (tid < 128) { const float v = tot[tid]; const float inc = incl_sum(v, lane); if (tid == 63) xw[0] = inc; bst[tid] = inc - v; }
        __syncthreads();
        if (tid >= 64 && tid < 128) bst[tid] += xw[0];
        __syncthreads();
#pragma unroll
        for (int q = 0; q < 16; ++q) { const int c = 16 * w + q; p[q] += bst[c]; g[q] = IG[c * 64 + lane] - p[q]; pm[q] = incl_max(g[q], lane); if (lane == 63) cmx[c] = pm[q]; }
        __syncthreads();
        if (tid < 128) { const float v = cmx[tid]; const float inc = incl_max(v, lane); if (tid == 63) xw[1] = inc; float ex = __shfl_up(inc, 1); if (lane == 0) ex = 0.f; rst[tid] = fmaxf(ex, 0.f); }
        __syncthreads();
        if (tid >= 64 && tid < 128) rst[tid] = fmaxf(rst[tid], xw[1]);
        __syncthreads();
#pragma unroll
        for (int q = 0; q < 16; ++q) { const int c = 16 * w + q; const float Rs = rst[c], Rn = fmaxf(Rs, cmx[c]), Rrun = fmaxf(Rs, pm[q]);
            wkA[c * 64 + lane] = expf(g[q] - Rn); if (lane == 0) decA[c] = expf(Rs - Rn);
            if (slice == 0) { const size_t o = (size_t)bh * SEQ + c * 64 + lane; ((float*)(F.ws + WS_GA))[o] = g[q]; ((float*)(F.ws + WS_RR))[o] = Rrun; ((float*)(F.ws + WS_MM))[o] = p[q] + Rrun;
                if (lane == 0) ((float*)(F.ws + WS_RC))[bh * NCH + c] = Rs; } }
        }
        __syncthreads();
        if (mode == 1) continue;
        const int dkh = slice & 1, dvs = slice >> 1;
        const bf16_t* KTg = (const bf16_t*)(F.ws + WS_KT) + ((size_t)bh * NCH * DK + 64 * dkh) * 64;
        const bf16_t* VTg = (const bf16_t*)(F.ws + WS_VT) + ((size_t)bh * NCH * DV + 32 * dvs) * 64;
        const int dkr = 64 * dkh + 16 * (w >> 1), dvc = 32 * dvs + 16 * (w & 1);
        bf16_t* STp = (bf16_t*)(F.ws + WS_ST) + ((size_t)bh * NCH * DV + dvc + (lane & 15)) * DK + dkr + 4 * (lane >> 4);
        float* NSp = (float*)(F.ws + WS_NS) + (size_t)bh * NCH * DK + dkr + 4 * (lane >> 4);
        const bool ns_writer = (dvs == 0) && ((w & 1) == 0) && ((lane & 15) == 0);
        f32x4 accS = (f32x4){0.f, 0.f, 0.f, 0.f}, accN = (f32x4){0.f, 0.f, 0.f, 0.f};
        constexpr int PD = 4;
        u32x4 gk[PD], gv[PD];
        const int wr0 = (tid >> 3) * 128 + (((tid & 7) ^ ((tid >> 3) & 7)) << 4);
        const int arow = 16 * (w >> 1) + (lane & 15), brow = 16 * (w & 1) + (lane & 15), lq = lane >> 4;
#define SC_LOAD(set, cc) do { gk[set] = *(const u32x4*)(KTg + (size_t)(cc) * DK * 64 + tid * 8); if (tid < 256) gv[set] = *(const u32x4*)(VTg + (size_t)(cc) * DV * 64 + tid * 8); } while (0)
#define SC_WRITE(set, slot) do { LAS unsigned char* sb_ = ring + (slot) * SLOT; *(LAS u32x4*)(sb_ + wr0) = gk[set]; if (tid < 256) *(LAS u32x4*)(sb_ + 8192 + wr0) = gv[set]; } while (0)
#pragma unroll
        for (int q = 0; q < PD; ++q) SC_LOAD(q, q);
        SC_WRITE(0, 0); SC_WRITE(1, 1);
        SC_LOAD(0, PD); SC_LOAD(1, PD + 1);
        LBAR();
        for (int c0 = 0; c0 < NCH; c0 += PD) {
#pragma unroll
            for (int q2 = 0; q2 < PD; q2 += 2) {
                { const int cw = c0 + q2 + 2;
                  if (cw < NCH) { SC_WRITE((q2 + 2) % PD, (q2 + 2) % PD); SC_WRITE((q2 + 3) % PD, (q2 + 3) % PD);
                      if (cw + PD < NCH) { SC_LOAD((q2 + 2) % PD, cw + PD); SC_LOAD((q2 + 3) % PD, cw + PD + 1); } } }
#pragma unroll
                for (int qq = 0; qq < 2; ++qq) {
                    const int q = q2 + qq, c = c0 + q;
                    if (mode < 3) { { u32x2 o; o.x = pk2(accS[0], accS[1]); o.y = pk2(accS[2], accS[3]); *(u32x2*)(STp + (size_t)c * DV * DK) = o; }
                    if (ns_writer) *(f32x4*)(NSp + (size_t)c * DK) = accN; }
                    const float dec = decA[c];
                    accS = accS * dec; accN = accN * dec;
                    const LAS unsigned char* sb = ring + q * SLOT;
#pragma unroll
                    for (int kk = 0; kk < 2; ++kk) {
                        const LAS f32x4* wp = (const LAS f32x4*)(wkA + c * 64 + kk * 32 + 8 * lq);
                        const f32x4 w0 = wp[0], w1 = wp[1];
                        const u32x4 ka = *(const LAS u32x4*)(sb + arow * 128 + (((4 * kk + lq) ^ (arow & 7)) << 4));
                        const u32x4 vv = *(const LAS u32x4*)(sb + 8192 + brow * 128 + (((4 * kk + lq) ^ (brow & 7)) << 4));
                        u32x4 bv, b1;
                        bv.x = pk2(bflo(vv.x) * w0[0], bfhi(vv.x) * w0[1]); bv.y = pk2(bflo(vv.y) * w0[2], bfhi(vv.y) * w0[3]);
                        bv.z = pk2(bflo(vv.z) * w1[0], bfhi(vv.z) * w1[1]); bv.w = pk2(bflo(vv.w) * w1[2], bfhi(vv.w) * w1[3]);
                        b1.x = pk2(w0[0], w0[1]); b1.y = pk2(w0[2], w0[3]); b1.z = pk2(w1[0], w1[1]); b1.w = pk2(w1[2], w1[3]);
                        const bf16x8 af = __builtin_bit_cast(bf16x8, ka);
                        accS = __builtin_amdgcn_mfma_f32_16x16x32_bf16(af, __builtin_bit_cast(bf16x8, bv), accS, 0, 0, 0);
                        accN = __builtin_amdgcn_mfma_f32_16x16x32_bf16(af, __builtin_bit_cast(bf16x8, b1), accN, 0, 0, 0);
                    }
                }
                LBAR();
            }
        }
        asm volatile("" :: "v"(accS), "v"(accN));
#undef SC_LOAD
#undef SC_WRITE
    }
    __syncthreads();
}

constexpr int OC_AP = 0, OC_STRIDE = 400, OC_BVEC = 25600, OC_INV = 26368, OC_PART = 26624, OC_GS = 28672, OC_RT = 28928, OC_EMM = 29184, OC_HT = 32768, OC_HSTR = 528;
__device__ __forceinline__ void phase_out(Frame& F) {
    LAS unsigned char* AP = F.lds + OC_AP; LAS unsigned char* HT = F.lds + OC_HT;
    LAS float* bvec = (LAS float*)(F.lds + OC_BVEC); LAS float* inv = (LAS float*)(F.lds + OC_INV); LAS float* part = (LAS float*)(F.lds + OC_PART);
    LAS float* gs = (LAS float*)(F.lds + OC_GS); LAS float* Rt = (LAS float*)(F.lds + OC_RT); LAS float* emm = (LAS float*)(F.lds + OC_EMM);
    const int lane = F.lane, w = F.wave, tid = F.tid, l15 = lane & 15, lq = lane >> 4;
    const bf16_t* Qg = (const bf16_t*)(F.ws + WS_Q); const bf16_t* Kg = (const bf16_t*)(F.ws + WS_K);
    const bf16_t* VTg = (const bf16_t*)(F.ws + WS_VT); const bf16_t* STg = (const bf16_t*)(F.ws + WS_ST); const bf16_t* OGS = (const bf16_t*)(F.ws + WS_OGS);
    const float* GAg = (const float*)(F.ws + WS_GA); const float* RRg = (const float*)(F.ws + WS_RR); const float* MMg = (const float*)(F.ws + WS_MM);
    const float* NSg = (const float*)(F.ws + WS_NS); const float* RCg = (const float*)(F.ws + WS_RC); const float* MNG = F.in[I_MNG];
    bf16_t* HN = (bf16_t*)(F.ws + WS_U);
    const int mt = w >> 1, ntb = (w & 1) * 2, tq = tid >> 3, pq = tid & 7, NU = 16 * NCH;
    u32x4 bfr[2][6], qk[4], og[4]; f32x4 ng0, ng1; float sc_g = 0.f, sc_r = 0.f, sc_m = 0.f, sc_b = 0.f, Rc = 0.f;
    LAS unsigned char* QL = F.lds + 69632; LAS unsigned char* KL = F.lds + 86016;
    const int prow = tid >> 4, pch = tid & 15;
    const int pwr = prow * 256 + ((pch ^ (prow & 15)) << 4);
#define OC_LOAD_MAIN(U_) do { const int bh_ = (U_) >> 7, c_ = (U_) & 127, tk_ = (bh_ >> 2) * SEQ + c_ * 64, h_ = bh_ & 3; \
        _Pragma("unroll") for (int n = 0; n < 2; ++n) { const int dv = 32 * w + 16 * n + l15; \
            _Pragma("unroll") for (int kk = 0; kk < 2; ++kk) bfr[n][kk] = *(const u32x4*)(VTg + ((((size_t)bh_ * NCH + c_) * DV + dv) << 6) + 32 * kk + 8 * lq); \
            _Pragma("unroll") for (int kk = 0; kk < 4; ++kk) bfr[n][2 + kk] = *(const u32x4*)(STg + (((size_t)bh_ * NCH + c_) * DV + dv) * DK + 32 * kk + 8 * lq); } \
        qk[0] = *(const u32x4*)(Qg + (size_t)(tk_ + prow) * MQK + h_ * DK + 8 * pch); qk[1] = *(const u32x4*)(Qg + (size_t)(tk_ + prow + 32) * MQK + h_ * DK + 8 * pch); \
        qk[2] = *(const u32x4*)(Kg + (size_t)(tk_ + prow) * MQK + h_ * DK + 8 * pch); qk[3] = *(const u32x4*)(Kg + (size_t)(tk_ + prow + 32) * MQK + h_ * DK + 8 * pch); \
        if (tid < 64) { const size_t o_ = (size_t)bh_ * SEQ + c_ * 64 + tid; sc_g = GAg[o_]; sc_r = RRg[o_]; sc_m = MMg[o_]; sc_b = 1.0f; } \
        else if (tid < 192) sc_b = NSg[((size_t)bh_ * NCH + c_) * DK + tid - 64]; \
        Rc = RCg[bh_ * NCH + c_]; } while (0)
#define OC_LOAD_OGS(U_) do { const int bh_ = (U_) >> 7, c_ = (U_) & 127, tk_ = (bh_ >> 2) * SEQ + c_ * 64, h_ = bh_ & 3; \
        _Pragma("unroll") for (int q = 0; q < 4; ++q) og[q] = *(const u32x4*)(OGS + (size_t)(tk_ + (tid >> 5) + 16 * q) * MV + h_ * DV + 8 * (tid & 31)); \
        ng0 = *(const f32x4*)(MNG + h_ * DV + 8 * (tid & 31)); ng1 = *(const f32x4*)(MNG + h_ * DV + 8 * (tid & 31) + 4); } while (0)
    int unit = F.vcu;
    if (unit < NU) { OC_LOAD_MAIN(unit); OC_LOAD_OGS(unit); }
    for (; unit < NU; unit += F.G) {
        const int bh = unit >> 7, c = unit & 127, b = bh >> 2, h = bh & 3;
        const int tk0 = b * SEQ + c * 64;
        if (tid < 64) { gs[tid] = sc_g; Rt[tid] = sc_r; emm[tid] = expf(-sc_m); }
        if (tid < 192) bvec[tid] = sc_b;
        *(LAS u32x4*)(QL + pwr) = qk[0]; *(LAS u32x4*)(QL + 8192 + pwr) = qk[1]; *(LAS u32x4*)(KL + pwr) = qk[2]; *(LAS u32x4*)(KL + 8192 + pwr) = qk[3];
        const float Rc_cur = Rc;
        LBAR();
        u32x4 qa[4], kb[2][4];
#pragma unroll
        for (int kk = 0; kk < 4; ++kk) { { const int row = 16 * mt + l15; qa[kk] = *(const LAS u32x4*)(QL + row * 256 + (((4 * kk + lq) ^ (row & 15)) << 4)); }
#pragma unroll
            for (int n = 0; n < 2; ++n) { const int row = 16 * (ntb + n) + l15; kb[n][kk] = *(const LAS u32x4*)(KL + row * 256 + (((4 * kk + lq) ^ (row & 15)) << 4)); } }
        const u32x4 q0 = *(const LAS u32x4*)(QL + tq * 256 + (((2 * pq) ^ (tq & 15)) << 4)), q1 = *(const LAS u32x4*)(QL + tq * 256 + (((2 * pq + 1) ^ (tq & 15)) << 4));
        f32x4 pacc[2];
#pragma unroll
        for (int n = 0; n < 2; ++n) { pacc[n] = (f32x4){0.f, 0.f, 0.f, 0.f};
#pragma unroll
            for (int kk = 0; kk < 4; ++kk) pacc[n] = __builtin_amdgcn_mfma_f32_16x16x32_bf16(__builtin_bit_cast(bf16x8, qa[kk]), __builtin_bit_cast(bf16x8, kb[n][kk]), pacc[n], 0, 0, 0); }
#pragma unroll
        for (int n = 0; n < 2; ++n) { const int sl = 16 * (ntb + n) + l15; const float gsv = gs[sl];
#pragma unroll
            for (int r = 0; r < 4; ++r) { const int tl = 16 * mt + 4 * lq + r; const float pv = (sl <= tl) ? pacc[n][r] * expf(gsv - Rt[tl]) : 0.f;
                *(LAS bf16_t*)(AP + tl * OC_STRIDE + sl * 2) = (bf16_t)f2bf(pv); } }
        { const float wq = expf(Rc_cur - Rt[tq]);
          u32x4 o0, o1;
          o0.x = pk2(bflo(q0.x) * wq, bfhi(q0.x) * wq); o0.y = pk2(bflo(q0.y) * wq, bfhi(q0.y) * wq); o0.z = pk2(bflo(q0.z) * wq, bfhi(q0.z) * wq); o0.w = pk2(bflo(q0.w) * wq, bfhi(q0.w) * wq);
          o1.x = pk2(bflo(q1.x) * wq, bfhi(q1.x) * wq); o1.y = pk2(bflo(q1.y) * wq, bfhi(q1.y) * wq); o1.z = pk2(bflo(q1.z) * wq, bfhi(q1.z) * wq); o1.w = pk2(bflo(q1.w) * wq, bfhi(q1.w) * wq);
          *(LAS u32x4*)(AP + tq * OC_STRIDE + 128 + 32 * pq) = o0; *(LAS u32x4*)(AP + tq * OC_STRIDE + 128 + 32 * pq + 16) = o1; }
        LBAR();
        { float s = 0.f;
#pragma unroll
          for (int q = 0; q < 3; ++q) { const u32x4 a = *(const LAS u32x4*)(AP + tq * OC_STRIDE + 48 * pq + 16 * q); const LAS f32x4* bp = (const LAS f32x4*)(bvec + 24 * pq + 8 * q); const f32x4 b0 = bp[0], b1 = bp[1];
              s += bflo(a.x) * b0[0] + bfhi(a.x) * b0[1] + bflo(a.y) * b0[2] + bfhi(a.y) * b0[3] + bflo(a.z) * b1[0] + bfhi(a.z) * b1[1] + bflo(a.w) * b1[2] + bfhi(a.w) * b1[3]; }
          s += __shfl_xor(s, 1); s += __shfl_xor(s, 2); s += __shfl_xor(s, 4);
          if (pq == 0) inv[tq] = 1.0f / fmaxf(fabsf(s), emm[tq]); }
        f32x4 acc[4][2];
#pragma unroll
        for (int m = 0; m < 4; ++m)
#pragma unroll
            for (int n = 0; n < 2; ++n) acc[m][n] = (f32x4){0.f, 0.f, 0.f, 0.f};
#pragma unroll
        for (int kk = 0; kk < 6; ++kk) {
            bf16x8 af[4];
#pragma unroll
            for (int m = 0; m < 4; ++m) af[m] = *(const LAS bf16x8*)(AP + (16 * m + l15) * OC_STRIDE + 64 * kk + 16 * lq);
#pragma unroll
            for (int m = 0; m < 4; ++m)
#pragma unroll
                for (int n = 0; n < 2; ++n) acc[m][n] = __builtin_amdgcn_mfma_f32_16x16x32_bf16(af[m], __builtin_bit_cast(bf16x8, bfr[n][kk]), acc[m][n], 0, 0, 0);
        }
        const int nxt = unit + F.G;
        if (nxt < NU) OC_LOAD_MAIN(nxt);
        LBAR();
#pragma unroll
        for (int m = 0; m < 4; ++m)
#pragma unroll
            for (int r = 0; r < 4; ++r) { const int tl = 16 * m + 4 * lq + r; const float iv = inv[tl];
                const float h0 = acc[m][0][r] * iv, h1 = acc[m][1][r] * iv;
                *(LAS bf16_t*)(HT + tl * OC_HSTR + (32 * w + l15) * 2) = (bf16_t)f2bf(h0); *(LAS bf16_t*)(HT + tl * OC_HSTR + (32 * w + 16 + l15) * 2) = (bf16_t)f2bf(h1);
                float s = h0 * h0 + h1 * h1; s += __shfl_xor(s, 1); s += __shfl_xor(s, 2); s += __shfl_xor(s, 4); s += __shfl_xor(s, 8);
                if (l15 == 0) part[w * 64 + tl] = s; }
        LBAR();
#pragma unroll
        for (int q = 0; q < 4; ++q) { const int row = (tid >> 5) + 16 * q, ch = tid & 31; float ss = 0.f;
#pragma unroll
            for (int ww = 0; ww < 8; ++ww) ss += part[ww * 64 + row];
            const float rs = 1.0f / sqrtf(ss * (1.0f / DV) + EPS);
            const u32x4 hv = *(const LAS u32x4*)(HT + row * OC_HSTR + ch * 16); const u32x4 g = og[q];
            u32x4 o;
            o.x = pk2(bflo(hv.x) * rs * ng0[0] * bflo(g.x), bfhi(hv.x) * rs * ng0[1] * bfhi(g.x)); o.y = pk2(bflo(hv.y) * rs * ng0[2] * bflo(g.y), bfhi(hv.y) * rs * ng0[3] * bfhi(g.y));
            o.z = pk2(bflo(hv.z) * rs * ng1[0] * bflo(g.z), bfhi(hv.z) * rs * ng1[1] * bfhi(g.z)); o.w = pk2(bflo(hv.w) * rs * ng1[2] * bflo(g.w), bfhi(hv.w) * rs * ng1[3] * bfhi(g.w));
            *(u32x4*)(HN + (size_t)(tk0 + row) * MV + h * DV + 8 * ch) = o; }
        if (nxt < NU) OC_LOAD_OGS(nxt);
    }
#undef OC_LOAD_MAIN
#undef OC_LOAD_OGS
    __syncthreads();
}

__device__ __forceinline__ void phase_conv(Frame& F) {
    const bf16_t* BG = (const bf16_t*)(F.ws + WS_BG); const bf16_t* Z = (const bf16_t*)(F.ws + WS_Z); bf16_t* Y = (bf16_t*)(F.ws + WS_Y);
    const int cg = F.tid & 127, rsub = F.tid >> 7, col = 8 * cg;
    float w0[8], w1[8], w2[8], cb[8];
#pragma unroll
    for (int i = 0; i < 8; ++i) { w0[i] = F.in[I_CCW][col + i]; w1[i] = F.in[I_CCW][D + col + i]; w2[i] = F.in[I_CCW][2 * D + col + i]; cb[i] = F.in[I_CCB][col + i]; }
    for (int batch = F.vcu; batch < T / 128; batch += F.G) {
        const int t0 = batch * 128 + rsub * 32, s0 = t0 % SEQ;
        u32x4 z2 = (u32x4){0u, 0u, 0u, 0u}, z1 = z2;
        if (s0 >= 2) z2 = *(const u32x4*)(Z + (size_t)(t0 - 2) * D + col);
        if (s0 >= 1) z1 = *(const u32x4*)(Z + (size_t)(t0 - 1) * D + col);
#pragma unroll 4
        for (int r = 0; r < 32; ++r) {
            const u32x4 z0 = *(const u32x4*)(Z + (size_t)(t0 + r) * D + col), bg = *(const u32x4*)(BG + (size_t)(t0 + r) * D + col);
            float o[8];
#pragma unroll
            for (int i = 0; i < 4; ++i) {
                o[2 * i] = bflo(bg[i]) * (w0[2 * i] * bflo(z2[i]) + w1[2 * i] * bflo(z1[i]) + w2[2 * i] * bflo(z0[i]) + cb[2 * i]);
                o[2 * i + 1] = bfhi(bg[i]) * (w0[2 * i + 1] * bfhi(z2[i]) + w1[2 * i + 1] * bfhi(z1[i]) + w2[2 * i + 1] * bfhi(z0[i]) + cb[2 * i + 1]); }
            u32x4 ov; ov.x = pk2(o[0], o[1]); ov.y = pk2(o[2], o[3]); ov.z = pk2(o[4], o[5]); ov.w = pk2(o[6], o[7]);
            *(u32x4*)(Y + (size_t)(t0 + r) * D + col) = ov;
            z2 = z1; z1 = z0;
        }
    }
}

__device__ __forceinline__ void moe_table(Frame& F, int layer) {
    __syncthreads();
    if (F.tid == 0) { int a = 0; for (int e = 0; e < NE; ++e) { const int c = (int)__hip_atomic_load(F.ctl + CW_CNT + 64 * layer + e, RLX_AGENT); F.MISC[16 + e] = (unsigned)a; F.MISC[40 + e] = (unsigned)c; a += (c + 255) >> 8; } F.MISC[16 + NE] = (unsigned)a; }
    __syncthreads();
}

#ifndef TIMER_PHASE
#define TIMER_PHASE (-1)
#endif
#define STAMP(k) do { if (TIMER_PHASE >= 0 && blockIdx.x == 0 && threadIdx.x == 0) { unsigned long long t_ = __builtin_amdgcn_s_memrealtime(); ((unsigned long long*)karg_ptr(21))[4096 + (k)] = t_; } } while (0)
constexpr int N_PHASES = 17;
#define WSP(T_, off) ((T_*)(F.ws + (off)))
__global__ void __launch_bounds__(NTHR, 2) fwd_kernel(Args args) {
    extern __shared__ __attribute__((aligned(16))) unsigned char lds_raw[];
#define MAKE_FRAME() Frame F; { int t_ = threadIdx.x, bx_ = blockIdx.x, g_ = gridDim.x; asm volatile("" : "+v"(t_), "+s"(bx_), "+s"(g_)); \
        F.lds = (LAS unsigned char*)lds_raw; F.MISC = (volatile LAS unsigned*)(F.lds + MISC_OFF); F.tid = t_; F.lane = t_ & 63; F.wave = __builtin_amdgcn_readfirstlane(t_ >> 6); \
        F.G = g_; F.bx = bx_; F.vcu = (g_ % 8 == 0) ? (bx_ % 8) * (g_ / 8) + bx_ / 8 : bx_; }
    const int lo = args.ph_lo, hi = args.ph_hi;
    const bool one_launch = (hi - lo) > 1;
    XcdBarrier bar;
    { MAKE_FRAME();
      for (int u = F.tid; u < 256; u += NTHR) F.MISC[u] = 0u;
      __syncthreads();
      bar.bar = (unsigned*)(F.ctl + CW_BAR); bar.x = 0; bar.st = nullptr;
      if (one_launch) bar = xcd_barrier_post((unsigned*)(F.ctl + CW_BAR), F.MISC + 8); }
    STAMP(0);
#ifdef PH_ONLY
#define IN(k) ((k) == PH_ONLY && lo <= (k) && (k) < hi)
#else
#define IN(k) (lo <= (k) && (k) < hi)
#endif
#define SEAM(k) do { if (IN(k) && IN((k) + 1)) { xcd_barrier(bar); STAMP((k) + 1); } } while (0)
#ifndef DUP_MODE
#define DUP_MODE 0
#endif
#ifndef DUP_PHASE
#define DUP_PHASE (-1)
#endif
#define PHASE(k) if (IN(k)) { for (int rep_ = 0; rep_ < (((k) == DUP_PHASE) ? 2 : 1); ++rep_) { MAKE_FRAME(); asm volatile("; PHASE_MARK " #k);
#define END_PHASE(k) } } SEAM(k);
    PHASE(0) phase_prologue(F); END_PHASE(0)
    PHASE(1) row_pass<0>(F, 0); END_PHASE(1)
    PHASE(2) pg8::Gemm g{WSP(bf16_t, WS_U), WSP(bf16_t, WS_W0), D}; pg8::DenseOrder S; S.init(T, 3 * D, F.G, F.bx);
        pg8::EpiM1 E{WSP(bf16_t, WS_Q), WSP(bf16_t, WS_K), WSP(bf16_t, WS_KT), WSP(bf16_t, WS_VT), WSP(bf16_t, WS_OGS), F.lds + EPI_OFF};
        pg8::gemm_phase<pg8::EpiM1, pg8::DenseOrder, false, true, true>(F.lds, g, S, E, F.tid); END_PHASE(2)
    PHASE(3) phase_scan(F, rep_ == 0 ? 0 : DUP_MODE); END_PHASE(3)
    PHASE(4) phase_out(F); END_PHASE(4)
    PHASE(5) pg8::Gemm g{WSP(bf16_t, WS_U), WSP(bf16_t, WS_W1), D}; pg8::DenseOrder S; S.init(T, D, F.G, F.bx);
        pg8::EpiRes<true> E{F.in[I_X], WSP(bf16_t, WS_XB), WSP(float, WS_MOD) + 2 * D, (DBG_SKIP & 1) ? 0.f : 1.f};
        pg8::gemm_phase<pg8::EpiRes<true>, pg8::DenseOrder, false, true, true>(F.lds, g, S, E, F.tid); END_PHASE(5)
#define WL(L_, off) WSP(bf16_t, ((L_) == 0 ? (size_t)0 : WS_WL1) + (off))
#define MOE_BLOCK(L, p0, p1, p2) \
    PHASE(p0) row_pass<1>(F, L); END_PHASE(p0) \
    PHASE(p1) moe_table(F, L); \
        pg8::Gemm g{WSP(bf16_t, WS_U), WL(L, WS_WUP), D}; pg8::MoeOrder S{(const LAS int*)(F.MISC + 16), (const LAS int*)(F.MISC + 40), WSP(const int, WS_LIST), F.G, F.vcu, 1024}; \
        pg8::EpiGlu<true> E{WSP(bf16_t, WS_A), DE, 0, nullptr, 0}; \
        pg8::gemm_phase<pg8::EpiGlu<true>, pg8::MoeOrder, true, true, true>(F.lds, g, S, E, F.tid); END_PHASE(p1) \
    PHASE(p2) moe_table(F, L); \
        pg8::Gemm g{WSP(bf16_t, WS_A), WL(L, WS_WDN), DE}; pg8::MoeOrder S{(const LAS int*)(F.MISC + 16), (const LAS int*)(F.MISC + 40), WSP(const int, WS_LIST), F.G, F.vcu, 1024}; \
        pg8::EpiBf E{WSP(bf16_t, WS_O), D}; \
        pg8::gemm_phase<pg8::EpiBf, pg8::MoeOrder, false, true, true>(F.lds, g, S, E, F.tid); END_PHASE(p2)
    MOE_BLOCK(0, 6, 7, 8)
    PHASE(9) row_pass<2>(F, 1); convert_weights(F, 1); END_PHASE(9)
    PHASE(10) pg8::Gemm g{WSP(bf16_t, WS_U), WL(1, WS_W0), D}; pg8::DenseOrder S; S.init(T, 3 * D, F.G, F.bx);
        pg8::EpiGlu<false> E{WSP(bf16_t, WS_Z), D, 4, WSP(bf16_t, WS_BG), D};
        pg8::gemm_phase<pg8::EpiGlu<false>, pg8::DenseOrder, false, true, true>(F.lds, g, S, E, F.tid); END_PHASE(10)
    PHASE(11) phase_conv(F); END_PHASE(11)
    PHASE(12) pg8::Gemm g{WSP(bf16_t, WS_Y), WL(1, WS_W1), D}; pg8::DenseOrder S; S.init(T, D, F.G, F.bx);
        pg8::EpiRes<false> E{WSP(bf16_t, WS_XB), WSP(bf16_t, WS_XB), WSP(float, WS_MOD) + (size_t)NB * 6 * D + 2 * D, (DBG_SKIP & 4) ? 0.f : 1.f};
        pg8::gemm_phase<pg8::EpiRes<false>, pg8::DenseOrder, false, true, true>(F.lds, g, S, E, F.tid); END_PHASE(12)
    MOE_BLOCK(1, 13, 14, 15)
    if (IN(16)) { MAKE_FRAME(); asm volatile("; PHASE_MARK 16"); row_pass<3>(F, 1);
    }

    if (TIMER_PHASE >= 0 && one_launch) {
        STAMP(17);
        xcd_barrier(bar);
        const unsigned long long* ts = (const unsigned long long*)karg_ptr(21) + 4096;
        const unsigned long long d = __hip_atomic_load(ts + TIMER_PHASE + 1, RLX_AGENT) - __hip_atomic_load(ts + TIMER_PHASE, RLX_AGENT);
        const unsigned long long t0 = __builtin_amdgcn_s_memrealtime();
        while (__builtin_amdgcn_s_memrealtime() - t0 < 4ull * d) __builtin_amdgcn_s_sleep(8);
    }
#undef IN
#undef SEAM
}

extern "C" void kernel_launch(void* const* d_in, const int* in_sizes, int n_in, void* d_out, int out_size, void* d_ws, size_t ws_size, hipStream_t stream) {
    static int grid = 0;
    if (grid == 0) {
        if (n_in != 20 || in_sizes[0] != T * D || out_size != T * D || ws_size < WS_END) { fprintf(stderr, "kernel_launch: unexpected shapes: n_in %d in0 %d out %d ws %zu\n", n_in, n_in > 0 ? in_sizes[0] : -1, out_size, ws_size); grid = -1; return; }
        int dev = 0, cus = 0, per_cu = 0;
        if (hipGetDevice(&dev) != hipSuccess || hipDeviceGetAttribute(&cus, hipDeviceAttributeMultiprocessorCount, dev) != hipSuccess) { grid = -1; return; }
        if (hipFuncSetAttribute((const void*)fwd_kernel, hipFuncAttributeMaxDynamicSharedMemorySize, LDS_BYTES) != hipSuccess) { fprintf(stderr, "kernel_launch: hipFuncSetAttribute failed\n"); grid = -1; return; }
        if (hipOccupancyMaxActiveBlocksPerMultiprocessor(&per_cu, (const void*)fwd_kernel, NTHR, LDS_BYTES) != hipSuccess || per_cu < 1) { fprintf(stderr, "kernel_launch: occupancy query says %d blocks per CU\n", per_cu); (void)hipGetLastError(); grid = -1; return; }
        grid = cus;
        if (grid != 256) fprintf(stderr, "kernel_launch: %d CUs (built for 256)\n", grid);
    }
    if (grid < 0) return;
    (void)hipMemsetAsync((char*)d_ws + WS_CTL, 0, CTL_ZERO_BYTES, stream);
    Args a{};
    for (int i = 0; i < 20; ++i) a.in[i] = (const float*)d_in[i];
    a.out = (float*)d_out; a.ws = (unsigned char*)d_ws;
#if MK_N_LAUNCHES == 1
    a.ph_lo = 0; a.ph_hi = N_PHASES;
    void* kargs[] = {&a};
    hipError_t e = hipLaunchCooperativeKernel((const void*)fwd_kernel, dim3(grid), dim3(NTHR), kargs, LDS_BYTES, stream);
    if (e != hipSuccess) fprintf(stderr, "kernel_launch: cooperative launch failed: %s\n", hipGetErrorString(e));
#else
    for (int p = 0; p < N_PHASES; ++p) { a.ph_lo = p; a.ph_hi = p + 1; hipLaunchKernelGGL(fwd_kernel, dim3(grid), dim3(NTHR), LDS_BYTES, stream, a); }
#endif
}
```

```cpp
#include <hip/hip_runtime.h>
#include <cstdio>
#include <cstdint>

#ifndef DBG_SKIP
#define DBG_SKIP 0
#endif
#ifndef MK_N_LAUNCHES
#define MK_N_LAUNCHES 1
#endif

#define LAS __attribute__((address_space(3)))
#define GAS __attribute__((address_space(1)))
typedef unsigned short bf16_t;
typedef short bf16x8 __attribute__((ext_vector_type(8)));
typedef float f32x4 __attribute__((ext_vector_type(4)));
typedef float f32x2 __attribute__((ext_vector_type(2)));
typedef unsigned u32x4 __attribute__((ext_vector_type(4)));
typedef unsigned u32x2 __attribute__((ext_vector_type(2)));
typedef GAS unsigned gu32;
#define RLX_AGENT __ATOMIC_RELAXED, __HIP_MEMORY_SCOPE_AGENT
#define LDS_WAIT() asm volatile("s_waitcnt lgkmcnt(0)" ::: "memory")
#define VM_WAIT() asm volatile("s_waitcnt vmcnt(0)" ::: "memory")

constexpr int NB = 4, SEQ = 8192, D = 1024, T = NB * SEQ;
constexpr int NH = 4, DK = 128, DV = 256, MQK = NH * DK, MV = NH * DV, MPROJ = 2 * MQK + 2 * MV + 2 * NH;
constexpr int CH = 64, NCH = SEQ / CH;
constexpr int NE = 16, DE = 512, LCAP = 65536;
constexpr int SLOT_ROWS = 2 * T + NE * 256;
constexpr float EPS = 1e-6f;
constexpr int NWAVES = 8, NTHR = 512;

constexpr size_t MiB = 1u << 20;
constexpr size_t WS_CTL = 0, CTL_ZERO_BYTES = 64 * 1024;
constexpr size_t WS_MOD = 1 * MiB;
constexpr size_t WS_W0 = 2 * MiB;
constexpr size_t WS_W1 = 8 * MiB;
constexpr size_t WS_WUP = 10 * MiB;
constexpr size_t WS_WDN = 42 * MiB;
constexpr size_t WS_WL1 = 338 * MiB;
constexpr size_t WS_IG = 62 * MiB;
constexpr size_t WS_LF = WS_IG + 512 * 1024;
constexpr size_t WS_GA = WS_LF + 512 * 1024;
constexpr size_t WS_RR = WS_GA + 512 * 1024;
constexpr size_t WS_MM = WS_RR + 512 * 1024;
constexpr size_t WS_RC = WS_MM + 512 * 1024;
constexpr size_t WS_NS = 65 * MiB;
constexpr size_t WS_TOK = 66 * MiB;
constexpr size_t WS_LIST = 67 * MiB;
constexpr size_t WS_U = 72 * MiB;
constexpr size_t WS_Q = 136 * MiB;
constexpr size_t WS_K = 168 * MiB;
constexpr size_t WS_KT = 200 * MiB;
constexpr size_t WS_VT = 232 * MiB;
constexpr size_t WS_OGS = 296 * MiB;
constexpr size_t WS_ST = 360 * MiB;
constexpr size_t WS_A = 136 * MiB;
constexpr size_t WS_O = 204 * MiB;
constexpr size_t WS_BG = 136 * MiB;
constexpr size_t WS_Z = 200 * MiB;
constexpr size_t WS_Y = 264 * MiB;
constexpr size_t WS_XB = 400 * MiB;
constexpr size_t WS_U8 = 464 * MiB;
constexpr size_t WS_A8 = 136 * MiB;
constexpr size_t WS_END = 496 * MiB;
static_assert(WS_A + (size_t)SLOT_ROWS * DE * 2 <= WS_O && WS_O + (size_t)SLOT_ROWS * D * 2 <= WS_ST, "moe map");

constexpr int CW_CNT = 64;
constexpr int CW_CVT = 256;
constexpr int CW_BAR = 1024;

constexpr int RING_BYTES = 131072;
constexpr int MISC_OFF = RING_BYTES;
constexpr int EPI_OFF = MISC_OFF + 1024;
constexpr int LDS_BYTES = 149504;

typedef __bf16 bf16x2_t __attribute__((ext_vector_type(2)));
__device__ __forceinline__ unsigned f2bf(float f) { return (unsigned)__builtin_bit_cast(unsigned short, (__bf16)f); }
__device__ __forceinline__ unsigned pk2(float lo, float hi) { bf16x2_t v; v[0] = (__bf16)lo; v[1] = (__bf16)hi; return __builtin_bit_cast(unsigned, v); }
__device__ __forceinline__ float bf2f(unsigned short h) { return __builtin_bit_cast(float, (unsigned)h << 16); }
__device__ __forceinline__ float bflo(unsigned w) { return __builtin_bit_cast(float, w << 16); }
__device__ __forceinline__ float bfhi(unsigned w) { return __builtin_bit_cast(float, w & 0xffff0000u); }
__device__ __forceinline__ unsigned cvt_pk_bf16(float lo, float hi) { unsigned r; asm volatile("v_cvt_pk_bf16_f32 %0, %1, %2" : "=v"(r) : "v"(lo), "v"(hi)); return r; }
__device__ __forceinline__ unsigned pk4_fp8(float a, float b, float c, float d) { int w = 0; w = __builtin_amdgcn_cvt_pk_fp8_f32(a, b, w, false); w = __builtin_amdgcn_cvt_pk_fp8_f32(c, d, w, true); return (unsigned)w; }
__device__ __forceinline__ float fast_exp(float x) { return __builtin_amdgcn_exp2f(x * 1.44269504089f); }
__device__ __forceinline__ float sigmoidf_(float x) { return __builtin_amdgcn_rcpf(1.0f + fast_exp(-x)); }

namespace pg8 {
constexpr int BM = 256, BK = 64, HALF = 128, HTB = HALF * BK * 2, STAGE_BYTES = 8 * HTB, NXCD = 8, WGM = 8;
__host__ __device__ __forceinline__ int lds_byte(int r, int c) { const int st = (r >> 4) * 2 + (c >> 5), rr = r & 15, cc = c & 31, ob = rr * 64 + cc * 2; return st * 1024 + (ob ^ (((ob >> 9) & 1) << 5)); }
__host__ __device__ __forceinline__ void stage_rc(int b, int& R, int& C) { const int st = b / 1024, sb = b % 1024, swz = sb ^ (((sb >> 9) & 1) << 5); R = (st >> 1) * 16 + swz / 64; C = (st & 1) * 32 + (swz % 64) / 2; }
__host__ __device__ __forceinline__ int perm32(int rho) { const int n = rho >> 4, i = rho & 15; return 8 * (i >> 2) + 4 * n + (i & 3); }

struct Unit { int arow0, brow0, pm, pn, e, nvalid; const int* alist; };
typedef int i32x8 __attribute__((ext_vector_type(8)));
typedef int i32x4 __attribute__((ext_vector_type(4)));
template <bool FP8> struct Frag;
template <> struct Frag<false> { bf16x8 h[2]; };
template <> struct Frag<true> { i32x8 v; };
struct Gemm { const bf16_t* A; const bf16_t* Bt; int K; int scale_w = 0x7f7f7f7f, scale_a = 0x7f7f7f7f; };

struct DenseOrder {
    int nM, nN, nwg, G, c;
    __device__ void init(int M, int N, int G_, int c_) { nM = M / BM; nN = N / BM; nwg = nM * nN; G = G_; c = c_; }
    __device__ bool next(int i, Unit& u) const {
        const long L = (long)i * G + c; if (L >= nwg) return false;
        int wgid = (int)L; { const int q = nwg / NXCD, r = nwg % NXCD, xcd = wgid % NXCD, off = wgid / NXCD; wgid = (xcd < r ? xcd * (q + 1) : r * (q + 1) + (xcd - r) * q) + off; }
        const int nig = WGM * nN, gid = wgid / nig, fm = gid * WGM, gsz = (nM - fm) < WGM ? (nM - fm) : WGM;
        u.pm = fm + ((wgid % nig) % gsz); u.pn = (wgid % nig) / gsz; u.arow0 = u.pm * BM; u.brow0 = u.pn * BM; u.e = 0; u.nvalid = 256; u.alist = nullptr; return true;
    }
};
struct MoeOrder {
    const LAS int* tpre; const LAS int* cnt; const int* list; int G, vcu, bn;
    __device__ bool next(int i, Unit& u) const {
        const int U = i * G + vcu, rt = U >> 2, pn = U & 3;
        if (rt >= tpre[NE]) return false;
        int e = 0;
#pragma unroll
        for (int k = 1; k < NE; ++k) e += (rt >= tpre[k]) ? 1 : 0;
        const int r = rt - tpre[e];
        u.arow0 = rt * BM; u.brow0 = e * bn + pn * BM; u.pm = rt; u.pn = pn; u.e = e; u.nvalid = min(256, cnt[e] - r * 256); u.alist = list ? list + e * LCAP + r * 256 : nullptr; return true;
    }
};

template <class Epi, class Sched, bool GATHER, bool ALIGN_EPI, bool SP2, bool FP8 = false>
__device__ __forceinline__ void gemm_phase(LAS unsigned char* lds, const Gemm g, const Sched& S, const Epi& E, const int tid) {
    const int wid = __builtin_amdgcn_readfirstlane(tid >> 6), lane = tid & 63, wr = wid >> 2, wc = wid & 3, fr = lane & 15, fq = lane >> 4;
    const int K = g.K, nt = K / BK;
    unsigned voffA[2], voffB[2];
#pragma unroll
    for (int i = 0; i < 2; ++i) { int R, C; stage_rc(tid * 16 + i * 8192, R, C); const int Rb = Epi::PERM ? ((R & ~31) + perm32(R & 31)) : R;
        voffA[i] = (unsigned)(R * K + C) * 2u; voffB[i] = (unsigned)(Rb * K + C) * 2u; }
    const size_t kstep = (size_t)(BK * 2);
    const size_t hstep = (size_t)HALF * K * 2;
    const unsigned ldsw = (unsigned)wid * 1024u;
    const int aoff = lds_byte(wr * 64 + fr, fq * 8); int boff = 65536 + lds_byte(wc * 32 + fr, fq * 8); asm volatile("" : "+v"(boff));
#define PG8_SA(b, h) (((b) * 2 + (h)) * HTB)
#define PG8_SB(b, h) ((4 + (b) * 2 + (h)) * HTB)
#define PG8_SBR(b, h) (((b) * 2 + (h)) * HTB)
#define PG8_STAGE(bufoff, gbase, voff) do { _Pragma("unroll") for (int _i = 0; _i < 2; ++_i) \
        __builtin_amdgcn_global_load_lds((const unsigned*)((const char*)(gbase) + (voff)[_i]), (LAS unsigned*)(lds + (bufoff) + ldsw + _i * 8192), 16, 0, 0); } while (0)
#define PG8_STAGE_A(bufoff, kb, h, vo) do { if constexpr (GATHER) { PG8_STAGE(bufoff, kb, (vo)[h]); } else { PG8_STAGE(bufoff, (kb) + (h) * hstep, voffA); } } while (0)
#define PG8_LDF(dst, off) do { if constexpr (FP8) { const i32x4 lo_ = *(const LAS i32x4*)(lds + (off)), hi_ = *(const LAS i32x4*)(lds + (off) + 1024); (dst).v = __builtin_shufflevector(lo_, hi_, 0, 1, 2, 3, 4, 5, 6, 7); } \
        else { (dst).h[0] = *(const LAS bf16x8*)(lds + (off)); (dst).h[1] = *(const LAS bf16x8*)(lds + (off) + 1024); } } while (0)
#define PG8_LDA(dst, b, h) do { _Pragma("unroll") for (int m = 0; m < 4; ++m) PG8_LDF(dst[m], PG8_SA(b, h) + aoff + m * 2048); } while (0)
#define PG8_LDB(dst, b, h) do { _Pragma("unroll") for (int n = 0; n < 2; ++n) PG8_LDF(dst[n], PG8_SBR(b, h) + boff + n * 2048); } while (0)
#define PG8_MMA(ai, bj, At, Bt) do { __builtin_amdgcn_s_setprio(1); _Pragma("unroll") for (int m = 0; m < 4; ++m) _Pragma("unroll") for (int n = 0; n < 2; ++n) { \
        if constexpr (FP8) acc[ai][bj][m][n] = __builtin_amdgcn_mfma_scale_f32_16x16x128_f8f6f4(Bt[n].v, At[m].v, acc[ai][bj][m][n], 0, 0, 0, g.scale_w, 0, g.scale_a); \
        else { _Pragma("unroll") for (int k = 0; k < 2; ++k) acc[ai][bj][m][n] = __builtin_amdgcn_mfma_f32_16x16x32_bf16(Bt[n].h[k], At[m].h[k], acc[ai][bj][m][n], 0, 0, 0); } } \
        __builtin_amdgcn_s_setprio(0); } while (0)
#define PG8_WAIT_V(n) asm volatile("s_waitcnt vmcnt(" #n ")" ::: "memory")
#define PG8_WAIT_L(n) asm volatile("s_waitcnt lgkmcnt(" #n ")" ::: "memory")
#define PG8_BAR __builtin_amdgcn_s_barrier()
#define PG8_SCHED __builtin_amdgcn_sched_barrier(0)
    Unit cur, nxt; int ui = 0;
    if (!S.next(0, cur)) return;
    f32x4 acc[2][2][4][2];
#pragma unroll
    for (int a = 0; a < 2; ++a)
#pragma unroll
        for (int b = 0; b < 2; ++b)
#pragma unroll
            for (int m = 0; m < 4; ++m)
#pragma unroll
                for (int n = 0; n < 2; ++n) acc[a][b][m][n] = (f32x4){0.f, 0.f, 0.f, 0.f};
    Frag<FP8> At[4], B0[2], B1[2];
    unsigned vg[2][2];
#define PG8_GATHER(u) do { _Pragma("unroll") for (int _h = 0; _h < 2; ++_h) _Pragma("unroll") for (int _i = 0; _i < 2; ++_i) { int _R, _C; stage_rc(tid * 16 + _i * 8192, _R, _C); \
        const int _r = _h * HALF + _R; int _tok; if ((u).alist) _tok = (_r < (u).nvalid) ? (u).alist[_r] : 0; else _tok = (u).arow0 + _r; vg[_h][_i] = (unsigned)(_tok * K + _C) * 2u; } } while (0)
    const char* cA; const char* cB = (const char*)g.Bt + (size_t)cur.brow0 * K * 2;
    if constexpr (GATHER) { cA = (const char*)g.A; PG8_GATHER(cur); } else { cA = (const char*)g.A + (size_t)cur.arow0 * K * 2;
#pragma unroll
        for (int h = 0; h < 2; ++h)
#pragma unroll
            for (int i = 0; i < 2; ++i) vg[h][i] = 0u; }
    if constexpr (SP2) {
        PG8_STAGE(PG8_SB(0, 0), cB, voffB); PG8_STAGE(PG8_SB(0, 1), cB + hstep, voffB); PG8_STAGE_A(PG8_SA(0, 0), cA, 0, vg); PG8_STAGE_A(PG8_SA(0, 1), cA, 1, vg);
        if (wr == 1) PG8_BAR;
        PG8_WAIT_V(2); PG8_BAR;
        PG8_STAGE(PG8_SB(1, 0), cB + kstep, voffB); PG8_STAGE_A(PG8_SA(1, 0), cA + kstep, 0, vg); PG8_STAGE(PG8_SB(1, 1), cB + hstep + kstep, voffB);
        PG8_WAIT_V(6); PG8_BAR;
    } else {
        PG8_STAGE(PG8_SB(0, 0), cB, voffB); PG8_STAGE_A(PG8_SA(0, 0), cA, 0, vg); PG8_STAGE(PG8_SB(0, 1), cB + hstep, voffB); PG8_STAGE_A(PG8_SA(0, 1), cA, 1, vg);
        if (wr == 1) PG8_BAR;
        PG8_WAIT_V(4); PG8_BAR;
        PG8_STAGE(PG8_SB(1, 0), cB + kstep, voffB); PG8_STAGE_A(PG8_SA(1, 0), cA + kstep, 0, vg); PG8_STAGE(PG8_SB(1, 1), cB + hstep + kstep, voffB);
        PG8_WAIT_V(6); PG8_BAR;
    }
    for (;;) {
        const bool has_next = S.next(ui + 1, nxt);
        const char* nA; const char* nB = has_next ? (const char*)g.Bt + (size_t)nxt.brow0 * K * 2 : cB;
        if constexpr (GATHER) nA = cA; else nA = has_next ? (const char*)g.A + (size_t)nxt.arow0 * K * 2 : cA;
#pragma unroll 1
        for (int t = 0; t < nt; t += 2) {
            const bool last = (t == nt - 2);
            const char* a1 = cA + (size_t)(t + 1) * kstep;
            const char* a2 = last ? nA : cA + (size_t)(t + 2) * kstep; const char* b2 = last ? nB : cB + (size_t)(t + 2) * kstep;
            const char* a3 = a2 + kstep; const char* b3 = b2 + kstep;
            if constexpr (SP2) {
            PG8_LDB(B0, 0, 0); PG8_LDB(B1, 0, 1); PG8_SCHED; PG8_LDA(At, 0, 0); PG8_STAGE_A(PG8_SA(1, 1), a1, 1, vg);
            if constexpr (GATHER) { if (last && has_next) PG8_GATHER(nxt); }
            PG8_WAIT_V(8); PG8_WAIT_L(0); PG8_BAR; PG8_MMA(0, 0, At, B0); PG8_MMA(0, 1, At, B1); PG8_BAR; PG8_SCHED;
            PG8_LDA(At, 0, 1); PG8_STAGE(PG8_SB(0, 0), b2, voffB); PG8_STAGE(PG8_SB(0, 1), b2 + hstep, voffB); PG8_STAGE_A(PG8_SA(0, 0), a2, 0, vg);
            PG8_WAIT_V(8); PG8_WAIT_L(0); PG8_BAR; PG8_MMA(1, 0, At, B0); PG8_MMA(1, 1, At, B1); PG8_BAR; PG8_SCHED;
            PG8_LDB(B0, 1, 0); PG8_LDB(B1, 1, 1); PG8_SCHED; PG8_LDA(At, 1, 0); PG8_STAGE_A(PG8_SA(0, 1), a2, 1, vg);
            PG8_WAIT_V(8); PG8_WAIT_L(0); PG8_BAR; PG8_MMA(0, 0, At, B0); PG8_MMA(0, 1, At, B1); PG8_BAR; PG8_SCHED;
            PG8_LDA(At, 1, 1); PG8_STAGE(PG8_SB(1, 0), b3, voffB); PG8_STAGE(PG8_SB(1, 1), b3 + hstep, voffB); PG8_STAGE_A(PG8_SA(1, 0), a3, 0, vg);
            PG8_WAIT_V(8); PG8_WAIT_L(0); PG8_BAR; PG8_MMA(1, 0, At, B0); PG8_MMA(1, 1, At, B1); PG8_BAR; PG8_SCHED;
            } else {
            PG8_LDB(B0, 0, 0); PG8_SCHED; PG8_LDA(At, 0, 0); PG8_STAGE_A(PG8_SA(1, 1), a1, 1, vg);
            if constexpr (GATHER) { if (last && has_next) PG8_GATHER(nxt); }
            PG8_WAIT_L(8); PG8_BAR; PG8_WAIT_L(0); PG8_MMA(0, 0, At, B0); PG8_BAR; PG8_SCHED;
            PG8_LDB(B1, 0, 1); PG8_STAGE(PG8_SB(0, 0), b2, voffB);
            PG8_BAR; PG8_WAIT_L(0); PG8_MMA(0, 1, At, B1); PG8_BAR;
            PG8_LDA(At, 0, 1); PG8_STAGE_A(PG8_SA(0, 0), a2, 0, vg);
            PG8_BAR; PG8_WAIT_L(0); PG8_MMA(1, 0, At, B0); PG8_BAR; PG8_SCHED;
            PG8_STAGE(PG8_SB(0, 1), b2 + hstep, voffB);
            PG8_WAIT_V(6); PG8_BAR; PG8_MMA(1, 1, At, B1); PG8_BAR;
            PG8_LDB(B0, 1, 0); PG8_SCHED; PG8_LDA(At, 1, 0); PG8_STAGE_A(PG8_SA(0, 1), a2, 1, vg);
            PG8_WAIT_L(8); PG8_BAR; PG8_WAIT_L(0); PG8_MMA(0, 0, At, B0); PG8_BAR; PG8_SCHED;
            PG8_LDB(B1, 1, 1); PG8_STAGE(PG8_SB(1, 0), b3, voffB);
            PG8_BAR; PG8_WAIT_L(0); PG8_MMA(0, 1, At, B1); PG8_BAR;
            PG8_LDA(At, 1, 1); PG8_STAGE_A(PG8_SA(1, 0), a3, 0, vg);
            PG8_BAR; PG8_WAIT_L(0); PG8_MMA(1, 0, At, B0); PG8_BAR; PG8_SCHED;
            PG8_STAGE(PG8_SB(1, 1), b3 + hstep, voffB);
            PG8_WAIT_V(6); PG8_BAR; PG8_MMA(1, 1, At, B1); PG8_BAR;
            }
        }
        if constexpr (ALIGN_EPI) { if (wr == 0) PG8_BAR; }
        E(acc, cur, wr, wc, fr, fq);
        if (!has_next) break;
#pragma unroll
        for (int a = 0; a < 2; ++a)
#pragma unroll
            for (int b = 0; b < 2; ++b)
#pragma unroll
                for (int m = 0; m < 4; ++m)
#pragma unroll
                    for (int n = 0; n < 2; ++n) acc[a][b][m][n] = (f32x4){0.f, 0.f, 0.f, 0.f};
        cur = nxt; cA = nA; cB = nB; ++ui;
        if constexpr (ALIGN_EPI) { if (wr == 1) PG8_BAR; }
    }
    PG8_WAIT_V(0);
    if constexpr (!ALIGN_EPI) { if (wr == 0) PG8_BAR; }
    PG8_BAR;
#undef PG8_SA
#undef PG8_SB
#undef PG8_SBR
#undef PG8_STAGE
#undef PG8_STAGE_A
#undef PG8_GATHER
#undef PG8_LDF
#undef PG8_LDA
#undef PG8_LDB
#undef PG8_MMA
#undef PG8_WAIT_V
#undef PG8_WAIT_L
#undef PG8_BAR
#undef PG8_SCHED
}


struct EpiM1 {
    static constexpr bool PERM = true;
    bf16_t* Q; bf16_t* Kn; bf16_t* KT; bf16_t* VT; bf16_t* OGS; LAS unsigned char* tlds;
    __device__ __forceinline__ void operator()(const f32x4 (&acc)[2][2][4][2], const Unit& u, int wr, int wc, int fr, int fq) const {
        const int row0 = u.arow0 + wr * 64 + fr, pn = u.pn;
        if (pn < 4 || pn >= 8) {
            bf16_t* base; int ldc, colt; float sc = 1.f; const bool sig = pn >= 8;
            if (pn < 2) { base = Q; ldc = MQK; colt = pn * 256; sc = 0.08838834764831845f; }
            else if (pn < 4) { base = Kn; ldc = MQK; colt = (pn - 2) * 256; }
            else { base = OGS; ldc = MV; colt = (pn - 8) * 256; }
            const int col0 = colt + wc * 32 + 8 * fq;
#pragma unroll
            for (int ai = 0; ai < 2; ++ai)
#pragma unroll
                for (int m = 0; m < 4; ++m) { bf16_t* rowp = base + (size_t)(row0 + ai * HALF + m * 16) * ldc + col0;
#pragma unroll
                    for (int bj = 0; bj < 2; ++bj) { f32x4 v0 = acc[ai][bj][m][0] * sc, v1 = acc[ai][bj][m][1] * sc;
                        if (sig) {
#pragma unroll
                            for (int j = 0; j < 4; ++j) { v0[j] = sigmoidf_(v0[j]); v1[j] = sigmoidf_(v1[j]); } }
                        u32x4 w; w.x = cvt_pk_bf16(v0[0], v0[1]); w.y = cvt_pk_bf16(v0[2], v0[3]); w.z = cvt_pk_bf16(v1[0], v1[1]); w.w = cvt_pk_bf16(v1[2], v1[3]);
                        *(u32x4*)(rowp + bj * HALF) = w; } }
        }
        if (pn >= 2 && pn < 8) {
            const int b = u.arow0 / SEQ, s0 = (u.arow0 % SEQ) + wr * 64;
            bf16_t* base; int colt, feat;
            if (pn < 4) { base = KT; colt = (pn - 2) * 256; feat = DK; } else { base = VT; colt = (pn - 4) * 256; feat = DV; }
            LAS unsigned char* tb = tlds + (wr * 4 + wc) * 2048;
            const int lane = fq * 16 + fr;
#pragma unroll
            for (int ai = 0; ai < 2; ++ai) {
                const int ch = (s0 + ai * HALF) >> 6;
#pragma unroll
                for (int bj = 0; bj < 2; ++bj) {
                    const int col = colt + bj * HALF + wc * 32, hd = col / feat, f0 = col % feat;
                    bf16_t* xb = base + ((((size_t)(b * NH + hd) * NCH + ch) * feat + f0) << 6);
#pragma unroll
                    for (int n = 0; n < 2; ++n) {
#pragma unroll
                        for (int m = 0; m < 4; ++m)
#pragma unroll
                            for (int j = 0; j < 4; ++j) { const int t = m * 16 + fr;
                                *(LAS bf16_t*)(tb + (4 * fq + j) * 128 + ((((t >> 3) ^ (2 * fq)) & 7) << 4) + (t & 7) * 2) = (bf16_t)f2bf(acc[ai][bj][m][n][j]); }
#pragma unroll
                        for (int q = 0; q < 2; ++q) { const int id = lane + 64 * q, cr = id >> 3, p = id & 7, tc = (p ^ (2 * (cr >> 2))) & 7;
                            const u32x4 v = *(const LAS u32x4*)(tb + id * 16);
                            *(u32x4*)(xb + (size_t)(8 * (cr >> 2) + 4 * n + (cr & 3)) * 64 + tc * 8) = v; }
                    }
                }
            }
        }
    }
};
template <bool BASE_F32> struct EpiRes {
    static constexpr bool PERM = true;
    const void* base; bf16_t* out; const float* gate; float mul;
    __device__ __forceinline__ void operator()(const f32x4 (&acc)[2][2][4][2], const Unit& u, int wr, int wc, int fr, int fq) const {
        const int row0 = u.arow0 + wr * 64 + fr, col0 = u.pn * BM + wc * 32 + 8 * fq, b = u.arow0 / SEQ;
        f32x4 gv[2][2];
#pragma unroll
        for (int bj = 0; bj < 2; ++bj)
#pragma unroll
            for (int n = 0; n < 2; ++n) gv[bj][n] = *(const f32x4*)(gate + (size_t)b * 6 * D + col0 + bj * HALF + n * 4) * mul;
        u32x4 t[2][4][2];
#pragma unroll
        for (int ai = 0; ai < 2; ++ai)
#pragma unroll
            for (int m = 0; m < 4; ++m)
#pragma unroll
                for (int bj = 0; bj < 2; ++bj) { const f32x4 v0 = gv[bj][0] * acc[ai][bj][m][0], v1 = gv[bj][1] * acc[ai][bj][m][1];
                    t[ai][m][bj].x = cvt_pk_bf16(v0[0], v0[1]); t[ai][m][bj].y = cvt_pk_bf16(v0[2], v0[3]); t[ai][m][bj].z = cvt_pk_bf16(v1[0], v1[1]); t[ai][m][bj].w = cvt_pk_bf16(v1[2], v1[3]); }
        if (BASE_F32) {
#pragma unroll
            for (int ai = 0; ai < 2; ++ai) {
                f32x4 bf[4][2][2];
#pragma unroll
                for (int m = 0; m < 4; ++m)
#pragma unroll
                    for (int bj = 0; bj < 2; ++bj) { const float* p = (const float*)base + (size_t)(row0 + ai * HALF + m * 16) * D + col0 + bj * HALF; bf[m][bj][0] = *(const f32x4*)p; bf[m][bj][1] = *(const f32x4*)(p + 4); }
                asm volatile("" ::: "memory");
#pragma unroll
                for (int m = 0; m < 4; ++m)
#pragma unroll
                    for (int bj = 0; bj < 2; ++bj) { const f32x4 a0 = bf[m][bj][0], a1 = bf[m][bj][1]; const u32x4 c = t[ai][m][bj]; u32x4 w;
                        w.x = cvt_pk_bf16(a0[0] + bflo(c.x), a0[1] + bfhi(c.x)); w.y = cvt_pk_bf16(a0[2] + bflo(c.y), a0[3] + bfhi(c.y));
                        w.z = cvt_pk_bf16(a1[0] + bflo(c.z), a1[1] + bfhi(c.z)); w.w = cvt_pk_bf16(a1[2] + bflo(c.w), a1[3] + bfhi(c.w));
                        *(u32x4*)(out + (size_t)(row0 + ai * HALF + m * 16) * D + col0 + bj * HALF) = w; }
                asm volatile("" ::: "memory");
            }
        } else {
            u32x4 bw[2][4][2];
#pragma unroll
            for (int ai = 0; ai < 2; ++ai)
#pragma unroll
                for (int m = 0; m < 4; ++m)
#pragma unroll
                    for (int bj = 0; bj < 2; ++bj) bw[ai][m][bj] = *(const u32x4*)((const bf16_t*)base + (size_t)(row0 + ai * HALF + m * 16) * D + col0 + bj * HALF);
            asm volatile("" ::: "memory");
#pragma unroll
            for (int ai = 0; ai < 2; ++ai)
#pragma unroll
                for (int m = 0; m < 4; ++m)
#pragma unroll
                    for (int bj = 0; bj < 2; ++bj) { const u32x4 a = bw[ai][m][bj], c = t[ai][m][bj]; u32x4 w;
                        w.x = cvt_pk_bf16(bflo(a.x) + bflo(c.x), bfhi(a.x) + bfhi(c.x)); w.y = cvt_pk_bf16(bflo(a.y) + bflo(c.y), bfhi(a.y) + bfhi(c.y));
                        w.z = cvt_pk_bf16(bflo(a.z) + bflo(c.z), bfhi(a.z) + bfhi(c.z)); w.w = cvt_pk_bf16(bflo(a.w) + bflo(c.w), bfhi(a.w) + bfhi(c.w));
                        *(u32x4*)(out + (size_t)(row0 + ai * HALF + m * 16) * D + col0 + bj * HALF) = w; }
        }
    }
};
struct EpiBf {
    static constexpr bool PERM = true;
    bf16_t* O; int ldc;
    __device__ __forceinline__ void operator()(const f32x4 (&acc)[2][2][4][2], const Unit& u, int wr, int wc, int fr, int fq) const {
        const int row0 = u.arow0 + wr * 64 + fr, col0 = u.pn * BM + wc * 32 + 8 * fq;
#pragma unroll
        for (int ai = 0; ai < 2; ++ai)
#pragma unroll
            for (int m = 0; m < 4; ++m) { bf16_t* rowp = O + (size_t)(row0 + ai * HALF + m * 16) * ldc + col0;
#pragma unroll
                for (int bj = 0; bj < 2; ++bj) { const f32x4 v0 = acc[ai][bj][m][0], v1 = acc[ai][bj][m][1];
                    u32x4 w; w.x = cvt_pk_bf16(v0[0], v0[1]); w.y = cvt_pk_bf16(v0[2], v0[3]); w.z = cvt_pk_bf16(v1[0], v1[1]); w.w = cvt_pk_bf16(v1[2], v1[3]);
                    *(u32x4*)(rowp + bj * HALF) = w; } }
    }
};
template <bool SILU, bool F8OUT = false> struct EpiGlu {
    static constexpr bool PERM = true;
    bf16_t* O; int ldc; int plain_tiles; bf16_t* P; int ldp; float f8scale;
    __device__ __forceinline__ void operator()(const f32x4 (&acc)[2][2][4][2], const Unit& u, int wr, int wc, int fr, int fq) const {
        const int row0 = u.arow0 + wr * 64 + fr;
        if (u.pn < plain_tiles) {
            const int col0 = u.pn * BM + wc * 32 + 8 * fq;
#pragma unroll
            for (int ai = 0; ai < 2; ++ai)
#pragma unroll
                for (int m = 0; m < 4; ++m) { bf16_t* rowp = P + (size_t)(row0 + ai * HALF + m * 16) * ldp + col0;
#pragma unroll
                    for (int bj = 0; bj < 2; ++bj) { const f32x4 v0 = acc[ai][bj][m][0], v1 = acc[ai][bj][m][1];
                        u32x4 w; w.x = cvt_pk_bf16(v0[0], v0[1]); w.y = cvt_pk_bf16(v0[2], v0[3]); w.z = cvt_pk_bf16(v1[0], v1[1]); w.w = cvt_pk_bf16(v1[2], v1[3]);
                        *(u32x4*)(rowp + bj * HALF) = w; } }
            return;
        }
        const int col0 = (u.pn - plain_tiles) * HALF + wc * 32 + 8 * fq;
#pragma unroll
        for (int ai = 0; ai < 2; ++ai)
#pragma unroll
            for (int m = 0; m < 4; ++m) { bf16_t* rowp = O + (size_t)(row0 + ai * HALF + m * 16) * ldc + col0;
                f32x4 v0 = acc[ai][0][m][0], v1 = acc[ai][0][m][1]; const f32x4 u0 = acc[ai][1][m][0], u1 = acc[ai][1][m][1];
                if (SILU) {
#pragma unroll
                    for (int j = 0; j < 4; ++j) { v0[j] = v0[j] * sigmoidf_(v0[j]); v1[j] = v1[j] * sigmoidf_(v1[j]); } }
                v0 = v0 * u0; v1 = v1 * u1;
                if constexpr (F8OUT) { v0 = v0 * f8scale; v1 = v1 * f8scale; u32x2 w8; w8.x = pk4_fp8(v0[0], v0[1], v0[2], v0[3]); w8.y = pk4_fp8(v1[0], v1[1], v1[2], v1[3]);
                    *(u32x2*)((unsigned char*)O + (size_t)(row0 + ai * HALF + m * 16) * ldc + col0) = w8; }
                else { u32x4 w; w.x = cvt_pk_bf16(v0[0], v0[1]); w.y = cvt_pk_bf16(v0[2], v0[3]); w.z = cvt_pk_bf16(v1[0], v1[1]); w.w = cvt_pk_bf16(v1[2], v1[3]);
                    *(u32x4*)rowp = w; } }
    }
};
}

#define XB_TMO      128
#define XB_XCNT(j)  (256  + 64 * (j))
#define XB_XSUB(j)  (1280 + 64 * (j))
#define XB_XGEN(j)  (2304 + 64 * (j))
#define XB_TOP      3328
#define XB_TOPGEN   3392
#define XCD_BAR_WORDS 3456
#define XB_SPIN_CAP (1u << 18)
__device__ __forceinline__ unsigned xb_ld(unsigned* p)              { return __hip_atomic_load(p, __ATOMIC_RELAXED, __HIP_MEMORY_SCOPE_AGENT); }
__device__ __forceinline__ unsigned xb_add(unsigned* p, unsigned v) { return __hip_atomic_fetch_add(p, v, __ATOMIC_RELAXED, __HIP_MEMORY_SCOPE_AGENT); }
__device__ __forceinline__ unsigned xb_xcc_id() { return (unsigned)__builtin_amdgcn_s_getreg((3 << 11) | 20) & 0xFu; }
#define XB_SPIN(cond, bar) do { unsigned _sp = 0; while (cond) { __builtin_amdgcn_s_sleep(1); \
    if ((++_sp & 255u) == 0u) { if (xb_ld(&(bar)[XB_TMO])) break; if (_sp > XB_SPIN_CAP) { atomicAdd(&(bar)[XB_TMO], 1u); break; } } } } while (0)
struct XcdBarrier { unsigned* bar; unsigned x; volatile LAS unsigned* st; };
__device__ __forceinline__ XcdBarrier xcd_barrier_post(unsigned* bar, volatile LAS unsigned* st) {
    XcdBarrier b; b.bar = bar; b.x = xb_xcc_id(); b.st = st;
    if (threadIdx.x == 0) (void)xb_add(&bar[XB_XCNT(b.x)], 1u);
    return b;
}
__device__ __forceinline__ void xcd_barrier_complete(unsigned* bar, unsigned x, unsigned& nloc, unsigned& nx) {
    const unsigned G = gridDim.x * gridDim.y * gridDim.z;
    unsigned sum, cnt, mine, sp = 0u;
    for (;;) {
        sum = 0u; cnt = 0u; mine = 0u;
#pragma unroll
        for (unsigned j = 0; j < 16; ++j) { const unsigned c = xb_ld(&bar[XB_XCNT(j)]); sum += c; cnt += (c > 0u) ? 1u : 0u; mine = (j == x) ? c : mine; }
        if (sum == G) break;
        __builtin_amdgcn_s_sleep(1);
        if ((++sp & 255u) == 0u) { if (xb_ld(&bar[XB_TMO])) break; if (sp > XB_SPIN_CAP) { atomicAdd(&bar[XB_TMO], 1u); break; } }
    }
    nloc = mine > 0u ? mine : 1u; nx = cnt > 0u ? cnt : 1u;
}
__device__ __forceinline__ void xcd_barrier(const XcdBarrier& b) {
    asm volatile("s_waitcnt vmcnt(0)" ::: "memory");
    __syncthreads();
    if (threadIdx.x == 0) {
        unsigned* bar = b.bar;
        __builtin_amdgcn_s_waitcnt(0);
        unsigned nloc = b.st[0], nx = b.st[1];
        if (nloc == 0u) { xcd_barrier_complete(bar, b.x, nloc, nx); b.st[0] = nloc; b.st[1] = nx; }
        const unsigned old = xb_add(&bar[XB_XSUB(b.x)], 1u);
        const unsigned gen = old / nloc;
        if (old + 1u == (gen + 1u) * nloc) {
            __builtin_amdgcn_fence(__ATOMIC_RELEASE, "agent");
            asm volatile("s_waitcnt vmcnt(0)" ::: "memory");
            const unsigned og = xb_add(&bar[XB_TOP], 1u);
            const unsigned tg = og / nx;
            if (og + 1u == (tg + 1u) * nx) xb_add(&bar[XB_TOPGEN], 1u);
            else XB_SPIN(xb_ld(&bar[XB_TOPGEN]) == tg, bar);
            __builtin_amdgcn_fence(__ATOMIC_ACQUIRE, "agent");
            xb_add(&bar[XB_XGEN(b.x)], 1u);
            asm volatile("s_waitcnt vmcnt(0)" ::: "memory");
        } else {
            XB_SPIN(xb_ld(&bar[XB_XGEN(b.x)]) == gen, bar);
            __builtin_amdgcn_fence(__ATOMIC_ACQUIRE, "agent");
            asm volatile("s_waitcnt vmcnt(0)" ::: "memory");
        }
    }
    __syncthreads();
}

struct Args { const float* in[20]; float* out; unsigned char* ws; int ph_lo, ph_hi; };
__device__ __forceinline__ const void* karg_ptr(int idx) {
    unsigned long long v = (unsigned long long)((const void* const __attribute__((address_space(4)))*)__builtin_amdgcn_kernarg_segment_ptr())[idx];
    asm volatile("" : "+s"(v)); return (const void*)(const GAS char*)v;
}
struct InProxy { __device__ __forceinline__ const float* operator[](int i) const { return (const float*)karg_ptr(i); } };
struct WsProxy { __device__ __forceinline__ operator unsigned char*() const { return (unsigned char*)karg_ptr(21); }
                 __device__ __forceinline__ unsigned char* operator+(size_t o) const { return (unsigned char*)karg_ptr(21) + o; } };
struct OutProxy { __device__ __forceinline__ operator float*() const { return (float*)karg_ptr(20); }
                  __device__ __forceinline__ float* operator+(size_t o) const { return (float*)karg_ptr(20) + o; } };
struct CtlProxy { __device__ __forceinline__ operator gu32*() const { return (gu32*)karg_ptr(21); }
                  __device__ __forceinline__ gu32* operator+(int o) const { return (gu32*)karg_ptr(21) + o; } };
struct Frame {
    LAS unsigned char* lds; volatile LAS unsigned* MISC; CtlProxy ctl;
    int tid, lane, wave, vcu, G, bx;
    InProxy in; OutProxy out; WsProxy ws;
};
enum { I_X = 0, I_C, I_N1G, I_N2G, I_WADA, I_BADA, I_MWIN, I_MBG, I_MNG, I_MWOUT, I_CWIN, I_CCW, I_CCB, I_CWOUT, I_WR, I_BR, I_EWG, I_EWU, I_EWD, I_FG };

__device__ __forceinline__ float wave_sum(float v) {
#pragma unroll
    for (int o = 1; o < 64; o <<= 1) v += __shfl_xor(v, o);
    return v;
}

__device__ __forceinline__ int glu_row(int n, int which) { return (n >> 7) * 256 + which * 128 + (n & 127); }
struct CvtItem { const float* src; bf16_t* dst; int ldw, K; float f8scale; };
constexpr int CVT_IN = 16 * 96, CVT_OUT = 16 * 32, CVT_G = NE * 16 * 16, CVT_D = NE * 8 * 32, CVT_ITEMS = CVT_IN + CVT_OUT + 2 * CVT_G + CVT_D;
__device__ __forceinline__ CvtItem cvt_decode(Frame& F, int L, int it) {
    const size_t lo_ = (L == 0) ? 0 : WS_WL1;
    CvtItem d; d.f8scale = 0.f; int r = it;
    if (r < CVT_IN) { const int kb = r / 96, nb = r % 96, n0 = nb * 32; d.K = D;
        if (L == 0) { d.src = F.in[I_MWIN] + (size_t)kb * 64 * MPROJ + n0; d.ldw = MPROJ; d.dst = (bf16_t*)(F.ws + lo_ + WS_W0) + (size_t)n0 * D + kb * 64; }
        else { int dr; if (n0 < D) dr = n0; else if (n0 < 2 * D) dr = D + glu_row(n0 - D, 0); else dr = D + glu_row(n0 - 2 * D, 1);
            d.src = F.in[I_CWIN] + (size_t)kb * 64 * 3 * D + n0; d.ldw = 3 * D; d.dst = (bf16_t*)(F.ws + lo_ + WS_W0) + (size_t)dr * D + kb * 64; }
        return d; } r -= CVT_IN;
    if (r < CVT_OUT) { const int kb = r / 32, nb = r % 32; d.K = D; d.ldw = D; d.src = (L == 0 ? F.in[I_MWOUT] : F.in[I_CWOUT]) + (size_t)kb * 64 * D + nb * 32; d.dst = (bf16_t*)(F.ws + lo_ + WS_W1) + (size_t)nb * 32 * D + kb * 64; return d; } r -= CVT_OUT;
    if (r < 2 * CVT_G) { const int which = r / CVT_G; r %= CVT_G; const int e = r / 256, kb = (r % 256) / 16, nb = r % 16, n0 = nb * 32; d.K = D; d.ldw = DE;
        d.src = (which == 0 ? F.in[I_EWG] : F.in[I_EWU]) + ((size_t)L * NE + e) * D * DE + (size_t)kb * 64 * DE + n0;
        d.dst = (bf16_t*)((unsigned char*)(F.ws + lo_ + WS_WUP) + (size_t)e * 1024 * D + (size_t)glu_row(n0, which) * D + kb * 64); d.f8scale = 32.f; return d; } r -= 2 * CVT_G;
    { const int e = r / 256, kb = (r % 256) / 32, nb = r % 32; d.K = DE; d.ldw = D;
      d.src = F.in[I_EWD] + ((size_t)L * NE + e) * DE * D + (size_t)kb * 64 * D + nb * 32;
      d.dst = (bf16_t*)((unsigned char*)(F.ws + lo_ + WS_WDN) + (size_t)e * D * DE + (size_t)nb * 32 * DE + kb * 64); d.f8scale = 16.f; }
    return d;
}
__device__ __forceinline__ void convert_weights(Frame& F, int L) {
    LAS float* scr = (LAS float*)(F.lds + F.wave * 16384);
    const int gw = F.vcu * NWAVES + F.wave, NGW = F.G * NWAVES, lane = F.lane;
    float ld[32];
    CvtItem cur, nxt;
    int it = gw;
    if (it < CVT_ITEMS) { cur = cvt_decode(F, L, it);
#pragma unroll
        for (int i = 0; i < 32; ++i) ld[i] = cur.src[(size_t)(2 * i + (lane >> 5)) * cur.ldw + (lane & 31)]; }
    for (; it < CVT_ITEMS; it += NGW) {
#pragma unroll
        for (int i = 0; i < 32; ++i) scr[(2 * i + (lane >> 5)) * 33 + (lane & 31)] = ld[i];
        const bool more = it + NGW < CVT_ITEMS;
        if (more) { nxt = cvt_decode(F, L, it + NGW);
#pragma unroll
            for (int i = 0; i < 32; ++i) ld[i] = nxt.src[(size_t)(2 * i + (lane >> 5)) * nxt.ldw + (lane & 31)]; }
        LDS_WAIT(); asm volatile("" ::: "memory");
        const int c = lane & 7;
#pragma unroll
        for (int j = 0; j < 4; ++j) { const int n = (lane >> 3) + 8 * j; const LAS float* s = scr + (8 * c) * 33 + n;
            if (cur.f8scale != 0.f) { const float f = cur.f8scale; u32x2 o8; o8.x = pk4_fp8(s[0 * 33] * f, s[1 * 33] * f, s[2 * 33] * f, s[3 * 33] * f); o8.y = pk4_fp8(s[4 * 33] * f, s[5 * 33] * f, s[6 * 33] * f, s[7 * 33] * f);
                *(GAS u32x2*)((unsigned char*)cur.dst + (size_t)n * cur.K + 8 * c) = o8; }
            else { u32x4 o; o.x = pk2(s[0 * 33], s[1 * 33]); o.y = pk2(s[2 * 33], s[3 * 33]); o.z = pk2(s[4 * 33], s[5 * 33]); o.w = pk2(s[6 * 33], s[7 * 33]);
                *(GAS u32x4*)(cur.dst + (size_t)n * cur.K + 8 * c) = o; } }
        LDS_WAIT(); asm volatile("" ::: "memory");
        cur = nxt;
    }
}

__device__ __forceinline__ void phase_prologue(Frame& F) {
    float* MOD = (float*)(F.ws + WS_MOD);
    LAS float* cond = (LAS float*)(F.lds + 0);
    LAS float* red = (LAS float*)(F.lds + 16384);
    bool did = false;
    for (int task = F.bx; task < 192; task += F.G) {
        if (did) __syncthreads();
        did = true;
        for (int i = F.tid; i < NB * D; i += NTHR) { const int b = i / D, k = i % D; const float c = F.in[I_C][i]; cond[k * 4 + b] = c * sigmoidf_(c); }
        __syncthreads();
        const int layer = task / 96, col = (task % 96) * 64 + F.lane;
        const float* W = F.in[I_WADA] + (size_t)layer * D * 6 * D;
        float a0 = 0.f, a1 = 0.f, a2 = 0.f, a3 = 0.f;
#pragma unroll 8
        for (int kk = 0; kk < 128; ++kk) { const int k = F.wave * 128 + kk; const float w = W[(size_t)k * 6 * D + col]; const f32x4 c4 = *(const LAS f32x4*)(cond + k * 4);
            a0 += c4[0] * w; a1 += c4[1] * w; a2 += c4[2] * w; a3 += c4[3] * w; }
        red[(F.wave * 4 + 0) * 64 + F.lane] = a0; red[(F.wave * 4 + 1) * 64 + F.lane] = a1; red[(F.wave * 4 + 2) * 64 + F.lane] = a2; red[(F.wave * 4 + 3) * 64 + F.lane] = a3;
        __syncthreads();
        if (F.tid < 256) { const int b = F.tid >> 6, l = F.tid & 63; float s = 0.f;
#pragma unroll
            for (int w = 0; w < 8; ++w) s += red[(w * 4 + b) * 64 + l];
            const int c = (task % 96) * 64 + l;
            MOD[((size_t)layer * NB + b) * 6 * D + c] = s + F.in[I_BADA][(size_t)layer * 6 * D + c]; }
    }
    __syncthreads();
    convert_weights(F, 0);
}

template <int N>
__device__ __forceinline__ void xreduce(float (&v)[N], int lane) {
    constexpr int STEPS = (N == 32) ? 5 : 4;
#pragma unroll
    for (int i = 0; i < N / 2; ++i) { const auto r = __builtin_amdgcn_permlane32_swap(__builtin_bit_cast(unsigned, v[i]), __builtin_bit_cast(unsigned, v[i + N / 2]), false, false);
        const unsigned r0_ = r[0], r1_ = r[1]; v[i] = __uint_as_float(r0_) + __uint_as_float(r1_); }
#pragma unroll
    for (int i = 0; i < N / 4; ++i) { const auto r = __builtin_amdgcn_permlane16_swap(__builtin_bit_cast(unsigned, v[i]), __builtin_bit_cast(unsigned, v[i + N / 4]), false, false);
        const unsigned r0_ = r[0], r1_ = r[1]; v[i] = __uint_as_float(r0_) + __uint_as_float(r1_); }
#pragma unroll
    for (int step = 2; step < STEPS; ++step) {
        const int M = 32 >> step, n = N >> step;
        const bool up = (lane & M) != 0;
#pragma unroll
        for (int i = 0; i < n / 2; ++i) { float a = v[i], b = v[i + n / 2]; asm volatile("" : "+v"(a), "+v"(b));
            const float send = up ? a : b, keep = up ? b : a; v[i] = keep + __shfl_xor(send, M); }
    }
    if (N == 16) v[0] += __shfl_xor(v[0], 2);
    v[0] += __shfl_xor(v[0], 1);
}

constexpr int RP_WL = 0, RP_RINFO = 65536, RP_LCNT = RP_RINFO + 128 * 8 * 4, RP_TPRE = RP_LCNT + 256;
template <int MODE>
__device__ __forceinline__ void row_pass(Frame& F, int layer) {
    constexpr int DOTS = (MODE == 0) ? 8 : (MODE == 1 ? 16 : 0);
    constexpr int RPI = 2, NIT = 16 / RPI, NV = (DOTS > 0) ? RPI * DOTS : 16;
    constexpr bool COMBINE = (MODE == 2 || MODE == 3), MODUL = (MODE != 3);
    const float* MOD = (const float*)(F.ws + WS_MOD);
    LAS float* wl = (LAS float*)(F.lds + RP_WL);
    LAS int* rinfo = (LAS int*)(F.lds + RP_RINFO);
    LAS int* lcnt = (LAS int*)(F.lds + RP_LCNT);
    LAS int* tpre = (LAS int*)(F.lds + RP_TPRE);
    const float* xin = F.in[I_X];
    bf16_t* XB = (bf16_t*)(F.ws + WS_XB);
    float* xout = F.out;
    bf16_t* U = (bf16_t*)(F.ws + WS_U);
    const bf16_t* O = (const bf16_t*)(F.ws + WS_O);
    const unsigned char* TOKp = (const unsigned char*)(F.ws + WS_TOK);
    const int lane = F.lane;
    const int clayer = (MODE == 2) ? 0 : 1;
    if (DOTS > 0) { constexpr int NQ = D * (DOTS > 0 ? DOTS : 4) / 4 / NTHR;
        f32x4 tv[NQ];
#pragma unroll
        for (int q = 0; q < NQ; ++q) { const int piece = F.tid + q * NTHR, k = piece / (DOTS / 4), c4 = piece % (DOTS / 4);
            tv[q] = (DOTS == 8) ? *(const f32x4*)(F.in[I_MWIN] + (size_t)k * MPROJ + 3072 + 4 * c4) : *(const f32x4*)(F.in[I_WR] + (size_t)piece * 4); }
#pragma unroll
        for (int q = 0; q < NQ; ++q) { const int piece = F.tid + q * NTHR, k = piece / (DOTS / 4), c4 = piece % (DOTS / 4), jj = k >> 8, l = (k >> 2) & 63, ii = k & 3;
            const int rot = (DOTS == 16) ? ((l >> 2) & 3) : ((l >> 3) & 1), ch = (c4 + rot) & (DOTS / 4 - 1);
            *(LAS f32x4*)(wl + ((jj * 4 + ii) * 64 + l) * DOTS + ch * 4) = tv[q]; } }
    if (COMBINE && F.tid == 0) { int a = 0; for (int e = 0; e < NE; ++e) { tpre[e] = a; a += ((int)__hip_atomic_load(F.ctl + CW_CNT + 64 * clayer + e, RLX_AGENT) + 255) >> 8; } tpre[NE] = a; }
    float brt[16];
    if (MODE == 1) {
#pragma unroll
        for (int e = 0; e < 16; ++e) brt[e] = F.in[I_BR][e]; }
    for (int batch = F.vcu; batch < T / 128; batch += F.G) {
        __syncthreads();
        if (MODE == 1 && F.tid < 32) lcnt[F.tid] = 0;
        __syncthreads();
        const int row_base = batch * 128 + F.wave * 16, b = row_base / SEQ;
        const float* gam = (MODE == 3) ? F.in[I_FG] : ((MODE == 1) ? F.in[I_N2G] + (size_t)layer * D : F.in[I_N1G] + (size_t)layer * D);
        const float* mod = MOD + ((size_t)layer * NB + b) * 6 * D;
        const float* shp = mod + ((MODE == 1) ? 3 * D : 0); const float* scp = shp + D;
        const float* g2p = MOD + ((size_t)clayer * NB + b) * 6 * D + 5 * D;
        f32x4 gm[4], sh[4], sc[4], g2[4];
#pragma unroll
        for (int j = 0; j < 4; ++j) { gm[j] = *(const f32x4*)(gam + 256 * j + 4 * lane);
            if (MODUL) { sh[j] = *(const f32x4*)(shp + 256 * j + 4 * lane); sc[j] = *(const f32x4*)(scp + 256 * j + 4 * lane) + 1.0f; }
            if (COMBINE) g2[j] = *(const f32x4*)(g2p + 256 * j + 4 * lane); }
        f32x4 xn[RPI][4]; u32x2 on[RPI][2][4]; u32x4 tkn[RPI], tkn2[RPI];
#define RP_LOAD_X(IT) do { _Pragma("unroll") for (int r = 0; r < RPI; ++r) _Pragma("unroll") for (int j = 0; j < 4; ++j) { \
            if (MODE == 0) xn[r][j] = *(const f32x4*)(xin + (size_t)(row_base + (IT) * RPI + r) * D + 256 * j + 4 * lane); \
            else { const u32x2 xb_ = *(const u32x2*)(XB + (size_t)(row_base + (IT) * RPI + r) * D + 256 * j + 4 * lane); xn[r][j] = (f32x4){bflo(xb_.x), bfhi(xb_.x), bflo(xb_.y), bfhi(xb_.y)}; } } } while (0)
#define RP_LOAD_TOK(dst, IT) do { _Pragma("unroll") for (int r = 0; r < RPI; ++r) dst[r] = *(const u32x4*)(TOKp + (size_t)(row_base + (IT) * RPI + r) * 16); } while (0)
#define RP_LOAD_O(tk) do { _Pragma("unroll") for (int r = 0; r < RPI; ++r) { const unsigned tx_ = tk[r].x, ty_ = tk[r].y; \
            const int e0_ = __builtin_amdgcn_readfirstlane((int)(tx_ >> 16)), e1_ = __builtin_amdgcn_readfirstlane((int)(ty_ >> 16)); \
            const int s0_ = tpre[e0_] * 256 + (int)(tx_ & 0xffffu), s1_ = tpre[e1_] * 256 + (int)(ty_ & 0xffffu); \
            _Pragma("unroll") for (int j = 0; j < 4; ++j) { on[r][0][j] = *(const u32x2*)(O + (size_t)s0_ * D + 256 * j + 4 * lane); on[r][1][j] = *(const u32x2*)(O + (size_t)s1_ * D + 256 * j + 4 * lane); } } } while (0)
        RP_LOAD_X(0);
        if (COMBINE) { RP_LOAD_TOK(tkn, 0); RP_LOAD_O(tkn); RP_LOAD_TOK(tkn2, 1); }
#pragma unroll 1
        for (int it = 0; it < NIT; ++it) {
            const int r0 = row_base + it * RPI;
            f32x4 x[RPI][4]; u32x2 oc[RPI][2][4]; float w0c[RPI], w1c[RPI];
#pragma unroll
            for (int r = 0; r < RPI; ++r) {
#pragma unroll
                for (int j = 0; j < 4; ++j) { x[r][j] = xn[r][j]; if (COMBINE) { oc[r][0][j] = on[r][0][j]; oc[r][1][j] = on[r][1][j]; } }
                if (COMBINE) { const unsigned wz_ = tkn[r].z, ww_ = tkn[r].w; w0c[r] = __uint_as_float(wz_); w1c[r] = __uint_as_float(ww_); } }
            if (it + 1 < NIT) {
                RP_LOAD_X(it + 1);
                if (COMBINE) {
#pragma unroll
                    for (int r = 0; r < RPI; ++r) tkn[r] = tkn2[r];
                    RP_LOAD_O(tkn);
                    if (it + 2 < NIT) RP_LOAD_TOK(tkn2, it + 2); } }
            if (COMBINE) {
#pragma unroll
                for (int r = 0; r < RPI; ++r)
#pragma unroll
                    for (int j = 0; j < 4; ++j) { const u32x2 a = oc[r][0][j], c = oc[r][1][j]; const float w0 = w0c[r], w1 = w1c[r];
                        f32x4 mo; mo[0] = w0 * bflo(a.x) + w1 * bflo(c.x); mo[1] = w0 * bfhi(a.x) + w1 * bfhi(c.x); mo[2] = w0 * bflo(a.y) + w1 * bflo(c.y); mo[3] = w0 * bfhi(a.y) + w1 * bfhi(c.y);
                        x[r][j] = x[r][j] + g2[j] * mo;
                        if (MODE == 2) { u32x2 xw_; xw_.x = pk2(x[r][j][0], x[r][j][1]); xw_.y = pk2(x[r][j][2], x[r][j][3]); *(u32x2*)(XB + (size_t)(r0 + r) * D + 256 * j + 4 * lane) = xw_; } }
            }
            float rstd[RPI];
#pragma unroll
            for (int r = 0; r < RPI; ++r) { float s = 0.f;
#pragma unroll
                for (int j = 0; j < 4; ++j) s += (x[r][j][0] * x[r][j][0] + x[r][j][1] * x[r][j][1]) + (x[r][j][2] * x[r][j][2] + x[r][j][3] * x[r][j][3]);
                rstd[r] = 1.0f / sqrtf(wave_sum(s) * (1.0f / D) + EPS); }
#pragma unroll
            for (int r = 0; r < RPI; ++r)
#pragma unroll
                for (int j = 0; j < 4; ++j) { f32x4 y = x[r][j] * rstd[r] * gm[j]; if (MODUL) y = y * sc[j] + sh[j]; x[r][j] = y;
                    if (MODE == 3) *(f32x4*)(xout + (size_t)(r0 + r) * D + 256 * j + 4 * lane) = y;
                    else if (MODE == 1) *(unsigned*)((unsigned char*)(F.ws + WS_U8) + (size_t)(r0 + r) * D + 256 * j + 4 * lane) = pk4_fp8(y[0], y[1], y[2], y[3]);
                    else { u32x2 w; w.x = pk2(y[0], y[1]); w.y = pk2(y[2], y[3]); *(u32x2*)(U + (size_t)(r0 + r) * D + 256 * j + 4 * lane) = w; } }
            if (DOTS > 0) {
                float v[NV];
#pragma unroll
                for (int i = 0; i < NV; ++i) v[i] = 0.f;
#pragma unroll
                for (int j = 0; j < 4; ++j)
#pragma unroll
                    for (int i = 0; i < 4; ++i) {
                        float w[DOTS > 0 ? DOTS : 1];
#pragma unroll
                        for (int q = 0; q < DOTS / 4; ++q) { const int rot = (DOTS == 16) ? ((lane >> 2) & 3) : ((lane >> 3) & 1);
                            const f32x4 t4 = *(const LAS f32x4*)(wl + ((j * 4 + i) * 64 + lane) * DOTS + ((q + rot) & (DOTS / 4 - 1)) * 4); w[4 * q] = t4[0]; w[4 * q + 1] = t4[1]; w[4 * q + 2] = t4[2]; w[4 * q + 3] = t4[3]; }
#pragma unroll
                        for (int r = 0; r < RPI; ++r)
#pragma unroll
                            for (int e = 0; e < DOTS; ++e) v[r * DOTS + e] += x[r][j][i] * w[e];
                        asm volatile("" ::: "memory"); }
                xreduce<NV>(v, lane);
                const float tot = v[0];
                if (MODE == 0) {
                    const int idx = lane >> 2, r = idx >> 3, gi = idx & 7, row = r0 + r, bb = row / SEQ, s = row % SEQ;
                    if ((lane & 3) == 0) {
                        const float pre = tot + F.in[I_MBG][gi];
                        if (gi < 4) ((float*)(F.ws + WS_IG))[(size_t)(bb * NH + gi) * SEQ + s] = pre;
                        else { const float ls = (pre >= 0.f) ? -log1pf(expf(-pre)) : (pre - log1pf(expf(pre))); ((float*)(F.ws + WS_LF))[(size_t)(bb * NH + gi - 4) * SEQ + s] = ls; }
                    }
                }
                if (MODE == 1) {
                    const int r = lane >> 5;
                    float lg[16], mx = -INFINITY;
#pragma unroll
                    for (int e = 0; e < 16; ++e) { lg[e] = __shfl(tot, 32 * r + 2 * e); mx = fmaxf(mx, lg[e]); }
                    float se = 0.f;
#pragma unroll
                    for (int e = 0; e < 16; ++e) { lg[e] = __builtin_amdgcn_exp2f((lg[e] - mx) * 1.44269504089f); se += lg[e]; }
                    const float inv = 1.0f / se;
                    float sel[16];
#pragma unroll
                    for (int e = 0; e < 16; ++e) { lg[e] *= inv; sel[e] = lg[e] + brt[e]; }
                    int best = 0; float bscore = -INFINITY;
#pragma unroll
                    for (int gq = 0; gq < 4; ++gq) { const float a = sel[4 * gq], bq = sel[4 * gq + 1], c = sel[4 * gq + 2], d = sel[4 * gq + 3];
                        const float m1 = fmaxf(fmaxf(a, bq), fmaxf(c, d));
                        const float lo1 = fminf(a, bq), hi1 = fmaxf(a, bq), lo2 = fminf(c, d), hi2 = fmaxf(c, d);
                        const float m2 = fmaxf(fminf(hi1, hi2), fmaxf(lo1, lo2));
                        const float gs = m1 + m2; if (gs > bscore) { bscore = gs; best = gq; } }
                    float s4[4], p4[4];
#pragma unroll
                    for (int q = 0; q < 4; ++q) { s4[q] = -INFINITY; p4[q] = 0.f; }
#pragma unroll
                    for (int gq = 0; gq < 4; ++gq) if (best == gq) {
#pragma unroll
                        for (int q = 0; q < 4; ++q) { s4[q] = sel[4 * gq + q]; p4[q] = lg[4 * gq + q]; } }
                    int i0 = 0; float v0 = s4[0], pp0 = p4[0];
#pragma unroll
                    for (int q = 1; q < 4; ++q) if (s4[q] > v0) { v0 = s4[q]; i0 = q; pp0 = p4[q]; }
                    int i1 = -1; float v1 = -INFINITY, pp1 = 0.f;
#pragma unroll
                    for (int q = 0; q < 4; ++q) if (q != i0 && s4[q] > v1) { v1 = s4[q]; i1 = q; pp1 = p4[q]; }
                    const float wsum = pp0 + pp1, w0 = pp0 / wsum, w1 = pp1 / wsum;
                    const int e0 = best * 4 + i0, e1 = best * 4 + i1;
                    if ((lane & 31) == 0) {
                        const int lp0 = __hip_atomic_fetch_add(lcnt + e0, 1, __ATOMIC_RELAXED, __HIP_MEMORY_SCOPE_WORKGROUP), lp1 = __hip_atomic_fetch_add(lcnt + e1, 1, __ATOMIC_RELAXED, __HIP_MEMORY_SCOPE_WORKGROUP);
                        LAS int* ri = rinfo + (F.wave * 16 + it * RPI + r) * 8;
                        ri[0] = e0; ri[1] = e1; ri[2] = lp0; ri[3] = lp1; ri[4] = __builtin_bit_cast(int, w0); ri[5] = __builtin_bit_cast(int, w1);
                    }
                }
            }
        }
#undef RP_LOAD_X
#undef RP_LOAD_TOK
#undef RP_LOAD_O
        if (MODE == 1) {
            __syncthreads();
            if (F.tid < 16) lcnt[16 + F.tid] = (int)__hip_atomic_fetch_add(F.ctl + CW_CNT + 64 * layer + F.tid, (unsigned)lcnt[F.tid], RLX_AGENT);
            __syncthreads();
            if (F.tid < 128) { const LAS int* ri = rinfo + F.tid * 8; const int row = batch * 128 + F.tid; const int e0 = ri[0], e1 = ri[1], p0 = lcnt[16 + e0] + ri[2], p1 = lcnt[16 + e1] + ri[3];
                int* LIST = (int*)(F.ws + WS_LIST); LIST[e0 * LCAP + p0] = row; LIST[e1 * LCAP + p1] = row;
                u32x4 ti; ti.x = (unsigned)(e0 << 16) | (unsigned)p0; ti.y = (unsigned)(e1 << 16) | (unsigned)p1; ti.z = (unsigned)ri[4]; ti.w = (unsigned)ri[5];
                *(u32x4*)(F.ws + WS_TOK + (size_t)row * 16) = ti; }
        }
    }
    __syncthreads();
}

#define LBAR() do { asm volatile("s_waitcnt lgkmcnt(0)" ::: "memory"); __builtin_amdgcn_s_barrier(); asm volatile("" ::: "memory"); } while (0)
__device__ __forceinline__ float incl_sum(float v, int lane) {
#pragma unroll
    for (int o = 1; o < 64; o <<= 1) { const float t = __shfl_up(v, o); if (lane >= o) v += t; }
    return v;
}
__device__ __forceinline__ float incl_max(float v, int lane) {
#pragma unroll
    for (int o = 1; o < 64; o <<= 1) { const float t = __shfl_up(v, o); if (lane >= o) v = fmaxf(v, t); }
    return v;
}
__device__ __forceinline__ void phase_scan(Frame& F, int mode = 0) {
    LAS float* wkA = (LAS float*)(F.lds + 0);
    LAS float* decA = (LAS float*)(F.lds + 32768);
    LAS float* tot = (LAS float*)(F.lds + 33280);
    LAS float* bst = (LAS float*)(F.lds + 33792);
    LAS float* cmx = (LAS float*)(F.lds + 34304);
    LAS float* rst = (LAS float*)(F.lds + 34816);
    LAS float* xw = (LAS float*)(F.lds + 35328);
    LAS unsigned char* ring = F.lds + 40960;
    constexpr int SLOT = 12288;
    const int lane = F.lane, w = F.wave, tid = F.tid;
    for (int unit = F.vcu; unit < 256; unit += F.G) {
        const int bh = unit >> 4, slice = unit & 15;
        const float* IG = (const float*)(F.ws + WS_IG) + (size_t)bh * SEQ; const float* LF = (const float*)(F.ws + WS_LF) + (size_t)bh * SEQ;
        __syncthreads();
        if (mode < 2) {
        float p[16], g[16], pm[16];
#pragma unroll
        for (int q = 0; q < 16; ++q) { const int c = 16 * w + q; p[q] = incl_sum(LF[c * 64 + lane], lane); if (lane == 63) tot[c] = p[q]; }
        __syncthreads();
        if (tid < 128) { const float v = tot[tid]; const float inc = incl_sum(v, lane); if (tid == 63) xw[0] = inc; bst[tid] = inc - v; }
        __syncthreads();
        if (tid >= 64 && tid < 128) bst[tid] += xw[0];
        __syncthreads();
#pragma unroll
        for (int q = 0; q < 16; ++q) { const int c = 16 * w + q; p[q] += bst[c]; g[q] = IG[c * 64 + lane] - p[q]; pm[q] = incl_max(g[q], lane); if (lane == 63) cmx[c] = pm[q]; }
        __syncthreads();
        if (tid < 128) { const float v = cmx[tid]; const float inc = incl_max(v, lane); if (tid == 63) xw[1] = inc; float ex = __shfl_up(inc, 1); if (lane == 0) ex = 0.f; rst[tid] = fmaxf(ex, 0.f); }
        __syncthreads();
        if (tid >= 64 && tid < 128) rst[tid] = fmaxf(rst[tid], xw[1]);
        __syncthreads();
#pragma unroll
        for (int q = 0; q < 16; ++q) { const int c = 16 * w + q; const float Rs = rst[c], Rn = fmaxf(Rs, cmx[c]), Rrun = fmaxf(Rs, pm[q]);
            wkA[c * 64 + lane] = expf(g[q] - Rn); if (lane == 0) decA[c] = expf(Rs - Rn);
            if (slice == 0) { const size_t o = (size_t)bh * SEQ + c * 64 + lane; ((float*)(F.ws + WS_GA))[o] = g[q]; ((float*)(F.ws + WS_RR))[o] = Rrun; ((float*)(F.ws + WS_MM))[o] = p[q] + Rrun;
                if (lane == 0) ((float*)(F.ws + WS_RC))[bh * NCH + c] = Rs; } }
        }
        __syncthreads();
        if (mode == 1) continue;
        const int dkh = slice & 1, dvs = slice >> 1;
        const bf16_t* KTg = (const bf16_t*)(F.ws + WS_KT) + ((size_t)bh * NCH * DK + 64 * dkh) * 64;
        const bf16_t* VTg = (const bf16_t*)(F.ws + WS_VT) + ((size_t)bh * NCH * DV + 32 * dvs) * 64;
        const int dkr = 64 * dkh + 16 * (w >> 1), dvc = 32 * dvs + 16 * (w & 1);
        bf16_t* STp = (bf16_t*)(F.ws + WS_ST) + ((size_t)bh * NCH * DV + dvc + (lane & 15)) * DK + dkr + 4 * (lane >> 4);
        float* NSp = (float*)(F.ws + WS_NS) + (size_t)bh * NCH * DK + dkr + 4 * (lane >> 4);
        const bool ns_writer = (dvs == 0) && ((w & 1) == 0) && ((lane & 15) == 0);
        f32x4 accS = (f32x4){0.f, 0.f, 0.f, 0.f}, accN = (f32x4){0.f, 0.f, 0.f, 0.f};
        constexpr int PD = 4;
        u32x4 gk[PD], gv[PD];
        const int wr0 = (tid >> 3) * 128 + (((tid & 7) ^ ((tid >> 3) & 7)) << 4);
        const int arow = 16 * (w >> 1) + (lane & 15), brow = 16 * (w & 1) + (lane & 15), lq = lane >> 4;
#define SC_LOAD(set, cc) do { gk[set] = *(const u32x4*)(KTg + (size_t)(cc) * DK * 64 + tid * 8); if (tid < 256) gv[set] = *(const u32x4*)(VTg + (size_t)(cc) * DV * 64 + tid * 8); } while (0)
#define SC_WRITE(set, slot) do { LAS unsigned char* sb_ = ring + (slot) * SLOT; *(LAS u32x4*)(sb_ + wr0) = gk[set]; if (tid < 256) *(LAS u32x4*)(sb_ + 8192 + wr0) = gv[set]; } while (0)
#pragma unroll
        for (int q = 0; q < PD; ++q) SC_LOAD(q, q);
        SC_WRITE(0, 0); SC_WRITE(1, 1);
        SC_LOAD(0, PD); SC_LOAD(1, PD + 1);
        LBAR();
        for (int c0 = 0; c0 < NCH; c0 += PD) {
#pragma unroll
            for (int q2 = 0; q2 < PD; q2 += 2) {
                { const int cw = c0 + q2 + 2;
                  if (cw < NCH) { SC_WRITE((q2 + 2) % PD, (q2 + 2) % PD); SC_WRITE((q2 + 3) % PD, (q2 + 3) % PD);
                      if (cw + PD < NCH) { SC_LOAD((q2 + 2) % PD, cw + PD); SC_LOAD((q2 + 3) % PD, cw + PD + 1); } } }
#pragma unroll
                for (int qq = 0; qq < 2; ++qq) {
                    const int q = q2 + qq, c = c0 + q;
                    if (mode < 3) { { u32x2 o; o.x = pk2(accS[0], accS[1]); o.y = pk2(accS[2], accS[3]); *(u32x2*)(STp + (size_t)c * DV * DK) = o; }
                    if (ns_writer) *(f32x4*)(NSp + (size_t)c * DK) = accN; }
                    const float dec = decA[c];
                    accS = accS * dec; accN = accN * dec;
                    const LAS unsigned char* sb = ring + q * SLOT;
#pragma unroll
                    for (int kk = 0; kk < 2; ++kk) {
                        const LAS f32x4* wp = (const LAS f32x4*)(wkA + c * 64 + kk * 32 + 8 * lq);
                        const f32x4 w0 = wp[0], w1 = wp[1];
                        const u32x4 ka = *(const LAS u32x4*)(sb + arow * 128 + (((4 * kk + lq) ^ (arow & 7)) << 4));
                        const u32x4 vv = *(const LAS u32x4*)(sb + 8192 + brow * 128 + (((4 * kk + lq) ^ (brow & 7)) << 4));
                        u32x4 bv, b1;
                        bv.x = pk2(bflo(vv.x) * w0[0], bfhi(vv.x) * w0[1]); bv.y = pk2(bflo(vv.y) * w0[2], bfhi(vv.y) * w0[3]);
                        bv.z = pk2(bflo(vv.z) * w1[0], bfhi(vv.z) * w1[1]); bv.w = pk2(bflo(vv.w) * w1[2], bfhi(vv.w) * w1[3]);
                        b1.x = pk2(w0[0], w0[1]); b1.y = pk2(w0[2], w0[3]); b1.z = pk2(w1[0], w1[1]); b1.w = pk2(w1[2], w1[3]);
                        const bf16x8 af = __builtin_bit_cast(bf16x8, ka);
                        accS = __builtin_amdgcn_mfma_f32_16x16x32_bf16(af, __builtin_bit_cast(bf16x8, bv), accS, 0, 0, 0);
                        accN = __builtin_amdgcn_mfma_f32_16x16x32_bf16(af, __builtin_bit_cast(bf16x8, b1), accN, 0, 0, 0);
                    }
                }
                LBAR();
            }
        }
        asm volatile("" :: "v"(accS), "v"(accN));
#undef SC_LOAD
#undef SC_WRITE
    }
    __syncthreads();
}

constexpr int OC_AP = 0, OC_STRIDE = 400, OC_BVEC = 25600, OC_INV = 26368, OC_PART = 26624, OC_GS = 28672, OC_RT = 28928, OC_EMM = 29184, OC_HT = 32768, OC_HSTR = 528;
__device__ __forceinline__ void phase_out(Frame& F) {
    LAS unsigned char* AP = F.lds + OC_AP; LAS unsigned char* HT = F.lds + OC_HT;
    LAS float* bvec = (LAS float*)(F.lds + OC_BVEC); LAS float* inv = (LAS float*)(F.lds + OC_INV); LAS float* part = (LAS float*)(F.lds + OC_PART);
    LAS float* gs = (LAS float*)(F.lds + OC_GS); LAS float* Rt = (LAS float*)(F.lds + OC_RT); LAS float* emm = (LAS float*)(F.lds + OC_EMM);
    const int lane = F.lane, w = F.wave, tid = F.tid, l15 = lane & 15, lq = lane >> 4;
    const bf16_t* Qg = (const bf16_t*)(F.ws + WS_Q); const bf16_t* Kg = (const bf16_t*)(F.ws + WS_K);
    const bf16_t* VTg = (const bf16_t*)(F.ws + WS_VT); const bf16_t* STg = (const bf16_t*)(F.ws + WS_ST); const bf16_t* OGS = (const bf16_t*)(F.ws + WS_OGS);
    const float* GAg = (const float*)(F.ws + WS_GA); const float* RRg = (const float*)(F.ws + WS_RR); const float* MMg = (const float*)(F.ws + WS_MM);
    const float* NSg = (const float*)(F.ws + WS_NS); const float* RCg = (const float*)(F.ws + WS_RC); const float* MNG = F.in[I_MNG];
    bf16_t* HN = (bf16_t*)(F.ws + WS_U);
    const int mt = w >> 1, ntb = (w & 1) * 2, tq = tid >> 3, pq = tid & 7, NU = 16 * NCH;
    u32x4 bfr[2][6], qk[4], og[4]; f32x4 ng0, ng1; float sc_g = 0.f, sc_r = 0.f, sc_m = 0.f, sc_b = 0.f, Rc = 0.f;
    LAS unsigned char* QL = F.lds + 69632; LAS unsigned char* KL = F.lds + 86016;
    const int prow = tid >> 4, pch = tid & 15;
    const int pwr = prow * 256 + ((pch ^ (prow & 15)) << 4);
#define OC_LOAD_MAIN(U_) do { const int bh_ = (U_) >> 7, c_ = (U_) & 127, tk_ = (bh_ >> 2) * SEQ + c_ * 64, h_ = bh_ & 3; \
        _Pragma("unroll") for (int n = 0; n < 2; ++n) { const int dv = 32 * w + 16 * n + l15; \
            _Pragma("unroll") for (int kk = 0; kk < 2; ++kk) bfr[n][kk] = *(const u32x4*)(VTg + ((((size_t)bh_ * NCH + c_) * DV + dv) << 6) + 32 * kk + 8 * lq); \
            _Pragma("unroll") for (int kk = 0; kk < 4; ++kk) bfr[n][2 + kk] = *(const u32x4*)(STg + (((size_t)bh_ * NCH + c_) * DV + dv) * DK + 32 * kk + 8 * lq); } \
        qk[0] = *(const u32x4*)(Qg + (size_t)(tk_ + prow) * MQK + h_ * DK + 8 * pch); qk[1] = *(const u32x4*)(Qg + (size_t)(tk_ + prow + 32) * MQK + h_ * DK + 8 * pch); \
        qk[2] = *(const u32x4*)(Kg + (size_t)(tk_ + prow) * MQK + h_ * DK + 8 * pch); qk[3] = *(const u32x4*)(Kg + (size_t)(tk_ + prow + 32) * MQK + h_ * DK + 8 * pch); \
        if (tid < 64) { const size_t o_ = (size_t)bh_ * SEQ + c_ * 64 + tid; sc_g = GAg[o_]; sc_r = RRg[o_]; sc_m = MMg[o_]; sc_b = 1.0f; } \
        else if (tid < 192) sc_b = NSg[((size_t)bh_ * NCH + c_) * DK + tid - 64]; \
        Rc = RCg[bh_ * NCH + c_]; } while (0)
#define OC_LOAD_OGS(U_) do { const int bh_ = (U_) >> 7, c_ = (U_) & 127, tk_ = (bh_ >> 2) * SEQ + c_ * 64, h_ = bh_ & 3; \
        _Pragma("unroll") for (int q = 0; q < 4; ++q) og[q] = *(const u32x4*)(OGS + (size_t)(tk_ + (tid >> 5) + 16 * q) * MV + h_ * DV + 8 * (tid & 31)); \
        ng0 = *(const f32x4*)(MNG + h_ * DV + 8 * (tid & 31)); ng1 = *(const f32x4*)(MNG + h_ * DV + 8 * (tid & 31) + 4); } while (0)
    int unit = F.vcu;
    if (unit < NU) { OC_LOAD_MAIN(unit); OC_LOAD_OGS(unit); }
    for (; unit < NU; unit += F.G) {
        const int bh = unit >> 7, c = unit & 127, b = bh >> 2, h = bh & 3;
        const int tk0 = b * SEQ + c * 64;
        if (tid < 64) { gs[tid] = sc_g; Rt[tid] = sc_r; emm[tid] = expf(-sc_m); }
        if (tid < 192) bvec[tid] = sc_b;
        *(LAS u32x4*)(QL + pwr) = qk[0]; *(LAS u32x4*)(QL + 8192 + pwr) = qk[1]; *(LAS u32x4*)(KL + pwr) = qk[2]; *(LAS u32x4*)(KL + 8192 + pwr) = qk[3];
        const float Rc_cur = Rc;
        LBAR();
        u32x4 qa[4], kb[2][4];
#pragma unroll
        for (int kk = 0; kk < 4; ++kk) { { const int row = 16 * mt + l15; qa[kk] = *(const LAS u32x4*)(QL + row * 256 + (((4 * kk + lq) ^ (row & 15)) << 4)); }
#pragma unroll
            for (int n = 0; n < 2; ++n) { const int row = 16 * (ntb + n) + l15; kb[n][kk] = *(const LAS u32x4*)(KL + row * 256 + (((4 * kk + lq) ^ (row & 15)) << 4)); } }
        const u32x4 q0 = *(const LAS u32x4*)(QL + tq * 256 + (((2 * pq) ^ (tq & 15)) << 4)), q1 = *(const LAS u32x4*)(QL + tq * 256 + (((2 * pq + 1) ^ (tq & 15)) << 4));
        f32x4 pacc[2];
#pragma unroll
        for (int n = 0; n < 2; ++n) { pacc[n] = (f32x4){0.f, 0.f, 0.f, 0.f};
#pragma unroll
            for (int kk = 0; kk < 4; ++kk) pacc[n] = __builtin_amdgcn_mfma_f32_16x16x32_bf16(__builtin_bit_cast(bf16x8, qa[kk]), __builtin_bit_cast(bf16x8, kb[n][kk]), pacc[n], 0, 0, 0); }
#pragma unroll
        for (int n = 0; n < 2; ++n) { const int sl = 16 * (ntb + n) + l15; const float gsv = gs[sl];
#pragma unroll
            for (int r = 0; r < 4; ++r) { const int tl = 16 * mt + 4 * lq + r; const float pv = (sl <= tl) ? pacc[n][r] * expf(gsv - Rt[tl]) : 0.f;
                *(LAS bf16_t*)(AP + tl * OC_STRIDE + sl * 2) = (bf16_t)f2bf(pv); } }
        { const float wq = expf(Rc_cur - Rt[tq]);
          u32x4 o0, o1;
          o0.x = pk2(bflo(q0.x) * wq, bfhi(q0.x) * wq); o0.y = pk2(bflo(q0.y) * wq, bfhi(q0.y) * wq); o0.z = pk2(bflo(q0.z) * wq, bfhi(q0.z) * wq); o0.w = pk2(bflo(q0.w) * wq, bfhi(q0.w) * wq);
          o1.x = pk2(bflo(q1.x) * wq, bfhi(q1.x) * wq); o1.y = pk2(bflo(q1.y) * wq, bfhi(q1.y) * wq); o1.z = pk2(bflo(q1.z) * wq, bfhi(q1.z) * wq); o1.w = pk2(bflo(q1.w) * wq, bfhi(q1.w) * wq);
          *(LAS u32x4*)(AP + tq * OC_STRIDE + 128 + 32 * pq) = o0; *(LAS u32x4*)(AP + tq * OC_STRIDE + 128 + 32 * pq + 16) = o1; }
        LBAR();
        { float s = 0.f;
#pragma unroll
          for (int q = 0; q < 3; ++q) { const u32x4 a = *(const LAS u32x4*)(AP + tq * OC_STRIDE + 48 * pq + 16 * q); const LAS f32x4* bp = (const LAS f32x4*)(bvec + 24 * pq + 8 * q); const f32x4 b0 = bp[0], b1 = bp[1];
              s += bflo(a.x) * b0[0] + bfhi(a.x) * b0[1] + bflo(a.y) * b0[2] + bfhi(a.y) * b0[3] + bflo(a.z) * b1[0] + bfhi(a.z) * b1[1] + bflo(a.w) * b1[2] + bfhi(a.w) * b1[3]; }
          s += __shfl_xor(s, 1); s += __shfl_xor(s, 2); s += __shfl_xor(s, 4);
          if (pq == 0) inv[tq] = 1.0f / fmaxf(fabsf(s), emm[tq]); }
        f32x4 acc[4][2];
#pragma unroll
        for (int m = 0; m < 4; ++m)
#pragma unroll
            for (int n = 0; n < 2; ++n) acc[m][n] = (f32x4){0.f, 0.f, 0.f, 0.f};
#pragma unroll
        for (int kk = 0; kk < 6; ++kk) {
            bf16x8 af[4];
#pragma unroll
            for (int m = 0; m < 4; ++m) af[m] = *(const LAS bf16x8*)(AP + (16 * m + l15) * OC_STRIDE + 64 * kk + 16 * lq);
#pragma unroll
            for (int m = 0; m < 4; ++m)
#pragma unroll
                for (int n = 0; n < 2; ++n) acc[m][n] = __builtin_amdgcn_mfma_f32_16x16x32_bf16(af[m], __builtin_bit_cast(bf16x8, bfr[n][kk]), acc[m][n], 0, 0, 0);
        }
        const int nxt = unit + F.G;
        if (nxt < NU) OC_LOAD_MAIN(nxt);
        LBAR();
#pragma unroll
        for (int m = 0; m < 4; ++m)
#pragma unroll
            for (int r = 0; r < 4; ++r) { const int tl = 16 * m + 4 * lq + r; const float iv = inv[tl];
                const float h0 = acc[m][0][r] * iv, h1 = acc[m][1][r] * iv;
                *(LAS bf16_t*)(HT + tl * OC_HSTR + (32 * w + l15) * 2) = (bf16_t)f2bf(h0); *(LAS bf16_t*)(HT + tl * OC_HSTR + (32 * w + 16 + l15) * 2) = (bf16_t)f2bf(h1);
                float s = h0 * h0 + h1 * h1; s += __shfl_xor(s, 1); s += __shfl_xor(s, 2); s += __shfl_xor(s, 4); s += __shfl_xor(s, 8);
                if (l15 == 0) part[w * 64 + tl] = s; }
        LBAR();
#pragma unroll
        for (int q = 0; q < 4; ++q) { const int row = (tid >> 5) + 16 * q, ch = tid & 31; float ss = 0.f;
#pragma unroll
            for (int ww = 0; ww < 8; ++ww) ss += part[ww * 64 + row];
            const float rs = 1.0f / sqrtf(ss * (1.0f / DV) + EPS);
            const u32x4 hv = *(const LAS u32x4*)(HT + row * OC_HSTR + ch * 16); const u32x4 g = og[q];
            u32x4 o;
            o.x = pk2(bflo(hv.x) * rs * ng0[0] * bflo(g.x), bfhi(hv.x) * rs * ng0[1] * bfhi(g.x)); o.y = pk2(bflo(hv.y) * rs * ng0[2] * bflo(g.y), bfhi(hv.y) * rs * ng0[3] * bfhi(g.y));
            o.z = pk2(bflo(hv.z) * rs * ng1[0] * bflo(g.z), bfhi(hv.z) * rs * ng1[1] * bfhi(g.z)); o.w = pk2(bflo(hv.w) * rs * ng1[2] * bflo(g.w), bfhi(hv.w) * rs * ng1[3] * bfhi(g.w));
            *(u32x4*)(HN + (size_t)(tk0 + row) * MV + h * DV + 8 * ch) = o; }
        if (nxt < NU) OC_LOAD_OGS(nxt);
    }
#undef OC_LOAD_MAIN
#undef OC_LOAD_OGS
    __syncthreads();
}

__device__ __forceinline__ void phase_conv(Frame& F) {
    const bf16_t* BG = (const bf16_t*)(F.ws + WS_BG); const bf16_t* Z = (const bf16_t*)(F.ws + WS_Z); bf16_t* Y = (bf16_t*)(F.ws + WS_Y);
    const int cg = F.tid & 127, rsub = F.tid >> 7, col = 8 * cg;
    float w0[8], w1[8], w2[8], cb[8];
#pragma unroll
    for (int i = 0; i < 8; ++i) { w0[i] = F.in[I_CCW][col + i]; w1[i] = F.in[I_CCW][D + col + i]; w2[i] = F.in[I_CCW][2 * D + col + i]; cb[i] = F.in[I_CCB][col + i]; }
    for (int batch = F.vcu; batch < T / 128; batch += F.G) {
        const int t0 = batch * 128 + rsub * 32, s0 = t0 % SEQ;
        u32x4 z2 = (u32x4){0u, 0u, 0u, 0u}, z1 = z2;
        if (s0 >= 2) z2 = *(const u32x4*)(Z + (size_t)(t0 - 2) * D + col);
        if (s0 >= 1) z1 = *(const u32x4*)(Z + (size_t)(t0 - 1) * D + col);
#pragma unroll 4
        for (int r = 0; r < 32; ++r) {
            const u32x4 z0 = *(const u32x4*)(Z + (size_t)(t0 + r) * D + col), bg = *(const u32x4*)(BG + (size_t)(t0 + r) * D + col);
            float o[8];
#pragma unroll
            for (int i = 0; i < 4; ++i) {
                o[2 * i] = bflo(bg[i]) * (w0[2 * i] * bflo(z2[i]) + w1[2 * i] * bflo(z1[i]) + w2[2 * i] * bflo(z0[i]) + cb[2 * i]);
                o[2 * i + 1] = bfhi(bg[i]) * (w0[2 * i + 1] * bfhi(z2[i]) + w1[2 * i + 1] * bfhi(z1[i]) + w2[2 * i + 1] * bfhi(z0[i]) + cb[2 * i + 1]); }
            u32x4 ov; ov.x = pk2(o[0], o[1]); ov.y = pk2(o[2], o[3]); ov.z = pk2(o[4], o[5]); ov.w = pk2(o[6], o[7]);
            *(u32x4*)(Y + (size_t)(t0 + r) * D + col) = ov;
            z2 = z1; z1 = z0;
        }
    }
}

__device__ __forceinline__ void moe_table(Frame& F, int layer) {
    __syncthreads();
    if (F.tid == 0) { int a = 0; for (int e = 0; e < NE; ++e) { const int c = (int)__hip_atomic_load(F.ctl + CW_CNT + 64 * layer + e, RLX_AGENT); F.MISC[16 + e] = (unsigned)a; F.MISC[40 + e] = (unsigned)c; a += (c + 255) >> 8; } F.MISC[16 + NE] = (unsigned)a; }
    __syncthreads();
}

#ifndef TIMER_PHASE
#define TIMER_PHASE (-1)
#endif
#define STAMP(k) do { if (TIMER_PHASE >= 0 && blockIdx.x == 0 && threadIdx.x == 0) { unsigned long long t_ = __builtin_amdgcn_s_memrealtime(); ((unsigned long long*)karg_ptr(21))[4096 + (k)] = t_; } } while (0)
constexpr int N_PHASES = 17;
#define WSP(T_, off) ((T_*)(F.ws + (off)))
__global__ void __launch_bounds__(NTHR, 2) fwd_kernel(Args args) {
    extern __shared__ __attribute__((aligned(16))) unsigned char lds_raw[];
#define MAKE_FRAME() Frame F; { int t_ = threadIdx.x, bx_ = blockIdx.x, g_ = gridDim.x; asm volatile("" : "+v"(t_), "+s"(bx_), "+s"(g_)); \
        F.lds = (LAS unsigned char*)lds_raw; F.MISC = (volatile LAS unsigned*)(F.lds + MISC_OFF); F.tid = t_; F.lane = t_ & 63; F.wave = __builtin_amdgcn_readfirstlane(t_ >> 6); \
        F.G = g_; F.bx = bx_; F.vcu = (g_ % 8 == 0) ? (bx_ % 8) * (g_ / 8) + bx_ / 8 : bx_; }
    const int lo = args.ph_lo, hi = args.ph_hi;
    const bool one_launch = (hi - lo) > 1;
    XcdBarrier bar;
    { MAKE_FRAME();
      for (int u = F.tid; u < 256; u += NTHR) F.MISC[u] = 0u;
      __syncthreads();
      bar.bar = (unsigned*)(F.ctl + CW_BAR); bar.x = 0; bar.st = nullptr;
      if (one_launch) bar = xcd_barrier_post((unsigned*)(F.ctl + CW_BAR), F.MISC + 8); }
    STAMP(0);
#ifdef PH_ONLY
#define IN(k) ((k) == PH_ONLY && lo <= (k) && (k) < hi)
#else
#define IN(k) (lo <= (k) && (k) < hi)
#endif
#define SEAM(k) do { if (IN(k) && IN((k) + 1)) { xcd_barrier(bar); STAMP((k) + 1); } } while (0)
#ifndef DUP_MODE
#define DUP_MODE 0
#endif
#ifndef DUP_PHASE
#define DUP_PHASE (-1)
#endif
#define PHASE(k) if (IN(k)) { for (int rep_ = 0; rep_ < (((k) == DUP_PHASE) ? 2 : 1); ++rep_) { MAKE_FRAME(); asm volatile("; PHASE_MARK " #k);
#define END_PHASE(k) } } SEAM(k);
    PHASE(0) phase_prologue(F); END_PHASE(0)
    PHASE(1) row_pass<0>(F, 0); END_PHASE(1)
    PHASE(2) pg8::Gemm g{WSP(bf16_t, WS_U), WSP(bf16_t, WS_W0), D}; pg8::DenseOrder S; S.init(T, 3 * D, F.G, F.bx);
        pg8::EpiM1 E{WSP(bf16_t, WS_Q), WSP(bf16_t, WS_K), WSP(bf16_t, WS_KT), WSP(bf16_t, WS_VT), WSP(bf16_t, WS_OGS), F.lds + EPI_OFF};
        pg8::gemm_phase<pg8::EpiM1, pg8::DenseOrder, false, true, true>(F.lds, g, S, E, F.tid); END_PHASE(2)
    PHASE(3) phase_scan(F, rep_ == 0 ? 0 : DUP_MODE); END_PHASE(3)
    PHASE(4) phase_out(F); END_PHASE(4)
    PHASE(5) pg8::Gemm g{WSP(bf16_t, WS_U), WSP(bf16_t, WS_W1), D}; pg8::DenseOrder S; S.init(T, D, F.G, F.bx);
        pg8::EpiRes<true> E{F.in[I_X], WSP(bf16_t, WS_XB), WSP(float, WS_MOD) + 2 * D, (DBG_SKIP & 1) ? 0.f : 1.f};
        pg8::gemm_phase<pg8::EpiRes<true>, pg8::DenseOrder, false, true, true>(F.lds, g, S, E, F.tid); END_PHASE(5)
#define WL(L_, off) WSP(bf16_t, ((L_) == 0 ? (size_t)0 : WS_WL1) + (off))
#define MOE_BLOCK(L, p0, p1, p2) \
    PHASE(p0) row_pass<1>(F, L); END_PHASE(p0) \
    PHASE(p1) moe_table(F, L); \
        pg8::Gemm g{WSP(bf16_t, WS_U8), WL(L, WS_WUP), D / 2, 0x7a7a7a7a, 0x7f7f7f7f}; pg8::MoeOrder S{(const LAS int*)(F.MISC + 16), (const LAS int*)(F.MISC + 40), WSP(const int, WS_LIST), F.G, F.vcu, 1024}; \
        pg8::EpiGlu<true, true> E{WSP(bf16_t, WS_A8), DE, 0, nullptr, 0, 2.0f}; \
        pg8::gemm_phase<pg8::EpiGlu<true, true>, pg8::MoeOrder, true, true, true, true>(F.lds, g, S, E, F.tid); END_PHASE(p1) \
    PHASE(p2) moe_table(F, L); \
        pg8::Gemm g{WSP(bf16_t, WS_A8), WL(L, WS_WDN), DE / 2, 0x7b7b7b7b, 0x7e7e7e7e}; pg8::MoeOrder S{(const LAS int*)(F.MISC + 16), (const LAS int*)(F.MISC + 40), nullptr, F.G, F.vcu, 1024}; \
        pg8::EpiBf E{WSP(bf16_t, WS_O), D}; \
        pg8::gemm_phase<pg8::EpiBf, pg8::MoeOrder, true, true, true, true>(F.lds, g, S, E, F.tid); END_PHASE(p2)
    MOE_BLOCK(0, 6, 7, 8)
    PHASE(9) row_pass<2>(F, 1); convert_weights(F, 1); END_PHASE(9)
    PHASE(10) pg8::Gemm g{WSP(bf16_t, WS_U), WL(1, WS_W0), D}; pg8::DenseOrder S; S.init(T, 3 * D, F.G, F.bx);
        pg8::EpiGlu<false> E{WSP(bf16_t, WS_Z), D, 4, WSP(bf16_t, WS_BG), D, 0.f};
        pg8::gemm_phase<pg8::EpiGlu<false>, pg8::DenseOrder, false, true, true>(F.lds, g, S, E, F.tid); END_PHASE(10)
    PHASE(11) phase_conv(F); END_PHASE(11)
    PHASE(12) pg8::Gemm g{WSP(bf16_t, WS_Y), WL(1, WS_W1), D}; pg8::DenseOrder S; S.init(T, D, F.G, F.bx);
        pg8::EpiRes<false> E{WSP(bf16_t, WS_XB), WSP(bf16_t, WS_XB), WSP(float, WS_MOD) + (size_t)NB * 6 * D + 2 * D, (DBG_SKIP & 4) ? 0.f : 1.f};
        pg8::gemm_phase<pg8::EpiRes<false>, pg8::DenseOrder, false, true, true>(F.lds, g, S, E, F.tid); END_PHASE(12)
    MOE_BLOCK(1, 13, 14, 15)
    if (IN(16)) { MAKE_FRAME(); asm volatile("; PHASE_MARK 16"); row_pass<3>(F, 1);
    }

    if (TIMER_PHASE >= 0 && one_launch) {
        STAMP(17);
        xcd_barrier(bar);
        const unsigned long long* ts = (const unsigned long long*)karg_ptr(21) + 4096;
        const unsigned long long d = __hip_atomic_load(ts + TIMER_PHASE + 1, RLX_AGENT) - __hip_atomic_load(ts + TIMER_PHASE, RLX_AGENT);
        const unsigned long long t0 = __builtin_amdgcn_s_memrealtime();
        while (__builtin_amdgcn_s_memrealtime() - t0 < 4ull * d) __builtin_amdgcn_s_sleep(8);
    }
#undef IN
#undef SEAM
}

extern "C" void kernel_launch(void* const* d_in, const int* in_sizes, int n_in, void* d_out, int out_size, void* d_ws, size_t ws_size, hipStream_t stream) {
    static int grid = 0;
    if (grid == 0) {
        if (n_in != 20 || in_sizes[0] != T * D || out_size != T * D || ws_size < WS_END) { fprintf(stderr, "kernel_launch: unexpected shapes: n_in %d in0 %d out %d ws %zu\n", n_in, n_in > 0 ? in_sizes[0] : -1, out_size, ws_size); grid = -1; return; }
        int dev = 0, cus = 0, per_cu = 0;
        if (hipGetDevice(&dev) != hipSuccess || hipDeviceGetAttribute(&cus, hipDeviceAttributeMultiprocessorCount, dev) != hipSuccess) { grid = -1; return; }
        if (hipFuncSetAttribute((const void*)fwd_kernel, hipFuncAttributeMaxDynamicSharedMemorySize, LDS_BYTES) != hipSuccess) { fprintf(stderr, "kernel_launch: hipFuncSetAttribute failed\n"); grid = -1; return; }
        if (hipOccupancyMaxActiveBlocksPerMultiprocessor(&per_cu, (const void*)fwd_kernel, NTHR, LDS_BYTES) != hipSuccess || per_cu < 1) { fprintf(stderr, "kernel_launch: occupancy query says %d blocks per CU\n", per_cu); (void)hipGetLastError(); grid = -1; return; }
        grid = cus;
        if (grid != 256) fprintf(stderr, "kernel_launch: %d CUs (built for 256)\n", grid);
    }
    if (grid < 0) return;
    (void)hipMemsetAsync((char*)d_ws + WS_CTL, 0, CTL_ZERO_BYTES, stream);
    Args a{};
    for (int i = 0; i < 20; ++i) a.in[i] = (const float*)d_in[i];
    a.out = (float*)d_out; a.ws = (unsigned char*)d_ws;
#if MK_N_LAUNCHES == 1
    a.ph_lo = 0; a.ph_hi = N_PHASES;
    void* kargs[] = {&a};
    hipError_t e = hipLaunchCooperativeKernel((const void*)fwd_kernel, dim3(grid), dim3(NTHR), kargs, LDS_BYTES, stream);
    if (e != hipSuccess) fprintf(stderr, "kernel_launch: cooperative launch failed: %s\n", hipGetErrorString(e));
#else
    for (int p = 0; p < N_PHASES; ++p) { a.ph_lo = p; a.ph_hi = p + 1; hipLaunchKernelGGL(fwd_kernel, dim3(grid), dim3(NTHR), LDS_BYTES, stream, a); }
#endif
}
```

```cpp
#include <hip/hip_runtime.h>
#include <cstdio>
#include <cstdint>

#ifndef FP8_G1
#define FP8_G1 2
#endif
#ifndef FP8_CIN
#define FP8_CIN 1
#endif
#ifndef DBG_SKIP
#define DBG_SKIP 0
#endif
#ifndef MK_N_LAUNCHES
#define MK_N_LAUNCHES 1
#endif

#define LAS __attribute__((address_space(3)))
#define GAS __attribute__((address_space(1)))
typedef unsigned short bf16_t;
typedef short bf16x8 __attribute__((ext_vector_type(8)));
typedef float f32x4 __attribute__((ext_vector_type(4)));
typedef float f32x2 __attribute__((ext_vector_type(2)));
typedef unsigned u32x4 __attribute__((ext_vector_type(4)));
typedef unsigned u32x2 __attribute__((ext_vector_type(2)));
typedef GAS unsigned gu32;
#define RLX_AGENT __ATOMIC_RELAXED, __HIP_MEMORY_SCOPE_AGENT
#define LDS_WAIT() asm volatile("s_waitcnt lgkmcnt(0)" ::: "memory")
#define VM_WAIT() asm volatile("s_waitcnt vmcnt(0)" ::: "memory")

constexpr int NB = 4, SEQ = 8192, D = 1024, T = NB * SEQ;
constexpr int NH = 4, DK = 128, DV = 256, MQK = NH * DK, MV = NH * DV, MPROJ = 2 * MQK + 2 * MV + 2 * NH;
constexpr int CH = 64, NCH = SEQ / CH;
constexpr int NE = 16, DE = 512, LCAP = 65536;
constexpr int SLOT_ROWS = 2 * T + NE * 256;
constexpr float EPS = 1e-6f;
constexpr int NWAVES = 8, NTHR = 512;

constexpr size_t MiB = 1u << 20;
constexpr size_t WS_CTL = 0, CTL_ZERO_BYTES = 64 * 1024;
constexpr size_t WS_MOD = 1 * MiB;
constexpr size_t WS_W0 = 2 * MiB;
constexpr size_t WS_W1 = 8 * MiB;
constexpr size_t WS_WUP = 10 * MiB;
constexpr size_t WS_WDN = 42 * MiB;
constexpr size_t WS_WL1 = 338 * MiB;
constexpr size_t WS_IG = 62 * MiB;
constexpr size_t WS_LF = WS_IG + 512 * 1024;
constexpr size_t WS_GA = WS_LF + 512 * 1024;
constexpr size_t WS_RR = WS_GA + 512 * 1024;
constexpr size_t WS_MM = WS_RR + 512 * 1024;
constexpr size_t WS_RC = WS_MM + 512 * 1024;
constexpr size_t WS_NS = 65 * MiB;
constexpr size_t WS_TOK = 66 * MiB;
constexpr size_t WS_LIST = 67 * MiB;
constexpr size_t WS_U = 72 * MiB;
constexpr size_t WS_Q = 136 * MiB;
constexpr size_t WS_K = 168 * MiB;
constexpr size_t WS_KT = 200 * MiB;
constexpr size_t WS_VT = 232 * MiB;
constexpr size_t WS_OGS = 296 * MiB;
constexpr size_t WS_ST = 360 * MiB;
constexpr size_t WS_A = 136 * MiB;
constexpr size_t WS_O = 204 * MiB;
constexpr size_t WS_BG = 136 * MiB;
constexpr size_t WS_Z = 200 * MiB;
constexpr size_t WS_Y = 264 * MiB;
constexpr size_t WS_XB = 400 * MiB;
constexpr size_t WS_U8 = 464 * MiB;
constexpr size_t WS_A8 = 136 * MiB;
constexpr size_t WS_END = 496 * MiB;
static_assert(WS_A + (size_t)SLOT_ROWS * DE * 2 <= WS_O && WS_O + (size_t)SLOT_ROWS * D * 2 <= WS_ST, "moe map");

constexpr int CW_CNT = 64;
constexpr int CW_CVT = 256;
constexpr int CW_BAR = 1024;

constexpr int RING_BYTES = 131072;
constexpr int MISC_OFF = RING_BYTES;
constexpr int EPI_OFF = MISC_OFF + 1024;
constexpr int LDS_BYTES = 149504;

typedef __bf16 bf16x2_t __attribute__((ext_vector_type(2)));
__device__ __forceinline__ unsigned f2bf(float f) { return (unsigned)__builtin_bit_cast(unsigned short, (__bf16)f); }
__device__ __forceinline__ unsigned pk2(float lo, float hi) { bf16x2_t v; v[0] = (__bf16)lo; v[1] = (__bf16)hi; return __builtin_bit_cast(unsigned, v); }
__device__ __forceinline__ float bf2f(unsigned short h) { return __builtin_bit_cast(float, (unsigned)h << 16); }
__device__ __forceinline__ float bflo(unsigned w) { return __builtin_bit_cast(float, w << 16); }
__device__ __forceinline__ float bfhi(unsigned w) { return __builtin_bit_cast(float, w & 0xffff0000u); }
__device__ __forceinline__ unsigned cvt_pk_bf16(float lo, float hi) { unsigned r; asm volatile("v_cvt_pk_bf16_f32 %0, %1, %2" : "=v"(r) : "v"(lo), "v"(hi)); return r; }
__device__ __forceinline__ unsigned pk4_fp8(float a, float b, float c, float d) { int w = 0; w = __builtin_amdgcn_cvt_pk_fp8_f32(a, b, w, false); w = __builtin_amdgcn_cvt_pk_fp8_f32(c, d, w, true); return (unsigned)w; }
__device__ __forceinline__ unsigned pk4_fp8_sat(float a, float b, float c, float d) {
    return pk4_fp8(__builtin_amdgcn_fmed3f(a, -448.f, 448.f), __builtin_amdgcn_fmed3f(b, -448.f, 448.f), __builtin_amdgcn_fmed3f(c, -448.f, 448.f), __builtin_amdgcn_fmed3f(d, -448.f, 448.f)); }
__device__ __forceinline__ float fast_exp(float x) { return __builtin_amdgcn_exp2f(x * 1.44269504089f); }
__device__ __forceinline__ float sigmoidf_(float x) { return __builtin_amdgcn_rcpf(1.0f + fast_exp(-x)); }

namespace pg8 {
constexpr int BM = 256, BK = 64, HALF = 128, HTB = HALF * BK * 2, STAGE_BYTES = 8 * HTB, NXCD = 8, WGM = 8;
__host__ __device__ __forceinline__ int lds_byte(int r, int c) { const int st = (r >> 4) * 2 + (c >> 5), rr = r & 15, cc = c & 31, ob = rr * 64 + cc * 2; return st * 1024 + (ob ^ (((ob >> 9) & 1) << 5)); }
__host__ __device__ __forceinline__ void stage_rc(int b, int& R, int& C) { const int st = b / 1024, sb = b % 1024, swz = sb ^ (((sb >> 9) & 1) << 5); R = (st >> 1) * 16 + swz / 64; C = (st & 1) * 32 + (swz % 64) / 2; }
__host__ __device__ __forceinline__ int perm32(int rho) { const int n = rho >> 4, i = rho & 15; return 8 * (i >> 2) + 4 * n + (i & 3); }

struct Unit { int arow0, brow0, pm, pn, e, nvalid; const int* alist; };
typedef int i32x8 __attribute__((ext_vector_type(8)));
typedef int i32x4 __attribute__((ext_vector_type(4)));
template <bool FP8> struct Frag;
template <> struct Frag<false> { bf16x8 h[2]; };
template <> struct Frag<true> { i32x8 v; };
struct Gemm { const bf16_t* A; const bf16_t* Bt; int K; int scale_w = 0x7f7f7f7f, scale_a = 0x7f7f7f7f; };

struct DenseOrder {
    int nM, nN, nwg, G, c, pn0 = 0;
    __device__ void init(int M, int N, int G_, int c_) { nM = M / BM; nN = N / BM; nwg = nM * nN; G = G_; c = c_; }
    __device__ bool next(int i, Unit& u) const {
        const long L = (long)i * G + c; if (L >= nwg) return false;
        int wgid = (int)L; { const int q = nwg / NXCD, r = nwg % NXCD, xcd = wgid % NXCD, off = wgid / NXCD; wgid = (xcd < r ? xcd * (q + 1) : r * (q + 1) + (xcd - r) * q) + off; }
        const int nig = WGM * nN, gid = wgid / nig, fm = gid * WGM, gsz = (nM - fm) < WGM ? (nM - fm) : WGM;
        u.pm = fm + ((wgid % nig) % gsz); u.pn = pn0 + (wgid % nig) / gsz; u.arow0 = u.pm * BM; u.brow0 = u.pn * BM; u.e = 0; u.nvalid = 256; u.alist = nullptr; return true;
    }
};
struct MoeOrder {
    const LAS int* tpre; const LAS int* cnt; const int* list; int G, vcu, bn;
    __device__ bool next(int i, Unit& u) const {
        const int U = i * G + vcu, rt = U >> 2, pn = U & 3;
        if (rt >= tpre[NE]) return false;
        int e = 0;
#pragma unroll
        for (int k = 1; k < NE; ++k) e += (rt >= tpre[k]) ? 1 : 0;
        const int r = rt - tpre[e];
        u.arow0 = rt * BM; u.brow0 = e * bn + pn * BM; u.pm = rt; u.pn = pn; u.e = e; u.nvalid = min(256, cnt[e] - r * 256); u.alist = list ? list + e * LCAP + r * 256 : nullptr; return true;
    }
};

template <class Epi, class Sched, bool GATHER, bool ALIGN_EPI, bool SP2, bool FP8 = false>
__device__ __forceinline__ void gemm_phase(LAS unsigned char* lds, const Gemm g, const Sched& S, const Epi& E, const int tid) {
    const int wid = __builtin_amdgcn_readfirstlane(tid >> 6), lane = tid & 63, wr = wid >> 2, wc = wid & 3, fr = lane & 15, fq = lane >> 4;
    const int K = g.K, nt = K / BK;
    unsigned voffA[2], voffB[2];
#pragma unroll
    for (int i = 0; i < 2; ++i) { int R, C; stage_rc(tid * 16 + i * 8192, R, C); const int Rb = Epi::PERM ? ((R & ~31) + perm32(R & 31)) : R;
        voffA[i] = (unsigned)(R * K + C) * 2u; voffB[i] = (unsigned)(Rb * K + C) * 2u; }
    const size_t kstep = (size_t)(BK * 2);
    const size_t hstep = (size_t)HALF * K * 2;
    const unsigned ldsw = (unsigned)wid * 1024u;
    const int aoff = lds_byte(wr * 64 + fr, fq * 8); int boff = 65536 + lds_byte(wc * 32 + fr, fq * 8); asm volatile("" : "+v"(boff));
#define PG8_SA(b, h) (((b) * 2 + (h)) * HTB)
#define PG8_SB(b, h) ((4 + (b) * 2 + (h)) * HTB)
#define PG8_SBR(b, h) (((b) * 2 + (h)) * HTB)
#define PG8_STAGE(bufoff, gbase, voff) do { _Pragma("unroll") for (int _i = 0; _i < 2; ++_i) \
        __builtin_amdgcn_global_load_lds((const unsigned*)((const char*)(gbase) + (voff)[_i]), (LAS unsigned*)(lds + (bufoff) + ldsw + _i * 8192), 16, 0, 0); } while (0)
#define PG8_STAGE_A(bufoff, kb, h, vo) do { if constexpr (GATHER) { PG8_STAGE(bufoff, kb, (vo)[h]); } else { PG8_STAGE(bufoff, (kb) + (h) * hstep, voffA); } } while (0)
#define PG8_LDF(dst, off) do { if constexpr (FP8) { const i32x4 lo_ = *(const LAS i32x4*)(lds + (off)), hi_ = *(const LAS i32x4*)(lds + (off) + 1024); (dst).v = __builtin_shufflevector(lo_, hi_, 0, 1, 2, 3, 4, 5, 6, 7); } \
        else { (dst).h[0] = *(const LAS bf16x8*)(lds + (off)); (dst).h[1] = *(const LAS bf16x8*)(lds + (off) + 1024); } } while (0)
#define PG8_LDA(dst, b, h) do { _Pragma("unroll") for (int m = 0; m < 4; ++m) PG8_LDF(dst[m], PG8_SA(b, h) + aoff + m * 2048); } while (0)
#define PG8_LDB(dst, b, h) do { _Pragma("unroll") for (int n = 0; n < 2; ++n) PG8_LDF(dst[n], PG8_SBR(b, h) + boff + n * 2048); } while (0)
#define PG8_MMA(ai, bj, At, Bt) do { __builtin_amdgcn_s_setprio(1); _Pragma("unroll") for (int m = 0; m < 4; ++m) _Pragma("unroll") for (int n = 0; n < 2; ++n) { \
        if constexpr (FP8) acc[ai][bj][m][n] = __builtin_amdgcn_mfma_scale_f32_16x16x128_f8f6f4(Bt[n].v, At[m].v, acc[ai][bj][m][n], 0, 0, 0, g.scale_w, 0, g.scale_a); \
        else { _Pragma("unroll") for (int k = 0; k < 2; ++k) acc[ai][bj][m][n] = __builtin_amdgcn_mfma_f32_16x16x32_bf16(Bt[n].h[k], At[m].h[k], acc[ai][bj][m][n], 0, 0, 0); } } \
        __builtin_amdgcn_s_setprio(0); } while (0)
#define PG8_WAIT_V(n) asm volatile("s_waitcnt vmcnt(" #n ")" ::: "memory")
#define PG8_WAIT_L(n) asm volatile("s_waitcnt lgkmcnt(" #n ")" ::: "memory")
#define PG8_BAR __builtin_amdgcn_s_barrier()
#define PG8_SCHED __builtin_amdgcn_sched_barrier(0)
    Unit cur, nxt; int ui = 0;
    if (!S.next(0, cur)) return;
    f32x4 acc[2][2][4][2];
#pragma unroll
    for (int a = 0; a < 2; ++a)
#pragma unroll
        for (int b = 0; b < 2; ++b)
#pragma unroll
            for (int m = 0; m < 4; ++m)
#pragma unroll
                for (int n = 0; n < 2; ++n) acc[a][b][m][n] = (f32x4){0.f, 0.f, 0.f, 0.f};
    Frag<FP8> At[4], B0[2], B1[2];
    unsigned vg[2][2];
#define PG8_GATHER(u) do { _Pragma("unroll") for (int _h = 0; _h < 2; ++_h) _Pragma("unroll") for (int _i = 0; _i < 2; ++_i) { int _R, _C; stage_rc(tid * 16 + _i * 8192, _R, _C); \
        const int _r = _h * HALF + _R; int _tok; if ((u).alist) _tok = (_r < (u).nvalid) ? (u).alist[_r] : 0; else _tok = (u).arow0 + _r; vg[_h][_i] = (unsigned)(_tok * K + _C) * 2u; } } while (0)
    const char* cA; const char* cB = (const char*)g.Bt + (size_t)cur.brow0 * K * 2;
    if constexpr (GATHER) { cA = (const char*)g.A; PG8_GATHER(cur); } else { cA = (const char*)g.A + (size_t)cur.arow0 * K * 2;
#pragma unroll
        for (int h = 0; h < 2; ++h)
#pragma unroll
            for (int i = 0; i < 2; ++i) vg[h][i] = 0u; }
    if constexpr (SP2) {
        PG8_STAGE(PG8_SB(0, 0), cB, voffB); PG8_STAGE(PG8_SB(0, 1), cB + hstep, voffB); PG8_STAGE_A(PG8_SA(0, 0), cA, 0, vg); PG8_STAGE_A(PG8_SA(0, 1), cA, 1, vg);
        if (wr == 1) PG8_BAR;
        PG8_WAIT_V(2); PG8_BAR;
        PG8_STAGE(PG8_SB(1, 0), cB + kstep, voffB); PG8_STAGE_A(PG8_SA(1, 0), cA + kstep, 0, vg); PG8_STAGE(PG8_SB(1, 1), cB + hstep + kstep, voffB);
        PG8_WAIT_V(6); PG8_BAR;
    } else {
        PG8_STAGE(PG8_SB(0, 0), cB, voffB); PG8_STAGE_A(PG8_SA(0, 0), cA, 0, vg); PG8_STAGE(PG8_SB(0, 1), cB + hstep, voffB); PG8_STAGE_A(PG8_SA(0, 1), cA, 1, vg);
        if (wr == 1) PG8_BAR;
        PG8_WAIT_V(4); PG8_BAR;
        PG8_STAGE(PG8_SB(1, 0), cB + kstep, voffB); PG8_STAGE_A(PG8_SA(1, 0), cA + kstep, 0, vg); PG8_STAGE(PG8_SB(1, 1), cB + hstep + kstep, voffB);
        PG8_WAIT_V(6); PG8_BAR;
    }
    for (;;) {
        const bool has_next = S.next(ui + 1, nxt);
        const char* nA; const char* nB = has_next ? (const char*)g.Bt + (size_t)nxt.brow0 * K * 2 : cB;
        if constexpr (GATHER) nA = cA; else nA = has_next ? (const char*)g.A + (size_t)nxt.arow0 * K * 2 : cA;
#pragma unroll 1
        for (int t = 0; t < nt; t += 2) {
            const bool last = (t == nt - 2);
            const char* a1 = cA + (size_t)(t + 1) * kstep;
            const char* a2 = last ? nA : cA + (size_t)(t + 2) * kstep; const char* b2 = last ? nB : cB + (size_t)(t + 2) * kstep;
            const char* a3 = a2 + kstep; const char* b3 = b2 + kstep;
            if constexpr (SP2) {
            PG8_LDB(B0, 0, 0); PG8_LDB(B1, 0, 1); PG8_SCHED; PG8_LDA(At, 0, 0); PG8_STAGE_A(PG8_SA(1, 1), a1, 1, vg);
            if constexpr (GATHER) { if (last && has_next) PG8_GATHER(nxt); }
            PG8_WAIT_V(8); PG8_WAIT_L(0); PG8_BAR; PG8_MMA(0, 0, At, B0); PG8_MMA(0, 1, At, B1); PG8_BAR; PG8_SCHED;
            PG8_LDA(At, 0, 1); PG8_STAGE(PG8_SB(0, 0), b2, voffB); PG8_STAGE(PG8_SB(0, 1), b2 + hstep, voffB); PG8_STAGE_A(PG8_SA(0, 0), a2, 0, vg);
            PG8_WAIT_V(8); PG8_WAIT_L(0); PG8_BAR; PG8_MMA(1, 0, At, B0); PG8_MMA(1, 1, At, B1); PG8_BAR; PG8_SCHED;
            PG8_LDB(B0, 1, 0); PG8_LDB(B1, 1, 1); PG8_SCHED; PG8_LDA(At, 1, 0); PG8_STAGE_A(PG8_SA(0, 1), a2, 1, vg);
            PG8_WAIT_V(8); PG8_WAIT_L(0); PG8_BAR; PG8_MMA(0, 0, At, B0); PG8_MMA(0, 1, At, B1); PG8_BAR; PG8_SCHED;
            PG8_LDA(At, 1, 1); PG8_STAGE(PG8_SB(1, 0), b3, voffB); PG8_STAGE(PG8_SB(1, 1), b3 + hstep, voffB); PG8_STAGE_A(PG8_SA(1, 0), a3, 0, vg);
            PG8_WAIT_V(8); PG8_WAIT_L(0); PG8_BAR; PG8_MMA(1, 0, At, B0); PG8_MMA(1, 1, At, B1); PG8_BAR; PG8_SCHED;
            } else {
            PG8_LDB(B0, 0, 0); PG8_SCHED; PG8_LDA(At, 0, 0); PG8_STAGE_A(PG8_SA(1, 1), a1, 1, vg);
            if constexpr (GATHER) { if (last && has_next) PG8_GATHER(nxt); }
            PG8_WAIT_L(8); PG8_BAR; PG8_WAIT_L(0); PG8_MMA(0, 0, At, B0); PG8_BAR; PG8_SCHED;
            PG8_LDB(B1, 0, 1); PG8_STAGE(PG8_SB(0, 0), b2, voffB);
            PG8_BAR; PG8_WAIT_L(0); PG8_MMA(0, 1, At, B1); PG8_BAR;
            PG8_LDA(At, 0, 1); PG8_STAGE_A(PG8_SA(0, 0), a2, 0, vg);
            PG8_BAR; PG8_WAIT_L(0); PG8_MMA(1, 0, At, B0); PG8_BAR; PG8_SCHED;
            PG8_STAGE(PG8_SB(0, 1), b2 + hstep, voffB);
            PG8_WAIT_V(6); PG8_BAR; PG8_MMA(1, 1, At, B1); PG8_BAR;
            PG8_LDB(B0, 1, 0); PG8_SCHED; PG8_LDA(At, 1, 0); PG8_STAGE_A(PG8_SA(0, 1), a2, 1, vg);
            PG8_WAIT_L(8); PG8_BAR; PG8_WAIT_L(0); PG8_MMA(0, 0, At, B0); PG8_BAR; PG8_SCHED;
            PG8_LDB(B1, 1, 1); PG8_STAGE(PG8_SB(1, 0), b3, voffB);
            PG8_BAR; PG8_WAIT_L(0); PG8_MMA(0, 1, At, B1); PG8_BAR;
            PG8_LDA(At, 1, 1); PG8_STAGE_A(PG8_SA(1, 0), a3, 0, vg);
            PG8_BAR; PG8_WAIT_L(0); PG8_MMA(1, 0, At, B0); PG8_BAR; PG8_SCHED;
            PG8_STAGE(PG8_SB(1, 1), b3 + hstep, voffB);
            PG8_WAIT_V(6); PG8_BAR; PG8_MMA(1, 1, At, B1); PG8_BAR;
            }
        }
        if constexpr (ALIGN_EPI) { if (wr == 0) PG8_BAR; }
        E(acc, cur, wr, wc, fr, fq);
        if (!has_next) break;
#pragma unroll
        for (int a = 0; a < 2; ++a)
#pragma unroll
            for (int b = 0; b < 2; ++b)
#pragma unroll
                for (int m = 0; m < 4; ++m)
#pragma unroll
                    for (int n = 0; n < 2; ++n) acc[a][b][m][n] = (f32x4){0.f, 0.f, 0.f, 0.f};
        cur = nxt; cA = nA; cB = nB; ++ui;
        if constexpr (ALIGN_EPI) { if (wr == 1) PG8_BAR; }
    }
    PG8_WAIT_V(0);
    if constexpr (!ALIGN_EPI) { if (wr == 0) PG8_BAR; }
    PG8_BAR;
#undef PG8_SA
#undef PG8_SB
#undef PG8_SBR
#undef PG8_STAGE
#undef PG8_STAGE_A
#undef PG8_GATHER
#undef PG8_LDF
#undef PG8_LDA
#undef PG8_LDB
#undef PG8_MMA
#undef PG8_WAIT_V
#undef PG8_WAIT_L
#undef PG8_BAR
#undef PG8_SCHED
}


struct EpiM1 {
    static constexpr bool PERM = true;
    bf16_t* Q; bf16_t* Kn; bf16_t* KT; bf16_t* VT; bf16_t* OGS; LAS unsigned char* tlds;
    __device__ __forceinline__ void operator()(const f32x4 (&acc)[2][2][4][2], const Unit& u, int wr, int wc, int fr, int fq) const {
        const int row0 = u.arow0 + wr * 64 + fr, pn = u.pn;
        if (pn < 4 || pn >= 8) {
            bf16_t* base; int ldc, colt; float sc = 1.f; const bool sig = pn >= 8;
            if (pn < 2) { base = Q; ldc = MQK; colt = pn * 256; sc = 0.08838834764831845f; }
            else if (pn < 4) { base = Kn; ldc = MQK; colt = (pn - 2) * 256; }
            else { base = OGS; ldc = MV; colt = (pn - 8) * 256; }
            const int col0 = colt + wc * 32 + 8 * fq;
#pragma unroll
            for (int ai = 0; ai < 2; ++ai)
#pragma unroll
                for (int m = 0; m < 4; ++m) { bf16_t* rowp = base + (size_t)(row0 + ai * HALF + m * 16) * ldc + col0;
#pragma unroll
                    for (int bj = 0; bj < 2; ++bj) { f32x4 v0 = acc[ai][bj][m][0] * sc, v1 = acc[ai][bj][m][1] * sc;
                        if (sig) {
#pragma unroll
                            for (int j = 0; j < 4; ++j) { v0[j] = sigmoidf_(v0[j]); v1[j] = sigmoidf_(v1[j]); } }
                        u32x4 w; w.x = cvt_pk_bf16(v0[0], v0[1]); w.y = cvt_pk_bf16(v0[2], v0[3]); w.z = cvt_pk_bf16(v1[0], v1[1]); w.w = cvt_pk_bf16(v1[2], v1[3]);
                        *(u32x4*)(rowp + bj * HALF) = w; } }
        }
        if (pn >= 2 && pn < 8) {
            const int b = u.arow0 / SEQ, s0 = (u.arow0 % SEQ) + wr * 64;
            bf16_t* base; int colt, feat;
            if (pn < 4) { base = KT; colt = (pn - 2) * 256; feat = DK; } else { base = VT; colt = (pn - 4) * 256; feat = DV; }
            LAS unsigned char* tb = tlds + (wr * 4 + wc) * 2048;
            const int lane = fq * 16 + fr;
#pragma unroll
            for (int ai = 0; ai < 2; ++ai) {
                const int ch = (s0 + ai * HALF) >> 6;
#pragma unroll
                for (int bj = 0; bj < 2; ++bj) {
                    const int col = colt + bj * HALF + wc * 32, hd = col / feat, f0 = col % feat;
                    bf16_t* xb = base + ((((size_t)(b * NH + hd) * NCH + ch) * feat + f0) << 6);
#pragma unroll
                    for (int n = 0; n < 2; ++n) {
#pragma unroll
                        for (int m = 0; m < 4; ++m)
#pragma unroll
                            for (int j = 0; j < 4; ++j) { const int t = m * 16 + fr;
                                *(LAS bf16_t*)(tb + (4 * fq + j) * 128 + ((((t >> 3) ^ (2 * fq)) & 7) << 4) + (t & 7) * 2) = (bf16_t)f2bf(acc[ai][bj][m][n][j]); }
#pragma unroll
                        for (int q = 0; q < 2; ++q) { const int id = lane + 64 * q, cr = id >> 3, p = id & 7, tc = (p ^ (2 * (cr >> 2))) & 7;
                            const u32x4 v = *(const LAS u32x4*)(tb + id * 16);
                            *(u32x4*)(xb + (size_t)(8 * (cr >> 2) + 4 * n + (cr & 3)) * 64 + tc * 8) = v; }
                    }
                }
            }
        }
    }
};
template <bool BASE_F32> struct EpiRes {
    static constexpr bool PERM = true;
    const void* base; bf16_t* out; const float* gate; float mul;
    __device__ __forceinline__ void operator()(const f32x4 (&acc)[2][2][4][2], const Unit& u, int wr, int wc, int fr, int fq) const {
        const int row0 = u.arow0 + wr * 64 + fr, col0 = u.pn * BM + wc * 32 + 8 * fq, b = u.arow0 / SEQ;
        f32x4 gv[2][2];
#pragma unroll
        for (int bj = 0; bj < 2; ++bj)
#pragma unroll
            for (int n = 0; n < 2; ++n) gv[bj][n] = *(const f32x4*)(gate + (size_t)b * 6 * D + col0 + bj * HALF + n * 4) * mul;
        u32x4 t[2][4][2];
#pragma unroll
        for (int ai = 0; ai < 2; ++ai)
#pragma unroll
            for (int m = 0; m < 4; ++m)
#pragma unroll
                for (int bj = 0; bj < 2; ++bj) { const f32x4 v0 = gv[bj][0] * acc[ai][bj][m][0], v1 = gv[bj][1] * acc[ai][bj][m][1];
                    t[ai][m][bj].x = cvt_pk_bf16(v0[0], v0[1]); t[ai][m][bj].y = cvt_pk_bf16(v0[2], v0[3]); t[ai][m][bj].z = cvt_pk_bf16(v1[0], v1[1]); t[ai][m][bj].w = cvt_pk_bf16(v1[2], v1[3]); }
        if (BASE_F32) {
#pragma unroll
            for (int ai = 0; ai < 2; ++ai) {
                f32x4 bf[4][2][2];
#pragma unroll
                for (int m = 0; m < 4; ++m)
#pragma unroll
                    for (int bj = 0; bj < 2; ++bj) { const float* p = (const float*)base + (size_t)(row0 + ai * HALF + m * 16) * D + col0 + bj * HALF; bf[m][bj][0] = *(const f32x4*)p; bf[m][bj][1] = *(const f32x4*)(p + 4); }
                asm volatile("" ::: "memory");
#pragma unroll
                for (int m = 0; m < 4; ++m)
#pragma unroll
                    for (int bj = 0; bj < 2; ++bj) { const f32x4 a0 = bf[m][bj][0], a1 = bf[m][bj][1]; const u32x4 c = t[ai][m][bj]; u32x4 w;
                        w.x = cvt_pk_bf16(a0[0] + bflo(c.x), a0[1] + bfhi(c.x)); w.y = cvt_pk_bf16(a0[2] + bflo(c.y), a0[3] + bfhi(c.y));
                        w.z = cvt_pk_bf16(a1[0] + bflo(c.z), a1[1] + bfhi(c.z)); w.w = cvt_pk_bf16(a1[2] + bflo(c.w), a1[3] + bfhi(c.w));
                        *(u32x4*)(out + (size_t)(row0 + ai * HALF + m * 16) * D + col0 + bj * HALF) = w; }
                asm volatile("" ::: "memory");
            }
        } else {
            u32x4 bw[2][4][2];
#pragma unroll
            for (int ai = 0; ai < 2; ++ai)
#pragma unroll
                for (int m = 0; m < 4; ++m)
#pragma unroll
                    for (int bj = 0; bj < 2; ++bj) bw[ai][m][bj] = *(const u32x4*)((const bf16_t*)base + (size_t)(row0 + ai * HALF + m * 16) * D + col0 + bj * HALF);
            asm volatile("" ::: "memory");
#pragma unroll
            for (int ai = 0; ai < 2; ++ai)
#pragma unroll
                for (int m = 0; m < 4; ++m)
#pragma unroll
                    for (int bj = 0; bj < 2; ++bj) { const u32x4 a = bw[ai][m][bj], c = t[ai][m][bj]; u32x4 w;
                        w.x = cvt_pk_bf16(bflo(a.x) + bflo(c.x), bfhi(a.x) + bfhi(c.x)); w.y = cvt_pk_bf16(bflo(a.y) + bflo(c.y), bfhi(a.y) + bfhi(c.y));
                        w.z = cvt_pk_bf16(bflo(a.z) + bflo(c.z), bfhi(a.z) + bfhi(c.z)); w.w = cvt_pk_bf16(bflo(a.w) + bflo(c.w), bfhi(a.w) + bfhi(c.w));
                        *(u32x4*)(out + (size_t)(row0 + ai * HALF + m * 16) * D + col0 + bj * HALF) = w; }
        }
    }
};
struct EpiBf {
    static constexpr bool PERM = true;
    bf16_t* O; int ldc;
    __device__ __forceinline__ void operator()(const f32x4 (&acc)[2][2][4][2], const Unit& u, int wr, int wc, int fr, int fq) const {
        const int row0 = u.arow0 + wr * 64 + fr, col0 = u.pn * BM + wc * 32 + 8 * fq;
#pragma unroll
        for (int ai = 0; ai < 2; ++ai)
#pragma unroll
            for (int m = 0; m < 4; ++m) { bf16_t* rowp = O + (size_t)(row0 + ai * HALF + m * 16) * ldc + col0;
#pragma unroll
                for (int bj = 0; bj < 2; ++bj) { const f32x4 v0 = acc[ai][bj][m][0], v1 = acc[ai][bj][m][1];
                    u32x4 w; w.x = cvt_pk_bf16(v0[0], v0[1]); w.y = cvt_pk_bf16(v0[2], v0[3]); w.z = cvt_pk_bf16(v1[0], v1[1]); w.w = cvt_pk_bf16(v1[2], v1[3]);
                    *(u32x4*)(rowp + bj * HALF) = w; } }
    }
};
template <bool SILU, bool F8OUT = false> struct EpiGlu {
    static constexpr bool PERM = true;
    bf16_t* O; int ldc; int plain_tiles; bf16_t* P; int ldp; float f8scale;
    __device__ __forceinline__ void operator()(const f32x4 (&acc)[2][2][4][2], const Unit& u, int wr, int wc, int fr, int fq) const {
        const int row0 = u.arow0 + wr * 64 + fr;
        if (u.pn < plain_tiles) {
            const int col0 = u.pn * BM + wc * 32 + 8 * fq;
#pragma unroll
            for (int ai = 0; ai < 2; ++ai)
#pragma unroll
                for (int m = 0; m < 4; ++m) { bf16_t* rowp = P + (size_t)(row0 + ai * HALF + m * 16) * ldp + col0;
#pragma unroll
                    for (int bj = 0; bj < 2; ++bj) { const f32x4 v0 = acc[ai][bj][m][0], v1 = acc[ai][bj][m][1];
                        u32x4 w; w.x = cvt_pk_bf16(v0[0], v0[1]); w.y = cvt_pk_bf16(v0[2], v0[3]); w.z = cvt_pk_bf16(v1[0], v1[1]); w.w = cvt_pk_bf16(v1[2], v1[3]);
                        *(u32x4*)(rowp + bj * HALF) = w; } }
            return;
        }
        const int col0 = (u.pn - plain_tiles) * HALF + wc * 32 + 8 * fq;
#pragma unroll
        for (int ai = 0; ai < 2; ++ai)
#pragma unroll
            for (int m = 0; m < 4; ++m) { bf16_t* rowp = O + (size_t)(row0 + ai * HALF + m * 16) * ldc + col0;
                f32x4 v0 = acc[ai][0][m][0], v1 = acc[ai][0][m][1]; const f32x4 u0 = acc[ai][1][m][0], u1 = acc[ai][1][m][1];
                if (SILU) {
#pragma unroll
                    for (int j = 0; j < 4; ++j) { v0[j] = v0[j] * sigmoidf_(v0[j]); v1[j] = v1[j] * sigmoidf_(v1[j]); } }
                v0 = v0 * u0; v1 = v1 * u1;
                if constexpr (F8OUT) { v0 = v0 * f8scale; v1 = v1 * f8scale; u32x2 w8; w8.x = pk4_fp8_sat(v0[0], v0[1], v0[2], v0[3]); w8.y = pk4_fp8_sat(v1[0], v1[1], v1[2], v1[3]);
                    *(u32x2*)((unsigned char*)O + (size_t)(row0 + ai * HALF + m * 16) * ldc + col0) = w8; }
                else { u32x4 w; w.x = cvt_pk_bf16(v0[0], v0[1]); w.y = cvt_pk_bf16(v0[2], v0[3]); w.z = cvt_pk_bf16(v1[0], v1[1]); w.w = cvt_pk_bf16(v1[2], v1[3]);
                    *(u32x4*)rowp = w; } }
    }
};
}

#define XB_TMO      128
#define XB_XCNT(j)  (256  + 64 * (j))
#define XB_XSUB(j)  (1280 + 64 * (j))
#define XB_XGEN(j)  (2304 + 64 * (j))
#define XB_TOP      3328
#define XB_TOPGEN   3392
#define XCD_BAR_WORDS 3456
#define XB_SPIN_CAP (1u << 18)
__device__ __forceinline__ unsigned xb_ld(unsigned* p)              { return __hip_atomic_load(p, __ATOMIC_RELAXED, __HIP_MEMORY_SCOPE_AGENT); }
__device__ __forceinline__ unsigned xb_add(unsigned* p, unsigned v) { return __hip_atomic_fetch_add(p, v, __ATOMIC_RELAXED, __HIP_MEMORY_SCOPE_AGENT); }
__device__ __forceinline__ unsigned xb_xcc_id() { return (unsigned)__builtin_amdgcn_s_getreg((3 << 11) | 20) & 0xFu; }
#define XB_SPIN(cond, bar) do { unsigned _sp = 0; while (cond) { __builtin_amdgcn_s_sleep(1); \
    if ((++_sp & 255u) == 0u) { if (xb_ld(&(bar)[XB_TMO])) break; if (_sp > XB_SPIN_CAP) { atomicAdd(&(bar)[XB_TMO], 1u); break; } } } } while (0)
struct XcdBarrier { unsigned* bar; unsigned x; volatile LAS unsigned* st; };
__device__ __forceinline__ XcdBarrier xcd_barrier_post(unsigned* bar, volatile LAS unsigned* st) {
    XcdBarrier b; b.bar = bar; b.x = xb_xcc_id(); b.st = st;
    if (threadIdx.x == 0) (void)xb_add(&bar[XB_XCNT(b.x)], 1u);
    return b;
}
__device__ __forceinline__ void xcd_barrier_complete(unsigned* bar, unsigned x, unsigned& nloc, unsigned& nx) {
    const unsigned G = gridDim.x * gridDim.y * gridDim.z;
    unsigned sum, cnt, mine, sp = 0u;
    for (;;) {
        sum = 0u; cnt = 0u; mine = 0u;
#pragma unroll
        for (unsigned j = 0; j < 16; ++j) { const unsigned c = xb_ld(&bar[XB_XCNT(j)]); sum += c; cnt += (c > 0u) ? 1u : 0u; mine = (j == x) ? c : mine; }
        if (sum == G) break;
        __builtin_amdgcn_s_sleep(1);
        if ((++sp & 255u) == 0u) { if (xb_ld(&bar[XB_TMO])) break; if (sp > XB_SPIN_CAP) { atomicAdd(&bar[XB_TMO], 1u); break; } }
    }
    nloc = mine > 0u ? mine : 1u; nx = cnt > 0u ? cnt : 1u;
}
__device__ __forceinline__ void xcd_barrier(const XcdBarrier& b) {
    asm volatile("s_waitcnt vmcnt(0)" ::: "memory");
    __syncthreads();
    if (threadIdx.x == 0) {
        unsigned* bar = b.bar;
        __builtin_amdgcn_s_waitcnt(0);
        unsigned nloc = b.st[0], nx = b.st[1];
        if (nloc == 0u) { xcd_barrier_complete(bar, b.x, nloc, nx); b.st[0] = nloc; b.st[1] = nx; }
        const unsigned old = xb_add(&bar[XB_XSUB(b.x)], 1u);
        const unsigned gen = old / nloc;
        if (old + 1u == (gen + 1u) * nloc) {
            __builtin_amdgcn_fence(__ATOMIC_RELEASE, "agent");
            asm volatile("s_waitcnt vmcnt(0)" ::: "memory");
            const unsigned og = xb_add(&bar[XB_TOP], 1u);
            const unsigned tg = og / nx;
            if (og + 1u == (tg + 1u) * nx) xb_add(&bar[XB_TOPGEN], 1u);
            else XB_SPIN(xb_ld(&bar[XB_TOPGEN]) == tg, bar);
            __builtin_amdgcn_fence(__ATOMIC_ACQUIRE, "agent");
            xb_add(&bar[XB_XGEN(b.x)], 1u);
            asm volatile("s_waitcnt vmcnt(0)" ::: "memory");
        } else {
            XB_SPIN(xb_ld(&bar[XB_XGEN(b.x)]) == gen, bar);
            __builtin_amdgcn_fence(__ATOMIC_ACQUIRE, "agent");
            asm volatile("s_waitcnt vmcnt(0)" ::: "memory");
        }
    }
    __syncthreads();
}

struct Args { const float* in[20]; float* out; unsigned char* ws; int ph_lo, ph_hi; };
__device__ __forceinline__ const void* karg_ptr(int idx) {
    unsigned long long v = (unsigned long long)((const void* const __attribute__((address_space(4)))*)__builtin_amdgcn_kernarg_segment_ptr())[idx];
    asm volatile("" : "+s"(v)); return (const void*)(const GAS char*)v;
}
struct InProxy { __device__ __forceinline__ const float* operator[](int i) const { return (const float*)karg_ptr(i); } };
struct WsProxy { __device__ __forceinline__ operator unsigned char*() const { return (unsigned char*)karg_ptr(21); }
                 __device__ __forceinline__ unsigned char* operator+(size_t o) const { return (unsigned char*)karg_ptr(21) + o; } };
struct OutProxy { __device__ __forceinline__ operator float*() const { return (float*)karg_ptr(20); }
                  __device__ __forceinline__ float* operator+(size_t o) const { return (float*)karg_ptr(20) + o; } };
struct CtlProxy { __device__ __forceinline__ operator gu32*() const { return (gu32*)karg_ptr(21); }
                  __device__ __forceinline__ gu32* operator+(int o) const { return (gu32*)karg_ptr(21) + o; } };
struct Frame {
    LAS unsigned char* lds; volatile LAS unsigned* MISC; CtlProxy ctl;
    int tid, lane, wave, vcu, G, bx;
    InProxy in; OutProxy out; WsProxy ws;
};
enum { I_X = 0, I_C, I_N1G, I_N2G, I_WADA, I_BADA, I_MWIN, I_MBG, I_MNG, I_MWOUT, I_CWIN, I_CCW, I_CCB, I_CWOUT, I_WR, I_BR, I_EWG, I_EWU, I_EWD, I_FG };

__device__ __forceinline__ float wave_sum(float v) {
#pragma unroll
    for (int o = 1; o < 64; o <<= 1) v += __shfl_xor(v, o);
    return v;
}

__device__ __forceinline__ int glu_row(int n, int which) { return (n >> 7) * 256 + which * 128 + (n & 127); }
struct CvtItem { const float* src; bf16_t* dst; int ldw, K; float f8scale; };
constexpr int CVT_IN = 16 * 96, CVT_OUT = 16 * 32, CVT_G = NE * 16 * 16, CVT_D = NE * 8 * 32, CVT_ITEMS = CVT_IN + CVT_OUT + 2 * CVT_G + CVT_D;
__device__ __forceinline__ CvtItem cvt_decode(Frame& F, int L, int it) {
    const size_t lo_ = (L == 0) ? 0 : WS_WL1;
    CvtItem d; d.f8scale = 0.f; int r = it;
    if (r < CVT_IN) { const int kb = r / 96, nb = r % 96, n0 = nb * 32; d.K = D;
        if (L == 0) { d.src = F.in[I_MWIN] + (size_t)kb * 64 * MPROJ + n0; d.ldw = MPROJ;
            if (FP8_G1 == 1 || (FP8_G1 == 2 && n0 >= 1024)) { d.dst = (bf16_t*)((unsigned char*)(F.ws + lo_ + WS_W0) + (FP8_G1 == 2 ? 2 * MiB : 0) + (size_t)n0 * D + kb * 64); d.f8scale = 32.f; } else d.dst = (bf16_t*)(F.ws + lo_ + WS_W0) + (size_t)n0 * D + kb * 64; }
        else { int dr; if (n0 < D) dr = n0; else if (n0 < 2 * D) dr = D + glu_row(n0 - D, 0); else dr = D + glu_row(n0 - 2 * D, 1);
            d.src = F.in[I_CWIN] + (size_t)kb * 64 * 3 * D + n0; d.ldw = 3 * D;
            if (FP8_CIN) { d.dst = (bf16_t*)((unsigned char*)(F.ws + lo_ + WS_W0) + (size_t)dr * D + kb * 64); d.f8scale = 32.f; } else d.dst = (bf16_t*)(F.ws + lo_ + WS_W0) + (size_t)dr * D + kb * 64; }
        return d; } r -= CVT_IN;
    if (r < CVT_OUT) { const int kb = r / 32, nb = r % 32; d.K = D; d.ldw = D; d.src = (L == 0 ? F.in[I_MWOUT] : F.in[I_CWOUT]) + (size_t)kb * 64 * D + nb * 32; d.dst = (bf16_t*)(F.ws + lo_ + WS_W1) + (size_t)nb * 32 * D + kb * 64; return d; } r -= CVT_OUT;
    if (r < 2 * CVT_G) { const int which = r / CVT_G; r %= CVT_G; const int e = r / 256, kb = (r % 256) / 16, nb = r % 16, n0 = nb * 32; d.K = D; d.ldw = DE;
        d.src = (which == 0 ? F.in[I_EWG] : F.in[I_EWU]) + ((size_t)L * NE + e) * D * DE + (size_t)kb * 64 * DE + n0;
        d.dst = (bf16_t*)((unsigned char*)(F.ws + lo_ + WS_WUP) + (size_t)e * 1024 * D + (size_t)glu_row(n0, which) * D + kb * 64); d.f8scale = 32.f; return d; } r -= 2 * CVT_G;
    { const int e = r / 256, kb = (r % 256) / 32, nb = r % 32; d.K = DE; d.ldw = D;
      d.src = F.in[I_EWD] + ((size_t)L * NE + e) * DE * D + (size_t)kb * 64 * D + nb * 32;
      d.dst = (bf16_t*)((unsigned char*)(F.ws + lo_ + WS_WDN) + (size_t)e * D * DE + (size_t)nb * 32 * DE + kb * 64); d.f8scale = 16.f; }
    return d;
}
__device__ __forceinline__ void convert_weights(Frame& F, int L) {
    LAS float* scr = (LAS float*)(F.lds + F.wave * 16384);
    const int gw = F.vcu * NWAVES + F.wave, NGW = F.G * NWAVES, lane = F.lane;
    float ld[32];
    CvtItem cur, nxt;
    int it = gw;
    if (it < CVT_ITEMS) { cur = cvt_decode(F, L, it);
#pragma unroll
        for (int i = 0; i < 32; ++i) ld[i] = cur.src[(size_t)(2 * i + (lane >> 5)) * cur.ldw + (lane & 31)]; }
    for (; it < CVT_ITEMS; it += NGW) {
#pragma unroll
        for (int i = 0; i < 32; ++i) scr[(2 * i + (lane >> 5)) * 33 + (lane & 31)] = ld[i];
        const bool more = it + NGW < CVT_ITEMS;
        if (more) { nxt = cvt_decode(F, L, it + NGW);
#pragma unroll
            for (int i = 0; i < 32; ++i) ld[i] = nxt.src[(size_t)(2 * i + (lane >> 5)) * nxt.ldw + (lane & 31)]; }
        LDS_WAIT(); asm volatile("" ::: "memory");
        const int c = lane & 7;
#pragma unroll
        for (int j = 0; j < 4; ++j) { const int n = (lane >> 3) + 8 * j; const LAS float* s = scr + (8 * c) * 33 + n;
            if (cur.f8scale != 0.f) { const float f = cur.f8scale; u32x2 o8; o8.x = pk4_fp8(s[0 * 33] * f, s[1 * 33] * f, s[2 * 33] * f, s[3 * 33] * f); o8.y = pk4_fp8(s[4 * 33] * f, s[5 * 33] * f, s[6 * 33] * f, s[7 * 33] * f);
                *(GAS u32x2*)((unsigned char*)cur.dst + (size_t)n * cur.K + 8 * c) = o8; }
            else { u32x4 o; o.x = pk2(s[0 * 33], s[1 * 33]); o.y = pk2(s[2 * 33], s[3 * 33]); o.z = pk2(s[4 * 33], s[5 * 33]); o.w = pk2(s[6 * 33], s[7 * 33]);
                *(GAS u32x4*)(cur.dst + (size_t)n * cur.K + 8 * c) = o; } }
        LDS_WAIT(); asm volatile("" ::: "memory");
        cur = nxt;
    }
}

__device__ __forceinline__ void phase_prologue(Frame& F) {
    float* MOD = (float*)(F.ws + WS_MOD);
    LAS float* cond = (LAS float*)(F.lds + 0);
    LAS float* red = (LAS float*)(F.lds + 16384);
    bool did = false;
    for (int task = F.bx; task < 192; task += F.G) {
        if (did) __syncthreads();
        did = true;
        for (int i = F.tid; i < NB * D; i += NTHR) { const int b = i / D, k = i % D; const float c = F.in[I_C][i]; cond[k * 4 + b] = c * sigmoidf_(c); }
        __syncthreads();
        const int layer = task / 96, col = (task % 96) * 64 + F.lane;
        const float* W = F.in[I_WADA] + (size_t)layer * D * 6 * D;
        float a0 = 0.f, a1 = 0.f, a2 = 0.f, a3 = 0.f;
#pragma unroll 8
        for (int kk = 0; kk < 128; ++kk) { const int k = F.wave * 128 + kk; const float w = W[(size_t)k * 6 * D + col]; const f32x4 c4 = *(const LAS f32x4*)(cond + k * 4);
            a0 += c4[0] * w; a1 += c4[1] * w; a2 += c4[2] * w; a3 += c4[3] * w; }
        red[(F.wave * 4 + 0) * 64 + F.lane] = a0; red[(F.wave * 4 + 1) * 64 + F.lane] = a1; red[(F.wave * 4 + 2) * 64 + F.lane] = a2; red[(F.wave * 4 + 3) * 64 + F.lane] = a3;
        __syncthreads();
        if (F.tid < 256) { const int b = F.tid >> 6, l = F.tid & 63; float s = 0.f;
#pragma unroll
            for (int w = 0; w < 8; ++w) s += red[(w * 4 + b) * 64 + l];
            const int c = (task % 96) * 64 + l;
            MOD[((size_t)layer * NB + b) * 6 * D + c] = s + F.in[I_BADA][(size_t)layer * 6 * D + c]; }
    }
    __syncthreads();
    convert_weights(F, 0);
}

template <int N>
__device__ __forceinline__ void xreduce(float (&v)[N], int lane) {
    constexpr int STEPS = (N == 32) ? 5 : 4;
#pragma unroll
    for (int i = 0; i < N / 2; ++i) { const auto r = __builtin_amdgcn_permlane32_swap(__builtin_bit_cast(unsigned, v[i]), __builtin_bit_cast(unsigned, v[i + N / 2]), false, false);
        const unsigned r0_ = r[0], r1_ = r[1]; v[i] = __uint_as_float(r0_) + __uint_as_float(r1_); }
#pragma unroll
    for (int i = 0; i < N / 4; ++i) { const auto r = __builtin_amdgcn_permlane16_swap(__builtin_bit_cast(unsigned, v[i]), __builtin_bit_cast(unsigned, v[i + N / 4]), false, false);
        const unsigned r0_ = r[0], r1_ = r[1]; v[i] = __uint_as_float(r0_) + __uint_as_float(r1_); }
#pragma unroll
    for (int step = 2; step < STEPS; ++step) {
        const int M = 32 >> step, n = N >> step;
        const bool up = (lane & M) != 0;
#pragma unroll
        for (int i = 0; i < n / 2; ++i) { float a = v[i], b = v[i + n / 2]; asm volatile("" : "+v"(a), "+v"(b));
            const float send = up ? a : b, keep = up ? b : a; v[i] = keep + __shfl_xor(send, M); }
    }
    if (N == 16) v[0] += __shfl_xor(v[0], 2);
    v[0] += __shfl_xor(v[0], 1);
}

constexpr int RP_WL = 0, RP_RINFO = 65536, RP_LCNT = RP_RINFO + 128 * 8 * 4, RP_TPRE = RP_LCNT + 256;
template <int MODE>
__device__ __forceinline__ void row_pass(Frame& F, int layer) {
    constexpr int DOTS = (MODE == 0) ? 8 : (MODE == 1 ? 16 : 0);
    constexpr int RPI = 2, NIT = 16 / RPI, NV = (DOTS > 0) ? RPI * DOTS : 16;
    constexpr bool COMBINE = (MODE == 2 || MODE == 3), MODUL = (MODE != 3);
    const float* MOD = (const float*)(F.ws + WS_MOD);
    LAS float* wl = (LAS float*)(F.lds + RP_WL);
    LAS int* rinfo = (LAS int*)(F.lds + RP_RINFO);
    LAS int* lcnt = (LAS int*)(F.lds + RP_LCNT);
    LAS int* tpre = (LAS int*)(F.lds + RP_TPRE);
    const float* xin = F.in[I_X];
    bf16_t* XB = (bf16_t*)(F.ws + WS_XB);
    float* xout = F.out;
    bf16_t* U = (bf16_t*)(F.ws + WS_U);
    const bf16_t* O = (const bf16_t*)(F.ws + WS_O);
    const unsigned char* TOKp = (const unsigned char*)(F.ws + WS_TOK);
    const int lane = F.lane;
    const int clayer = (MODE == 2) ? 0 : 1;
    if (DOTS > 0) { constexpr int NQ = D * (DOTS > 0 ? DOTS : 4) / 4 / NTHR;
        f32x4 tv[NQ];
#pragma unroll
        for (int q = 0; q < NQ; ++q) { const int piece = F.tid + q * NTHR, k = piece / (DOTS / 4), c4 = piece % (DOTS / 4);
            tv[q] = (DOTS == 8) ? *(const f32x4*)(F.in[I_MWIN] + (size_t)k * MPROJ + 3072 + 4 * c4) : *(const f32x4*)(F.in[I_WR] + (size_t)piece * 4); }
#pragma unroll
        for (int q = 0; q < NQ; ++q) { const int piece = F.tid + q * NTHR, k = piece / (DOTS / 4), c4 = piece % (DOTS / 4), jj = k >> 8, l = (k >> 2) & 63, ii = k & 3;
            const int rot = (DOTS == 16) ? ((l >> 2) & 3) : ((l >> 3) & 1), ch = (c4 + rot) & (DOTS / 4 - 1);
            *(LAS f32x4*)(wl + ((jj * 4 + ii) * 64 + l) * DOTS + ch * 4) = tv[q]; } }
    if (COMBINE && F.tid == 0) { int a = 0; for (int e = 0; e < NE; ++e) { tpre[e] = a; a += ((int)__hip_atomic_load(F.ctl + CW_CNT + 64 * clayer + e, RLX_AGENT) + 255) >> 8; } tpre[NE] = a; }
    float brt[16];
    if (MODE == 1) {
#pragma unroll
        for (int e = 0; e < 16; ++e) brt[e] = F.in[I_BR][e]; }
    for (int batch = F.vcu; batch < T / 128; batch += F.G) {
        __syncthreads();
        if (MODE == 1 && F.tid < 32) lcnt[F.tid] = 0;
        __syncthreads();
        const int row_base = batch * 128 + F.wave * 16, b = row_base / SEQ;
        const float* gam = (MODE == 3) ? F.in[I_FG] : ((MODE == 1) ? F.in[I_N2G] + (size_t)layer * D : F.in[I_N1G] + (size_t)layer * D);
        const float* mod = MOD + ((size_t)layer * NB + b) * 6 * D;
        const float* shp = mod + ((MODE == 1) ? 3 * D : 0); const float* scp = shp + D;
        const float* g2p = MOD + ((size_t)clayer * NB + b) * 6 * D + 5 * D;
        f32x4 gm[4], sh[4], sc[4], g2[4];
#pragma unroll
        for (int j = 0; j < 4; ++j) { gm[j] = *(const f32x4*)(gam + 256 * j + 4 * lane);
            if (MODUL) { sh[j] = *(const f32x4*)(shp + 256 * j + 4 * lane); sc[j] = *(const f32x4*)(scp + 256 * j + 4 * lane) + 1.0f; }
            if (COMBINE) g2[j] = *(const f32x4*)(g2p + 256 * j + 4 * lane); }
        f32x4 xn[RPI][4]; u32x2 on[RPI][2][4]; u32x4 tkn[RPI], tkn2[RPI];
#define RP_LOAD_X(IT) do { _Pragma("unroll") for (int r = 0; r < RPI; ++r) _Pragma("unroll") for (int j = 0; j < 4; ++j) { \
            if (MODE == 0) xn[r][j] = *(const f32x4*)(xin + (size_t)(row_base + (IT) * RPI + r) * D + 256 * j + 4 * lane); \
            else { const u32x2 xb_ = *(const u32x2*)(XB + (size_t)(row_base + (IT) * RPI + r) * D + 256 * j + 4 * lane); xn[r][j] = (f32x4){bflo(xb_.x), bfhi(xb_.x), bflo(xb_.y), bfhi(xb_.y)}; } } } while (0)
#define RP_LOAD_TOK(dst, IT) do { _Pragma("unroll") for (int r = 0; r < RPI; ++r) dst[r] = *(const u32x4*)(TOKp + (size_t)(row_base + (IT) * RPI + r) * 16); } while (0)
#define RP_LOAD_O(tk) do { _Pragma("unroll") for (int r = 0; r < RPI; ++r) { const unsigned tx_ = tk[r].x, ty_ = tk[r].y; \
            const int e0_ = __builtin_amdgcn_readfirstlane((int)(tx_ >> 16)), e1_ = __builtin_amdgcn_readfirstlane((int)(ty_ >> 16)); \
            const int s0_ = tpre[e0_] * 256 + (int)(tx_ & 0xffffu), s1_ = tpre[e1_] * 256 + (int)(ty_ & 0xffffu); \
            _Pragma("unroll") for (int j = 0; j < 4; ++j) { on[r][0][j] = *(const u32x2*)(O + (size_t)s0_ * D + 256 * j + 4 * lane); on[r][1][j] = *(const u32x2*)(O + (size_t)s1_ * D + 256 * j + 4 * lane); } } } while (0)
        RP_LOAD_X(0);
        if (COMBINE) { RP_LOAD_TOK(tkn, 0); RP_LOAD_O(tkn); RP_LOAD_TOK(tkn2, 1); }
#pragma unroll 1
        for (int it = 0; it < NIT; ++it) {
            const int r0 = row_base + it * RPI;
            f32x4 x[RPI][4]; u32x2 oc[RPI][2][4]; float w0c[RPI], w1c[RPI];
#pragma unroll
            for (int r = 0; r < RPI; ++r) {
#pragma unroll
                for (int j = 0; j < 4; ++j) { x[r][j] = xn[r][j]; if (COMBINE) { oc[r][0][j] = on[r][0][j]; oc[r][1][j] = on[r][1][j]; } }
                if (COMBINE) { const unsigned wz_ = tkn[r].z, ww_ = tkn[r].w; w0c[r] = __uint_as_float(wz_); w1c[r] = __uint_as_float(ww_); } }
            if (it + 1 < NIT) {
                RP_LOAD_X(it + 1);
                if (COMBINE) {
#pragma unroll
                    for (int r = 0; r < RPI; ++r) tkn[r] = tkn2[r];
                    RP_LOAD_O(tkn);
                    if (it + 2 < NIT) RP_LOAD_TOK(tkn2, it + 2); } }
            if (COMBINE) {
#pragma unroll
                for (int r = 0; r < RPI; ++r)
#pragma unroll
                    for (int j = 0; j < 4; ++j) { const u32x2 a = oc[r][0][j], c = oc[r][1][j]; const float w0 = w0c[r], w1 = w1c[r];
                        f32x4 mo; mo[0] = w0 * bflo(a.x) + w1 * bflo(c.x); mo[1] = w0 * bfhi(a.x) + w1 * bfhi(c.x); mo[2] = w0 * bflo(a.y) + w1 * bflo(c.y); mo[3] = w0 * bfhi(a.y) + w1 * bfhi(c.y);
                        x[r][j] = x[r][j] + g2[j] * mo;
                        if (MODE == 2) { u32x2 xw_; xw_.x = pk2(x[r][j][0], x[r][j][1]); xw_.y = pk2(x[r][j][2], x[r][j][3]); *(u32x2*)(XB + (size_t)(r0 + r) * D + 256 * j + 4 * lane) = xw_; } }
            }
            float rstd[RPI];
#pragma unroll
            for (int r = 0; r < RPI; ++r) { float s = 0.f;
#pragma unroll
                for (int j = 0; j < 4; ++j) s += (x[r][j][0] * x[r][j][0] + x[r][j][1] * x[r][j][1]) + (x[r][j][2] * x[r][j][2] + x[r][j][3] * x[r][j][3]);
                rstd[r] = 1.0f / sqrtf(wave_sum(s) * (1.0f / D) + EPS); }
#pragma unroll
            for (int r = 0; r < RPI; ++r)
#pragma unroll
                for (int j = 0; j < 4; ++j) { f32x4 y = x[r][j] * rstd[r] * gm[j]; if (MODUL) y = y * sc[j] + sh[j]; x[r][j] = y;
                    if (MODE == 3) *(f32x4*)(xout + (size_t)(r0 + r) * D + 256 * j + 4 * lane) = y;
                    else if (MODE == 1 || (MODE == 2 && FP8_CIN) || (MODE == 0 && FP8_G1)) { *(unsigned*)((unsigned char*)(F.ws + WS_U8) + (size_t)(r0 + r) * D + 256 * j + 4 * lane) = pk4_fp8(y[0], y[1], y[2], y[3]);
                        if (MODE == 0 && FP8_G1 == 2) { u32x2 w; w.x = pk2(y[0], y[1]); w.y = pk2(y[2], y[3]); *(u32x2*)(U + (size_t)(r0 + r) * D + 256 * j + 4 * lane) = w; } }
                    else { u32x2 w; w.x = pk2(y[0], y[1]); w.y = pk2(y[2], y[3]); *(u32x2*)(U + (size_t)(r0 + r) * D + 256 * j + 4 * lane) = w; } }
            if (DOTS > 0) {
                float v[NV];
#pragma unroll
                for (int i = 0; i < NV; ++i) v[i] = 0.f;
#pragma unroll
                for (int j = 0; j < 4; ++j)
#pragma unroll
                    for (int i = 0; i < 4; ++i) {
                        float w[DOTS > 0 ? DOTS : 1];
#pragma unroll
                        for (int q = 0; q < DOTS / 4; ++q) { const int rot = (DOTS == 16) ? ((lane >> 2) & 3) : ((lane >> 3) & 1);
                            const f32x4 t4 = *(const LAS f32x4*)(wl + ((j * 4 + i) * 64 + lane) * DOTS + ((q + rot) & (DOTS / 4 - 1)) * 4); w[4 * q] = t4[0]; w[4 * q + 1] = t4[1]; w[4 * q + 2] = t4[2]; w[4 * q + 3] = t4[3]; }
#pragma unroll
                        for (int r = 0; r < RPI; ++r)
#pragma unroll
                            for (int e = 0; e < DOTS; ++e) v[r * DOTS + e] += x[r][j][i] * w[e];
                        asm volatile("" ::: "memory"); }
                xreduce<NV>(v, lane);
                const float tot = v[0];
                if (MODE == 0) {
                    const int idx = lane >> 2, r = idx >> 3, gi = idx & 7, row = r0 + r, bb = row / SEQ, s = row % SEQ;
                    if ((lane & 3) == 0) {
                        const float pre = tot + F.in[I_MBG][gi];
                        if (gi < 4) ((float*)(F.ws + WS_IG))[(size_t)(bb * NH + gi) * SEQ + s] = pre;
                        else { const float ls = (pre >= 0.f) ? -log1pf(expf(-pre)) : (pre - log1pf(expf(pre))); ((float*)(F.ws + WS_LF))[(size_t)(bb * NH + gi - 4) * SEQ + s] = ls; }
                    }
                }
                if (MODE == 1) {
                    const int r = lane >> 5;
                    float lg[16], mx = -INFINITY;
#pragma unroll
                    for (int e = 0; e < 16; ++e) { lg[e] = __shfl(tot, 32 * r + 2 * e); mx = fmaxf(mx, lg[e]); }
                    float se = 0.f;
#pragma unroll
                    for (int e = 0; e < 16; ++e) { lg[e] = __builtin_amdgcn_exp2f((lg[e] - mx) * 1.44269504089f); se += lg[e]; }
                    const float inv = 1.0f / se;
                    float sel[16];
#pragma unroll
                    for (int e = 0; e < 16; ++e) { lg[e] *= inv; sel[e] = lg[e] + brt[e]; }
                    int best = 0; float bscore = -INFINITY;
#pragma unroll
                    for (int gq = 0; gq < 4; ++gq) { const float a = sel[4 * gq], bq = sel[4 * gq + 1], c = sel[4 * gq + 2], d = sel[4 * gq + 3];
                        const float m1 = fmaxf(fmaxf(a, bq), fmaxf(c, d));
                        const float lo1 = fminf(a, bq), hi1 = fmaxf(a, bq), lo2 = fminf(c, d), hi2 = fmaxf(c, d);
                        const float m2 = fmaxf(fminf(hi1, hi2), fmaxf(lo1, lo2));
                        const float gs = m1 + m2; if (gs > bscore) { bscore = gs; best = gq; } }
                    float s4[4], p4[4];
#pragma unroll
                    for (int q = 0; q < 4; ++q) { s4[q] = -INFINITY; p4[q] = 0.f; }
#pragma unroll
                    for (int gq = 0; gq < 4; ++gq) if (best == gq) {
#pragma unroll
                        for (int q = 0; q < 4; ++q) { s4[q] = sel[4 * gq + q]; p4[q] = lg[4 * gq + q]; } }
                    int i0 = 0; float v0 = s4[0], pp0 = p4[0];
#pragma unroll
                    for (int q = 1; q < 4; ++q) if (s4[q] > v0) { v0 = s4[q]; i0 = q; pp0 = p4[q]; }
                    int i1 = -1; float v1 = -INFINITY, pp1 = 0.f;
#pragma unroll
                    for (int q = 0; q < 4; ++q) if (q != i0 && s4[q] > v1) { v1 = s4[q]; i1 = q; pp1 = p4[q]; }
                    const float wsum = pp0 + pp1, w0 = pp0 / wsum, w1 = pp1 / wsum;
                    const int e0 = best * 4 + i0, e1 = best * 4 + i1;
                    if ((lane & 31) == 0) {
                        const int lp0 = __hip_atomic_fetch_add(lcnt + e0, 1, __ATOMIC_RELAXED, __HIP_MEMORY_SCOPE_WORKGROUP), lp1 = __hip_atomic_fetch_add(lcnt + e1, 1, __ATOMIC_RELAXED, __HIP_MEMORY_SCOPE_WORKGROUP);
                        LAS int* ri = rinfo + (F.wave * 16 + it * RPI + r) * 8;
                        ri[0] = e0; ri[1] = e1; ri[2] = lp0; ri[3] = lp1; ri[4] = __builtin_bit_cast(int, w0); ri[5] = __builtin_bit_cast(int, w1);
                    }
                }
            }
        }
#undef RP_LOAD_X
#undef RP_LOAD_TOK
#undef RP_LOAD_O
        if (MODE == 1) {
            __syncthreads();
            if (F.tid < 16) lcnt[16 + F.tid] = (int)__hip_atomic_fetch_add(F.ctl + CW_CNT + 64 * layer + F.tid, (unsigned)lcnt[F.tid], RLX_AGENT);
            __syncthreads();
            if (F.tid < 128) { const LAS int* ri = rinfo + F.tid * 8; const int row = batch * 128 + F.tid; const int e0 = ri[0], e1 = ri[1], p0 = lcnt[16 + e0] + ri[2], p1 = lcnt[16 + e1] + ri[3];
                int* LIST = (int*)(F.ws + WS_LIST); LIST[e0 * LCAP + p0] = row; LIST[e1 * LCAP + p1] = row;
                u32x4 ti; ti.x = (unsigned)(e0 << 16) | (unsigned)p0; ti.y = (unsigned)(e1 << 16) | (unsigned)p1; ti.z = (unsigned)ri[4]; ti.w = (unsigned)ri[5];
                *(u32x4*)(F.ws + WS_TOK + (size_t)row * 16) = ti; }
        }
    }
    __syncthreads();
}

#define LBAR() do { asm volatile("s_waitcnt lgkmcnt(0)" ::: "memory"); __builtin_amdgcn_s_barrier(); asm volatile("" ::: "memory"); } while (0)
__device__ __forceinline__ float incl_sum(float v, int lane) {
#pragma unroll
    for (int o = 1; o < 64; o <<= 1) { const float t = __shfl_up(v, o); if (lane >= o) v += t; }
    return v;
}
__device__ __forceinline__ float incl_max(float v, int lane) {
#pragma unroll
    for (int o = 1; o < 64; o <<= 1) { const float t = __shfl_up(v, o); if (lane >= o) v = fmaxf(v, t); }
    return v;
}
__device__ __forceinline__ void phase_scan(Frame& F, int mode = 0) {
    LAS float* wkA = (LAS float*)(F.lds + 0);
    LAS float* decA = (LAS float*)(F.lds + 32768);
    LAS float* tot = (LAS float*)(F.lds + 33280);
    LAS float* bst = (LAS float*)(F.lds + 33792);
    LAS float* cmx = (LAS float*)(F.lds + 34304);
    LAS float* rst = (LAS float*)(F.lds + 34816);
    LAS float* xw = (LAS float*)(F.lds + 35328);
    LAS unsigned char* ring = F.lds + 40960;
    constexpr int SLOT = 12288;
    const int lane = F.lane, w = F.wave, tid = F.tid;
    for (int unit = F.vcu; unit < 256; unit += F.G) {
        const int bh = unit >> 4, slice = unit & 15;
        const float* IG = (const float*)(F.ws + WS_IG) + (size_t)bh * SEQ; const float* LF = (const float*)(F.ws + WS_LF) + (size_t)bh * SEQ;
        __syncthreads();
        if (mode < 2) {
        float p[16], g[16], pm[16];
#pragma unroll
        for (int q = 0; q < 16; ++q) { const int c = 16 * w + q; p[q] = incl_sum(LF[c * 64 + lane], lane); if (lane == 63) tot[c] = p[q]; }
        __syncthreads();
        if (tid < 128) { const float v = tot[tid]; const float inc = incl_sum(v, lane); if (tid == 63) xw[0] = inc; bst[tid] = inc - v; }
        __syncthreads();
        if (tid >= 64 && tid < 128) bst[tid] += xw[0];
        __syncthreads();
#pragma unroll
        for (int q = 0; q < 16; ++q) { const int c = 16 * w + q; p[q] += bst[c]; g[q] = IG[c * 64 + lane] - p[q]; pm[q] = incl_max(g[q], lane); if (lane == 63) cmx[c] = pm[q]; }
        __syncthreads();
        if (tid < 128) { const float v = cmx[tid]; const float inc = incl_max(v, lane); if (tid == 63) xw[1] = inc; float ex = __shfl_up(inc, 1); if (lane == 0) ex = 0.f; rst[tid] = fmaxf(ex, 0.f); }
        __syncthreads();
        if (tid >= 64 && tid < 128) rst[tid] = fmaxf(rst[tid], xw[1]);
        __syncthreads();
#pragma unroll
        for (int q = 0; q < 16; ++q) { const int c = 16 * w + q; const float Rs = rst[c], Rn = fmaxf(Rs, cmx[c]), Rrun = fmaxf(Rs, pm[q]);
            wkA[c * 64 + lane] = expf(g[q] - Rn); if (lane == 0) decA[c] = expf(Rs - Rn);
            if (slice == 0) { const size_t o = (size_t)bh * SEQ + c * 64 + lane; ((float*)(F.ws + WS_GA))[o] = g[q]; ((float*)(F.ws + WS_RR))[o] = Rrun; ((float*)(F.ws + WS_MM))[o] = p[q] + Rrun;
                if (lane == 0) ((float*)(F.ws + WS_RC))[bh * NCH + c] = Rs; } }
        }
        __syncthreads();
        if (mode == 1) continue;
        const int dkh = slice & 1, dvs = slice >> 1;
        const bf16_t* KTg = (const bf16_t*)(F.ws + WS_KT) + ((size_t)bh * NCH * DK + 64 * dkh) * 64;
        const bf16_t* VTg = (const bf16_t*)(F.ws + WS_VT) + ((size_t)bh * NCH * DV + 32 * dvs) * 64;
        const int dkr = 64 * dkh + 16 * (w >> 1), dvc = 32 * dvs + 16 * (w & 1);
        bf16_t* STp = (bf16_t*)(F.ws + WS_ST) + ((size_t)bh * NCH * DV + dvc + (lane & 15)) * DK + dkr + 4 * (lane >> 4);
        float* NSp = (float*)(F.ws + WS_NS) + (size_t)bh * NCH * DK + dkr + 4 * (lane >> 4);
        const bool ns_writer = (dvs == 0) && ((w & 1) == 0) && ((lane & 15) == 0);
        f32x4 accS = (f32x4){0.f, 0.f, 0.f, 0.f}, accN = (f32x4){0.f, 0.f, 0.f, 0.f};
        constexpr int PD = 4;
        u32x4 gk[PD], gv[PD];
        const int wr0 = (tid >> 3) * 128 + (((tid & 7) ^ ((tid >> 3) & 7)) << 4);
        const int arow = 16 * (w >> 1) + (lane & 15), brow = 16 * (w & 1) + (lane & 15), lq = lane >> 4;
#define SC_LOAD(set, cc) do { gk[set] = *(const u32x4*)(KTg + (size_t)(cc) * DK * 64 + tid * 8); if (tid < 256) gv[set] = *(const u32x4*)(VTg + (size_t)(cc) * DV * 64 + tid * 8); } while (0)
#define SC_WRITE(set, slot) do { LAS unsigned char* sb_ = ring + (slot) * SLOT; *(LAS u32x4*)(sb_ + wr0) = gk[set]; if (tid < 256) *(LAS u32x4*)(sb_ + 8192 + wr0) = gv[set]; } while (0)
#pragma unroll
        for (int q = 0; q < PD; ++q) SC_LOAD(q, q);
        SC_WRITE(0, 0); SC_WRITE(1, 1);
        SC_LOAD(0, PD); SC_LOAD(1, PD + 1);
        LBAR();
        for (int c0 = 0; c0 < NCH; c0 += PD) {
#pragma unroll
            for (int q2 = 0; q2 < PD; q2 += 2) {
                { const int cw = c0 + q2 + 2;
                  if (cw < NCH) { SC_WRITE((q2 + 2) % PD, (q2 + 2) % PD); SC_WRITE((q2 + 3) % PD, (q2 + 3) % PD);
                      if (cw + PD < NCH) { SC_LOAD((q2 + 2) % PD, cw + PD); SC_LOAD((q2 + 3) % PD, cw + PD + 1); } } }
#pragma unroll
                for (int qq = 0; qq < 2; ++qq) {
                    const int q = q2 + qq, c = c0 + q;
                    if (mode < 3) { { u32x2 o; o.x = pk2(accS[0], accS[1]); o.y = pk2(accS[2], accS[3]); *(u32x2*)(STp + (size_t)c * DV * DK) = o; }
                    if (ns_writer) *(f32x4*)(NSp + (size_t)c * DK) = accN; }
                    const float dec = decA[c];
                    accS = accS * dec; accN = accN * dec;
                    const LAS unsigned char* sb = ring + q * SLOT;
#pragma unroll
                    for (int kk = 0; kk < 2; ++kk) {
                        const LAS f32x4* wp = (const LAS f32x4*)(wkA + c * 64 + kk * 32 + 8 * lq);
                        const f32x4 w0 = wp[0], w1 = wp[1];
                        const u32x4 ka = *(const LAS u32x4*)(sb + arow * 128 + (((4 * kk + lq) ^ (arow & 7)) << 4));
                        const u32x4 vv = *(const LAS u32x4*)(sb + 8192 + brow * 128 + (((4 * kk + lq) ^ (brow & 7)) << 4));
                        u32x4 bv, b1;
                        bv.x = pk2(bflo(vv.x) * w0[0], bfhi(vv.x) * w0[1]); bv.y = pk2(bflo(vv.y) * w0[2], bfhi(vv.y) * w0[3]);
                        bv.z = pk2(bflo(vv.z) * w1[0], bfhi(vv.z) * w1[1]); bv.w = pk2(bflo(vv.w) * w1[2], bfhi(vv.w) * w1[3]);
                        b1.x = pk2(w0[0], w0[1]); b1.y = pk2(w0[2], w0[3]); b1.z = pk2(w1[0], w1[1]); b1.w = pk2(w1[2], w1[3]);
                        const bf16x8 af = __builtin_bit_cast(bf16x8, ka);
                        accS = __builtin_amdgcn_mfma_f32_16x16x32_bf16(af, __builtin_bit_cast(bf16x8, bv), accS, 0, 0, 0);
                        accN = __builtin_amdgcn_mfma_f32_16x16x32_bf16(af, __builtin_bit_cast(bf16x8, b1), accN, 0, 0, 0);
                    }
                }
                LBAR();
            }
        }
        asm volatile("" :: "v"(accS), "v"(accN));
#undef SC_LOAD
#undef SC_WRITE
    }
    __syncthreads();
}

constexpr int OC_AP = 0, OC_STRIDE = 400, OC_BVEC = 25600, OC_INV = 26368, OC_PART = 26624, OC_GS = 28672, OC_RT = 28928, OC_EMM = 29184, OC_HT = 32768, OC_HSTR = 528;
__device__ __forceinline__ void phase_out(Frame& F) {
    LAS unsigned char* AP = F.lds + OC_AP; LAS unsigned char* HT = F.lds + OC_HT;
    LAS float* bvec = (LAS float*)(F.lds + OC_BVEC); LAS float* inv = (LAS float*)(F.lds + OC_INV); LAS float* part = (LAS float*)(F.lds + OC_PART);
    LAS float* gs = (LAS float*)(F.lds + OC_GS); LAS float* Rt = (LAS float*)(F.lds + OC_RT); LAS float* emm = (LAS float*)(F.lds + OC_EMM);
    const int lane = F.lane, w = F.wave, tid = F.tid, l15 = lane & 15, lq = lane >> 4;
    const bf16_t* Qg = (const bf16_t*)(F.ws + WS_Q); const bf16_t* Kg = (const bf16_t*)(F.ws + WS_K);
    const bf16_t* VTg = (const bf16_t*)(F.ws + WS_VT); const bf16_t* STg = (const bf16_t*)(F.ws + WS_ST); const bf16_t* OGS = (const bf16_t*)(F.ws + WS_OGS);
    const float* GAg = (const float*)(F.ws + WS_GA); const float* RRg = (const float*)(F.ws + WS_RR); const float* MMg = (const float*)(F.ws + WS_MM);
    const float* NSg = (const float*)(F.ws + WS_NS); const float* RCg = (const float*)(F.ws + WS_RC); const float* MNG = F.in[I_MNG];
    bf16_t* HN = (bf16_t*)(F.ws + WS_U);
    const int mt = w >> 1, ntb = (w & 1) * 2, tq = tid >> 3, pq = tid & 7, NU = 16 * NCH;
    u32x4 bfr[2][6], qk[4], og[4]; f32x4 ng0, ng1; float sc_g = 0.f, sc_r = 0.f, sc_m = 0.f, sc_b = 0.f, Rc = 0.f;
    LAS unsigned char* QL = F.lds + 69632; LAS unsigned char* KL = F.lds + 86016;
    const int prow = tid >> 4, pch = tid & 15;
    const int pwr = prow * 256 + ((pch ^ (prow & 15)) << 4);
#define OC_LOAD_MAIN(U_) do { const int bh_ = (U_) >> 7, c_ = (U_) & 127, tk_ = (bh_ >> 2) * SEQ + c_ * 64, h_ = bh_ & 3; \
        _Pragma("unroll") for (int n = 0; n < 2; ++n) { const int dv = 32 * w + 16 * n + l15; \
            _Pragma("unroll") for (int kk = 0; kk < 2; ++kk) bfr[n][kk] = *(const u32x4*)(VTg + ((((size_t)bh_ * NCH + c_) * DV + dv) << 6) + 32 * kk + 8 * lq); \
            _Pragma("unroll") for (int kk = 0; kk < 4; ++kk) bfr[n][2 + kk] = *(const u32x4*)(STg + (((size_t)bh_ * NCH + c_) * DV + dv) * DK + 32 * kk + 8 * lq); } \
        qk[0] = *(const u32x4*)(Qg + (size_t)(tk_ + prow) * MQK + h_ * DK + 8 * pch); qk[1] = *(const u32x4*)(Qg + (size_t)(tk_ + prow + 32) * MQK + h_ * DK + 8 * pch); \
        qk[2] = *(const u32x4*)(Kg + (size_t)(tk_ + prow) * MQK + h_ * DK + 8 * pch); qk[3] = *(const u32x4*)(Kg + (size_t)(tk_ + prow + 32) * MQK + h_ * DK + 8 * pch); \
        if (tid < 64) { const size_t o_ = (size_t)bh_ * SEQ + c_ * 64 + tid; sc_g = GAg[o_]; sc_r = RRg[o_]; sc_m = MMg[o_]; sc_b = 1.0f; } \
        else if (tid < 192) sc_b = NSg[((size_t)bh_ * NCH + c_) * DK + tid - 64]; \
        Rc = RCg[bh_ * NCH + c_]; } while (0)
#define OC_LOAD_OGS(U_) do { const int bh_ = (U_) >> 7, c_ = (U_) & 127, tk_ = (bh_ >> 2) * SEQ + c_ * 64, h_ = bh_ & 3; \
        _Pragma("unroll") for (int q = 0; q < 4; ++q) og[q] = *(const u32x4*)(OGS + (size_t)(tk_ + (tid >> 5) + 16 * q) * MV + h_ * DV + 8 * (tid & 31)); \
        ng0 = *(const f32x4*)(MNG + h_ * DV + 8 * (tid & 31)); ng1 = *(const f32x4*)(MNG + h_ * DV + 8 * (tid & 31) + 4); } while (0)
    int unit = F.vcu;
    if (unit < NU) { OC_LOAD_MAIN(unit); OC_LOAD_OGS(unit); }
    for (; unit < NU; unit += F.G) {
        const int bh = unit >> 7, c = unit & 127, b = bh >> 2, h = bh & 3;
        const int tk0 = b * SEQ + c * 64;
        if (tid < 64) { gs[tid] = sc_g; Rt[tid] = sc_r; emm[tid] = expf(-sc_m); }
        if (tid < 192) bvec[tid] = sc_b;
        *(LAS u32x4*)(QL + pwr) = qk[0]; *(LAS u32x4*)(QL + 8192 + pwr) = qk[1]; *(LAS u32x4*)(KL + pwr) = qk[2]; *(LAS u32x4*)(KL + 8192 + pwr) = qk[3];
        const float Rc_cur = Rc;
        LBAR();
        u32x4 qa[4], kb[2][4];
#pragma unroll
        for (int kk = 0; kk < 4; ++kk) { { const int row = 16 * mt + l15; qa[kk] = *(const LAS u32x4*)(QL + row * 256 + (((4 * kk + lq) ^ (row & 15)) << 4)); }
#pragma unroll
            for (int n = 0; n < 2; ++n) { const int row = 16 * (ntb + n) + l15; kb[n][kk] = *(const LAS u32x4*)(KL + row * 256 + (((4 * kk + lq) ^ (row & 15)) << 4)); } }
        const u32x4 q0 = *(const LAS u32x4*)(QL + tq * 256 + (((2 * pq) ^ (tq & 15)) << 4)), q1 = *(const LAS u32x4*)(QL + tq * 256 + (((2 * pq + 1) ^ (tq & 15)) << 4));
        f32x4 pacc[2];
#pragma unroll
        for (int n = 0; n < 2; ++n) { pacc[n] = (f32x4){0.f, 0.f, 0.f, 0.f};
#pragma unroll
            for (int kk = 0; kk < 4; ++kk) pacc[n] = __builtin_amdgcn_mfma_f32_16x16x32_bf16(__builtin_bit_cast(bf16x8, qa[kk]), __builtin_bit_cast(bf16x8, kb[n][kk]), pacc[n], 0, 0, 0); }
#pragma unroll
        for (int n = 0; n < 2; ++n) { const int sl = 16 * (ntb + n) + l15; const float gsv = gs[sl];
#pragma unroll
            for (int r = 0; r < 4; ++r) { const int tl = 16 * mt + 4 * lq + r; const float pv = (sl <= tl) ? pacc[n][r] * expf(gsv - Rt[tl]) : 0.f;
                *(LAS bf16_t*)(AP + tl * OC_STRIDE + sl * 2) = (bf16_t)f2bf(pv); } }
        { const float wq = expf(Rc_cur - Rt[tq]);
          u32x4 o0, o1;
          o0.x = pk2(bflo(q0.x) * wq, bfhi(q0.x) * wq); o0.y = pk2(bflo(q0.y) * wq, bfhi(q0.y) * wq); o0.z = pk2(bflo(q0.z) * wq, bfhi(q0.z) * wq); o0.w = pk2(bflo(q0.w) * wq, bfhi(q0.w) * wq);
          o1.x = pk2(bflo(q1.x) * wq, bfhi(q1.x) * wq); o1.y = pk2(bflo(q1.y) * wq, bfhi(q1.y) * wq); o1.z = pk2(bflo(q1.z) * wq, bfhi(q1.z) * wq); o1.w = pk2(bflo(q1.w) * wq, bfhi(q1.w) * wq);
          *(LAS u32x4*)(AP + tq * OC_STRIDE + 128 + 32 * pq) = o0; *(LAS u32x4*)(AP + tq * OC_STRIDE + 128 + 32 * pq + 16) = o1; }
        LBAR();
        { float s = 0.f;
#pragma unroll
          for (int q = 0; q < 3; ++q) { const u32x4 a = *(const LAS u32x4*)(AP + tq * OC_STRIDE + 48 * pq + 16 * q); const LAS f32x4* bp = (const LAS f32x4*)(bvec + 24 * pq + 8 * q); const f32x4 b0 = bp[0], b1 = bp[1];
              s += bflo(a.x) * b0[0] + bfhi(a.x) * b0[1] + bflo(a.y) * b0[2] + bfhi(a.y) * b0[3] + bflo(a.z) * b1[0] + bfhi(a.z) * b1[1] + bflo(a.w) * b1[2] + bfhi(a.w) * b1[3]; }
          s += __shfl_xor(s, 1); s += __shfl_xor(s, 2); s += __shfl_xor(s, 4);
          if (pq == 0) inv[tq] = 1.0f / fmaxf(fabsf(s), emm[tq]); }
        f32x4 acc[4][2];
#pragma unroll
        for (int m = 0; m < 4; ++m)
#pragma unroll
            for (int n = 0; n < 2; ++n) acc[m][n] = (f32x4){0.f, 0.f, 0.f, 0.f};
#pragma unroll
        for (int kk = 0; kk < 6; ++kk) {
            bf16x8 af[4];
#pragma unroll
            for (int m = 0; m < 4; ++m) af[m] = *(const LAS bf16x8*)(AP + (16 * m + l15) * OC_STRIDE + 64 * kk + 16 * lq);
#pragma unroll
            for (int m = 0; m < 4; ++m)
#pragma unroll
                for (int n = 0; n < 2; ++n) acc[m][n] = __builtin_amdgcn_mfma_f32_16x16x32_bf16(af[m], __builtin_bit_cast(bf16x8, bfr[n][kk]), acc[m][n], 0, 0, 0);
        }
        const int nxt = unit + F.G;
        if (nxt < NU) OC_LOAD_MAIN(nxt);
        LBAR();
#pragma unroll
        for (int m = 0; m < 4; ++m)
#pragma unroll
            for (int r = 0; r < 4; ++r) { const int tl = 16 * m + 4 * lq + r; const float iv = inv[tl];
                const float h0 = acc[m][0][r] * iv, h1 = acc[m][1][r] * iv;
                *(LAS bf16_t*)(HT + tl * OC_HSTR + (32 * w + l15) * 2) = (bf16_t)f2bf(h0); *(LAS bf16_t*)(HT + tl * OC_HSTR + (32 * w + 16 + l15) * 2) = (bf16_t)f2bf(h1);
                float s = h0 * h0 + h1 * h1; s += __shfl_xor(s, 1); s += __shfl_xor(s, 2); s += __shfl_xor(s, 4); s += __shfl_xor(s, 8);
                if (l15 == 0) part[w * 64 + tl] = s; }
        LBAR();
#pragma unroll
        for (int q = 0; q < 4; ++q) { const int row = (tid >> 5) + 16 * q, ch = tid & 31; float ss = 0.f;
#pragma unroll
            for (int ww = 0; ww < 8; ++ww) ss += part[ww * 64 + row];
            const float rs = 1.0f / sqrtf(ss * (1.0f / DV) + EPS);
            const u32x4 hv = *(const LAS u32x4*)(HT + row * OC_HSTR + ch * 16); const u32x4 g = og[q];
            u32x4 o;
            o.x = pk2(bflo(hv.x) * rs * ng0[0] * bflo(g.x), bfhi(hv.x) * rs * ng0[1] * bfhi(g.x)); o.y = pk2(bflo(hv.y) * rs * ng0[2] * bflo(g.y), bfhi(hv.y) * rs * ng0[3] * bfhi(g.y));
            o.z = pk2(bflo(hv.z) * rs * ng1[0] * bflo(g.z), bfhi(hv.z) * rs * ng1[1] * bfhi(g.z)); o.w = pk2(bflo(hv.w) * rs * ng1[2] * bflo(g.w), bfhi(hv.w) * rs * ng1[3] * bfhi(g.w));
            *(u32x4*)(HN + (size_t)(tk0 + row) * MV + h * DV + 8 * ch) = o; }
        if (nxt < NU) OC_LOAD_OGS(nxt);
    }
#undef OC_LOAD_MAIN
#undef OC_LOAD_OGS
    __syncthreads();
}

__device__ __forceinline__ void phase_conv(Frame& F) {
    const bf16_t* BG = (const bf16_t*)(F.ws + WS_BG); const bf16_t* Z = (const bf16_t*)(F.ws + WS_Z); bf16_t* Y = (bf16_t*)(F.ws + WS_Y);
    const int cg = F.tid & 127, rsub = F.tid >> 7, col = 8 * cg;
    float w0[8], w1[8], w2[8], cb[8];
#pragma unroll
    for (int i = 0; i < 8; ++i) { w0[i] = F.in[I_CCW][col + i]; w1[i] = F.in[I_CCW][D + col + i]; w2[i] = F.in[I_CCW][2 * D + col + i]; cb[i] = F.in[I_CCB][col + i]; }
    for (int batch = F.vcu; batch < T / 128; batch += F.G) {
        const int t0 = batch * 128 + rsub * 32, s0 = t0 % SEQ;
        u32x4 z2 = (u32x4){0u, 0u, 0u, 0u}, z1 = z2;
        if (s0 >= 2) z2 = *(const u32x4*)(Z + (size_t)(t0 - 2) * D + col);
        if (s0 >= 1) z1 = *(const u32x4*)(Z + (size_t)(t0 - 1) * D + col);
#pragma unroll 4
        for (int r = 0; r < 32; ++r) {
            const u32x4 z0 = *(const u32x4*)(Z + (size_t)(t0 + r) * D + col), bg = *(const u32x4*)(BG + (size_t)(t0 + r) * D + col);
            float o[8];
#pragma unroll
            for (int i = 0; i < 4; ++i) {
                o[2 * i] = bflo(bg[i]) * (w0[2 * i] * bflo(z2[i]) + w1[2 * i] * bflo(z1[i]) + w2[2 * i] * bflo(z0[i]) + cb[2 * i]);
                o[2 * i + 1] = bfhi(bg[i]) * (w0[2 * i + 1] * bfhi(z2[i]) + w1[2 * i + 1] * bfhi(z1[i]) + w2[2 * i + 1] * bfhi(z0[i]) + cb[2 * i + 1]); }
            u32x4 ov; ov.x = pk2(o[0], o[1]); ov.y = pk2(o[2], o[3]); ov.z = pk2(o[4], o[5]); ov.w = pk2(o[6], o[7]);
            *(u32x4*)(Y + (size_t)(t0 + r) * D + col) = ov;
            z2 = z1; z1 = z0;
        }
    }
}

__device__ __forceinline__ void moe_table(Frame& F, int layer) {
    __syncthreads();
    if (F.tid == 0) { int a = 0; for (int e = 0; e < NE; ++e) { const int c = (int)__hip_atomic_load(F.ctl + CW_CNT + 64 * layer + e, RLX_AGENT); F.MISC[16 + e] = (unsigned)a; F.MISC[40 + e] = (unsigned)c; a += (c + 255) >> 8; } F.MISC[16 + NE] = (unsigned)a; }
    __syncthreads();
}

#ifndef TIMER_PHASE
#define TIMER_PHASE (-1)
#endif
#define STAMP(k) do { if (TIMER_PHASE >= 0 && blockIdx.x == 0 && threadIdx.x == 0) { unsigned long long t_ = __builtin_amdgcn_s_memrealtime(); ((unsigned long long*)karg_ptr(21))[4096 + (k)] = t_; } } while (0)
constexpr int N_PHASES = 17;
#define WSP(T_, off) ((T_*)(F.ws + (off)))
__global__ void __launch_bounds__(NTHR, 2) fwd_kernel(Args args) {
    extern __shared__ __attribute__((aligned(16))) unsigned char lds_raw[];
#define MAKE_FRAME() Frame F; { int t_ = threadIdx.x, bx_ = blockIdx.x, g_ = gridDim.x; asm volatile("" : "+v"(t_), "+s"(bx_), "+s"(g_)); \
        F.lds = (LAS unsigned char*)lds_raw; F.MISC = (volatile LAS unsigned*)(F.lds + MISC_OFF); F.tid = t_; F.lane = t_ & 63; F.wave = __builtin_amdgcn_readfirstlane(t_ >> 6); \
        F.G = g_; F.bx = bx_; F.vcu = (g_ % 8 == 0) ? (bx_ % 8) * (g_ / 8) + bx_ / 8 : bx_; }
    const int lo = args.ph_lo, hi = args.ph_hi;
    const bool one_launch = (hi - lo) > 1;
    XcdBarrier bar;
    { MAKE_FRAME();
      for (int u = F.tid; u < 256; u += NTHR) F.MISC[u] = 0u;
      __syncthreads();
      bar.bar = (unsigned*)(F.ctl + CW_BAR); bar.x = 0; bar.st = nullptr;
      if (one_launch) bar = xcd_barrier_post((unsigned*)(F.ctl + CW_BAR), F.MISC + 8); }
    STAMP(0);
#ifdef PH_ONLY
#define IN(k) ((k) == PH_ONLY && lo <= (k) && (k) < hi)
#else
#define IN(k) (lo <= (k) && (k) < hi)
#endif
#define SEAM(k) do { if (IN(k) && IN((k) + 1)) { xcd_barrier(bar); STAMP((k) + 1); } } while (0)
#ifndef DUP_MODE
#define DUP_MODE 0
#endif
#ifndef DUP_PHASE
#define DUP_PHASE (-1)
#endif
#define PHASE(k) if (IN(k)) { for (int rep_ = 0; rep_ < (((k) == DUP_PHASE) ? 2 : 1); ++rep_) { MAKE_FRAME(); asm volatile("; PHASE_MARK " #k);
#define END_PHASE(k) } } SEAM(k);
    PHASE(0) phase_prologue(F); END_PHASE(0)
    PHASE(1) row_pass<0>(F, 0); END_PHASE(1)
    PHASE(2) pg8::DenseOrder S; S.init(T, 3 * D, F.G, F.bx);
        pg8::EpiM1 E{WSP(bf16_t, WS_Q), WSP(bf16_t, WS_K), WSP(bf16_t, WS_KT), WSP(bf16_t, WS_VT), WSP(bf16_t, WS_OGS), F.lds + EPI_OFF};
        if (FP8_G1 == 2) { S.init(T, 4 * 256, F.G, F.bx); { pg8::Gemm g{WSP(bf16_t, WS_U), WSP(bf16_t, WS_W0), D};
                pg8::gemm_phase<pg8::EpiM1, pg8::DenseOrder, false, true, true>(F.lds, g, S, E, F.tid); }
            S.init(T, 8 * 256, F.G, F.bx); S.pn0 = 4; { pg8::Gemm g{WSP(bf16_t, WS_U8), (const bf16_t*)(F.ws + WS_W0 + 2 * MiB), D / 2, 0x7a7a7a7a, 0x7f7f7f7f};
                pg8::gemm_phase<pg8::EpiM1, pg8::DenseOrder, true, true, true, true>(F.lds, g, S, E, F.tid); } }
        else if (FP8_G1) { pg8::Gemm g{WSP(bf16_t, WS_U8), WSP(bf16_t, WS_W0), D / 2, 0x7a7a7a7a, 0x7f7f7f7f};
            pg8::gemm_phase<pg8::EpiM1, pg8::DenseOrder, true, true, true, true>(F.lds, g, S, E, F.tid); }
        else { pg8::Gemm g{WSP(bf16_t, WS_U), WSP(bf16_t, WS_W0), D};
            pg8::gemm_phase<pg8::EpiM1, pg8::DenseOrder, false, true, true>(F.lds, g, S, E, F.tid); } END_PHASE(2)
    PHASE(3) phase_scan(F, rep_ == 0 ? 0 : DUP_MODE); END_PHASE(3)
    PHASE(4) phase_out(F); END_PHASE(4)
    PHASE(5) pg8::Gemm g{WSP(bf16_t, WS_U), WSP(bf16_t, WS_W1), D}; pg8::DenseOrder S; S.init(T, D, F.G, F.bx);
        pg8::EpiRes<true> E{F.in[I_X], WSP(bf16_t, WS_XB), WSP(float, WS_MOD) + 2 * D, (DBG_SKIP & 1) ? 0.f : 1.f};
        pg8::gemm_phase<pg8::EpiRes<true>, pg8::DenseOrder, false, true, true>(F.lds, g, S, E, F.tid); END_PHASE(5)
#define WL(L_, off) WSP(bf16_t, ((L_) == 0 ? (size_t)0 : WS_WL1) + (off))
#define MOE_BLOCK(L, p0, p1, p2) \
    PHASE(p0) row_pass<1>(F, L); END_PHASE(p0) \
    PHASE(p1) moe_table(F, L); \
        pg8::Gemm g{WSP(bf16_t, WS_U8), WL(L, WS_WUP), D / 2, 0x7a7a7a7a, 0x7f7f7f7f}; pg8::MoeOrder S{(const LAS int*)(F.MISC + 16), (const LAS int*)(F.MISC + 40), WSP(const int, WS_LIST), F.G, F.vcu, 1024}; \
        pg8::EpiGlu<true, true> E{WSP(bf16_t, WS_A8), DE, 0, nullptr, 0, 2.0f}; \
        pg8::gemm_phase<pg8::EpiGlu<true, true>, pg8::MoeOrder, true, true, true, true>(F.lds, g, S, E, F.tid); END_PHASE(p1) \
    PHASE(p2) moe_table(F, L); \
        pg8::Gemm g{WSP(bf16_t, WS_A8), WL(L, WS_WDN), DE / 2, 0x7b7b7b7b, 0x7e7e7e7e}; pg8::MoeOrder S{(const LAS int*)(F.MISC + 16), (const LAS int*)(F.MISC + 40), nullptr, F.G, F.vcu, 1024}; \
        pg8::EpiBf E{WSP(bf16_t, WS_O), D}; \
        pg8::gemm_phase<pg8::EpiBf, pg8::MoeOrder, true, true, true, true>(F.lds, g, S, E, F.tid); END_PHASE(p2)
    MOE_BLOCK(0, 6, 7, 8)
    PHASE(9) row_pass<2>(F, 1); convert_weights(F, 1); END_PHASE(9)
    PHASE(10) pg8::DenseOrder S; S.init(T, 3 * D, F.G, F.bx);
        pg8::EpiGlu<false> E{WSP(bf16_t, WS_Z), D, 4, WSP(bf16_t, WS_BG), D, 0.f};
        if (FP8_CIN) { pg8::Gemm g{WSP(bf16_t, WS_U8), WL(1, WS_W0), D / 2, 0x7a7a7a7a, 0x7f7f7f7f};
            pg8::gemm_phase<pg8::EpiGlu<false>, pg8::DenseOrder, true, true, true, true>(F.lds, g, S, E, F.tid); }
        else { pg8::Gemm g{WSP(bf16_t, WS_U), WL(1, WS_W0), D};
            pg8::gemm_phase<pg8::EpiGlu<false>, pg8::DenseOrder, false, true, true>(F.lds, g, S, E, F.tid); } END_PHASE(10)
    PHASE(11) phase_conv(F); END_PHASE(11)
    PHASE(12) pg8::Gemm g{WSP(bf16_t, WS_Y), WL(1, WS_W1), D}; pg8::DenseOrder S; S.init(T, D, F.G, F.bx);
        pg8::EpiRes<false> E{WSP(bf16_t, WS_XB), WSP(bf16_t, WS_XB), WSP(float, WS_MOD) + (size_t)NB * 6 * D + 2 * D, (DBG_SKIP & 4) ? 0.f : 1.f};
        pg8::gemm_phase<pg8::EpiRes<false>, pg8::DenseOrder, false, true, true>(F.lds, g, S, E, F.tid); END_PHASE(12)
    MOE_BLOCK(1, 13, 14, 15)
    if (IN(16)) { MAKE_FRAME(); asm volatile("; PHASE_MARK 16"); row_pass<3>(F, 1);
    }

    if (TIMER_PHASE >= 0 && one_launch) {
        STAMP(17);
        xcd_barrier(bar);
        const unsigned long long* ts = (const unsigned long long*)karg_ptr(21) + 4096;
        const unsigned long long d = __hip_atomic_load(ts + TIMER_PHASE + 1, RLX_AGENT) - __hip_atomic_load(ts + TIMER_PHASE, RLX_AGENT);
        const unsigned long long t0 = __builtin_amdgcn_s_memrealtime();
        while (__builtin_amdgcn_s_memrealtime() - t0 < 4ull * d) __builtin_amdgcn_s_sleep(8);
    }
#undef IN
#undef SEAM
}

extern "C" void kernel_launch(void* const* d_in, const int* in_sizes, int n_in, void* d_out, int out_size, void* d_ws, size_t ws_size, hipStream_t stream) {
    static int grid = 0;
    if (grid == 0) {
        if (n_in != 20 || in_sizes[0] != T * D || out_size != T * D || ws_size < WS_END) { fprintf(stderr, "kernel_launch: unexpected shapes: n_in %d in0 %d out %d ws %zu\n", n_in, n_in > 0 ? in_sizes[0] : -1, out_size, ws_size); grid = -1; return; }
        int dev = 0, cus = 0, per_cu = 0;
        if (hipGetDevice(&dev) != hipSuccess || hipDeviceGetAttribute(&cus, hipDeviceAttributeMultiprocessorCount, dev) != hipSuccess) { grid = -1; return; }
        if (hipFuncSetAttribute((const void*)fwd_kernel, hipFuncAttributeMaxDynamicSharedMemorySize, LDS_BYTES) != hipSuccess) { fprintf(stderr, "kernel_launch: hipFuncSetAttribute failed\n"); grid = -1; return; }
        if (hipOccupancyMaxActiveBlocksPerMultiprocessor(&per_cu, (const void*)fwd_kernel, NTHR, LDS_BYTES) != hipSuccess || per_cu < 1) { fprintf(stderr, "kernel_launch: occupancy query says %d blocks per CU\n", per_cu); (void)hipGetLastError(); grid = -1; return; }
        grid = cus;
        if (grid != 256) fprintf(stderr, "kernel_launch: %d CUs (built for 256)\n", grid);
    }
    if (grid < 0) return;
    (void)hipMemsetAsync((char*)d_ws + WS_CTL, 0, CTL_ZERO_BYTES, stream);
    Args a{};
    for (int i = 0; i < 20; ++i) a.in[i] = (const float*)d_in[i];
    a.out = (float*)d_out; a.ws = (unsigned char*)d_ws;
#if MK_N_LAUNCHES == 1
    a.ph_lo = 0; a.ph_hi = N_PHASES;
    void* kargs[] = {&a};
    hipError_t e = hipLaunchCooperativeKernel((const void*)fwd_kernel, dim3(grid), dim3(NTHR), kargs, LDS_BYTES, stream);
    if (e != hipSuccess) fprintf(stderr, "kernel_launch: cooperative launch failed: %s\n", hipGetErrorString(e));
#else
    for (int p = 0; p < N_PHASES; ++p) { a.ph_lo = p; a.ph_hi = p + 1; hipLaunchKernelGGL(fwd_kernel, dim3(grid), dim3(NTHR), LDS_BYTES, stream, a); }
#endif
}
```

```cpp
#include <hip/hip_runtime.h>
#include <cstdio>
#include <cstdint>

#ifndef FP8_G1
#define FP8_G1 2
#endif
#ifndef FP8_MOUT
#define FP8_MOUT 1
#endif
#ifndef FP8_COUT
#define FP8_COUT 1
#endif
#ifndef FP8_CIN
#define FP8_CIN 1
#endif
#ifndef DBG_SKIP
#define DBG_SKIP 0
#endif
#ifndef MK_N_LAUNCHES
#define MK_N_LAUNCHES 1
#endif

#define LAS __attribute__((address_space(3)))
#define GAS __attribute__((address_space(1)))
typedef unsigned short bf16_t;
typedef short bf16x8 __attribute__((ext_vector_type(8)));
typedef float f32x4 __attribute__((ext_vector_type(4)));
typedef float f32x2 __attribute__((ext_vector_type(2)));
typedef unsigned u32x4 __attribute__((ext_vector_type(4)));
typedef unsigned u32x2 __attribute__((ext_vector_type(2)));
typedef GAS unsigned gu32;
#define RLX_AGENT __ATOMIC_RELAXED, __HIP_MEMORY_SCOPE_AGENT
#define LDS_WAIT() asm volatile("s_waitcnt lgkmcnt(0)" ::: "memory")
#define VM_WAIT() asm volatile("s_waitcnt vmcnt(0)" ::: "memory")

constexpr int NB = 4, SEQ = 8192, D = 1024, T = NB * SEQ;
constexpr int NH = 4, DK = 128, DV = 256, MQK = NH * DK, MV = NH * DV, MPROJ = 2 * MQK + 2 * MV + 2 * NH;
constexpr int CH = 64, NCH = SEQ / CH;
constexpr int NE = 16, DE = 512, LCAP = 65536;
constexpr int SLOT_ROWS = 2 * T + NE * 256;
constexpr float EPS = 1e-6f;
constexpr int NWAVES = 8, NTHR = 512;

constexpr size_t MiB = 1u << 20;
constexpr size_t WS_CTL = 0, CTL_ZERO_BYTES = 64 * 1024;
constexpr size_t WS_MOD = 1 * MiB;
constexpr size_t WS_W0 = 2 * MiB;
constexpr size_t WS_W1 = 8 * MiB;
constexpr size_t WS_WUP = 10 * MiB;
constexpr size_t WS_WDN = 42 * MiB;
constexpr size_t WS_WL1 = 338 * MiB;
constexpr size_t WS_IG = 62 * MiB;
constexpr size_t WS_LF = WS_IG + 512 * 1024;
constexpr size_t WS_GA = WS_LF + 512 * 1024;
constexpr size_t WS_RR = WS_GA + 512 * 1024;
constexpr size_t WS_MM = WS_RR + 512 * 1024;
constexpr size_t WS_RC = WS_MM + 512 * 1024;
constexpr size_t WS_NS = 65 * MiB;
constexpr size_t WS_TOK = 66 * MiB;
constexpr size_t WS_LIST = 67 * MiB;
constexpr size_t WS_U = 72 * MiB;
constexpr size_t WS_Q = 136 * MiB;
constexpr size_t WS_K = 168 * MiB;
constexpr size_t WS_KT = 200 * MiB;
constexpr size_t WS_VT = 232 * MiB;
constexpr size_t WS_OGS = 296 * MiB;
constexpr size_t WS_ST = 360 * MiB;
constexpr size_t WS_A = 136 * MiB;
constexpr size_t WS_O = 204 * MiB;
constexpr size_t WS_BG = 136 * MiB;
constexpr size_t WS_Z = 200 * MiB;
constexpr size_t WS_Y = 264 * MiB;
constexpr size_t WS_XB = 400 * MiB;
constexpr size_t WS_U8 = 464 * MiB;
constexpr size_t WS_A8 = 136 * MiB;
constexpr size_t WS_END = 496 * MiB;
static_assert(WS_A + (size_t)SLOT_ROWS * DE * 2 <= WS_O && WS_O + (size_t)SLOT_ROWS * D * 2 <= WS_ST, "moe map");

constexpr int CW_CNT = 64;
constexpr int CW_CVT = 256;
constexpr int CW_BAR = 1024;

constexpr int RING_BYTES = 131072;
constexpr int MISC_OFF = RING_BYTES;
constexpr int EPI_OFF = MISC_OFF + 1024;
constexpr int LDS_BYTES = 149504;

typedef __bf16 bf16x2_t __attribute__((ext_vector_type(2)));
__device__ __forceinline__ unsigned f2bf(float f) { return (unsigned)__builtin_bit_cast(unsigned short, (__bf16)f); }
__device__ __forceinline__ unsigned pk2(float lo, float hi) { bf16x2_t v; v[0] = (__bf16)lo; v[1] = (__bf16)hi; return __builtin_bit_cast(unsigned, v); }
__device__ __forceinline__ float bf2f(unsigned short h) { return __builtin_bit_cast(float, (unsigned)h << 16); }
__device__ __forceinline__ float bflo(unsigned w) { return __builtin_bit_cast(float, w << 16); }
__device__ __forceinline__ float bfhi(unsigned w) { return __builtin_bit_cast(float, w & 0xffff0000u); }
__device__ __forceinline__ unsigned cvt_pk_bf16(float lo, float hi) { unsigned r; asm volatile("v_cvt_pk_bf16_f32 %0, %1, %2" : "=v"(r) : "v"(lo), "v"(hi)); return r; }
__device__ __forceinline__ unsigned pk4_fp8(float a, float b, float c, float d) { int w = 0; w = __builtin_amdgcn_cvt_pk_fp8_f32(a, b, w, false); w = __builtin_amdgcn_cvt_pk_fp8_f32(c, d, w, true); return (unsigned)w; }
__device__ __forceinline__ unsigned pk4_fp8_sat(float a, float b, float c, float d) {
    return pk4_fp8(__builtin_amdgcn_fmed3f(a, -448.f, 448.f), __builtin_amdgcn_fmed3f(b, -448.f, 448.f), __builtin_amdgcn_fmed3f(c, -448.f, 448.f), __builtin_amdgcn_fmed3f(d, -448.f, 448.f)); }
__device__ __forceinline__ float fast_exp(float x) { return __builtin_amdgcn_exp2f(x * 1.44269504089f); }
__device__ __forceinline__ float sigmoidf_(float x) { return __builtin_amdgcn_rcpf(1.0f + fast_exp(-x)); }

namespace pg8 {
constexpr int BM = 256, BK = 64, HALF = 128, HTB = HALF * BK * 2, STAGE_BYTES = 8 * HTB, NXCD = 8, WGM = 8;
__host__ __device__ __forceinline__ int lds_byte(int r, int c) { const int st = (r >> 4) * 2 + (c >> 5), rr = r & 15, cc = c & 31, ob = rr * 64 + cc * 2; return st * 1024 + (ob ^ (((ob >> 9) & 1) << 5)); }
__host__ __device__ __forceinline__ void stage_rc(int b, int& R, int& C) { const int st = b / 1024, sb = b % 1024, swz = sb ^ (((sb >> 9) & 1) << 5); R = (st >> 1) * 16 + swz / 64; C = (st & 1) * 32 + (swz % 64) / 2; }
__host__ __device__ __forceinline__ int perm32(int rho) { const int n = rho >> 4, i = rho & 15; return 8 * (i >> 2) + 4 * n + (i & 3); }

struct Unit { int arow0, brow0, pm, pn, e, nvalid; const int* alist; };
typedef int i32x8 __attribute__((ext_vector_type(8)));
typedef int i32x4 __attribute__((ext_vector_type(4)));
template <bool FP8> struct Frag;
template <> struct Frag<false> { bf16x8 h[2]; };
template <> struct Frag<true> { i32x8 v; };
struct Gemm { const bf16_t* A; const bf16_t* Bt; int K; int scale_w = 0x7f7f7f7f, scale_a = 0x7f7f7f7f; };

struct DenseOrder {
    int nM, nN, nwg, G, c, pn0 = 0;
    __device__ void init(int M, int N, int G_, int c_) { nM = M / BM; nN = N / BM; nwg = nM * nN; G = G_; c = c_; }
    __device__ bool next(int i, Unit& u) const {
        const long L = (long)i * G + c; if (L >= nwg) return false;
        int wgid = (int)L; { const int q = nwg / NXCD, r = nwg % NXCD, xcd = wgid % NXCD, off = wgid / NXCD; wgid = (xcd < r ? xcd * (q + 1) : r * (q + 1) + (xcd - r) * q) + off; }
        const int nig = WGM * nN, gid = wgid / nig, fm = gid * WGM, gsz = (nM - fm) < WGM ? (nM - fm) : WGM;
        u.pm = fm + ((wgid % nig) % gsz); u.pn = pn0 + (wgid % nig) / gsz; u.arow0 = u.pm * BM; u.brow0 = u.pn * BM; u.e = 0; u.nvalid = 256; u.alist = nullptr; return true;
    }
};
struct MoeOrder {
    const LAS int* tpre; const LAS int* cnt; const int* list; int G, vcu, bn;
    __device__ bool next(int i, Unit& u) const {
        const int U = i * G + vcu, rt = U >> 2, pn = U & 3;
        if (rt >= tpre[NE]) return false;
        int e = 0;
#pragma unroll
        for (int k = 1; k < NE; ++k) e += (rt >= tpre[k]) ? 1 : 0;
        const int r = rt - tpre[e];
        u.arow0 = rt * BM; u.brow0 = e * bn + pn * BM; u.pm = rt; u.pn = pn; u.e = e; u.nvalid = min(256, cnt[e] - r * 256); u.alist = list ? list + e * LCAP + r * 256 : nullptr; return true;
    }
};

template <class Epi, class Sched, bool GATHER, bool ALIGN_EPI, bool SP2, bool FP8 = false>
__device__ __forceinline__ void gemm_phase(LAS unsigned char* lds, const Gemm g, const Sched& S, const Epi& E, const int tid) {
    const int wid = __builtin_amdgcn_readfirstlane(tid >> 6), lane = tid & 63, wr = wid >> 2, wc = wid & 3, fr = lane & 15, fq = lane >> 4;
    const int K = g.K, nt = K / BK;
    unsigned voffA[2], voffB[2];
#pragma unroll
    for (int i = 0; i < 2; ++i) { int R, C; stage_rc(tid * 16 + i * 8192, R, C); const int Rb = Epi::PERM ? ((R & ~31) + perm32(R & 31)) : R;
        voffA[i] = (unsigned)(R * K + C) * 2u; voffB[i] = (unsigned)(Rb * K + C) * 2u; }
    const size_t kstep = (size_t)(BK * 2);
    const size_t hstep = (size_t)HALF * K * 2;
    const unsigned ldsw = (unsigned)wid * 1024u;
    const int aoff = lds_byte(wr * 64 + fr, fq * 8); int boff = 65536 + lds_byte(wc * 32 + fr, fq * 8); asm volatile("" : "+v"(boff));
#define PG8_SA(b, h) (((b) * 2 + (h)) * HTB)
#define PG8_SB(b, h) ((4 + (b) * 2 + (h)) * HTB)
#define PG8_SBR(b, h) (((b) * 2 + (h)) * HTB)
#define PG8_STAGE(bufoff, gbase, voff) do { _Pragma("unroll") for (int _i = 0; _i < 2; ++_i) \
        __builtin_amdgcn_global_load_lds((const unsigned*)((const char*)(gbase) + (voff)[_i]), (LAS unsigned*)(lds + (bufoff) + ldsw + _i * 8192), 16, 0, 0); } while (0)
#define PG8_STAGE_A(bufoff, kb, h, vo) do { if constexpr (GATHER) { PG8_STAGE(bufoff, kb, (vo)[h]); } else { PG8_STAGE(bufoff, (kb) + (h) * hstep, voffA); } } while (0)
#define PG8_LDF(dst, off) do { if constexpr (FP8) { const i32x4 lo_ = *(const LAS i32x4*)(lds + (off)), hi_ = *(const LAS i32x4*)(lds + (off) + 1024); (dst).v = __builtin_shufflevector(lo_, hi_, 0, 1, 2, 3, 4, 5, 6, 7); } \
        else { (dst).h[0] = *(const LAS bf16x8*)(lds + (off)); (dst).h[1] = *(const LAS bf16x8*)(lds + (off) + 1024); } } while (0)
#define PG8_LDA(dst, b, h) do { _Pragma("unroll") for (int m = 0; m < 4; ++m) PG8_LDF(dst[m], PG8_SA(b, h) + aoff + m * 2048); } while (0)
#define PG8_LDB(dst, b, h) do { _Pragma("unroll") for (int n = 0; n < 2; ++n) PG8_LDF(dst[n], PG8_SBR(b, h) + boff + n * 2048); } while (0)
#define PG8_MMA(ai, bj, At, Bt) do { __builtin_amdgcn_s_setprio(1); _Pragma("unroll") for (int m = 0; m < 4; ++m) _Pragma("unroll") for (int n = 0; n < 2; ++n) { \
        if constexpr (FP8) acc[ai][bj][m][n] = __builtin_amdgcn_mfma_scale_f32_16x16x128_f8f6f4(Bt[n].v, At[m].v, acc[ai][bj][m][n], 0, 0, 0, g.scale_w, 0, g.scale_a); \
        else { _Pragma("unroll") for (int k = 0; k < 2; ++k) acc[ai][bj][m][n] = __builtin_amdgcn_mfma_f32_16x16x32_bf16(Bt[n].h[k], At[m].h[k], acc[ai][bj][m][n], 0, 0, 0); } } \
        __builtin_amdgcn_s_setprio(0); } while (0)
#define PG8_WAIT_V(n) asm volatile("s_waitcnt vmcnt(" #n ")" ::: "memory")
#define PG8_WAIT_L(n) asm volatile("s_waitcnt lgkmcnt(" #n ")" ::: "memory")
#define PG8_BAR __builtin_amdgcn_s_barrier()
#define PG8_SCHED __builtin_amdgcn_sched_barrier(0)
    Unit cur, nxt; int ui = 0;
    if (!S.next(0, cur)) return;
    f32x4 acc[2][2][4][2];
#pragma unroll
    for (int a = 0; a < 2; ++a)
#pragma unroll
        for (int b = 0; b < 2; ++b)
#pragma unroll
            for (int m = 0; m < 4; ++m)
#pragma unroll
                for (int n = 0; n < 2; ++n) acc[a][b][m][n] = (f32x4){0.f, 0.f, 0.f, 0.f};
    Frag<FP8> At[4], B0[2], B1[2];
    unsigned vg[2][2];
#define PG8_GATHER(u) do { _Pragma("unroll") for (int _h = 0; _h < 2; ++_h) _Pragma("unroll") for (int _i = 0; _i < 2; ++_i) { int _R, _C; stage_rc(tid * 16 + _i * 8192, _R, _C); \
        const int _r = _h * HALF + _R; int _tok; if ((u).alist) _tok = (_r < (u).nvalid) ? (u).alist[_r] : 0; else _tok = (u).arow0 + _r; vg[_h][_i] = (unsigned)(_tok * K + _C) * 2u; } } while (0)
    const char* cA; const char* cB = (const char*)g.Bt + (size_t)cur.brow0 * K * 2;
    if constexpr (GATHER) { cA = (const char*)g.A; PG8_GATHER(cur); } else { cA = (const char*)g.A + (size_t)cur.arow0 * K * 2;
#pragma unroll
        for (int h = 0; h < 2; ++h)
#pragma unroll
            for (int i = 0; i < 2; ++i) vg[h][i] = 0u; }
    if constexpr (SP2) {
        PG8_STAGE(PG8_SB(0, 0), cB, voffB); PG8_STAGE(PG8_SB(0, 1), cB + hstep, voffB); PG8_STAGE_A(PG8_SA(0, 0), cA, 0, vg); PG8_STAGE_A(PG8_SA(0, 1), cA, 1, vg);
        if (wr == 1) PG8_BAR;
        PG8_WAIT_V(2); PG8_BAR;
        PG8_STAGE(PG8_SB(1, 0), cB + kstep, voffB); PG8_STAGE_A(PG8_SA(1, 0), cA + kstep, 0, vg); PG8_STAGE(PG8_SB(1, 1), cB + hstep + kstep, voffB);
        PG8_WAIT_V(6); PG8_BAR;
    } else {
        PG8_STAGE(PG8_SB(0, 0), cB, voffB); PG8_STAGE_A(PG8_SA(0, 0), cA, 0, vg); PG8_STAGE(PG8_SB(0, 1), cB + hstep, voffB); PG8_STAGE_A(PG8_SA(0, 1), cA, 1, vg);
        if (wr == 1) PG8_BAR;
        PG8_WAIT_V(4); PG8_BAR;
        PG8_STAGE(PG8_SB(1, 0), cB + kstep, voffB); PG8_STAGE_A(PG8_SA(1, 0), cA + kstep, 0, vg); PG8_STAGE(PG8_SB(1, 1), cB + hstep + kstep, voffB);
        PG8_WAIT_V(6); PG8_BAR;
    }
    for (;;) {
        const bool has_next = S.next(ui + 1, nxt);
        const char* nA; const char* nB = has_next ? (const char*)g.Bt + (size_t)nxt.brow0 * K * 2 : cB;
        if constexpr (GATHER) nA = cA; else nA = has_next ? (const char*)g.A + (size_t)nxt.arow0 * K * 2 : cA;
#pragma unroll 1
        for (int t = 0; t < nt; t += 2) {
            const bool last = (t == nt - 2);
            const char* a1 = cA + (size_t)(t + 1) * kstep;
            const char* a2 = last ? nA : cA + (size_t)(t + 2) * kstep; const char* b2 = last ? nB : cB + (size_t)(t + 2) * kstep;
            const char* a3 = a2 + kstep; const char* b3 = b2 + kstep;
            if constexpr (SP2) {
            PG8_LDB(B0, 0, 0); PG8_LDB(B1, 0, 1); PG8_SCHED; PG8_LDA(At, 0, 0); PG8_STAGE_A(PG8_SA(1, 1), a1, 1, vg);
            if constexpr (GATHER) { if (last && has_next) PG8_GATHER(nxt); }
            PG8_WAIT_V(8); PG8_WAIT_L(0); PG8_BAR; PG8_MMA(0, 0, At, B0); PG8_MMA(0, 1, At, B1); PG8_BAR; PG8_SCHED;
            PG8_LDA(At, 0, 1); PG8_STAGE(PG8_SB(0, 0), b2, voffB); PG8_STAGE(PG8_SB(0, 1), b2 + hstep, voffB); PG8_STAGE_A(PG8_SA(0, 0), a2, 0, vg);
            PG8_WAIT_V(8); PG8_WAIT_L(0); PG8_BAR; PG8_MMA(1, 0, At, B0); PG8_MMA(1, 1, At, B1); PG8_BAR; PG8_SCHED;
            PG8_LDB(B0, 1, 0); PG8_LDB(B1, 1, 1); PG8_SCHED; PG8_LDA(At, 1, 0); PG8_STAGE_A(PG8_SA(0, 1), a2, 1, vg);
            PG8_WAIT_V(8); PG8_WAIT_L(0); PG8_BAR; PG8_MMA(0, 0, At, B0); PG8_MMA(0, 1, At, B1); PG8_BAR; PG8_SCHED;
            PG8_LDA(At, 1, 1); PG8_STAGE(PG8_SB(1, 0), b3, voffB); PG8_STAGE(PG8_SB(1, 1), b3 + hstep, voffB); PG8_STAGE_A(PG8_SA(1, 0), a3, 0, vg);
            PG8_WAIT_V(8); PG8_WAIT_L(0); PG8_BAR; PG8_MMA(1, 0, At, B0); PG8_MMA(1, 1, At, B1); PG8_BAR; PG8_SCHED;
            } else {
            PG8_LDB(B0, 0, 0); PG8_SCHED; PG8_LDA(At, 0, 0); PG8_STAGE_A(PG8_SA(1, 1), a1, 1, vg);
            if constexpr (GATHER) { if (last && has_next) PG8_GATHER(nxt); }
            PG8_WAIT_L(8); PG8_BAR; PG8_WAIT_L(0); PG8_MMA(0, 0, At, B0); PG8_BAR; PG8_SCHED;
            PG8_LDB(B1, 0, 1); PG8_STAGE(PG8_SB(0, 0), b2, voffB);
            PG8_BAR; PG8_WAIT_L(0); PG8_MMA(0, 1, At, B1); PG8_BAR;
            PG8_LDA(At, 0, 1); PG8_STAGE_A(PG8_SA(0, 0), a2, 0, vg);
            PG8_BAR; PG8_WAIT_L(0); PG8_MMA(1, 0, At, B0); PG8_BAR; PG8_SCHED;
            PG8_STAGE(PG8_SB(0, 1), b2 + hstep, voffB);
            PG8_WAIT_V(6); PG8_BAR; PG8_MMA(1, 1, At, B1); PG8_BAR;
            PG8_LDB(B0, 1, 0); PG8_SCHED; PG8_LDA(At, 1, 0); PG8_STAGE_A(PG8_SA(0, 1), a2, 1, vg);
            PG8_WAIT_L(8); PG8_BAR; PG8_WAIT_L(0); PG8_MMA(0, 0, At, B0); PG8_BAR; PG8_SCHED;
            PG8_LDB(B1, 1, 1); PG8_STAGE(PG8_SB(1, 0), b3, voffB);
            PG8_BAR; PG8_WAIT_L(0); PG8_MMA(0, 1, At, B1); PG8_BAR;
            PG8_LDA(At, 1, 1); PG8_STAGE_A(PG8_SA(1, 0), a3, 0, vg);
            PG8_BAR; PG8_WAIT_L(0); PG8_MMA(1, 0, At, B0); PG8_BAR; PG8_SCHED;
            PG8_STAGE(PG8_SB(1, 1), b3 + hstep, voffB);
            PG8_WAIT_V(6); PG8_BAR; PG8_MMA(1, 1, At, B1); PG8_BAR;
            }
        }
        if constexpr (ALIGN_EPI) { if (wr == 0) PG8_BAR; }
        E(acc, cur, wr, wc, fr, fq);
        if (!has_next) break;
#pragma unroll
        for (int a = 0; a < 2; ++a)
#pragma unroll
            for (int b = 0; b < 2; ++b)
#pragma unroll
                for (int m = 0; m < 4; ++m)
#pragma unroll
                    for (int n = 0; n < 2; ++n) acc[a][b][m][n] = (f32x4){0.f, 0.f, 0.f, 0.f};
        cur = nxt; cA = nA; cB = nB; ++ui;
        if constexpr (ALIGN_EPI) { if (wr == 1) PG8_BAR; }
    }
    PG8_WAIT_V(0);
    if constexpr (!ALIGN_EPI) { if (wr == 0) PG8_BAR; }
    PG8_BAR;
#undef PG8_SA
#undef PG8_SB
#undef PG8_SBR
#undef PG8_STAGE
#undef PG8_STAGE_A
#undef PG8_GATHER
#undef PG8_LDF
#undef PG8_LDA
#undef PG8_LDB
#undef PG8_MMA
#undef PG8_WAIT_V
#undef PG8_WAIT_L
#undef PG8_BAR
#undef PG8_SCHED
}


struct EpiM1 {
    static constexpr bool PERM = true;
    bf16_t* Q; bf16_t* Kn; bf16_t* KT; bf16_t* VT; bf16_t* OGS; LAS unsigned char* tlds;
    __device__ __forceinline__ void operator()(const f32x4 (&acc)[2][2][4][2], const Unit& u, int wr, int wc, int fr, int fq) const {
        const int row0 = u.arow0 + wr * 64 + fr, pn = u.pn;
        if (pn < 4 || pn >= 8) {
            bf16_t* base; int ldc, colt; float sc = 1.f; const bool sig = pn >= 8;
            if (pn < 2) { base = Q; ldc = MQK; colt = pn * 256; sc = 0.08838834764831845f; }
            else if (pn < 4) { base = Kn; ldc = MQK; colt = (pn - 2) * 256; }
            else { base = OGS; ldc = MV; colt = (pn - 8) * 256; }
            const int col0 = colt + wc * 32 + 8 * fq;
#pragma unroll
            for (int ai = 0; ai < 2; ++ai)
#pragma unroll
                for (int m = 0; m < 4; ++m) { bf16_t* rowp = base + (size_t)(row0 + ai * HALF + m * 16) * ldc + col0;
#pragma unroll
                    for (int bj = 0; bj < 2; ++bj) { f32x4 v0 = acc[ai][bj][m][0] * sc, v1 = acc[ai][bj][m][1] * sc;
                        if (sig) {
#pragma unroll
                            for (int j = 0; j < 4; ++j) { v0[j] = sigmoidf_(v0[j]); v1[j] = sigmoidf_(v1[j]); } }
                        u32x4 w; w.x = cvt_pk_bf16(v0[0], v0[1]); w.y = cvt_pk_bf16(v0[2], v0[3]); w.z = cvt_pk_bf16(v1[0], v1[1]); w.w = cvt_pk_bf16(v1[2], v1[3]);
                        *(u32x4*)(rowp + bj * HALF) = w; } }
        }
        if (pn >= 2 && pn < 8) {
            const int b = u.arow0 / SEQ, s0 = (u.arow0 % SEQ) + wr * 64;
            bf16_t* base; int colt, feat;
            if (pn < 4) { base = KT; colt = (pn - 2) * 256; feat = DK; } else { base = VT; colt = (pn - 4) * 256; feat = DV; }
            LAS unsigned char* tb = tlds + (wr * 4 + wc) * 2048;
            const int lane = fq * 16 + fr;
#pragma unroll
            for (int ai = 0; ai < 2; ++ai) {
                const int ch = (s0 + ai * HALF) >> 6;
#pragma unroll
                for (int bj = 0; bj < 2; ++bj) {
                    const int col = colt + bj * HALF + wc * 32, hd = col / feat, f0 = col % feat;
                    bf16_t* xb = base + ((((size_t)(b * NH + hd) * NCH + ch) * feat + f0) << 6);
#pragma unroll
                    for (int n = 0; n < 2; ++n) {
#pragma unroll
                        for (int m = 0; m < 4; ++m)
#pragma unroll
                            for (int j = 0; j < 4; ++j) { const int t = m * 16 + fr;
                                *(LAS bf16_t*)(tb + (4 * fq + j) * 128 + ((((t >> 3) ^ (2 * fq)) & 7) << 4) + (t & 7) * 2) = (bf16_t)f2bf(acc[ai][bj][m][n][j]); }
#pragma unroll
                        for (int q = 0; q < 2; ++q) { const int id = lane + 64 * q, cr = id >> 3, p = id & 7, tc = (p ^ (2 * (cr >> 2))) & 7;
                            const u32x4 v = *(const LAS u32x4*)(tb + id * 16);
                            *(u32x4*)(xb + (size_t)(8 * (cr >> 2) + 4 * n + (cr & 3)) * 64 + tc * 8) = v; }
                    }
                }
            }
        }
    }
};
template <bool BASE_F32> struct EpiRes {
    static constexpr bool PERM = true;
    const void* base; bf16_t* out; const float* gate; float mul;
    __device__ __forceinline__ void operator()(const f32x4 (&acc)[2][2][4][2], const Unit& u, int wr, int wc, int fr, int fq) const {
        const int row0 = u.arow0 + wr * 64 + fr, col0 = u.pn * BM + wc * 32 + 8 * fq, b = u.arow0 / SEQ;
        f32x4 gv[2][2];
#pragma unroll
        for (int bj = 0; bj < 2; ++bj)
#pragma unroll
            for (int n = 0; n < 2; ++n) gv[bj][n] = *(const f32x4*)(gate + (size_t)b * 6 * D + col0 + bj * HALF + n * 4) * mul;
        u32x4 t[2][4][2];
#pragma unroll
        for (int ai = 0; ai < 2; ++ai)
#pragma unroll
            for (int m = 0; m < 4; ++m)
#pragma unroll
                for (int bj = 0; bj < 2; ++bj) { const f32x4 v0 = gv[bj][0] * acc[ai][bj][m][0], v1 = gv[bj][1] * acc[ai][bj][m][1];
                    t[ai][m][bj].x = cvt_pk_bf16(v0[0], v0[1]); t[ai][m][bj].y = cvt_pk_bf16(v0[2], v0[3]); t[ai][m][bj].z = cvt_pk_bf16(v1[0], v1[1]); t[ai][m][bj].w = cvt_pk_bf16(v1[2], v1[3]); }
        if (BASE_F32) {
#pragma unroll
            for (int ai = 0; ai < 2; ++ai) {
                f32x4 bf[4][2][2];
#pragma unroll
                for (int m = 0; m < 4; ++m)
#pragma unroll
                    for (int bj = 0; bj < 2; ++bj) { const float* p = (const float*)base + (size_t)(row0 + ai * HALF + m * 16) * D + col0 + bj * HALF; bf[m][bj][0] = *(const f32x4*)p; bf[m][bj][1] = *(const f32x4*)(p + 4); }
                asm volatile("" ::: "memory");
#pragma unroll
                for (int m = 0; m < 4; ++m)
#pragma unroll
                    for (int bj = 0; bj < 2; ++bj) { const f32x4 a0 = bf[m][bj][0], a1 = bf[m][bj][1]; const u32x4 c = t[ai][m][bj]; u32x4 w;
                        w.x = cvt_pk_bf16(a0[0] + bflo(c.x), a0[1] + bfhi(c.x)); w.y = cvt_pk_bf16(a0[2] + bflo(c.y), a0[3] + bfhi(c.y));
                        w.z = cvt_pk_bf16(a1[0] + bflo(c.z), a1[1] + bfhi(c.z)); w.w = cvt_pk_bf16(a1[2] + bflo(c.w), a1[3] + bfhi(c.w));
                        *(u32x4*)(out + (size_t)(row0 + ai * HALF + m * 16) * D + col0 + bj * HALF) = w; }
                asm volatile("" ::: "memory");
            }
        } else {
            u32x4 bw[2][4][2];
#pragma unroll
            for (int ai = 0; ai < 2; ++ai)
#pragma unroll
                for (int m = 0; m < 4; ++m)
#pragma unroll
                    for (int bj = 0; bj < 2; ++bj) bw[ai][m][bj] = *(const u32x4*)((const bf16_t*)base + (size_t)(row0 + ai * HALF + m * 16) * D + col0 + bj * HALF);
            asm volatile("" ::: "memory");
#pragma unroll
            for (int ai = 0; ai < 2; ++ai)
#pragma unroll
                for (int m = 0; m < 4; ++m)
#pragma unroll
                    for (int bj = 0; bj < 2; ++bj) { const u32x4 a = bw[ai][m][bj], c = t[ai][m][bj]; u32x4 w;
                        w.x = cvt_pk_bf16(bflo(a.x) + bflo(c.x), bfhi(a.x) + bfhi(c.x)); w.y = cvt_pk_bf16(bflo(a.y) + bflo(c.y), bfhi(a.y) + bfhi(c.y));
                        w.z = cvt_pk_bf16(bflo(a.z) + bflo(c.z), bfhi(a.z) + bfhi(c.z)); w.w = cvt_pk_bf16(bflo(a.w) + bflo(c.w), bfhi(a.w) + bfhi(c.w));
                        *(u32x4*)(out + (size_t)(row0 + ai * HALF + m * 16) * D + col0 + bj * HALF) = w; }
        }
    }
};
struct EpiBf {
    static constexpr bool PERM = true;
    bf16_t* O; int ldc;
    __device__ __forceinline__ void operator()(const f32x4 (&acc)[2][2][4][2], const Unit& u, int wr, int wc, int fr, int fq) const {
        const int row0 = u.arow0 + wr * 64 + fr, col0 = u.pn * BM + wc * 32 + 8 * fq;
#pragma unroll
        for (int ai = 0; ai < 2; ++ai)
#pragma unroll
            for (int m = 0; m < 4; ++m) { bf16_t* rowp = O + (size_t)(row0 + ai * HALF + m * 16) * ldc + col0;
#pragma unroll
                for (int bj = 0; bj < 2; ++bj) { const f32x4 v0 = acc[ai][bj][m][0], v1 = acc[ai][bj][m][1];
                    u32x4 w; w.x = cvt_pk_bf16(v0[0], v0[1]); w.y = cvt_pk_bf16(v0[2], v0[3]); w.z = cvt_pk_bf16(v1[0], v1[1]); w.w = cvt_pk_bf16(v1[2], v1[3]);
                    *(u32x4*)(rowp + bj * HALF) = w; } }
    }
};
template <bool SILU, bool F8OUT = false> struct EpiGlu {
    static constexpr bool PERM = true;
    bf16_t* O; int ldc; int plain_tiles; bf16_t* P; int ldp; float f8scale;
    __device__ __forceinline__ void operator()(const f32x4 (&acc)[2][2][4][2], const Unit& u, int wr, int wc, int fr, int fq) const {
        const int row0 = u.arow0 + wr * 64 + fr;
        if (u.pn < plain_tiles) {
            const int col0 = u.pn * BM + wc * 32 + 8 * fq;
#pragma unroll
            for (int ai = 0; ai < 2; ++ai)
#pragma unroll
                for (int m = 0; m < 4; ++m) { bf16_t* rowp = P + (size_t)(row0 + ai * HALF + m * 16) * ldp + col0;
#pragma unroll
                    for (int bj = 0; bj < 2; ++bj) { const f32x4 v0 = acc[ai][bj][m][0], v1 = acc[ai][bj][m][1];
                        u32x4 w; w.x = cvt_pk_bf16(v0[0], v0[1]); w.y = cvt_pk_bf16(v0[2], v0[3]); w.z = cvt_pk_bf16(v1[0], v1[1]); w.w = cvt_pk_bf16(v1[2], v1[3]);
                        *(u32x4*)(rowp + bj * HALF) = w; } }
            return;
        }
        const int col0 = (u.pn - plain_tiles) * HALF + wc * 32 + 8 * fq;
#pragma unroll
        for (int ai = 0; ai < 2; ++ai)
#pragma unroll
            for (int m = 0; m < 4; ++m) { bf16_t* rowp = O + (size_t)(row0 + ai * HALF + m * 16) * ldc + col0;
                f32x4 v0 = acc[ai][0][m][0], v1 = acc[ai][0][m][1]; const f32x4 u0 = acc[ai][1][m][0], u1 = acc[ai][1][m][1];
                if (SILU) {
#pragma unroll
                    for (int j = 0; j < 4; ++j) { v0[j] = v0[j] * sigmoidf_(v0[j]); v1[j] = v1[j] * sigmoidf_(v1[j]); } }
                v0 = v0 * u0; v1 = v1 * u1;
                if constexpr (F8OUT) { v0 = v0 * f8scale; v1 = v1 * f8scale; u32x2 w8; w8.x = pk4_fp8_sat(v0[0], v0[1], v0[2], v0[3]); w8.y = pk4_fp8_sat(v1[0], v1[1], v1[2], v1[3]);
                    *(u32x2*)((unsigned char*)O + (size_t)(row0 + ai * HALF + m * 16) * ldc + col0) = w8; }
                else { u32x4 w; w.x = cvt_pk_bf16(v0[0], v0[1]); w.y = cvt_pk_bf16(v0[2], v0[3]); w.z = cvt_pk_bf16(v1[0], v1[1]); w.w = cvt_pk_bf16(v1[2], v1[3]);
                    *(u32x4*)rowp = w; } }
    }
};
}

#define XB_TMO      128
#define XB_XCNT(j)  (256  + 64 * (j))
#define XB_XSUB(j)  (1280 + 64 * (j))
#define XB_XGEN(j)  (2304 + 64 * (j))
#define XB_TOP      3328
#define XB_TOPGEN   3392
#define XCD_BAR_WORDS 3456
#define XB_SPIN_CAP (1u << 18)
__device__ __forceinline__ unsigned xb_ld(unsigned* p)              { return __hip_atomic_load(p, __ATOMIC_RELAXED, __HIP_MEMORY_SCOPE_AGENT); }
__device__ __forceinline__ unsigned xb_add(unsigned* p, unsigned v) { return __hip_atomic_fetch_add(p, v, __ATOMIC_RELAXED, __HIP_MEMORY_SCOPE_AGENT); }
__device__ __forceinline__ unsigned xb_xcc_id() { return (unsigned)__builtin_amdgcn_s_getreg((3 << 11) | 20) & 0xFu; }
#define XB_SPIN(cond, bar) do { unsigned _sp = 0; while (cond) { __builtin_amdgcn_s_sleep(1); \
    if ((++_sp & 255u) == 0u) { if (xb_ld(&(bar)[XB_TMO])) break; if (_sp > XB_SPIN_CAP) { atomicAdd(&(bar)[XB_TMO], 1u); break; } } } } while (0)
struct XcdBarrier { unsigned* bar; unsigned x; volatile LAS unsigned* st; };
__device__ __forceinline__ XcdBarrier xcd_barrier_post(unsigned* bar, volatile LAS unsigned* st) {
    XcdBarrier b; b.bar = bar; b.x = xb_xcc_id(); b.st = st;
    if (threadIdx.x == 0) (void)xb_add(&bar[XB_XCNT(b.x)], 1u);
    return b;
}
__device__ __forceinline__ void xcd_barrier_complete(unsigned* bar, unsigned x, unsigned& nloc, unsigned& nx) {
    const unsigned G = gridDim.x * gridDim.y * gridDim.z;
    unsigned sum, cnt, mine, sp = 0u;
    for (;;) {
        sum = 0u; cnt = 0u; mine = 0u;
#pragma unroll
        for (unsigned j = 0; j < 16; ++j) { const unsigned c = xb_ld(&bar[XB_XCNT(j)]); sum += c; cnt += (c > 0u) ? 1u : 0u; mine = (j == x) ? c : mine; }
        if (sum == G) break;
        __builtin_amdgcn_s_sleep(1);
        if ((++sp & 255u) == 0u) { if (xb_ld(&bar[XB_TMO])) break; if (sp > XB_SPIN_CAP) { atomicAdd(&bar[XB_TMO], 1u); break; } }
    }
    nloc = mine > 0u ? mine : 1u; nx = cnt > 0u ? cnt : 1u;
}
__device__ __forceinline__ void xcd_barrier(const XcdBarrier& b) {
    asm volatile("s_waitcnt vmcnt(0)" ::: "memory");
    __syncthreads();
    if (threadIdx.x == 0) {
        unsigned* bar = b.bar;
        __builtin_amdgcn_s_waitcnt(0);
        unsigned nloc = b.st[0], nx = b.st[1];
        if (nloc == 0u) { xcd_barrier_complete(bar, b.x, nloc, nx); b.st[0] = nloc; b.st[1] = nx; }
        const unsigned old = xb_add(&bar[XB_XSUB(b.x)], 1u);
        const unsigned gen = old / nloc;
        if (old + 1u == (gen + 1u) * nloc) {
            __builtin_amdgcn_fence(__ATOMIC_RELEASE, "agent");
            asm volatile("s_waitcnt vmcnt(0)" ::: "memory");
            const unsigned og = xb_add(&bar[XB_TOP], 1u);
            const unsigned tg = og / nx;
            if (og + 1u == (tg + 1u) * nx) xb_add(&bar[XB_TOPGEN], 1u);
            else XB_SPIN(xb_ld(&bar[XB_TOPGEN]) == tg, bar);
            __builtin_amdgcn_fence(__ATOMIC_ACQUIRE, "agent");
            xb_add(&bar[XB_XGEN(b.x)], 1u);
            asm volatile("s_waitcnt vmcnt(0)" ::: "memory");
        } else {
            XB_SPIN(xb_ld(&bar[XB_XGEN(b.x)]) == gen, bar);
            __builtin_amdgcn_fence(__ATOMIC_ACQUIRE, "agent");
            asm volatile("s_waitcnt vmcnt(0)" ::: "memory");
        }
    }
    __syncthreads();
}

struct Args { const float* in[20]; float* out; unsigned char* ws; int ph_lo, ph_hi; };
__device__ __forceinline__ const void* karg_ptr(int idx) {
    unsigned long long v = (unsigned long long)((const void* const __attribute__((address_space(4)))*)__builtin_amdgcn_kernarg_segment_ptr())[idx];
    asm volatile("" : "+s"(v)); return (const void*)(const GAS char*)v;
}
struct InProxy { __device__ __forceinline__ const float* operator[](int i) const { return (const float*)karg_ptr(i); } };
struct WsProxy { __device__ __forceinline__ operator unsigned char*() const { return (unsigned char*)karg_ptr(21); }
                 __device__ __forceinline__ unsigned char* operator+(size_t o) const { return (unsigned char*)karg_ptr(21) + o; } };
struct OutProxy { __device__ __forceinline__ operator float*() const { return (float*)karg_ptr(20); }
                  __device__ __forceinline__ float* operator+(size_t o) const { return (float*)karg_ptr(20) + o; } };
struct CtlProxy { __device__ __forceinline__ operator gu32*() const { return (gu32*)karg_ptr(21); }
                  __device__ __forceinline__ gu32* operator+(int o) const { return (gu32*)karg_ptr(21) + o; } };
struct Frame {
    LAS unsigned char* lds; volatile LAS unsigned* MISC; CtlProxy ctl;
    int tid, lane, wave, vcu, G, bx;
    InProxy in; OutProxy out; WsProxy ws;
};
enum { I_X = 0, I_C, I_N1G, I_N2G, I_WADA, I_BADA, I_MWIN, I_MBG, I_MNG, I_MWOUT, I_CWIN, I_CCW, I_CCB, I_CWOUT, I_WR, I_BR, I_EWG, I_EWU, I_EWD, I_FG };

__device__ __forceinline__ float wave_sum(float v) {
#pragma unroll
    for (int o = 1; o < 64; o <<= 1) v += __shfl_xor(v, o);
    return v;
}

__device__ __forceinline__ int glu_row(int n, int which) { return (n >> 7) * 256 + which * 128 + (n & 127); }
struct CvtItem { const float* src; bf16_t* dst; int ldw, K; float f8scale; };
constexpr int CVT_IN = 16 * 96, CVT_OUT = 16 * 32, CVT_G = NE * 16 * 16, CVT_D = NE * 8 * 32, CVT_ITEMS = CVT_IN + CVT_OUT + 2 * CVT_G + CVT_D;
__device__ __forceinline__ CvtItem cvt_decode(Frame& F, int L, int it) {
    const size_t lo_ = (L == 0) ? 0 : WS_WL1;
    CvtItem d; d.f8scale = 0.f; int r = it;
    if (r < CVT_IN) { const int kb = r / 96, nb = r % 96, n0 = nb * 32; d.K = D;
        if (L == 0) { d.src = F.in[I_MWIN] + (size_t)kb * 64 * MPROJ + n0; d.ldw = MPROJ;
            if (FP8_G1 == 1 || (FP8_G1 == 2 && n0 >= 1024)) { d.dst = (bf16_t*)((unsigned char*)(F.ws + lo_ + WS_W0) + (FP8_G1 == 2 ? 2 * MiB : 0) + (size_t)n0 * D + kb * 64); d.f8scale = 32.f; } else d.dst = (bf16_t*)(F.ws + lo_ + WS_W0) + (size_t)n0 * D + kb * 64; }
        else { int dr; if (n0 < D) dr = n0; else if (n0 < 2 * D) dr = D + glu_row(n0 - D, 0); else dr = D + glu_row(n0 - 2 * D, 1);
            d.src = F.in[I_CWIN] + (size_t)kb * 64 * 3 * D + n0; d.ldw = 3 * D;
            if (FP8_CIN) { d.dst = (bf16_t*)((unsigned char*)(F.ws + lo_ + WS_W0) + (size_t)dr * D + kb * 64); d.f8scale = 32.f; } else d.dst = (bf16_t*)(F.ws + lo_ + WS_W0) + (size_t)dr * D + kb * 64; }
        return d; } r -= CVT_IN;
    if (r < CVT_OUT) { const int kb = r / 32, nb = r % 32; d.K = D; d.ldw = D; d.src = (L == 0 ? F.in[I_MWOUT] : F.in[I_CWOUT]) + (size_t)kb * 64 * D + nb * 32;
        if ((L == 1 && FP8_COUT) || (L == 0 && FP8_MOUT)) { d.dst = (bf16_t*)((unsigned char*)(F.ws + lo_ + WS_W1) + (size_t)nb * 32 * D + kb * 64); d.f8scale = 32.f; } else d.dst = (bf16_t*)(F.ws + lo_ + WS_W1) + (size_t)nb * 32 * D + kb * 64; return d; } r -= CVT_OUT;
    if (r < 2 * CVT_G) { const int which = r / CVT_G; r %= CVT_G; const int e = r / 256, kb = (r % 256) / 16, nb = r % 16, n0 = nb * 32; d.K = D; d.ldw = DE;
        d.src = (which == 0 ? F.in[I_EWG] : F.in[I_EWU]) + ((size_t)L * NE + e) * D * DE + (size_t)kb * 64 * DE + n0;
        d.dst = (bf16_t*)((unsigned char*)(F.ws + lo_ + WS_WUP) + (size_t)e * 1024 * D + (size_t)glu_row(n0, which) * D + kb * 64); d.f8scale = 32.f; return d; } r -= 2 * CVT_G;
    { const int e = r / 256, kb = (r % 256) / 32, nb = r % 32; d.K = DE; d.ldw = D;
      d.src = F.in[I_EWD] + ((size_t)L * NE + e) * DE * D + (size_t)kb * 64 * D + nb * 32;
      d.dst = (bf16_t*)((unsigned char*)(F.ws + lo_ + WS_WDN) + (size_t)e * D * DE + (size_t)nb * 32 * DE + kb * 64); d.f8scale = 16.f; }
    return d;
}
__device__ __forceinline__ void convert_weights(Frame& F, int L) {
    LAS float* scr = (LAS float*)(F.lds + F.wave * 16384);
    const int gw = F.vcu * NWAVES + F.wave, NGW = F.G * NWAVES, lane = F.lane;
    float ld[32];
    CvtItem cur, nxt;
    int it = gw;
    if (it < CVT_ITEMS) { cur = cvt_decode(F, L, it);
#pragma unroll
        for (int i = 0; i < 32; ++i) ld[i] = cur.src[(size_t)(2 * i + (lane >> 5)) * cur.ldw + (lane & 31)]; }
    for (; it < CVT_ITEMS; it += NGW) {
#pragma unroll
        for (int i = 0; i < 32; ++i) scr[(2 * i + (lane >> 5)) * 33 + (lane & 31)] = ld[i];
        const bool more = it + NGW < CVT_ITEMS;
        if (more) { nxt = cvt_decode(F, L, it + NGW);
#pragma unroll
            for (int i = 0; i < 32; ++i) ld[i] = nxt.src[(size_t)(2 * i + (lane >> 5)) * nxt.ldw + (lane & 31)]; }
        LDS_WAIT(); asm volatile("" ::: "memory");
        const int c = lane & 7;
#pragma unroll
        for (int j = 0; j < 4; ++j) { const int n = (lane >> 3) + 8 * j; const LAS float* s = scr + (8 * c) * 33 + n;
            if (cur.f8scale != 0.f) { const float f = cur.f8scale; u32x2 o8; o8.x = pk4_fp8(s[0 * 33] * f, s[1 * 33] * f, s[2 * 33] * f, s[3 * 33] * f); o8.y = pk4_fp8(s[4 * 33] * f, s[5 * 33] * f, s[6 * 33] * f, s[7 * 33] * f);
                *(GAS u32x2*)((unsigned char*)cur.dst + (size_t)n * cur.K + 8 * c) = o8; }
            else { u32x4 o; o.x = pk2(s[0 * 33], s[1 * 33]); o.y = pk2(s[2 * 33], s[3 * 33]); o.z = pk2(s[4 * 33], s[5 * 33]); o.w = pk2(s[6 * 33], s[7 * 33]);
                *(GAS u32x4*)(cur.dst + (size_t)n * cur.K + 8 * c) = o; } }
        LDS_WAIT(); asm volatile("" ::: "memory");
        cur = nxt;
    }
}

__device__ __forceinline__ void phase_prologue(Frame& F) {
    float* MOD = (float*)(F.ws + WS_MOD);
    LAS float* cond = (LAS float*)(F.lds + 0);
    LAS float* red = (LAS float*)(F.lds + 16384);
    bool did = false;
    for (int task = F.bx; task < 192; task += F.G) {
        if (did) __syncthreads();
        did = true;
        for (int i = F.tid; i < NB * D; i += NTHR) { const int b = i / D, k = i % D; const float c = F.in[I_C][i]; cond[k * 4 + b] = c * sigmoidf_(c); }
        __syncthreads();
        const int layer = task / 96, col = (task % 96) * 64 + F.lane;
        const float* W = F.in[I_WADA] + (size_t)layer * D * 6 * D;
        float a0 = 0.f, a1 = 0.f, a2 = 0.f, a3 = 0.f;
#pragma unroll 8
        for (int kk = 0; kk < 128; ++kk) { const int k = F.wave * 128 + kk; const float w = W[(size_t)k * 6 * D + col]; const f32x4 c4 = *(const LAS f32x4*)(cond + k * 4);
            a0 += c4[0] * w; a1 += c4[1] * w; a2 += c4[2] * w; a3 += c4[3] * w; }
        red[(F.wave * 4 + 0) * 64 + F.lane] = a0; red[(F.wave * 4 + 1) * 64 + F.lane] = a1; red[(F.wave * 4 + 2) * 64 + F.lane] = a2; red[(F.wave * 4 + 3) * 64 + F.lane] = a3;
        __syncthreads();
        if (F.tid < 256) { const int b = F.tid >> 6, l = F.tid & 63; float s = 0.f;
#pragma unroll
            for (int w = 0; w < 8; ++w) s += red[(w * 4 + b) * 64 + l];
            const int c = (task % 96) * 64 + l;
            MOD[((size_t)layer * NB + b) * 6 * D + c] = s + F.in[I_BADA][(size_t)layer * 6 * D + c]; }
    }
    __syncthreads();
    convert_weights(F, 0);
}

template <int N>
__device__ __forceinline__ void xreduce(float (&v)[N], int lane) {
    constexpr int STEPS = (N == 32) ? 5 : 4;
#pragma unroll
    for (int i = 0; i < N / 2; ++i) { const auto r = __builtin_amdgcn_permlane32_swap(__builtin_bit_cast(unsigned, v[i]), __builtin_bit_cast(unsigned, v[i + N / 2]), false, false);
        const unsigned r0_ = r[0], r1_ = r[1]; v[i] = __uint_as_float(r0_) + __uint_as_float(r1_); }
#pragma unroll
    for (int i = 0; i < N / 4; ++i) { const auto r = __builtin_amdgcn_permlane16_swap(__builtin_bit_cast(unsigned, v[i]), __builtin_bit_cast(unsigned, v[i + N / 4]), false, false);
        const unsigned r0_ = r[0], r1_ = r[1]; v[i] = __uint_as_float(r0_) + __uint_as_float(r1_); }
#pragma unroll
    for (int step = 2; step < STEPS; ++step) {
        const int M = 32 >> step, n = N >> step;
        const bool up = (lane & M) != 0;
#pragma unroll
        for (int i = 0; i < n / 2; ++i) { float a = v[i], b = v[i + n / 2]; asm volatile("" : "+v"(a), "+v"(b));
            const float send = up ? a : b, keep = up ? b : a; v[i] = keep + __shfl_xor(send, M); }
    }
    if (N == 16) v[0] += __shfl_xor(v[0], 2);
    v[0] += __shfl_xor(v[0], 1);
}

constexpr int RP_WL = 0, RP_RINFO = 65536, RP_LCNT = RP_RINFO + 128 * 8 * 4, RP_TPRE = RP_LCNT + 256;
template <int MODE>
__device__ __forceinline__ void row_pass(Frame& F, int layer) {
    constexpr int DOTS = (MODE == 0) ? 8 : (MODE == 1 ? 16 : 0);
    constexpr int RPI = 2, NIT = 16 / RPI, NV = (DOTS > 0) ? RPI * DOTS : 16;
    constexpr bool COMBINE = (MODE == 2 || MODE == 3), MODUL = (MODE != 3);
    const float* MOD = (const float*)(F.ws + WS_MOD);
    LAS float* wl = (LAS float*)(F.lds + RP_WL);
    LAS int* rinfo = (LAS int*)(F.lds + RP_RINFO);
    LAS int* lcnt = (LAS int*)(F.lds + RP_LCNT);
    LAS int* tpre = (LAS int*)(F.lds + RP_TPRE);
    const float* xin = F.in[I_X];
    bf16_t* XB = (bf16_t*)(F.ws + WS_XB);
    float* xout = F.out;
    bf16_t* U = (bf16_t*)(F.ws + WS_U);
    const bf16_t* O = (const bf16_t*)(F.ws + WS_O);
    const unsigned char* TOKp = (const unsigned char*)(F.ws + WS_TOK);
    const int lane = F.lane;
    const int clayer = (MODE == 2) ? 0 : 1;
    if (DOTS > 0) { constexpr int NQ = D * (DOTS > 0 ? DOTS : 4) / 4 / NTHR;
        f32x4 tv[NQ];
#pragma unroll
        for (int q = 0; q < NQ; ++q) { const int piece = F.tid + q * NTHR, k = piece / (DOTS / 4), c4 = piece % (DOTS / 4);
            tv[q] = (DOTS == 8) ? *(const f32x4*)(F.in[I_MWIN] + (size_t)k * MPROJ + 3072 + 4 * c4) : *(const f32x4*)(F.in[I_WR] + (size_t)piece * 4); }
#pragma unroll
        for (int q = 0; q < NQ; ++q) { const int piece = F.tid + q * NTHR, k = piece / (DOTS / 4), c4 = piece % (DOTS / 4), jj = k >> 8, l = (k >> 2) & 63, ii = k & 3;
            const int rot = (DOTS == 16) ? ((l >> 2) & 3) : ((l >> 3) & 1), ch = (c4 + rot) & (DOTS / 4 - 1);
            *(LAS f32x4*)(wl + ((jj * 4 + ii) * 64 + l) * DOTS + ch * 4) = tv[q]; } }
    if (COMBINE && F.tid == 0) { int a = 0; for (int e = 0; e < NE; ++e) { tpre[e] = a; a += ((int)__hip_atomic_load(F.ctl + CW_CNT + 64 * clayer + e, RLX_AGENT) + 255) >> 8; } tpre[NE] = a; }
    float brt[16];
    if (MODE == 1) {
#pragma unroll
        for (int e = 0; e < 16; ++e) brt[e] = F.in[I_BR][e]; }
    for (int batch = F.vcu; batch < T / 128; batch += F.G) {
        __syncthreads();
        if (MODE == 1 && F.tid < 32) lcnt[F.tid] = 0;
        __syncthreads();
        const int row_base = batch * 128 + F.wave * 16, b = row_base / SEQ;
        const float* gam = (MODE == 3) ? F.in[I_FG] : ((MODE == 1) ? F.in[I_N2G] + (size_t)layer * D : F.in[I_N1G] + (size_t)layer * D);
        const float* mod = MOD + ((size_t)layer * NB + b) * 6 * D;
        const float* shp = mod + ((MODE == 1) ? 3 * D : 0); const float* scp = shp + D;
        const float* g2p = MOD + ((size_t)clayer * NB + b) * 6 * D + 5 * D;
        f32x4 gm[4], sh[4], sc[4], g2[4];
#pragma unroll
        for (int j = 0; j < 4; ++j) { gm[j] = *(const f32x4*)(gam + 256 * j + 4 * lane);
            if (MODUL) { sh[j] = *(const f32x4*)(shp + 256 * j + 4 * lane); sc[j] = *(const f32x4*)(scp + 256 * j + 4 * lane) + 1.0f; }
            if (COMBINE) g2[j] = *(const f32x4*)(g2p + 256 * j + 4 * lane); }
        f32x4 xn[RPI][4]; u32x2 on[RPI][2][4]; u32x4 tkn[RPI], tkn2[RPI];
#define RP_LOAD_X(IT) do { _Pragma("unroll") for (int r = 0; r < RPI; ++r) _Pragma("unroll") for (int j = 0; j < 4; ++j) { \
            if (MODE == 0) xn[r][j] = *(const f32x4*)(xin + (size_t)(row_base + (IT) * RPI + r) * D + 256 * j + 4 * lane); \
            else { const u32x2 xb_ = *(const u32x2*)(XB + (size_t)(row_base + (IT) * RPI + r) * D + 256 * j + 4 * lane); xn[r][j] = (f32x4){bflo(xb_.x), bfhi(xb_.x), bflo(xb_.y), bfhi(xb_.y)}; } } } while (0)
#define RP_LOAD_TOK(dst, IT) do { _Pragma("unroll") for (int r = 0; r < RPI; ++r) dst[r] = *(const u32x4*)(TOKp + (size_t)(row_base + (IT) * RPI + r) * 16); } while (0)
#define RP_LOAD_O(tk) do { _Pragma("unroll") for (int r = 0; r < RPI; ++r) { const unsigned tx_ = tk[r].x, ty_ = tk[r].y; \
            const int e0_ = __builtin_amdgcn_readfirstlane((int)(tx_ >> 16)), e1_ = __builtin_amdgcn_readfirstlane((int)(ty_ >> 16)); \
            const int s0_ = tpre[e0_] * 256 + (int)(tx_ & 0xffffu), s1_ = tpre[e1_] * 256 + (int)(ty_ & 0xffffu); \
            _Pragma("unroll") for (int j = 0; j < 4; ++j) { on[r][0][j] = *(const u32x2*)(O + (size_t)s0_ * D + 256 * j + 4 * lane); on[r][1][j] = *(const u32x2*)(O + (size_t)s1_ * D + 256 * j + 4 * lane); } } } while (0)
        RP_LOAD_X(0);
        if (COMBINE) { RP_LOAD_TOK(tkn, 0); RP_LOAD_O(tkn); RP_LOAD_TOK(tkn2, 1); }
#pragma unroll 1
        for (int it = 0; it < NIT; ++it) {
            const int r0 = row_base + it * RPI;
            f32x4 x[RPI][4]; u32x2 oc[RPI][2][4]; float w0c[RPI], w1c[RPI];
#pragma unroll
            for (int r = 0; r < RPI; ++r) {
#pragma unroll
                for (int j = 0; j < 4; ++j) { x[r][j] = xn[r][j]; if (COMBINE) { oc[r][0][j] = on[r][0][j]; oc[r][1][j] = on[r][1][j]; } }
                if (COMBINE) { const unsigned wz_ = tkn[r].z, ww_ = tkn[r].w; w0c[r] = __uint_as_float(wz_); w1c[r] = __uint_as_float(ww_); } }
            if (it + 1 < NIT) {
                RP_LOAD_X(it + 1);
                if (COMBINE) {
#pragma unroll
                    for (int r = 0; r < RPI; ++r) tkn[r] = tkn2[r];
                    RP_LOAD_O(tkn);
                    if (it + 2 < NIT) RP_LOAD_TOK(tkn2, it + 2); } }
            if (COMBINE) {
#pragma unroll
                for (int r = 0; r < RPI; ++r)
#pragma unroll
                    for (int j = 0; j < 4; ++j) { const u32x2 a = oc[r][0][j], c = oc[r][1][j]; const float w0 = w0c[r], w1 = w1c[r];
                        f32x4 mo; mo[0] = w0 * bflo(a.x) + w1 * bflo(c.x); mo[1] = w0 * bfhi(a.x) + w1 * bfhi(c.x); mo[2] = w0 * bflo(a.y) + w1 * bflo(c.y); mo[3] = w0 * bfhi(a.y) + w1 * bfhi(c.y);
                        x[r][j] = x[r][j] + g2[j] * mo;
                        if (MODE == 2) { u32x2 xw_; xw_.x = pk2(x[r][j][0], x[r][j][1]); xw_.y = pk2(x[r][j][2], x[r][j][3]); *(u32x2*)(XB + (size_t)(r0 + r) * D + 256 * j + 4 * lane) = xw_; } }
            }
            float rstd[RPI];
#pragma unroll
            for (int r = 0; r < RPI; ++r) { float s = 0.f;
#pragma unroll
                for (int j = 0; j < 4; ++j) s += (x[r][j][0] * x[r][j][0] + x[r][j][1] * x[r][j][1]) + (x[r][j][2] * x[r][j][2] + x[r][j][3] * x[r][j][3]);
                rstd[r] = 1.0f / sqrtf(wave_sum(s) * (1.0f / D) + EPS); }
#pragma unroll
            for (int r = 0; r < RPI; ++r)
#pragma unroll
                for (int j = 0; j < 4; ++j) { f32x4 y = x[r][j] * rstd[r] * gm[j]; if (MODUL) y = y * sc[j] + sh[j]; x[r][j] = y;
                    if (MODE == 3) *(f32x4*)(xout + (size_t)(r0 + r) * D + 256 * j + 4 * lane) = y;
                    else if (MODE == 1 || (MODE == 2 && FP8_CIN) || (MODE == 0 && FP8_G1)) { *(unsigned*)((unsigned char*)(F.ws + WS_U8) + (size_t)(r0 + r) * D + 256 * j + 4 * lane) = pk4_fp8(y[0], y[1], y[2], y[3]);
                        if (MODE == 0 && FP8_G1 == 2) { u32x2 w; w.x = pk2(y[0], y[1]); w.y = pk2(y[2], y[3]); *(u32x2*)(U + (size_t)(r0 + r) * D + 256 * j + 4 * lane) = w; } }
                    else { u32x2 w; w.x = pk2(y[0], y[1]); w.y = pk2(y[2], y[3]); *(u32x2*)(U + (size_t)(r0 + r) * D + 256 * j + 4 * lane) = w; } }
            if (DOTS > 0) {
                float v[NV];
#pragma unroll
                for (int i = 0; i < NV; ++i) v[i] = 0.f;
#pragma unroll
                for (int j = 0; j < 4; ++j)
#pragma unroll
                    for (int i = 0; i < 4; ++i) {
                        float w[DOTS > 0 ? DOTS : 1];
#pragma unroll
                        for (int q = 0; q < DOTS / 4; ++q) { const int rot = (DOTS == 16) ? ((lane >> 2) & 3) : ((lane >> 3) & 1);
                            const f32x4 t4 = *(const LAS f32x4*)(wl + ((j * 4 + i) * 64 + lane) * DOTS + ((q + rot) & (DOTS / 4 - 1)) * 4); w[4 * q] = t4[0]; w[4 * q + 1] = t4[1]; w[4 * q + 2] = t4[2]; w[4 * q + 3] = t4[3]; }
#pragma unroll
                        for (int r = 0; r < RPI; ++r)
#pragma unroll
                            for (int e = 0; e < DOTS; ++e) v[r * DOTS + e] += x[r][j][i] * w[e];
                        asm volatile("" ::: "memory"); }
                xreduce<NV>(v, lane);
                const float tot = v[0];
                if (MODE == 0) {
                    const int idx = lane >> 2, r = idx >> 3, gi = idx & 7, row = r0 + r, bb = row / SEQ, s = row % SEQ;
                    if ((lane & 3) == 0) {
                        const float pre = tot + F.in[I_MBG][gi];
                        if (gi < 4) ((float*)(F.ws + WS_IG))[(size_t)(bb * NH + gi) * SEQ + s] = pre;
                        else { const float ls = (pre >= 0.f) ? -log1pf(expf(-pre)) : (pre - log1pf(expf(pre))); ((float*)(F.ws + WS_LF))[(size_t)(bb * NH + gi - 4) * SEQ + s] = ls; }
                    }
                }
                if (MODE == 1) {
                    const int r = lane >> 5;
                    float lg[16], mx = -INFINITY;
#pragma unroll
                    for (int e = 0; e < 16; ++e) { lg[e] = __shfl(tot, 32 * r + 2 * e); mx = fmaxf(mx, lg[e]); }
                    float se = 0.f;
#pragma unroll
                    for (int e = 0; e < 16; ++e) { lg[e] = __builtin_amdgcn_exp2f((lg[e] - mx) * 1.44269504089f); se += lg[e]; }
                    const float inv = 1.0f / se;
                    float sel[16];
#pragma unroll
                    for (int e = 0; e < 16; ++e) { lg[e] *= inv; sel[e] = lg[e] + brt[e]; }
                    int best = 0; float bscore = -INFINITY;
#pragma unroll
                    for (int gq = 0; gq < 4; ++gq) { const float a = sel[4 * gq], bq = sel[4 * gq + 1], c = sel[4 * gq + 2], d = sel[4 * gq + 3];
                        const float m1 = fmaxf(fmaxf(a, bq), fmaxf(c, d));
                        const float lo1 = fminf(a, bq), hi1 = fmaxf(a, bq), lo2 = fminf(c, d), hi2 = fmaxf(c, d);
                        const float m2 = fmaxf(fminf(hi1, hi2), fmaxf(lo1, lo2));
                        const float gs = m1 + m2; if (gs > bscore) { bscore = gs; best = gq; } }
                    float s4[4], p4[4];
#pragma unroll
                    for (int q = 0; q < 4; ++q) { s4[q] = -INFINITY; p4[q] = 0.f; }
#pragma unroll
                    for (int gq = 0; gq < 4; ++gq) if (best == gq) {
#pragma unroll
                        for (int q = 0; q < 4; ++q) { s4[q] = sel[4 * gq + q]; p4[q] = lg[4 * gq + q]; } }
                    int i0 = 0; float v0 = s4[0], pp0 = p4[0];
#pragma unroll
                    for (int q = 1; q < 4; ++q) if (s4[q] > v0) { v0 = s4[q]; i0 = q; pp0 = p4[q]; }
                    int i1 = -1; float v1 = -INFINITY, pp1 = 0.f;
#pragma unroll
                    for (int q = 0; q < 4; ++q) if (q != i0 && s4[q] > v1) { v1 = s4[q]; i1 = q; pp1 = p4[q]; }
                    const float wsum = pp0 + pp1, w0 = pp0 / wsum, w1 = pp1 / wsum;
                    const int e0 = best * 4 + i0, e1 = best * 4 + i1;
                    if ((lane & 31) == 0) {
                        const int lp0 = __hip_atomic_fetch_add(lcnt + e0, 1, __ATOMIC_RELAXED, __HIP_MEMORY_SCOPE_WORKGROUP), lp1 = __hip_atomic_fetch_add(lcnt + e1, 1, __ATOMIC_RELAXED, __HIP_MEMORY_SCOPE_WORKGROUP);
                        LAS int* ri = rinfo + (F.wave * 16 + it * RPI + r) * 8;
                        ri[0] = e0; ri[1] = e1; ri[2] = lp0; ri[3] = lp1; ri[4] = __builtin_bit_cast(int, w0); ri[5] = __builtin_bit_cast(int, w1);
                    }
                }
            }
        }
#undef RP_LOAD_X
#undef RP_LOAD_TOK
#undef RP_LOAD_O
        if (MODE == 1) {
            __syncthreads();
            if (F.tid < 16) lcnt[16 + F.tid] = (int)__hip_atomic_fetch_add(F.ctl + CW_CNT + 64 * layer + F.tid, (unsigned)lcnt[F.tid], RLX_AGENT);
            __syncthreads();
            if (F.tid < 128) { const LAS int* ri = rinfo + F.tid * 8; const int row = batch * 128 + F.tid; const int e0 = ri[0], e1 = ri[1], p0 = lcnt[16 + e0] + ri[2], p1 = lcnt[16 + e1] + ri[3];
                int* LIST = (int*)(F.ws + WS_LIST); LIST[e0 * LCAP + p0] = row; LIST[e1 * LCAP + p1] = row;
                u32x4 ti; ti.x = (unsigned)(e0 << 16) | (unsigned)p0; ti.y = (unsigned)(e1 << 16) | (unsigned)p1; ti.z = (unsigned)ri[4]; ti.w = (unsigned)ri[5];
                *(u32x4*)(F.ws + WS_TOK + (size_t)row * 16) = ti; }
        }
    }
    __syncthreads();
}

#define LBAR() do { asm volatile("s_waitcnt lgkmcnt(0)" ::: "memory"); __builtin_amdgcn_s_barrier(); asm volatile("" ::: "memory"); } while (0)
__device__ __forceinline__ float incl_sum(float v, int lane) {
#pragma unroll
    for (int o = 1; o < 64; o <<= 1) { const float t = __shfl_up(v, o); if (lane >= o) v += t; }
    return v;
}
__device__ __forceinline__ float incl_max(float v, int lane) {
#pragma unroll
    for (int o = 1; o < 64; o <<= 1) { const float t = __shfl_up(v, o); if (lane >= o) v = fmaxf(v, t); }
    return v;
}
__device__ __forceinline__ void phase_scan(Frame& F, int mode = 0) {
    LAS float* wkA = (LAS float*)(F.lds + 0);
    LAS float* decA = (LAS float*)(F.lds + 32768);
    LAS float* tot = (LAS float*)(F.lds + 33280);
    LAS float* bst = (LAS float*)(F.lds + 33792);
    LAS float* cmx = (LAS float*)(F.lds + 34304);
    LAS float* rst = (LAS float*)(F.lds + 34816);
    LAS float* xw = (LAS float*)(F.lds + 35328);
    LAS unsigned char* ring = F.lds + 40960;
    constexpr int SLOT = 12288;
    const int lane = F.lane, w = F.wave, tid = F.tid;
    for (int unit = F.vcu; unit < 256; unit += F.G) {
        const int bh = unit >> 4, slice = unit & 15;
        const float* IG = (const float*)(F.ws + WS_IG) + (size_t)bh * SEQ; const float* LF = (const float*)(F.ws + WS_LF) + (size_t)bh * SEQ;
        __syncthreads();
        if (mode < 2) {
        float p[16], g[16], pm[16];
#pragma unroll
        for (int q = 0; q < 16; ++q) { const int c = 16 * w + q; p[q] = incl_sum(LF[c * 64 + lane], lane); if (lane == 63) tot[c] = p[q]; }
        __syncthreads();
        if (tid < 128) { const float v = tot[tid]; const float inc = incl_sum(v, lane); if (tid == 63) xw[0] = inc; bst[tid] = inc - v; }
        __syncthreads();
        if (tid >= 64 && tid < 128) bst[tid] += xw[0];
        __syncthreads();
#pragma unroll
        for (int q = 0; q < 16; ++q) { const int c = 16 * w + q; p[q] += bst[c]; g[q] = IG[c * 64 + lane] - p[q]; pm[q] = incl_max(g[q], lane); if (lane == 63) cmx[c] = pm[q]; }
        __syncthreads();
        if (tid < 128) { const float v = cmx[tid]; const float inc = incl_max(v, lane); if (tid == 63) xw[1] = inc; float ex = __shfl_up(inc, 1); if (lane == 0) ex = 0.f; rst[tid] = fmaxf(ex, 0.f); }
        __syncthreads();
        if (tid >= 64 && tid < 128) rst[tid] = fmaxf(rst[tid], xw[1]);
        __syncthreads();
#pragma unroll
        for (int q = 0; q < 16; ++q) { const int c = 16 * w + q; const float Rs = rst[c], Rn = fmaxf(Rs, cmx[c]), Rrun = fmaxf(Rs, pm[q]);
            wkA[c * 64 + lane] = expf(g[q] - Rn); if (lane == 0) decA[c] = expf(Rs - Rn);
            if (slice == 0) { const size_t o = (size_t)bh * SEQ + c * 64 + lane; ((float*)(F.ws + WS_GA))[o] = g[q]; ((float*)(F.ws + WS_RR))[o] = Rrun; ((float*)(F.ws + WS_MM))[o] = p[q] + Rrun;
                if (lane == 0) ((float*)(F.ws + WS_RC))[bh * NCH + c] = Rs; } }
        }
        __syncthreads();
        if (mode == 1) continue;
        const int dkh = slice & 1, dvs = slice >> 1;
        const bf16_t* KTg = (const bf16_t*)(F.ws + WS_KT) + ((size_t)bh * NCH * DK + 64 * dkh) * 64;
        const bf16_t* VTg = (const bf16_t*)(F.ws + WS_VT) + ((size_t)bh * NCH * DV + 32 * dvs) * 64;
        const int dkr = 64 * dkh + 16 * (w >> 1), dvc = 32 * dvs + 16 * (w & 1);
        bf16_t* STp = (bf16_t*)(F.ws + WS_ST) + ((size_t)bh * NCH * DV + dvc + (lane & 15)) * DK + dkr + 4 * (lane >> 4);
        float* NSp = (float*)(F.ws + WS_NS) + (size_t)bh * NCH * DK + dkr + 4 * (lane >> 4);
        const bool ns_writer = (dvs == 0) && ((w & 1) == 0) && ((lane & 15) == 0);
        f32x4 accS = (f32x4){0.f, 0.f, 0.f, 0.f}, accN = (f32x4){0.f, 0.f, 0.f, 0.f};
        constexpr int PD = 4;
        u32x4 gk[PD], gv[PD];
        const int wr0 = (tid >> 3) * 128 + (((tid & 7) ^ ((tid >> 3) & 7)) << 4);
        const int arow = 16 * (w >> 1) + (lane & 15), brow = 16 * (w & 1) + (lane & 15), lq = lane >> 4;
#define SC_LOAD(set, cc) do { gk[set] = *(const u32x4*)(KTg + (size_t)(cc) * DK * 64 + tid * 8); if (tid < 256) gv[set] = *(const u32x4*)(VTg + (size_t)(cc) * DV * 64 + tid * 8); } while (0)
#define SC_WRITE(set, slot) do { LAS unsigned char* sb_ = ring + (slot) * SLOT; *(LAS u32x4*)(sb_ + wr0) = gk[set]; if (tid < 256) *(LAS u32x4*)(sb_ + 8192 + wr0) = gv[set]; } while (0)
#pragma unroll
        for (int q = 0; q < PD; ++q) SC_LOAD(q, q);
        SC_WRITE(0, 0); SC_WRITE(1, 1);
        SC_LOAD(0, PD); SC_LOAD(1, PD + 1);
        LBAR();
        for (int c0 = 0; c0 < NCH; c0 += PD) {
#pragma unroll
            for (int q2 = 0; q2 < PD; q2 += 2) {
                { const int cw = c0 + q2 + 2;
                  if (cw < NCH) { SC_WRITE((q2 + 2) % PD, (q2 + 2) % PD); SC_WRITE((q2 + 3) % PD, (q2 + 3) % PD);
                      if (cw + PD < NCH) { SC_LOAD((q2 + 2) % PD, cw + PD); SC_LOAD((q2 + 3) % PD, cw + PD + 1); } } }
#pragma unroll
                for (int qq = 0; qq < 2; ++qq) {
                    const int q = q2 + qq, c = c0 + q;
                    if (mode < 3) { { u32x2 o; o.x = pk2(accS[0], accS[1]); o.y = pk2(accS[2], accS[3]); *(u32x2*)(STp + (size_t)c * DV * DK) = o; }
                    if (ns_writer) *(f32x4*)(NSp + (size_t)c * DK) = accN; }
                    const float dec = decA[c];
                    accS = accS * dec; accN = accN * dec;
                    const LAS unsigned char* sb = ring + q * SLOT;
#pragma unroll
                    for (int kk = 0; kk < 2; ++kk) {
                        const LAS f32x4* wp = (const LAS f32x4*)(wkA + c * 64 + kk * 32 + 8 * lq);
                        const f32x4 w0 = wp[0], w1 = wp[1];
                        const u32x4 ka = *(const LAS u32x4*)(sb + arow * 128 + (((4 * kk + lq) ^ (arow & 7)) << 4));
                        const u32x4 vv = *(const LAS u32x4*)(sb + 8192 + brow * 128 + (((4 * kk + lq) ^ (brow & 7)) << 4));
                        u32x4 bv, b1;
                        bv.x = pk2(bflo(vv.x) * w0[0], bfhi(vv.x) * w0[1]); bv.y = pk2(bflo(vv.y) * w0[2], bfhi(vv.y) * w0[3]);
                        bv.z = pk2(bflo(vv.z) * w1[0], bfhi(vv.z) * w1[1]); bv.w = pk2(bflo(vv.w) * w1[2], bfhi(vv.w) * w1[3]);
                        b1.x = pk2(w0[0], w0[1]); b1.y = pk2(w0[2], w0[3]); b1.z = pk2(w1[0], w1[1]); b1.w = pk2(w1[2], w1[3]);
                        const bf16x8 af = __builtin_bit_cast(bf16x8, ka);
                        accS = __builtin_amdgcn_mfma_f32_16x16x32_bf16(af, __builtin_bit_cast(bf16x8, bv), accS, 0, 0, 0);
                        accN = __builtin_amdgcn_mfma_f32_16x16x32_bf16(af, __builtin_bit_cast(bf16x8, b1), accN, 0, 0, 0);
                    }
                }
                LBAR();
            }
        }
        asm volatile("" :: "v"(accS), "v"(accN));
#undef SC_LOAD
#undef SC_WRITE
    }
    __syncthreads();
}

constexpr int OC_AP = 0, OC_STRIDE = 400, OC_BVEC = 25600, OC_INV = 26368, OC_PART = 26624, OC_GS = 28672, OC_RT = 28928, OC_EMM = 29184, OC_HT = 32768, OC_HSTR = 528;
__device__ __forceinline__ void phase_out(Frame& F) {
    LAS unsigned char* AP = F.lds + OC_AP; LAS unsigned char* HT = F.lds + OC_HT;
    LAS float* bvec = (LAS float*)(F.lds + OC_BVEC); LAS float* inv = (LAS float*)(F.lds + OC_INV); LAS float* part = (LAS float*)(F.lds + OC_PART);
    LAS float* gs = (LAS float*)(F.lds + OC_GS); LAS float* Rt = (LAS float*)(F.lds + OC_RT); LAS float* emm = (LAS float*)(F.lds + OC_EMM);
    const int lane = F.lane, w = F.wave, tid = F.tid, l15 = lane & 15, lq = lane >> 4;
    const bf16_t* Qg = (const bf16_t*)(F.ws + WS_Q); const bf16_t* Kg = (const bf16_t*)(F.ws + WS_K);
    const bf16_t* VTg = (const bf16_t*)(F.ws + WS_VT); const bf16_t* STg = (const bf16_t*)(F.ws + WS_ST); const bf16_t* OGS = (const bf16_t*)(F.ws + WS_OGS);
    const float* GAg = (const float*)(F.ws + WS_GA); const float* RRg = (const float*)(F.ws + WS_RR); const float* MMg = (const float*)(F.ws + WS_MM);
    const float* NSg = (const float*)(F.ws + WS_NS); const float* RCg = (const float*)(F.ws + WS_RC); const float* MNG = F.in[I_MNG];
    bf16_t* HN = (bf16_t*)(F.ws + WS_U);
    const int mt = w >> 1, ntb = (w & 1) * 2, tq = tid >> 3, pq = tid & 7, NU = 16 * NCH;
    u32x4 bfr[2][6], qk[4], og[4]; f32x4 ng0, ng1; float sc_g = 0.f, sc_r = 0.f, sc_m = 0.f, sc_b = 0.f, Rc = 0.f;
    LAS unsigned char* QL = F.lds + 69632; LAS unsigned char* KL = F.lds + 86016;
    const int prow = tid >> 4, pch = tid & 15;
    const int pwr = prow * 256 + ((pch ^ (prow & 15)) << 4);
#define OC_LOAD_MAIN(U_) do { const int bh_ = (U_) >> 7, c_ = (U_) & 127, tk_ = (bh_ >> 2) * SEQ + c_ * 64, h_ = bh_ & 3; \
        _Pragma("unroll") for (int n = 0; n < 2; ++n) { const int dv = 32 * w + 16 * n + l15; \
            _Pragma("unroll") for (int kk = 0; kk < 2; ++kk) bfr[n][kk] = *(const u32x4*)(VTg + ((((size_t)bh_ * NCH + c_) * DV + dv) << 6) + 32 * kk + 8 * lq); \
            _Pragma("unroll") for (int kk = 0; kk < 4; ++kk) bfr[n][2 + kk] = *(const u32x4*)(STg + (((size_t)bh_ * NCH + c_) * DV + dv) * DK + 32 * kk + 8 * lq); } \
        qk[0] = *(const u32x4*)(Qg + (size_t)(tk_ + prow) * MQK + h_ * DK + 8 * pch); qk[1] = *(const u32x4*)(Qg + (size_t)(tk_ + prow + 32) * MQK + h_ * DK + 8 * pch); \
        qk[2] = *(const u32x4*)(Kg + (size_t)(tk_ + prow) * MQK + h_ * DK + 8 * pch); qk[3] = *(const u32x4*)(Kg + (size_t)(tk_ + prow + 32) * MQK + h_ * DK + 8 * pch); \
        if (tid < 64) { const size_t o_ = (size_t)bh_ * SEQ + c_ * 64 + tid; sc_g = GAg[o_]; sc_r = RRg[o_]; sc_m = MMg[o_]; sc_b = 1.0f; } \
        else if (tid < 192) sc_b = NSg[((size_t)bh_ * NCH + c_) * DK + tid - 64]; \
        Rc = RCg[bh_ * NCH + c_]; } while (0)
#define OC_LOAD_OGS(U_) do { const int bh_ = (U_) >> 7, c_ = (U_) & 127, tk_ = (bh_ >> 2) * SEQ + c_ * 64, h_ = bh_ & 3; \
        _Pragma("unroll") for (int q = 0; q < 4; ++q) og[q] = *(const u32x4*)(OGS + (size_t)(tk_ + (tid >> 5) + 16 * q) * MV + h_ * DV + 8 * (tid & 31)); \
        ng0 = *(const f32x4*)(MNG + h_ * DV + 8 * (tid & 31)); ng1 = *(const f32x4*)(MNG + h_ * DV + 8 * (tid & 31) + 4); } while (0)
    int unit = F.vcu;
    if (unit < NU) { OC_LOAD_MAIN(unit); OC_LOAD_OGS(unit); }
    for (; unit < NU; unit += F.G) {
        const int bh = unit >> 7, c = unit & 127, b = bh >> 2, h = bh & 3;
        const int tk0 = b * SEQ + c * 64;
        if (tid < 64) { gs[tid] = sc_g; Rt[tid] = sc_r; emm[tid] = expf(-sc_m); }
        if (tid < 192) bvec[tid] = sc_b;
        *(LAS u32x4*)(QL + pwr) = qk[0]; *(LAS u32x4*)(QL + 8192 + pwr) = qk[1]; *(LAS u32x4*)(KL + pwr) = qk[2]; *(LAS u32x4*)(KL + 8192 + pwr) = qk[3];
        const float Rc_cur = Rc;
        LBAR();
        u32x4 qa[4], kb[2][4];
#pragma unroll
        for (int kk = 0; kk < 4; ++kk) { { const int row = 16 * mt + l15; qa[kk] = *(const LAS u32x4*)(QL + row * 256 + (((4 * kk + lq) ^ (row & 15)) << 4)); }
#pragma unroll
            for (int n = 0; n < 2; ++n) { const int row = 16 * (ntb + n) + l15; kb[n][kk] = *(const LAS u32x4*)(KL + row * 256 + (((4 * kk + lq) ^ (row & 15)) << 4)); } }
        const u32x4 q0 = *(const LAS u32x4*)(QL + tq * 256 + (((2 * pq) ^ (tq & 15)) << 4)), q1 = *(const LAS u32x4*)(QL + tq * 256 + (((2 * pq + 1) ^ (tq & 15)) << 4));
        f32x4 pacc[2];
#pragma unroll
        for (int n = 0; n < 2; ++n) { pacc[n] = (f32x4){0.f, 0.f, 0.f, 0.f};
#pragma unroll
            for (int kk = 0; kk < 4; ++kk) pacc[n] = __builtin_amdgcn_mfma_f32_16x16x32_bf16(__builtin_bit_cast(bf16x8, qa[kk]), __builtin_bit_cast(bf16x8, kb[n][kk]), pacc[n], 0, 0, 0); }
#pragma unroll
        for (int n = 0; n < 2; ++n) { const int sl = 16 * (ntb + n) + l15; const float gsv = gs[sl];
#pragma unroll
            for (int r = 0; r < 4; ++r) { const int tl = 16 * mt + 4 * lq + r; const float pv = (sl <= tl) ? pacc[n][r] * expf(gsv - Rt[tl]) : 0.f;
                *(LAS bf16_t*)(AP + tl * OC_STRIDE + sl * 2) = (bf16_t)f2bf(pv); } }
        { const float wq = expf(Rc_cur - Rt[tq]);
          u32x4 o0, o1;
          o0.x = pk2(bflo(q0.x) * wq, bfhi(q0.x) * wq); o0.y = pk2(bflo(q0.y) * wq, bfhi(q0.y) * wq); o0.z = pk2(bflo(q0.z) * wq, bfhi(q0.z) * wq); o0.w = pk2(bflo(q0.w) * wq, bfhi(q0.w) * wq);
          o1.x = pk2(bflo(q1.x) * wq, bfhi(q1.x) * wq); o1.y = pk2(bflo(q1.y) * wq, bfhi(q1.y) * wq); o1.z = pk2(bflo(q1.z) * wq, bfhi(q1.z) * wq); o1.w = pk2(bflo(q1.w) * wq, bfhi(q1.w) * wq);
          *(LAS u32x4*)(AP + tq * OC_STRIDE + 128 + 32 * pq) = o0; *(LAS u32x4*)(AP + tq * OC_STRIDE + 128 + 32 * pq + 16) = o1; }
        LBAR();
        { float s = 0.f;
#pragma unroll
          for (int q = 0; q < 3; ++q) { const u32x4 a = *(const LAS u32x4*)(AP + tq * OC_STRIDE + 48 * pq + 16 * q); const LAS f32x4* bp = (const LAS f32x4*)(bvec + 24 * pq + 8 * q); const f32x4 b0 = bp[0], b1 = bp[1];
              s += bflo(a.x) * b0[0] + bfhi(a.x) * b0[1] + bflo(a.y) * b0[2] + bfhi(a.y) * b0[3] + bflo(a.z) * b1[0] + bfhi(a.z) * b1[1] + bflo(a.w) * b1[2] + bfhi(a.w) * b1[3]; }
          s += __shfl_xor(s, 1); s += __shfl_xor(s, 2); s += __shfl_xor(s, 4);
          if (pq == 0) inv[tq] = 1.0f / fmaxf(fabsf(s), emm[tq]); }
        f32x4 acc[4][2];
#pragma unroll
        for (int m = 0; m < 4; ++m)
#pragma unroll
            for (int n = 0; n < 2; ++n) acc[m][n] = (f32x4){0.f, 0.f, 0.f, 0.f};
#pragma unroll
        for (int kk = 0; kk < 6; ++kk) {
            bf16x8 af[4];
#pragma unroll
            for (int m = 0; m < 4; ++m) af[m] = *(const LAS bf16x8*)(AP + (16 * m + l15) * OC_STRIDE + 64 * kk + 16 * lq);
#pragma unroll
            for (int m = 0; m < 4; ++m)
#pragma unroll
                for (int n = 0; n < 2; ++n) acc[m][n] = __builtin_amdgcn_mfma_f32_16x16x32_bf16(af[m], __builtin_bit_cast(bf16x8, bfr[n][kk]), acc[m][n], 0, 0, 0);
        }
        const int nxt = unit + F.G;
        if (nxt < NU) OC_LOAD_MAIN(nxt);
        LBAR();
#pragma unroll
        for (int m = 0; m < 4; ++m)
#pragma unroll
            for (int r = 0; r < 4; ++r) { const int tl = 16 * m + 4 * lq + r; const float iv = inv[tl];
                const float h0 = acc[m][0][r] * iv, h1 = acc[m][1][r] * iv;
                *(LAS bf16_t*)(HT + tl * OC_HSTR + (32 * w + l15) * 2) = (bf16_t)f2bf(h0); *(LAS bf16_t*)(HT + tl * OC_HSTR + (32 * w + 16 + l15) * 2) = (bf16_t)f2bf(h1);
                float s = h0 * h0 + h1 * h1; s += __shfl_xor(s, 1); s += __shfl_xor(s, 2); s += __shfl_xor(s, 4); s += __shfl_xor(s, 8);
                if (l15 == 0) part[w * 64 + tl] = s; }
        LBAR();
#pragma unroll
        for (int q = 0; q < 4; ++q) { const int row = (tid >> 5) + 16 * q, ch = tid & 31; float ss = 0.f;
#pragma unroll
            for (int ww = 0; ww < 8; ++ww) ss += part[ww * 64 + row];
            const float rs = 1.0f / sqrtf(ss * (1.0f / DV) + EPS);
            const u32x4 hv = *(const LAS u32x4*)(HT + row * OC_HSTR + ch * 16); const u32x4 g = og[q];
            float f0 = bflo(hv.x) * rs * ng0[0] * bflo(g.x), f1 = bfhi(hv.x) * rs * ng0[1] * bfhi(g.x), f2 = bflo(hv.y) * rs * ng0[2] * bflo(g.y), f3 = bfhi(hv.y) * rs * ng0[3] * bfhi(g.y);
            float f4 = bflo(hv.z) * rs * ng1[0] * bflo(g.z), f5 = bfhi(hv.z) * rs * ng1[1] * bfhi(g.z), f6 = bflo(hv.w) * rs * ng1[2] * bflo(g.w), f7 = bfhi(hv.w) * rs * ng1[3] * bfhi(g.w);
            if (FP8_MOUT) { u32x2 o8; o8.x = pk4_fp8_sat(2.f * f0, 2.f * f1, 2.f * f2, 2.f * f3); o8.y = pk4_fp8_sat(2.f * f4, 2.f * f5, 2.f * f6, 2.f * f7);
                *(u32x2*)((unsigned char*)HN + (size_t)(tk0 + row) * MV + h * DV + 8 * ch) = o8; }
            else { u32x4 o; o.x = pk2(f0, f1); o.y = pk2(f2, f3); o.z = pk2(f4, f5); o.w = pk2(f6, f7);
            *(u32x4*)(HN + (size_t)(tk0 + row) * MV + h * DV + 8 * ch) = o; } }
        if (nxt < NU) OC_LOAD_OGS(nxt);
    }
#undef OC_LOAD_MAIN
#undef OC_LOAD_OGS
    __syncthreads();
}

__device__ __forceinline__ void phase_conv(Frame& F) {
    const bf16_t* BG = (const bf16_t*)(F.ws + WS_BG); const bf16_t* Z = (const bf16_t*)(F.ws + WS_Z); bf16_t* Y = (bf16_t*)(F.ws + WS_Y);
    const int cg = F.tid & 127, rsub = F.tid >> 7, col = 8 * cg;
    float w0[8], w1[8], w2[8], cb[8];
#pragma unroll
    for (int i = 0; i < 8; ++i) { w0[i] = F.in[I_CCW][col + i]; w1[i] = F.in[I_CCW][D + col + i]; w2[i] = F.in[I_CCW][2 * D + col + i]; cb[i] = F.in[I_CCB][col + i]; }
    for (int batch = F.vcu; batch < T / 128; batch += F.G) {
        const int t0 = batch * 128 + rsub * 32, s0 = t0 % SEQ;
        u32x4 z2 = (u32x4){0u, 0u, 0u, 0u}, z1 = z2;
        if (s0 >= 2) z2 = *(const u32x4*)(Z + (size_t)(t0 - 2) * D + col);
        if (s0 >= 1) z1 = *(const u32x4*)(Z + (size_t)(t0 - 1) * D + col);
#pragma unroll 4
        for (int r = 0; r < 32; ++r) {
            const u32x4 z0 = *(const u32x4*)(Z + (size_t)(t0 + r) * D + col), bg = *(const u32x4*)(BG + (size_t)(t0 + r) * D + col);
            float o[8];
#pragma unroll
            for (int i = 0; i < 4; ++i) {
                o[2 * i] = bflo(bg[i]) * (w0[2 * i] * bflo(z2[i]) + w1[2 * i] * bflo(z1[i]) + w2[2 * i] * bflo(z0[i]) + cb[2 * i]);
                o[2 * i + 1] = bfhi(bg[i]) * (w0[2 * i + 1] * bfhi(z2[i]) + w1[2 * i + 1] * bfhi(z1[i]) + w2[2 * i + 1] * bfhi(z0[i]) + cb[2 * i + 1]); }
            if (FP8_COUT) { u32x2 o8; o8.x = pk4_fp8_sat(o[0], o[1], o[2], o[3]); o8.y = pk4_fp8_sat(o[4], o[5], o[6], o[7]); *(u32x2*)((unsigned char*)Y + (size_t)(t0 + r) * D + col) = o8; }
            else { u32x4 ov; ov.x = pk2(o[0], o[1]); ov.y = pk2(o[2], o[3]); ov.z = pk2(o[4], o[5]); ov.w = pk2(o[6], o[7]);
            *(u32x4*)(Y + (size_t)(t0 + r) * D + col) = ov; }
            z2 = z1; z1 = z0;
        }
    }
}

__device__ __forceinline__ void moe_table(Frame& F, int layer) {
    __syncthreads();
    if (F.tid == 0) { int a = 0; for (int e = 0; e < NE; ++e) { const int c = (int)__hip_atomic_load(F.ctl + CW_CNT + 64 * layer + e, RLX_AGENT); F.MISC[16 + e] = (unsigned)a; F.MISC[40 + e] = (unsigned)c; a += (c + 255) >> 8; } F.MISC[16 + NE] = (unsigned)a; }
    __syncthreads();
}

#ifndef TIMER_PHASE
#define TIMER_PHASE (-1)
#endif
#define STAMP(k) do { if (TIMER_PHASE >= 0 && blockIdx.x == 0 && threadIdx.x == 0) { unsigned long long t_ = __builtin_amdgcn_s_memrealtime(); ((unsigned long long*)karg_ptr(21))[4096 + (k)] = t_; } } while (0)
constexpr int N_PHASES = 17;
#define WSP(T_, off) ((T_*)(F.ws + (off)))
__global__ void __launch_bounds__(NTHR, 2) fwd_kernel(Args args) {
    extern __shared__ __attribute__((aligned(16))) unsigned char lds_raw[];
#define MAKE_FRAME() Frame F; { int t_ = threadIdx.x, bx_ = blockIdx.x, g_ = gridDim.x; asm volatile("" : "+v"(t_), "+s"(bx_), "+s"(g_)); \
        F.lds = (LAS unsigned char*)lds_raw; F.MISC = (volatile LAS unsigned*)(F.lds + MISC_OFF); F.tid = t_; F.lane = t_ & 63; F.wave = __builtin_amdgcn_readfirstlane(t_ >> 6); \
        F.G = g_; F.bx = bx_; F.vcu = (g_ % 8 == 0) ? (bx_ % 8) * (g_ / 8) + bx_ / 8 : bx_; }
    const int lo = args.ph_lo, hi = args.ph_hi;
    const bool one_launch = (hi - lo) > 1;
    XcdBarrier bar;
    { MAKE_FRAME();
      for (int u = F.tid; u < 256; u += NTHR) F.MISC[u] = 0u;
      __syncthreads();
      bar.bar = (unsigned*)(F.ctl + CW_BAR); bar.x = 0; bar.st = nullptr;
      if (one_launch) bar = xcd_barrier_post((unsigned*)(F.ctl + CW_BAR), F.MISC + 8); }
    STAMP(0);
#ifdef PH_ONLY
#define IN(k) ((k) == PH_ONLY && lo <= (k) && (k) < hi)
#else
#define IN(k) (lo <= (k) && (k) < hi)
#endif
#define SEAM(k) do { if (IN(k) && IN((k) + 1)) { xcd_barrier(bar); STAMP((k) + 1); } } while (0)
#ifndef DUP_MODE
#define DUP_MODE 0
#endif
#ifndef DUP_PHASE
#define DUP_PHASE (-1)
#endif
#define PHASE(k) if (IN(k)) { for (int rep_ = 0; rep_ < (((k) == DUP_PHASE) ? 2 : 1); ++rep_) { MAKE_FRAME(); asm volatile("; PHASE_MARK " #k);
#define END_PHASE(k) } } SEAM(k);
    PHASE(0) phase_prologue(F); END_PHASE(0)
    PHASE(1) row_pass<0>(F, 0); END_PHASE(1)
    PHASE(2) pg8::DenseOrder S; S.init(T, 3 * D, F.G, F.bx);
        pg8::EpiM1 E{WSP(bf16_t, WS_Q), WSP(bf16_t, WS_K), WSP(bf16_t, WS_KT), WSP(bf16_t, WS_VT), WSP(bf16_t, WS_OGS), F.lds + EPI_OFF};
        if (FP8_G1 == 2) { S.init(T, 4 * 256, F.G, F.bx); { pg8::Gemm g{WSP(bf16_t, WS_U), WSP(bf16_t, WS_W0), D};
                pg8::gemm_phase<pg8::EpiM1, pg8::DenseOrder, false, true, true>(F.lds, g, S, E, F.tid); }
            S.init(T, 8 * 256, F.G, F.bx); S.pn0 = 4; { pg8::Gemm g{WSP(bf16_t, WS_U8), (const bf16_t*)(F.ws + WS_W0 + 2 * MiB), D / 2, 0x7a7a7a7a, 0x7f7f7f7f};
                pg8::gemm_phase<pg8::EpiM1, pg8::DenseOrder, true, true, true, true>(F.lds, g, S, E, F.tid); } }
        else if (FP8_G1) { pg8::Gemm g{WSP(bf16_t, WS_U8), WSP(bf16_t, WS_W0), D / 2, 0x7a7a7a7a, 0x7f7f7f7f};
            pg8::gemm_phase<pg8::EpiM1, pg8::DenseOrder, true, true, true, true>(F.lds, g, S, E, F.tid); }
        else { pg8::Gemm g{WSP(bf16_t, WS_U), WSP(bf16_t, WS_W0), D};
            pg8::gemm_phase<pg8::EpiM1, pg8::DenseOrder, false, true, true>(F.lds, g, S, E, F.tid); } END_PHASE(2)
    PHASE(3) phase_scan(F, rep_ == 0 ? 0 : DUP_MODE); END_PHASE(3)
    PHASE(4) phase_out(F); END_PHASE(4)
    PHASE(5) pg8::DenseOrder S; S.init(T, D, F.G, F.bx);
        pg8::EpiRes<true> E{F.in[I_X], WSP(bf16_t, WS_XB), WSP(float, WS_MOD) + 2 * D, (DBG_SKIP & 1) ? 0.f : 1.f};
        if (FP8_MOUT) { pg8::Gemm g{WSP(bf16_t, WS_U), WSP(bf16_t, WS_W1), D / 2, 0x7a7a7a7a, 0x7e7e7e7e};
            pg8::gemm_phase<pg8::EpiRes<true>, pg8::DenseOrder, true, true, true, true>(F.lds, g, S, E, F.tid); }
        else { pg8::Gemm g{WSP(bf16_t, WS_U), WSP(bf16_t, WS_W1), D};
            pg8::gemm_phase<pg8::EpiRes<true>, pg8::DenseOrder, false, true, true>(F.lds, g, S, E, F.tid); } END_PHASE(5)
#define WL(L_, off) WSP(bf16_t, ((L_) == 0 ? (size_t)0 : WS_WL1) + (off))
#define MOE_BLOCK(L, p0, p1, p2) \
    PHASE(p0) row_pass<1>(F, L); END_PHASE(p0) \
    PHASE(p1) moe_table(F, L); \
        pg8::Gemm g{WSP(bf16_t, WS_U8), WL(L, WS_WUP), D / 2, 0x7a7a7a7a, 0x7f7f7f7f}; pg8::MoeOrder S{(const LAS int*)(F.MISC + 16), (const LAS int*)(F.MISC + 40), WSP(const int, WS_LIST), F.G, F.vcu, 1024}; \
        pg8::EpiGlu<true, true> E{WSP(bf16_t, WS_A8), DE, 0, nullptr, 0, 2.0f}; \
        pg8::gemm_phase<pg8::EpiGlu<true, true>, pg8::MoeOrder, true, true, true, true>(F.lds, g, S, E, F.tid); END_PHASE(p1) \
    PHASE(p2) moe_table(F, L); \
        pg8::Gemm g{WSP(bf16_t, WS_A8), WL(L, WS_WDN), DE / 2, 0x7b7b7b7b, 0x7e7e7e7e}; pg8::MoeOrder S{(const LAS int*)(F.MISC + 16), (const LAS int*)(F.MISC + 40), nullptr, F.G, F.vcu, 1024}; \
        pg8::EpiBf E{WSP(bf16_t, WS_O), D}; \
        pg8::gemm_phase<pg8::EpiBf, pg8::MoeOrder, true, true, true, true>(F.lds, g, S, E, F.tid); END_PHASE(p2)
    MOE_BLOCK(0, 6, 7, 8)
    PHASE(9) row_pass<2>(F, 1); convert_weights(F, 1); END_PHASE(9)
    PHASE(10) pg8::DenseOrder S; S.init(T, 3 * D, F.G, F.bx);
        pg8::EpiGlu<false> E{WSP(bf16_t, WS_Z), D, 4, WSP(bf16_t, WS_BG), D, 0.f};
        if (FP8_CIN) { pg8::Gemm g{WSP(bf16_t, WS_U8), WL(1, WS_W0), D / 2, 0x7a7a7a7a, 0x7f7f7f7f};
            pg8::gemm_phase<pg8::EpiGlu<false>, pg8::DenseOrder, true, true, true, true>(F.lds, g, S, E, F.tid); }
        else { pg8::Gemm g{WSP(bf16_t, WS_U), WL(1, WS_W0), D};
            pg8::gemm_phase<pg8::EpiGlu<false>, pg8::DenseOrder, false, true, true>(F.lds, g, S, E, F.tid); } END_PHASE(10)
    PHASE(11) phase_conv(F); END_PHASE(11)
    PHASE(12) pg8::DenseOrder S; S.init(T, D, F.G, F.bx);
        pg8::EpiRes<false> E{WSP(bf16_t, WS_XB), WSP(bf16_t, WS_XB), WSP(float, WS_MOD) + (size_t)NB * 6 * D + 2 * D, (DBG_SKIP & 4) ? 0.f : 1.f};
        if (FP8_COUT) { pg8::Gemm g{WSP(bf16_t, WS_Y), WL(1, WS_W1), D / 2, 0x7a7a7a7a, 0x7f7f7f7f};
            pg8::gemm_phase<pg8::EpiRes<false>, pg8::DenseOrder, true, true, true, true>(F.lds, g, S, E, F.tid); }
        else { pg8::Gemm g{WSP(bf16_t, WS_Y), WL(1, WS_W1), D};
            pg8::gemm_phase<pg8::EpiRes<false>, pg8::DenseOrder, false, true, true>(F.lds, g, S, E, F.tid); } END_PHASE(12)
    MOE_BLOCK(1, 13, 14, 15)
    if (IN(16)) { MAKE_FRAME(); asm volatile("; PHASE_MARK 16"); row_pass<3>(F, 1);
    }

    if (TIMER_PHASE >= 0 && one_launch) {
        STAMP(17);
        xcd_barrier(bar);
        const unsigned long long* ts = (const unsigned long long*)karg_ptr(21) + 4096;
        const unsigned long long d = __hip_atomic_load(ts + TIMER_PHASE + 1, RLX_AGENT) - __hip_atomic_load(ts + TIMER_PHASE, RLX_AGENT);
        const unsigned long long t0 = __builtin_amdgcn_s_memrealtime();
        while (__builtin_amdgcn_s_memrealtime() - t0 < 4ull * d) __builtin_amdgcn_s_sleep(8);
    }
#undef IN
#undef SEAM
}

extern "C" void kernel_launch(void* const* d_in, const int* in_sizes, int n_in, void* d_out, int out_size, void* d_ws, size_t ws_size, hipStream_t stream) {
    static int grid = 0;
    if (grid == 0) {
        if (n_in != 20 || in_sizes[0] != T * D || out_size != T * D || ws_size < WS_END) { fprintf(stderr, "kernel_launch: unexpected shapes: n_in %d in0 %d out %d ws %zu\n", n_in, n_in > 0 ? in_sizes[0] : -1, out_size, ws_size); grid = -1; return; }
        int dev = 0, cus = 0, per_cu = 0;
        if (hipGetDevice(&dev) != hipSuccess || hipDeviceGetAttribute(&cus, hipDeviceAttributeMultiprocessorCount, dev) != hipSuccess) { grid = -1; return; }
        if (hipFuncSetAttribute((const void*)fwd_kernel, hipFuncAttributeMaxDynamicSharedMemorySize, LDS_BYTES) != hipSuccess) { fprintf(stderr, "kernel_launch: hipFuncSetAttribute failed\n"); grid = -1; return; }
        if (hipOccupancyMaxActiveBlocksPerMultiprocessor(&per_cu, (const void*)fwd_kernel, NTHR, LDS_BYTES) != hipSuccess || per_cu < 1) { fprintf(stderr, "kernel_launch: occupancy query says %d blocks per CU\n", per_cu); (void)hipGetLastError(); grid = -1; return; }
        grid = cus;
        if (grid != 256) fprintf(stderr, "kernel_launch: %d CUs (built for 256)\n", grid);
    }
    if (grid < 0) return;
    (void)hipMemsetAsync((char*)d_ws + WS_CTL, 0, CTL_ZERO_BYTES, stream);
    Args a{};
    for (int i = 0; i < 20; ++i) a.in[i] = (const float*)d_in[i];
    a.out = (float*)d_out; a.ws = (unsigned char*)d_ws;
#if MK_N_LAUNCHES == 1
    a.ph_lo = 0; a.ph_hi = N_PHASES;
    void* kargs[] = {&a};
    hipError_t e = hipLaunchCooperativeKernel((const void*)fwd_kernel, dim3(grid), dim3(NTHR), kargs, LDS_BYTES, stream);
    if (e != hipSuccess) fprintf(stderr, "kernel_launch: cooperative launch failed: %s\n", hipGetErrorString(e));
#else
    for (int p = 0; p < N_PHASES; ++p) { a.ph_lo = p; a.ph_hi = p + 1; hipLaunchKernelGGL(fwd_kernel, dim3(grid), dim3(NTHR), LDS_BYTES, stream, a); }
#endif
}
```

```cpp
#include <hip/hip_runtime.h>
#include <cstdio>
#include <cstdint>

#ifndef FP8_G1
#define FP8_G1 2
#endif
#ifndef FP8_MOUT
#define FP8_MOUT 1
#endif
#ifndef FP8_COUT
#define FP8_COUT 1
#endif
#ifndef FP8_CIN
#define FP8_CIN 1
#endif
#ifndef DBG_SKIP
#define DBG_SKIP 0
#endif
#ifndef MK_N_LAUNCHES
#define MK_N_LAUNCHES 1
#endif

#define LAS __attribute__((address_space(3)))
#define GAS __attribute__((address_space(1)))
typedef unsigned short bf16_t;
typedef short bf16x8 __attribute__((ext_vector_type(8)));
typedef float f32x4 __attribute__((ext_vector_type(4)));
typedef float f32x2 __attribute__((ext_vector_type(2)));
typedef unsigned u32x4 __attribute__((ext_vector_type(4)));
typedef unsigned u32x2 __attribute__((ext_vector_type(2)));
typedef GAS unsigned gu32;
#define RLX_AGENT __ATOMIC_RELAXED, __HIP_MEMORY_SCOPE_AGENT
#define LDS_WAIT() asm volatile("s_waitcnt lgkmcnt(0)" ::: "memory")
#define VM_WAIT() asm volatile("s_waitcnt vmcnt(0)" ::: "memory")

constexpr int NB = 4, SEQ = 8192, D = 1024, T = NB * SEQ;
constexpr int NH = 4, DK = 128, DV = 256, MQK = NH * DK, MV = NH * DV, MPROJ = 2 * MQK + 2 * MV + 2 * NH;
constexpr int CH = 64, NCH = SEQ / CH;
constexpr int NE = 16, DE = 512, LCAP = 65536;
constexpr int SLOT_ROWS = 2 * T + NE * 256;
constexpr float EPS = 1e-6f;
constexpr int NWAVES = 8, NTHR = 512;

constexpr size_t MiB = 1u << 20;
constexpr size_t WS_CTL = 0, CTL_ZERO_BYTES = 64 * 1024;
constexpr size_t WS_MOD = 1 * MiB;
constexpr size_t WS_W0 = 2 * MiB;
constexpr size_t WS_W1 = 8 * MiB;
constexpr size_t WS_WUP = 10 * MiB;
constexpr size_t WS_WDN = 42 * MiB;
constexpr size_t WS_WL1 = 338 * MiB;
constexpr size_t WS_IG = 62 * MiB;
constexpr size_t WS_LF = WS_IG + 512 * 1024;
constexpr size_t WS_GA = WS_LF + 512 * 1024;
constexpr size_t WS_RR = WS_GA + 512 * 1024;
constexpr size_t WS_MM = WS_RR + 512 * 1024;
constexpr size_t WS_RC = WS_MM + 512 * 1024;
constexpr size_t WS_NS = 65 * MiB;
constexpr size_t WS_TOK = 66 * MiB;
constexpr size_t WS_LIST = 67 * MiB;
constexpr size_t WS_U = 72 * MiB;
constexpr size_t WS_Q = 136 * MiB;
constexpr size_t WS_K = 168 * MiB;
constexpr size_t WS_KT = 200 * MiB;
constexpr size_t WS_VT = 232 * MiB;
constexpr size_t WS_OGS = 296 * MiB;
constexpr size_t WS_ST = 360 * MiB;
constexpr size_t WS_A = 136 * MiB;
constexpr size_t WS_O = 204 * MiB;
constexpr size_t WS_BG = 136 * MiB;
constexpr size_t WS_Z = 200 * MiB;
constexpr size_t WS_Y = 264 * MiB;
constexpr size_t WS_XB = 400 * MiB;
constexpr size_t WS_U8 = 464 * MiB;
constexpr size_t WS_A8 = 136 * MiB;
constexpr size_t WS_END = 496 * MiB;
static_assert(WS_A + (size_t)SLOT_ROWS * DE * 2 <= WS_O && WS_O + (size_t)SLOT_ROWS * D * 2 <= WS_ST, "moe map");

constexpr int CW_CNT = 64;
constexpr int CW_CVT = 256;
constexpr int CW_BAR = 1024;

constexpr int RING_BYTES = 131072;
constexpr int MISC_OFF = RING_BYTES;
constexpr int EPI_OFF = MISC_OFF + 1024;
constexpr int LDS_BYTES = 149504;

typedef __bf16 bf16x2_t __attribute__((ext_vector_type(2)));
__device__ __forceinline__ unsigned f2bf(float f) { return (unsigned)__builtin_bit_cast(unsigned short, (__bf16)f); }
__device__ __forceinline__ unsigned pk2(float lo, float hi) { bf16x2_t v; v[0] = (__bf16)lo; v[1] = (__bf16)hi; return __builtin_bit_cast(unsigned, v); }
__device__ __forceinline__ float bf2f(unsigned short h) { return __builtin_bit_cast(float, (unsigned)h << 16); }
__device__ __forceinline__ float bflo(unsigned w) { return __builtin_bit_cast(float, w << 16); }
__device__ __forceinline__ float bfhi(unsigned w) { return __builtin_bit_cast(float, w & 0xffff0000u); }
__device__ __forceinline__ unsigned cvt_pk_bf16(float lo, float hi) { unsigned r; asm volatile("v_cvt_pk_bf16_f32 %0, %1, %2" : "=v"(r) : "v"(lo), "v"(hi)); return r; }
__device__ __forceinline__ unsigned pk4_fp8(float a, float b, float c, float d) { int w = 0; w = __builtin_amdgcn_cvt_pk_fp8_f32(a, b, w, false); w = __builtin_amdgcn_cvt_pk_fp8_f32(c, d, w, true); return (unsigned)w; }
__device__ __forceinline__ unsigned pk4_fp8_sat(float a, float b, float c, float d) {
    return pk4_fp8(__builtin_amdgcn_fmed3f(a, -448.f, 448.f), __builtin_amdgcn_fmed3f(b, -448.f, 448.f), __builtin_amdgcn_fmed3f(c, -448.f, 448.f), __builtin_amdgcn_fmed3f(d, -448.f, 448.f)); }
__device__ __forceinline__ float fast_exp(float x) { return __builtin_amdgcn_exp2f(x * 1.44269504089f); }
__device__ __forceinline__ float sigmoidf_(float x) { return __builtin_amdgcn_rcpf(1.0f + fast_exp(-x)); }

namespace pg8 {
constexpr int BM = 256, BK = 64, HALF = 128, HTB = HALF * BK * 2, STAGE_BYTES = 8 * HTB, NXCD = 8, WGM = 8;
__host__ __device__ __forceinline__ int lds_byte(int r, int c) { const int st = (r >> 4) * 2 + (c >> 5), rr = r & 15, cc = c & 31, ob = rr * 64 + cc * 2; return st * 1024 + (ob ^ (((ob >> 9) & 1) << 5)); }
__host__ __device__ __forceinline__ void stage_rc(int b, int& R, int& C) { const int st = b / 1024, sb = b % 1024, swz = sb ^ (((sb >> 9) & 1) << 5); R = (st >> 1) * 16 + swz / 64; C = (st & 1) * 32 + (swz % 64) / 2; }
__host__ __device__ __forceinline__ int perm32(int rho) { const int n = rho >> 4, i = rho & 15; return 8 * (i >> 2) + 4 * n + (i & 3); }

struct Unit { int arow0, brow0, pm, pn, e, nvalid; const int* alist; };
typedef int i32x8 __attribute__((ext_vector_type(8)));
typedef int i32x4 __attribute__((ext_vector_type(4)));
template <bool FP8> struct Frag;
template <> struct Frag<false> { bf16x8 h[2]; };
template <> struct Frag<true> { i32x8 v; };
struct Gemm { const bf16_t* A; const bf16_t* Bt; int K; int scale_w = 0x7f7f7f7f, scale_a = 0x7f7f7f7f; LAS int* tokbuf = nullptr; const int* zero = nullptr; };

struct DenseOrder {
    int nM, nN, nwg, G, c, pn0 = 0;
    __device__ void init(int M, int N, int G_, int c_) { nM = M / BM; nN = N / BM; nwg = nM * nN; G = G_; c = c_; }
    __device__ bool next(int i, Unit& u) const {
        const long L = (long)i * G + c; if (L >= nwg) return false;
        int wgid = (int)L; { const int q = nwg / NXCD, r = nwg % NXCD, xcd = wgid % NXCD, off = wgid / NXCD; wgid = (xcd < r ? xcd * (q + 1) : r * (q + 1) + (xcd - r) * q) + off; }
        const int nig = WGM * nN, gid = wgid / nig, fm = gid * WGM, gsz = (nM - fm) < WGM ? (nM - fm) : WGM;
        u.pm = fm + ((wgid % nig) % gsz); u.pn = pn0 + (wgid % nig) / gsz; u.arow0 = u.pm * BM; u.brow0 = u.pn * BM; u.e = 0; u.nvalid = 256; u.alist = nullptr; return true;
    }
};
struct MoeOrder {
    const LAS int* tpre; const LAS int* cnt; const int* list; int G, vcu, bn;
    __device__ bool next(int i, Unit& u) const {
        const int U = i * G + vcu, rt = U >> 2, pn = U & 3;
        if (rt >= tpre[NE]) return false;
        int e = 0;
#pragma unroll
        for (int k = 1; k < NE; ++k) e += (rt >= tpre[k]) ? 1 : 0;
        const int r = rt - tpre[e];
        u.arow0 = rt * BM; u.brow0 = e * bn + pn * BM; u.pm = rt; u.pn = pn; u.e = e; u.nvalid = min(256, cnt[e] - r * 256); u.alist = list ? list + e * LCAP + r * 256 : nullptr; return true;
    }
};

template <class Epi, class Sched, bool GATHER, bool ALIGN_EPI, bool SP2, bool FP8 = false>
__device__ __forceinline__ void gemm_phase(LAS unsigned char* lds, const Gemm g, const Sched& S, const Epi& E, const int tid) {
    const int wid = __builtin_amdgcn_readfirstlane(tid >> 6), lane = tid & 63, wr = wid >> 2, wc = wid & 3, fr = lane & 15, fq = lane >> 4;
    const int K = g.K, nt = K / BK;
    unsigned voffA[2], voffB[2];
#pragma unroll
    for (int i = 0; i < 2; ++i) { int R, C; stage_rc(tid * 16 + i * 8192, R, C); const int Rb = Epi::PERM ? ((R & ~31) + perm32(R & 31)) : R;
        voffA[i] = (unsigned)(R * K + C) * 2u; voffB[i] = (unsigned)(Rb * K + C) * 2u; }
    const size_t kstep = (size_t)(BK * 2);
    const size_t hstep = (size_t)HALF * K * 2;
    const unsigned ldsw = (unsigned)wid * 1024u;
    const int aoff = lds_byte(wr * 64 + fr, fq * 8); int boff = 65536 + lds_byte(wc * 32 + fr, fq * 8); asm volatile("" : "+v"(boff));
#define PG8_SA(b, h) (((b) * 2 + (h)) * HTB)
#define PG8_SB(b, h) ((4 + (b) * 2 + (h)) * HTB)
#define PG8_SBR(b, h) (((b) * 2 + (h)) * HTB)
#define PG8_STAGE(bufoff, gbase, voff) do { _Pragma("unroll") for (int _i = 0; _i < 2; ++_i) \
        __builtin_amdgcn_global_load_lds((const unsigned*)((const char*)(gbase) + (voff)[_i]), (LAS unsigned*)(lds + (bufoff) + ldsw + _i * 8192), 16, 0, 0); } while (0)
#define PG8_STAGE_A(bufoff, kb, h, vo) do { if constexpr (GATHER) { PG8_STAGE(bufoff, kb, (vo)[h]); } else { PG8_STAGE(bufoff, (kb) + (h) * hstep, voffA); } } while (0)
#define PG8_LDF(dst, off) do { if constexpr (FP8) { const i32x4 lo_ = *(const LAS i32x4*)(lds + (off)), hi_ = *(const LAS i32x4*)(lds + (off) + 1024); (dst).v = __builtin_shufflevector(lo_, hi_, 0, 1, 2, 3, 4, 5, 6, 7); } \
        else { (dst).h[0] = *(const LAS bf16x8*)(lds + (off)); (dst).h[1] = *(const LAS bf16x8*)(lds + (off) + 1024); } } while (0)
#define PG8_LDA(dst, b, h) do { _Pragma("unroll") for (int m = 0; m < 4; ++m) PG8_LDF(dst[m], PG8_SA(b, h) + aoff + m * 2048); } while (0)
#define PG8_LDB(dst, b, h) do { _Pragma("unroll") for (int n = 0; n < 2; ++n) PG8_LDF(dst[n], PG8_SBR(b, h) + boff + n * 2048); } while (0)
#define PG8_MMA(ai, bj, At, Bt) do { __builtin_amdgcn_s_setprio(1); _Pragma("unroll") for (int m = 0; m < 4; ++m) _Pragma("unroll") for (int n = 0; n < 2; ++n) { \
        if constexpr (FP8) acc[ai][bj][m][n] = __builtin_amdgcn_mfma_scale_f32_16x16x128_f8f6f4(Bt[n].v, At[m].v, acc[ai][bj][m][n], 0, 0, 0, g.scale_w, 0, g.scale_a); \
        else { _Pragma("unroll") for (int k = 0; k < 2; ++k) acc[ai][bj][m][n] = __builtin_amdgcn_mfma_f32_16x16x32_bf16(Bt[n].h[k], At[m].h[k], acc[ai][bj][m][n], 0, 0, 0); } } \
        __builtin_amdgcn_s_setprio(0); } while (0)
#define PG8_WAIT_V(n) asm volatile("s_waitcnt vmcnt(" #n ")" ::: "memory")
#define PG8_WAIT_L(n) asm volatile("s_waitcnt lgkmcnt(" #n ")" ::: "memory")
#define PG8_BAR __builtin_amdgcn_s_barrier()
#define PG8_SCHED __builtin_amdgcn_sched_barrier(0)
    Unit cur, nxt; int ui = 0;
    if (!S.next(0, cur)) return;
    f32x4 acc[2][2][4][2];
#pragma unroll
    for (int a = 0; a < 2; ++a)
#pragma unroll
        for (int b = 0; b < 2; ++b)
#pragma unroll
            for (int m = 0; m < 4; ++m)
#pragma unroll
                for (int n = 0; n < 2; ++n) acc[a][b][m][n] = (f32x4){0.f, 0.f, 0.f, 0.f};
    Frag<FP8> At[4], B0[2], B1[2];
    unsigned vg[2][2];
#define PG8_GATHER(u) do { _Pragma("unroll") for (int _h = 0; _h < 2; ++_h) _Pragma("unroll") for (int _i = 0; _i < 2; ++_i) { int _R, _C; stage_rc(tid * 16 + _i * 8192, _R, _C); \
        const int _r = _h * HALF + _R; int _tok; if ((u).alist) _tok = (_r < (u).nvalid) ? (u).alist[_r] : 0; else _tok = (u).arow0 + _r; vg[_h][_i] = (unsigned)(_tok * K + _C) * 2u; } } while (0)
#define PG8_GATHER_LDS(u) do { _Pragma("unroll") for (int _h = 0; _h < 2; ++_h) _Pragma("unroll") for (int _i = 0; _i < 2; ++_i) { int _R, _C; stage_rc(tid * 16 + _i * 8192, _R, _C); \
        const int _r = _h * HALF + _R; const int _tok = (u).alist ? g.tokbuf[_r] : (u).arow0 + _r; vg[_h][_i] = (unsigned)(_tok * K + _C) * 2u; } } while (0)
    const char* cA; const char* cB = (const char*)g.Bt + (size_t)cur.brow0 * K * 2;
    if constexpr (GATHER) { cA = (const char*)g.A; PG8_GATHER(cur); } else { cA = (const char*)g.A + (size_t)cur.arow0 * K * 2;
#pragma unroll
        for (int h = 0; h < 2; ++h)
#pragma unroll
            for (int i = 0; i < 2; ++i) vg[h][i] = 0u; }
    if constexpr (SP2) {
        PG8_STAGE(PG8_SB(0, 0), cB, voffB); PG8_STAGE(PG8_SB(0, 1), cB + hstep, voffB); PG8_STAGE_A(PG8_SA(0, 0), cA, 0, vg); PG8_STAGE_A(PG8_SA(0, 1), cA, 1, vg);
        if (wr == 1) PG8_BAR;
        PG8_WAIT_V(2); PG8_BAR;
        PG8_STAGE(PG8_SB(1, 0), cB + kstep, voffB); PG8_STAGE_A(PG8_SA(1, 0), cA + kstep, 0, vg); PG8_STAGE(PG8_SB(1, 1), cB + hstep + kstep, voffB);
        PG8_WAIT_V(6); PG8_BAR;
    } else {
        PG8_STAGE(PG8_SB(0, 0), cB, voffB); PG8_STAGE_A(PG8_SA(0, 0), cA, 0, vg); PG8_STAGE(PG8_SB(0, 1), cB + hstep, voffB); PG8_STAGE_A(PG8_SA(0, 1), cA, 1, vg);
        if (wr == 1) PG8_BAR;
        PG8_WAIT_V(4); PG8_BAR;
        PG8_STAGE(PG8_SB(1, 0), cB + kstep, voffB); PG8_STAGE_A(PG8_SA(1, 0), cA + kstep, 0, vg); PG8_STAGE(PG8_SB(1, 1), cB + hstep + kstep, voffB);
        PG8_WAIT_V(6); PG8_BAR;
    }
    for (;;) {
        const bool has_next = S.next(ui + 1, nxt);
        if constexpr (GATHER) { if (g.tokbuf && has_next && nxt.alist && wid < 4) {
                const int r_ = wid * 64 + lane; const int* sp_ = (r_ < nxt.nvalid) ? nxt.alist + r_ : g.zero;
                __builtin_amdgcn_global_load_lds((const unsigned*)sp_, (LAS unsigned*)(g.tokbuf + wid * 64), 4, 0, 0); } }
        const char* nA; const char* nB = has_next ? (const char*)g.Bt + (size_t)nxt.brow0 * K * 2 : cB;
        if constexpr (GATHER) nA = cA; else nA = has_next ? (const char*)g.A + (size_t)nxt.arow0 * K * 2 : cA;
#pragma unroll 1
        for (int t = 0; t < nt; t += 2) {
            const bool last = (t == nt - 2);
            const char* a1 = cA + (size_t)(t + 1) * kstep;
            const char* a2 = last ? nA : cA + (size_t)(t + 2) * kstep; const char* b2 = last ? nB : cB + (size_t)(t + 2) * kstep;
            const char* a3 = a2 + kstep; const char* b3 = b2 + kstep;
            if constexpr (SP2) {
            PG8_LDB(B0, 0, 0); PG8_LDB(B1, 0, 1); PG8_SCHED; PG8_LDA(At, 0, 0); PG8_STAGE_A(PG8_SA(1, 1), a1, 1, vg);
            if constexpr (GATHER) { if (last && has_next) { if (g.tokbuf) PG8_GATHER_LDS(nxt); else PG8_GATHER(nxt); } }
            PG8_WAIT_V(8); PG8_WAIT_L(0); PG8_BAR; PG8_MMA(0, 0, At, B0); PG8_MMA(0, 1, At, B1); PG8_BAR; PG8_SCHED;
            PG8_LDA(At, 0, 1); PG8_STAGE(PG8_SB(0, 0), b2, voffB); PG8_STAGE(PG8_SB(0, 1), b2 + hstep, voffB); PG8_STAGE_A(PG8_SA(0, 0), a2, 0, vg);
            PG8_WAIT_V(8); PG8_WAIT_L(0); PG8_BAR; PG8_MMA(1, 0, At, B0); PG8_MMA(1, 1, At, B1); PG8_BAR; PG8_SCHED;
            PG8_LDB(B0, 1, 0); PG8_LDB(B1, 1, 1); PG8_SCHED; PG8_LDA(At, 1, 0); PG8_STAGE_A(PG8_SA(0, 1), a2, 1, vg);
            PG8_WAIT_V(8); PG8_WAIT_L(0); PG8_BAR; PG8_MMA(0, 0, At, B0); PG8_MMA(0, 1, At, B1); PG8_BAR; PG8_SCHED;
            PG8_LDA(At, 1, 1); PG8_STAGE(PG8_SB(1, 0), b3, voffB); PG8_STAGE(PG8_SB(1, 1), b3 + hstep, voffB); PG8_STAGE_A(PG8_SA(1, 0), a3, 0, vg);
            PG8_WAIT_V(8); PG8_WAIT_L(0); PG8_BAR; PG8_MMA(1, 0, At, B0); PG8_MMA(1, 1, At, B1); PG8_BAR; PG8_SCHED;
            } else {
            PG8_LDB(B0, 0, 0); PG8_SCHED; PG8_LDA(At, 0, 0); PG8_STAGE_A(PG8_SA(1, 1), a1, 1, vg);
            if constexpr (GATHER) { if (last && has_next) PG8_GATHER(nxt); }
            PG8_WAIT_L(8); PG8_BAR; PG8_WAIT_L(0); PG8_MMA(0, 0, At, B0); PG8_BAR; PG8_SCHED;
            PG8_LDB(B1, 0, 1); PG8_STAGE(PG8_SB(0, 0), b2, voffB);
            PG8_BAR; PG8_WAIT_L(0); PG8_MMA(0, 1, At, B1); PG8_BAR;
            PG8_LDA(At, 0, 1); PG8_STAGE_A(PG8_SA(0, 0), a2, 0, vg);
            PG8_BAR; PG8_WAIT_L(0); PG8_MMA(1, 0, At, B0); PG8_BAR; PG8_SCHED;
            PG8_STAGE(PG8_SB(0, 1), b2 + hstep, voffB);
            PG8_WAIT_V(6); PG8_BAR; PG8_MMA(1, 1, At, B1); PG8_BAR;
            PG8_LDB(B0, 1, 0); PG8_SCHED; PG8_LDA(At, 1, 0); PG8_STAGE_A(PG8_SA(0, 1), a2, 1, vg);
            PG8_WAIT_L(8); PG8_BAR; PG8_WAIT_L(0); PG8_MMA(0, 0, At, B0); PG8_BAR; PG8_SCHED;
            PG8_LDB(B1, 1, 1); PG8_STAGE(PG8_SB(1, 0), b3, voffB);
            PG8_BAR; PG8_WAIT_L(0); PG8_MMA(0, 1, At, B1); PG8_BAR;
            PG8_LDA(At, 1, 1); PG8_STAGE_A(PG8_SA(1, 0), a3, 0, vg);
            PG8_BAR; PG8_WAIT_L(0); PG8_MMA(1, 0, At, B0); PG8_BAR; PG8_SCHED;
            PG8_STAGE(PG8_SB(1, 1), b3 + hstep, voffB);
            PG8_WAIT_V(6); PG8_BAR; PG8_MMA(1, 1, At, B1); PG8_BAR;
            }
        }
        if constexpr (ALIGN_EPI) { if (wr == 0) PG8_BAR; }
        E(acc, cur, wr, wc, fr, fq);
        if (!has_next) break;
#pragma unroll
        for (int a = 0; a < 2; ++a)
#pragma unroll
            for (int b = 0; b < 2; ++b)
#pragma unroll
                for (int m = 0; m < 4; ++m)
#pragma unroll
                    for (int n = 0; n < 2; ++n) acc[a][b][m][n] = (f32x4){0.f, 0.f, 0.f, 0.f};
        cur = nxt; cA = nA; cB = nB; ++ui;
        if constexpr (ALIGN_EPI) { if (wr == 1) PG8_BAR; }
    }
    PG8_WAIT_V(0);
    if constexpr (!ALIGN_EPI) { if (wr == 0) PG8_BAR; }
    PG8_BAR;
#undef PG8_SA
#undef PG8_SB
#undef PG8_SBR
#undef PG8_STAGE
#undef PG8_STAGE_A
#undef PG8_GATHER
#undef PG8_GATHER_LDS
#undef PG8_LDF
#undef PG8_LDA
#undef PG8_LDB
#undef PG8_MMA
#undef PG8_WAIT_V
#undef PG8_WAIT_L
#undef PG8_BAR
#undef PG8_SCHED
}


struct EpiM1 {
    static constexpr bool PERM = true;
    bf16_t* Q; bf16_t* Kn; bf16_t* KT; bf16_t* VT; bf16_t* OGS; LAS unsigned char* tlds;
    __device__ __forceinline__ void operator()(const f32x4 (&acc)[2][2][4][2], const Unit& u, int wr, int wc, int fr, int fq) const {
        const int row0 = u.arow0 + wr * 64 + fr, pn = u.pn;
        if (pn < 4 || pn >= 8) {
            bf16_t* base; int ldc, colt; float sc = 1.f; const bool sig = pn >= 8;
            if (pn < 2) { base = Q; ldc = MQK; colt = pn * 256; sc = 0.08838834764831845f; }
            else if (pn < 4) { base = Kn; ldc = MQK; colt = (pn - 2) * 256; }
            else { base = OGS; ldc = MV; colt = (pn - 8) * 256; }
            const int col0 = colt + wc * 32 + 8 * fq;
#pragma unroll
            for (int ai = 0; ai < 2; ++ai)
#pragma unroll
                for (int m = 0; m < 4; ++m) { bf16_t* rowp = base + (size_t)(row0 + ai * HALF + m * 16) * ldc + col0;
#pragma unroll
                    for (int bj = 0; bj < 2; ++bj) { f32x4 v0 = acc[ai][bj][m][0] * sc, v1 = acc[ai][bj][m][1] * sc;
                        if (sig) {
#pragma unroll
                            for (int j = 0; j < 4; ++j) { v0[j] = sigmoidf_(v0[j]); v1[j] = sigmoidf_(v1[j]); } }
                        u32x4 w; w.x = cvt_pk_bf16(v0[0], v0[1]); w.y = cvt_pk_bf16(v0[2], v0[3]); w.z = cvt_pk_bf16(v1[0], v1[1]); w.w = cvt_pk_bf16(v1[2], v1[3]);
                        *(u32x4*)(rowp + bj * HALF) = w; } }
        }
        if (pn >= 2 && pn < 8) {
            const int b = u.arow0 / SEQ, s0 = (u.arow0 % SEQ) + wr * 64;
            bf16_t* base; int colt, feat;
            if (pn < 4) { base = KT; colt = (pn - 2) * 256; feat = DK; } else { base = VT; colt = (pn - 4) * 256; feat = DV; }
            LAS unsigned char* tb = tlds + (wr * 4 + wc) * 2048;
            const int lane = fq * 16 + fr;
#pragma unroll
            for (int ai = 0; ai < 2; ++ai) {
                const int ch = (s0 + ai * HALF) >> 6;
#pragma unroll
                for (int bj = 0; bj < 2; ++bj) {
                    const int col = colt + bj * HALF + wc * 32, hd = col / feat, f0 = col % feat;
                    bf16_t* xb = base + ((((size_t)(b * NH + hd) * NCH + ch) * feat + f0) << 6);
#pragma unroll
                    for (int n = 0; n < 2; ++n) {
#pragma unroll
                        for (int m = 0; m < 4; ++m)
#pragma unroll
                            for (int j = 0; j < 4; ++j) { const int t = m * 16 + fr;
                                *(LAS bf16_t*)(tb + (4 * fq + j) * 128 + ((((t >> 3) ^ (2 * fq)) & 7) << 4) + (t & 7) * 2) = (bf16_t)f2bf(acc[ai][bj][m][n][j]); }
#pragma unroll
                        for (int q = 0; q < 2; ++q) { const int id = lane + 64 * q, cr = id >> 3, p = id & 7, tc = (p ^ (2 * (cr >> 2))) & 7;
                            const u32x4 v = *(const LAS u32x4*)(tb + id * 16);
                            *(u32x4*)(xb + (size_t)(8 * (cr >> 2) + 4 * n + (cr & 3)) * 64 + tc * 8) = v; }
                    }
                }
            }
        }
    }
};
template <bool BASE_F32> struct EpiRes {
    static constexpr bool PERM = true;
    const void* base; bf16_t* out; const float* gate; float mul;
    __device__ __forceinline__ void operator()(const f32x4 (&acc)[2][2][4][2], const Unit& u, int wr, int wc, int fr, int fq) const {
        const int row0 = u.arow0 + wr * 64 + fr, col0 = u.pn * BM + wc * 32 + 8 * fq, b = u.arow0 / SEQ;
        f32x4 gv[2][2];
#pragma unroll
        for (int bj = 0; bj < 2; ++bj)
#pragma unroll
            for (int n = 0; n < 2; ++n) gv[bj][n] = *(const f32x4*)(gate + (size_t)b * 6 * D + col0 + bj * HALF + n * 4) * mul;
        u32x4 t[2][4][2];
#pragma unroll
        for (int ai = 0; ai < 2; ++ai)
#pragma unroll
            for (int m = 0; m < 4; ++m)
#pragma unroll
                for (int bj = 0; bj < 2; ++bj) { const f32x4 v0 = gv[bj][0] * acc[ai][bj][m][0], v1 = gv[bj][1] * acc[ai][bj][m][1];
                    t[ai][m][bj].x = cvt_pk_bf16(v0[0], v0[1]); t[ai][m][bj].y = cvt_pk_bf16(v0[2], v0[3]); t[ai][m][bj].z = cvt_pk_bf16(v1[0], v1[1]); t[ai][m][bj].w = cvt_pk_bf16(v1[2], v1[3]); }
        if (BASE_F32) {
#pragma unroll
            for (int ai = 0; ai < 2; ++ai) {
                f32x4 bf[4][2][2];
#pragma unroll
                for (int m = 0; m < 4; ++m)
#pragma unroll
                    for (int bj = 0; bj < 2; ++bj) { const float* p = (const float*)base + (size_t)(row0 + ai * HALF + m * 16) * D + col0 + bj * HALF; bf[m][bj][0] = *(const f32x4*)p; bf[m][bj][1] = *(const f32x4*)(p + 4); }
                asm volatile("" ::: "memory");
#pragma unroll
                for (int m = 0; m < 4; ++m)
#pragma unroll
                    for (int bj = 0; bj < 2; ++bj) { const f32x4 a0 = bf[m][bj][0], a1 = bf[m][bj][1]; const u32x4 c = t[ai][m][bj]; u32x4 w;
                        w.x = cvt_pk_bf16(a0[0] + bflo(c.x), a0[1] + bfhi(c.x)); w.y = cvt_pk_bf16(a0[2] + bflo(c.y), a0[3] + bfhi(c.y));
                        w.z = cvt_pk_bf16(a1[0] + bflo(c.z), a1[1] + bfhi(c.z)); w.w = cvt_pk_bf16(a1[2] + bflo(c.w), a1[3] + bfhi(c.w));
                        *(u32x4*)(out + (size_t)(row0 + ai * HALF + m * 16) * D + col0 + bj * HALF) = w; }
                asm volatile("" ::: "memory");
            }
        } else {
            u32x4 bw[2][4][2];
#pragma unroll
            for (int ai = 0; ai < 2; ++ai)
#pragma unroll
                for (int m = 0; m < 4; ++m)
#pragma unroll
                    for (int bj = 0; bj < 2; ++bj) bw[ai][m][bj] = *(const u32x4*)((const bf16_t*)base + (size_t)(row0 + ai * HALF + m * 16) * D + col0 + bj * HALF);
            asm volatile("" ::: "memory");
#pragma unroll
            for (int ai = 0; ai < 2; ++ai)
#pragma unroll
                for (int m = 0; m < 4; ++m)
#pragma unroll
                    for (int bj = 0; bj < 2; ++bj) { const u32x4 a = bw[ai][m][bj], c = t[ai][m][bj]; u32x4 w;
                        w.x = cvt_pk_bf16(bflo(a.x) + bflo(c.x), bfhi(a.x) + bfhi(c.x)); w.y = cvt_pk_bf16(bflo(a.y) + bflo(c.y), bfhi(a.y) + bfhi(c.y));
                        w.z = cvt_pk_bf16(bflo(a.z) + bflo(c.z), bfhi(a.z) + bfhi(c.z)); w.w = cvt_pk_bf16(bflo(a.w) + bflo(c.w), bfhi(a.w) + bfhi(c.w));
                        *(u32x4*)(out + (size_t)(row0 + ai * HALF + m * 16) * D + col0 + bj * HALF) = w; }
        }
    }
};
struct EpiBf {
    static constexpr bool PERM = true;
    bf16_t* O; int ldc;
    __device__ __forceinline__ void operator()(const f32x4 (&acc)[2][2][4][2], const Unit& u, int wr, int wc, int fr, int fq) const {
        const int row0 = u.arow0 + wr * 64 + fr, col0 = u.pn * BM + wc * 32 + 8 * fq;
#pragma unroll
        for (int ai = 0; ai < 2; ++ai)
#pragma unroll
            for (int m = 0; m < 4; ++m) { bf16_t* rowp = O + (size_t)(row0 + ai * HALF + m * 16) * ldc + col0;
#pragma unroll
                for (int bj = 0; bj < 2; ++bj) { const f32x4 v0 = acc[ai][bj][m][0], v1 = acc[ai][bj][m][1];
                    u32x4 w; w.x = cvt_pk_bf16(v0[0], v0[1]); w.y = cvt_pk_bf16(v0[2], v0[3]); w.z = cvt_pk_bf16(v1[0], v1[1]); w.w = cvt_pk_bf16(v1[2], v1[3]);
                    *(u32x4*)(rowp + bj * HALF) = w; } }
    }
};
template <bool SILU, bool F8OUT = false> struct EpiGlu {
    static constexpr bool PERM = true;
    bf16_t* O; int ldc; int plain_tiles; bf16_t* P; int ldp; float f8scale;
    __device__ __forceinline__ void operator()(const f32x4 (&acc)[2][2][4][2], const Unit& u, int wr, int wc, int fr, int fq) const {
        const int row0 = u.arow0 + wr * 64 + fr;
        if (u.pn < plain_tiles) {
            const int col0 = u.pn * BM + wc * 32 + 8 * fq;
#pragma unroll
            for (int ai = 0; ai < 2; ++ai)
#pragma unroll
                for (int m = 0; m < 4; ++m) { bf16_t* rowp = P + (size_t)(row0 + ai * HALF + m * 16) * ldp + col0;
#pragma unroll
                    for (int bj = 0; bj < 2; ++bj) { const f32x4 v0 = acc[ai][bj][m][0], v1 = acc[ai][bj][m][1];
                        u32x4 w; w.x = cvt_pk_bf16(v0[0], v0[1]); w.y = cvt_pk_bf16(v0[2], v0[3]); w.z = cvt_pk_bf16(v1[0], v1[1]); w.w = cvt_pk_bf16(v1[2], v1[3]);
                        *(u32x4*)(rowp + bj * HALF) = w; } }
            return;
        }
        const int col0 = (u.pn - plain_tiles) * HALF + wc * 32 + 8 * fq;
#pragma unroll
        for (int ai = 0; ai < 2; ++ai)
#pragma unroll
            for (int m = 0; m < 4; ++m) { bf16_t* rowp = O + (size_t)(row0 + ai * HALF + m * 16) * ldc + col0;
                f32x4 v0 = acc[ai][0][m][0], v1 = acc[ai][0][m][1]; const f32x4 u0 = acc[ai][1][m][0], u1 = acc[ai][1][m][1];
                if (SILU) {
#pragma unroll
                    for (int j = 0; j < 4; ++j) { v0[j] = v0[j] * sigmoidf_(v0[j]); v1[j] = v1[j] * sigmoidf_(v1[j]); } }
                v0 = v0 * u0; v1 = v1 * u1;
                if constexpr (F8OUT) { v0 = v0 * f8scale; v1 = v1 * f8scale; u32x2 w8; w8.x = pk4_fp8_sat(v0[0], v0[1], v0[2], v0[3]); w8.y = pk4_fp8_sat(v1[0], v1[1], v1[2], v1[3]);
                    *(u32x2*)((unsigned char*)O + (size_t)(row0 + ai * HALF + m * 16) * ldc + col0) = w8; }
                else { u32x4 w; w.x = cvt_pk_bf16(v0[0], v0[1]); w.y = cvt_pk_bf16(v0[2], v0[3]); w.z = cvt_pk_bf16(v1[0], v1[1]); w.w = cvt_pk_bf16(v1[2], v1[3]);
                    *(u32x4*)rowp = w; } }
    }
};
}

#define XB_TMO      128
#define XB_XCNT(j)  (256  + 64 * (j))
#define XB_XSUB(j)  (1280 + 64 * (j))
#define XB_XGEN(j)  (2304 + 64 * (j))
#define XB_TOP      3328
#define XB_TOPGEN   3392
#define XCD_BAR_WORDS 3456
#define XB_SPIN_CAP (1u << 18)
__device__ __forceinline__ unsigned xb_ld(unsigned* p)              { return __hip_atomic_load(p, __ATOMIC_RELAXED, __HIP_MEMORY_SCOPE_AGENT); }
__device__ __forceinline__ unsigned xb_add(unsigned* p, unsigned v) { return __hip_atomic_fetch_add(p, v, __ATOMIC_RELAXED, __HIP_MEMORY_SCOPE_AGENT); }
__device__ __forceinline__ unsigned xb_xcc_id() { return (unsigned)__builtin_amdgcn_s_getreg((3 << 11) | 20) & 0xFu; }
#define XB_SPIN(cond, bar) do { unsigned _sp = 0; while (cond) { __builtin_amdgcn_s_sleep(1); \
    if ((++_sp & 255u) == 0u) { if (xb_ld(&(bar)[XB_TMO])) break; if (_sp > XB_SPIN_CAP) { atomicAdd(&(bar)[XB_TMO], 1u); break; } } } } while (0)
struct XcdBarrier { unsigned* bar; unsigned x; volatile LAS unsigned* st; };
__device__ __forceinline__ XcdBarrier xcd_barrier_post(unsigned* bar, volatile LAS unsigned* st) {
    XcdBarrier b; b.bar = bar; b.x = xb_xcc_id(); b.st = st;
    if (threadIdx.x == 0) (void)xb_add(&bar[XB_XCNT(b.x)], 1u);
    return b;
}
__device__ __forceinline__ void xcd_barrier_complete(unsigned* bar, unsigned x, unsigned& nloc, unsigned& nx) {
    const unsigned G = gridDim.x * gridDim.y * gridDim.z;
    unsigned sum, cnt, mine, sp = 0u;
    for (;;) {
        sum = 0u; cnt = 0u; mine = 0u;
#pragma unroll
        for (unsigned j = 0; j < 16; ++j) { const unsigned c = xb_ld(&bar[XB_XCNT(j)]); sum += c; cnt += (c > 0u) ? 1u : 0u; mine = (j == x) ? c : mine; }
        if (sum == G) break;
        __builtin_amdgcn_s_sleep(1);
        if ((++sp & 255u) == 0u) { if (xb_ld(&bar[XB_TMO])) break; if (sp > XB_SPIN_CAP) { atomicAdd(&bar[XB_TMO], 1u); break; } }
    }
    nloc = mine > 0u ? mine : 1u; nx = cnt > 0u ? cnt : 1u;
}
__device__ __forceinline__ void xcd_barrier(const XcdBarrier& b) {
    asm volatile("s_waitcnt vmcnt(0)" ::: "memory");
    __syncthreads();
    if (threadIdx.x == 0) {
        unsigned* bar = b.bar;
        __builtin_amdgcn_s_waitcnt(0);
        unsigned nloc = b.st[0], nx = b.st[1];
        if (nloc == 0u) { xcd_barrier_complete(bar, b.x, nloc, nx); b.st[0] = nloc; b.st[1] = nx; }
        const unsigned old = xb_add(&bar[XB_XSUB(b.x)], 1u);
        const unsigned gen = old / nloc;
        if (old + 1u == (gen + 1u) * nloc) {
            __builtin_amdgcn_fence(__ATOMIC_RELEASE, "agent");
            asm volatile("s_waitcnt vmcnt(0)" ::: "memory");
            const unsigned og = xb_add(&bar[XB_TOP], 1u);
            const unsigned tg = og / nx;
            if (og + 1u == (tg + 1u) * nx) xb_add(&bar[XB_TOPGEN], 1u);
            else XB_SPIN(xb_ld(&bar[XB_TOPGEN]) == tg, bar);
            __builtin_amdgcn_fence(__ATOMIC_ACQUIRE, "agent");
            xb_add(&bar[XB_XGEN(b.x)], 1u);
            asm volatile("s_waitcnt vmcnt(0)" ::: "memory");
        } else {
            XB_SPIN(xb_ld(&bar[XB_XGEN(b.x)]) == gen, bar);
            __builtin_amdgcn_fence(__ATOMIC_ACQUIRE, "agent");
            asm volatile("s_waitcnt vmcnt(0)" ::: "memory");
        }
    }
    __syncthreads();
}

struct Args { const float* in[20]; float* out; unsigned char* ws; int ph_lo, ph_hi; };
__device__ __forceinline__ const void* karg_ptr(int idx) {
    unsigned long long v = (unsigned long long)((const void* const __attribute__((address_space(4)))*)__builtin_amdgcn_kernarg_segment_ptr())[idx];
    asm volatile("" : "+s"(v)); return (const void*)(const GAS char*)v;
}
struct InProxy { __device__ __forceinline__ const float* operator[](int i) const { return (const float*)karg_ptr(i); } };
struct WsProxy { __device__ __forceinline__ operator unsigned char*() const { return (unsigned char*)karg_ptr(21); }
                 __device__ __forceinline__ unsigned char* operator+(size_t o) const { return (unsigned char*)karg_ptr(21) + o; } };
struct OutProxy { __device__ __forceinline__ operator float*() const { return (float*)karg_ptr(20); }
                  __device__ __forceinline__ float* operator+(size_t o) const { return (float*)karg_ptr(20) + o; } };
struct CtlProxy { __device__ __forceinline__ operator gu32*() const { return (gu32*)karg_ptr(21); }
                  __device__ __forceinline__ gu32* operator+(int o) const { return (gu32*)karg_ptr(21) + o; } };
struct Frame {
    LAS unsigned char* lds; volatile LAS unsigned* MISC; CtlProxy ctl;
    int tid, lane, wave, vcu, G, bx;
    InProxy in; OutProxy out; WsProxy ws;
};
enum { I_X = 0, I_C, I_N1G, I_N2G, I_WADA, I_BADA, I_MWIN, I_MBG, I_MNG, I_MWOUT, I_CWIN, I_CCW, I_CCB, I_CWOUT, I_WR, I_BR, I_EWG, I_EWU, I_EWD, I_FG };

__device__ __forceinline__ float wave_sum(float v) {
#pragma unroll
    for (int o = 1; o < 64; o <<= 1) v += __shfl_xor(v, o);
    return v;
}

__device__ __forceinline__ int glu_row(int n, int which) { return (n >> 7) * 256 + which * 128 + (n & 127); }
struct CvtItem { const float* src; bf16_t* dst; int ldw, K; float f8scale; };
constexpr int CVT_IN = 16 * 96, CVT_OUT = 16 * 32, CVT_G = NE * 16 * 16, CVT_D = NE * 8 * 32, CVT_ITEMS = CVT_IN + CVT_OUT + 2 * CVT_G + CVT_D;
__device__ __forceinline__ CvtItem cvt_decode(Frame& F, int L, int it) {
    const size_t lo_ = (L == 0) ? 0 : WS_WL1;
    CvtItem d; d.f8scale = 0.f; int r = it;
    if (r < CVT_IN) { const int kb = r / 96, nb = r % 96, n0 = nb * 32; d.K = D;
        if (L == 0) { d.src = F.in[I_MWIN] + (size_t)kb * 64 * MPROJ + n0; d.ldw = MPROJ;
            if (FP8_G1 == 1 || (FP8_G1 == 2 && n0 >= 1024)) { d.dst = (bf16_t*)((unsigned char*)(F.ws + lo_ + WS_W0) + (FP8_G1 == 2 ? 2 * MiB : 0) + (size_t)n0 * D + kb * 64); d.f8scale = 32.f; } else d.dst = (bf16_t*)(F.ws + lo_ + WS_W0) + (size_t)n0 * D + kb * 64; }
        else { int dr; if (n0 < D) dr = n0; else if (n0 < 2 * D) dr = D + glu_row(n0 - D, 0); else dr = D + glu_row(n0 - 2 * D, 1);
            d.src = F.in[I_CWIN] + (size_t)kb * 64 * 3 * D + n0; d.ldw = 3 * D;
            if (FP8_CIN) { d.dst = (bf16_t*)((unsigned char*)(F.ws + lo_ + WS_W0) + (size_t)dr * D + kb * 64); d.f8scale = 32.f; } else d.dst = (bf16_t*)(F.ws + lo_ + WS_W0) + (size_t)dr * D + kb * 64; }
        return d; } r -= CVT_IN;
    if (r < CVT_OUT) { const int kb = r / 32, nb = r % 32; d.K = D; d.ldw = D; d.src = (L == 0 ? F.in[I_MWOUT] : F.in[I_CWOUT]) + (size_t)kb * 64 * D + nb * 32;
        if ((L == 1 && FP8_COUT) || (L == 0 && FP8_MOUT)) { d.dst = (bf16_t*)((unsigned char*)(F.ws + lo_ + WS_W1) + (size_t)nb * 32 * D + kb * 64); d.f8scale = 32.f; } else d.dst = (bf16_t*)(F.ws + lo_ + WS_W1) + (size_t)nb * 32 * D + kb * 64; return d; } r -= CVT_OUT;
    if (r < 2 * CVT_G) { const int which = r / CVT_G; r %= CVT_G; const int e = r / 256, kb = (r % 256) / 16, nb = r % 16, n0 = nb * 32; d.K = D; d.ldw = DE;
        d.src = (which == 0 ? F.in[I_EWG] : F.in[I_EWU]) + ((size_t)L * NE + e) * D * DE + (size_t)kb * 64 * DE + n0;
        d.dst = (bf16_t*)((unsigned char*)(F.ws + lo_ + WS_WUP) + (size_t)e * 1024 * D + (size_t)glu_row(n0, which) * D + kb * 64); d.f8scale = 32.f; return d; } r -= 2 * CVT_G;
    { const int e = r / 256, kb = (r % 256) / 32, nb = r % 32; d.K = DE; d.ldw = D;
      d.src = F.in[I_EWD] + ((size_t)L * NE + e) * DE * D + (size_t)kb * 64 * D + nb * 32;
      d.dst = (bf16_t*)((unsigned char*)(F.ws + lo_ + WS_WDN) + (size_t)e * D * DE + (size_t)nb * 32 * DE + kb * 64); d.f8scale = 16.f; }
    return d;
}
__device__ __forceinline__ void convert_weights(Frame& F, int L) {
    LAS float* scr = (LAS float*)(F.lds + F.wave * 16384);
    const int gw = F.vcu * NWAVES + F.wave, NGW = F.G * NWAVES, lane = F.lane;
    float ld[32];
    CvtItem cur, nxt;
    int it = gw;
    if (it < CVT_ITEMS) { cur = cvt_decode(F, L, it);
#pragma unroll
        for (int i = 0; i < 32; ++i) ld[i] = cur.src[(size_t)(2 * i + (lane >> 5)) * cur.ldw + (lane & 31)]; }
    for (; it < CVT_ITEMS; it += NGW) {
#pragma unroll
        for (int i = 0; i < 32; ++i) scr[(2 * i + (lane >> 5)) * 33 + (lane & 31)] = ld[i];
        const bool more = it + NGW < CVT_ITEMS;
        if (more) { nxt = cvt_decode(F, L, it + NGW);
#pragma unroll
            for (int i = 0; i < 32; ++i) ld[i] = nxt.src[(size_t)(2 * i + (lane >> 5)) * nxt.ldw + (lane & 31)]; }
        LDS_WAIT(); asm volatile("" ::: "memory");
        const int c = lane & 7;
#pragma unroll
        for (int j = 0; j < 4; ++j) { const int n = (lane >> 3) + 8 * j; const LAS float* s = scr + (8 * c) * 33 + n;
            if (cur.f8scale != 0.f) { const float f = cur.f8scale; u32x2 o8; o8.x = pk4_fp8(s[0 * 33] * f, s[1 * 33] * f, s[2 * 33] * f, s[3 * 33] * f); o8.y = pk4_fp8(s[4 * 33] * f, s[5 * 33] * f, s[6 * 33] * f, s[7 * 33] * f);
                *(GAS u32x2*)((unsigned char*)cur.dst + (size_t)n * cur.K + 8 * c) = o8; }
            else { u32x4 o; o.x = pk2(s[0 * 33], s[1 * 33]); o.y = pk2(s[2 * 33], s[3 * 33]); o.z = pk2(s[4 * 33], s[5 * 33]); o.w = pk2(s[6 * 33], s[7 * 33]);
                *(GAS u32x4*)(cur.dst + (size_t)n * cur.K + 8 * c) = o; } }
        LDS_WAIT(); asm volatile("" ::: "memory");
        cur = nxt;
    }
}

__device__ __forceinline__ void phase_prologue(Frame& F) {
    float* MOD = (float*)(F.ws + WS_MOD);
    LAS float* cond = (LAS float*)(F.lds + 0);
    LAS float* red = (LAS float*)(F.lds + 16384);
    bool did = false;
    for (int task = F.bx; task < 192; task += F.G) {
        if (did) __syncthreads();
        did = true;
        for (int i = F.tid; i < NB * D; i += NTHR) { const int b = i / D, k = i % D; const float c = F.in[I_C][i]; cond[k * 4 + b] = c * sigmoidf_(c); }
        __syncthreads();
        const int layer = task / 96, col = (task % 96) * 64 + F.lane;
        const float* W = F.in[I_WADA] + (size_t)layer * D * 6 * D;
        float a0 = 0.f, a1 = 0.f, a2 = 0.f, a3 = 0.f;
#pragma unroll 8
        for (int kk = 0; kk < 128; ++kk) { const int k = F.wave * 128 + kk; const float w = W[(size_t)k * 6 * D + col]; const f32x4 c4 = *(const LAS f32x4*)(cond + k * 4);
            a0 += c4[0] * w; a1 += c4[1] * w; a2 += c4[2] * w; a3 += c4[3] * w; }
        red[(F.wave * 4 + 0) * 64 + F.lane] = a0; red[(F.wave * 4 + 1) * 64 + F.lane] = a1; red[(F.wave * 4 + 2) * 64 + F.lane] = a2; red[(F.wave * 4 + 3) * 64 + F.lane] = a3;
        __syncthreads();
        if (F.tid < 256) { const int b = F.tid >> 6, l = F.tid & 63; float s = 0.f;
#pragma unroll
            for (int w = 0; w < 8; ++w) s += red[(w * 4 + b) * 64 + l];
            const int c = (task % 96) * 64 + l;
            MOD[((size_t)layer * NB + b) * 6 * D + c] = s + F.in[I_BADA][(size_t)layer * 6 * D + c]; }
    }
    __syncthreads();
    convert_weights(F, 0);
}

template <int N>
__device__ __forceinline__ void xreduce(float (&v)[N], int lane) {
    constexpr int STEPS = (N == 32) ? 5 : 4;
#pragma unroll
    for (int i = 0; i < N / 2; ++i) { const auto r = __builtin_amdgcn_permlane32_swap(__builtin_bit_cast(unsigned, v[i]), __builtin_bit_cast(unsigned, v[i + N / 2]), false, false);
        const unsigned r0_ = r[0], r1_ = r[1]; v[i] = __uint_as_float(r0_) + __uint_as_float(r1_); }
#pragma unroll
    for (int i = 0; i < N / 4; ++i) { const auto r = __builtin_amdgcn_permlane16_swap(__builtin_bit_cast(unsigned, v[i]), __builtin_bit_cast(unsigned, v[i + N / 4]), false, false);
        const unsigned r0_ = r[0], r1_ = r[1]; v[i] = __uint_as_float(r0_) + __uint_as_float(r1_); }
#pragma unroll
    for (int step = 2; step < STEPS; ++step) {
        const int M = 32 >> step, n = N >> step;
        const bool up = (lane & M) != 0;
#pragma unroll
        for (int i = 0; i < n / 2; ++i) { float a = v[i], b = v[i + n / 2]; asm volatile("" : "+v"(a), "+v"(b));
            const float send = up ? a : b, keep = up ? b : a; v[i] = keep + __shfl_xor(send, M); }
    }
    if (N == 16) v[0] += __shfl_xor(v[0], 2);
    v[0] += __shfl_xor(v[0], 1);
}

constexpr int RP_WL = 0, RP_RINFO = 65536, RP_LCNT = RP_RINFO + 128 * 8 * 4, RP_TPRE = RP_LCNT + 256;
template <int MODE>
__device__ __forceinline__ void row_pass(Frame& F, int layer) {
    constexpr int DOTS = (MODE == 0) ? 8 : (MODE == 1 ? 16 : 0);
    constexpr int RPI = 2, NIT = 16 / RPI, NV = (DOTS > 0) ? RPI * DOTS : 16;
    constexpr bool COMBINE = (MODE == 2 || MODE == 3), MODUL = (MODE != 3);
    const float* MOD = (const float*)(F.ws + WS_MOD);
    LAS float* wl = (LAS float*)(F.lds + RP_WL);
    LAS int* rinfo = (LAS int*)(F.lds + RP_RINFO);
    LAS int* lcnt = (LAS int*)(F.lds + RP_LCNT);
    LAS int* tpre = (LAS int*)(F.lds + RP_TPRE);
    const float* xin = F.in[I_X];
    bf16_t* XB = (bf16_t*)(F.ws + WS_XB);
    float* xout = F.out;
    bf16_t* U = (bf16_t*)(F.ws + WS_U);
    const bf16_t* O = (const bf16_t*)(F.ws + WS_O);
    const unsigned char* TOKp = (const unsigned char*)(F.ws + WS_TOK);
    const int lane = F.lane;
    const int clayer = (MODE == 2) ? 0 : 1;
    if (DOTS > 0) { constexpr int NQ = D * (DOTS > 0 ? DOTS : 4) / 4 / NTHR;
        f32x4 tv[NQ];
#pragma unroll
        for (int q = 0; q < NQ; ++q) { const int piece = F.tid + q * NTHR, k = piece / (DOTS / 4), c4 = piece % (DOTS / 4);
            tv[q] = (DOTS == 8) ? *(const f32x4*)(F.in[I_MWIN] + (size_t)k * MPROJ + 3072 + 4 * c4) : *(const f32x4*)(F.in[I_WR] + (size_t)piece * 4); }
#pragma unroll
        for (int q = 0; q < NQ; ++q) { const int piece = F.tid + q * NTHR, k = piece / (DOTS / 4), c4 = piece % (DOTS / 4), jj = k >> 8, l = (k >> 2) & 63, ii = k & 3;
            const int rot = (DOTS == 16) ? ((l >> 2) & 3) : ((l >> 3) & 1), ch = (c4 + rot) & (DOTS / 4 - 1);
            *(LAS f32x4*)(wl + ((jj * 4 + ii) * 64 + l) * DOTS + ch * 4) = tv[q]; } }
    if (COMBINE && F.tid == 0) { int a = 0; for (int e = 0; e < NE; ++e) { tpre[e] = a; a += ((int)__hip_atomic_load(F.ctl + CW_CNT + 64 * clayer + e, RLX_AGENT) + 255) >> 8; } tpre[NE] = a; }
    float brt[16];
    if (MODE == 1) {
#pragma unroll
        for (int e = 0; e < 16; ++e) brt[e] = F.in[I_BR][e]; }
    for (int batch = F.vcu; batch < T / 128; batch += F.G) {
        __syncthreads();
        if (MODE == 1 && F.tid < 32) lcnt[F.tid] = 0;
        __syncthreads();
        const int row_base = batch * 128 + F.wave * 16, b = row_base / SEQ;
        const float* gam = (MODE == 3) ? F.in[I_FG] : ((MODE == 1) ? F.in[I_N2G] + (size_t)layer * D : F.in[I_N1G] + (size_t)layer * D);
        const float* mod = MOD + ((size_t)layer * NB + b) * 6 * D;
        const float* shp = mod + ((MODE == 1) ? 3 * D : 0); const float* scp = shp + D;
        const float* g2p = MOD + ((size_t)clayer * NB + b) * 6 * D + 5 * D;
        f32x4 gm[4], sh[4], sc[4], g2[4];
#pragma unroll
        for (int j = 0; j < 4; ++j) { gm[j] = *(const f32x4*)(gam + 256 * j + 4 * lane);
            if (MODUL) { sh[j] = *(const f32x4*)(shp + 256 * j + 4 * lane); sc[j] = *(const f32x4*)(scp + 256 * j + 4 * lane) + 1.0f; }
            if (COMBINE) g2[j] = *(const f32x4*)(g2p + 256 * j + 4 * lane); }
        f32x4 xn[RPI][4]; u32x2 on[RPI][2][4]; u32x4 tkn[RPI], tkn2[RPI];
#define RP_LOAD_X(IT) do { _Pragma("unroll") for (int r = 0; r < RPI; ++r) _Pragma("unroll") for (int j = 0; j < 4; ++j) { \
            if (MODE == 0) xn[r][j] = *(const f32x4*)(xin + (size_t)(row_base + (IT) * RPI + r) * D + 256 * j + 4 * lane); \
            else { const u32x2 xb_ = *(const u32x2*)(XB + (size_t)(row_base + (IT) * RPI + r) * D + 256 * j + 4 * lane); xn[r][j] = (f32x4){bflo(xb_.x), bfhi(xb_.x), bflo(xb_.y), bfhi(xb_.y)}; } } } while (0)
#define RP_LOAD_TOK(dst, IT) do { _Pragma("unroll") for (int r = 0; r < RPI; ++r) dst[r] = *(const u32x4*)(TOKp + (size_t)(row_base + (IT) * RPI + r) * 16); } while (0)
#define RP_LOAD_O(tk) do { _Pragma("unroll") for (int r = 0; r < RPI; ++r) { const unsigned tx_ = tk[r].x, ty_ = tk[r].y; \
            const int e0_ = __builtin_amdgcn_readfirstlane((int)(tx_ >> 16)), e1_ = __builtin_amdgcn_readfirstlane((int)(ty_ >> 16)); \
            const int s0_ = tpre[e0_] * 256 + (int)(tx_ & 0xffffu), s1_ = tpre[e1_] * 256 + (int)(ty_ & 0xffffu); \
            _Pragma("unroll") for (int j = 0; j < 4; ++j) { on[r][0][j] = *(const u32x2*)(O + (size_t)s0_ * D + 256 * j + 4 * lane); on[r][1][j] = *(const u32x2*)(O + (size_t)s1_ * D + 256 * j + 4 * lane); } } } while (0)
        RP_LOAD_X(0);
        if (COMBINE) { RP_LOAD_TOK(tkn, 0); RP_LOAD_O(tkn); RP_LOAD_TOK(tkn2, 1); }
#pragma unroll 1
        for (int it = 0; it < NIT; ++it) {
            const int r0 = row_base + it * RPI;
            f32x4 x[RPI][4]; u32x2 oc[RPI][2][4]; float w0c[RPI], w1c[RPI];
#pragma unroll
            for (int r = 0; r < RPI; ++r) {
#pragma unroll
                for (int j = 0; j < 4; ++j) { x[r][j] = xn[r][j]; if (COMBINE) { oc[r][0][j] = on[r][0][j]; oc[r][1][j] = on[r][1][j]; } }
                if (COMBINE) { const unsigned wz_ = tkn[r].z, ww_ = tkn[r].w; w0c[r] = __uint_as_float(wz_); w1c[r] = __uint_as_float(ww_); } }
            if (it + 1 < NIT) {
                RP_LOAD_X(it + 1);
                if (COMBINE) {
#pragma unroll
                    for (int r = 0; r < RPI; ++r) tkn[r] = tkn2[r];
                    RP_LOAD_O(tkn);
                    if (it + 2 < NIT) RP_LOAD_TOK(tkn2, it + 2); } }
            if (COMBINE) {
#pragma unroll
                for (int r = 0; r < RPI; ++r)
#pragma unroll
                    for (int j = 0; j < 4; ++j) { const u32x2 a = oc[r][0][j], c = oc[r][1][j]; const float w0 = w0c[r], w1 = w1c[r];
                        f32x4 mo; mo[0] = w0 * bflo(a.x) + w1 * bflo(c.x); mo[1] = w0 * bfhi(a.x) + w1 * bfhi(c.x); mo[2] = w0 * bflo(a.y) + w1 * bflo(c.y); mo[3] = w0 * bfhi(a.y) + w1 * bfhi(c.y);
                        x[r][j] = x[r][j] + g2[j] * mo;
                        if (MODE == 2) { u32x2 xw_; xw_.x = pk2(x[r][j][0], x[r][j][1]); xw_.y = pk2(x[r][j][2], x[r][j][3]); *(u32x2*)(XB + (size_t)(r0 + r) * D + 256 * j + 4 * lane) = xw_; } }
            }
            float rstd[RPI];
#pragma unroll
            for (int r = 0; r < RPI; ++r) { float s = 0.f;
#pragma unroll
                for (int j = 0; j < 4; ++j) s += (x[r][j][0] * x[r][j][0] + x[r][j][1] * x[r][j][1]) + (x[r][j][2] * x[r][j][2] + x[r][j][3] * x[r][j][3]);
                rstd[r] = 1.0f / sqrtf(wave_sum(s) * (1.0f / D) + EPS); }
#pragma unroll
            for (int r = 0; r < RPI; ++r)
#pragma unroll
                for (int j = 0; j < 4; ++j) { f32x4 y = x[r][j] * rstd[r] * gm[j]; if (MODUL) y = y * sc[j] + sh[j]; x[r][j] = y;
                    if (MODE == 3) *(f32x4*)(xout + (size_t)(r0 + r) * D + 256 * j + 4 * lane) = y;
                    else if (MODE == 1 || (MODE == 2 && FP8_CIN) || (MODE == 0 && FP8_G1)) { *(unsigned*)((unsigned char*)(F.ws + WS_U8) + (size_t)(r0 + r) * D + 256 * j + 4 * lane) = pk4_fp8(y[0], y[1], y[2], y[3]);
                        if (MODE == 0 && FP8_G1 == 2) { u32x2 w; w.x = pk2(y[0], y[1]); w.y = pk2(y[2], y[3]); *(u32x2*)(U + (size_t)(r0 + r) * D + 256 * j + 4 * lane) = w; } }
                    else { u32x2 w; w.x = pk2(y[0], y[1]); w.y = pk2(y[2], y[3]); *(u32x2*)(U + (size_t)(r0 + r) * D + 256 * j + 4 * lane) = w; } }
            if (DOTS > 0) {
                float v[NV];
#pragma unroll
                for (int i = 0; i < NV; ++i) v[i] = 0.f;
#pragma unroll
                for (int j = 0; j < 4; ++j)
#pragma unroll
                    for (int i = 0; i < 4; ++i) {
                        float w[DOTS > 0 ? DOTS : 1];
#pragma unroll
                        for (int q = 0; q < DOTS / 4; ++q) { const int rot = (DOTS == 16) ? ((lane >> 2) & 3) : ((lane >> 3) & 1);
                            const f32x4 t4 = *(const LAS f32x4*)(wl + ((j * 4 + i) * 64 + lane) * DOTS + ((q + rot) & (DOTS / 4 - 1)) * 4); w[4 * q] = t4[0]; w[4 * q + 1] = t4[1]; w[4 * q + 2] = t4[2]; w[4 * q + 3] = t4[3]; }
#pragma unroll
                        for (int r = 0; r < RPI; ++r)
#pragma unroll
                            for (int e = 0; e < DOTS; ++e) v[r * DOTS + e] += x[r][j][i] * w[e];
                        asm volatile("" ::: "memory"); }
                xreduce<NV>(v, lane);
                const float tot = v[0];
                if (MODE == 0) {
                    const int idx = lane >> 2, r = idx >> 3, gi = idx & 7, row = r0 + r, bb = row / SEQ, s = row % SEQ;
                    if ((lane & 3) == 0) {
                        const float pre = tot + F.in[I_MBG][gi];
                        if (gi < 4) ((float*)(F.ws + WS_IG))[(size_t)(bb * NH + gi) * SEQ + s] = pre;
                        else { const float ls = (pre >= 0.f) ? -log1pf(expf(-pre)) : (pre - log1pf(expf(pre))); ((float*)(F.ws + WS_LF))[(size_t)(bb * NH + gi - 4) * SEQ + s] = ls; }
                    }
                }
                if (MODE == 1) {
                    const int r = lane >> 5;
                    float lg[16], mx = -INFINITY;
#pragma unroll
                    for (int e = 0; e < 16; ++e) { lg[e] = __shfl(tot, 32 * r + 2 * e); mx = fmaxf(mx, lg[e]); }
                    float se = 0.f;
#pragma unroll
                    for (int e = 0; e < 16; ++e) { lg[e] = __builtin_amdgcn_exp2f((lg[e] - mx) * 1.44269504089f); se += lg[e]; }
                    const float inv = 1.0f / se;
                    float sel[16];
#pragma unroll
                    for (int e = 0; e < 16; ++e) { lg[e] *= inv; sel[e] = lg[e] + brt[e]; }
                    int best = 0; float bscore = -INFINITY;
#pragma unroll
                    for (int gq = 0; gq < 4; ++gq) { const float a = sel[4 * gq], bq = sel[4 * gq + 1], c = sel[4 * gq + 2], d = sel[4 * gq + 3];
                        const float m1 = fmaxf(fmaxf(a, bq), fmaxf(c, d));
                        const float lo1 = fminf(a, bq), hi1 = fmaxf(a, bq), lo2 = fminf(c, d), hi2 = fmaxf(c, d);
                        const float m2 = fmaxf(fminf(hi1, hi2), fmaxf(lo1, lo2));
                        const float gs = m1 + m2; if (gs > bscore) { bscore = gs; best = gq; } }
                    float s4[4], p4[4];
#pragma unroll
                    for (int q = 0; q < 4; ++q) { s4[q] = -INFINITY; p4[q] = 0.f; }
#pragma unroll
                    for (int gq = 0; gq < 4; ++gq) if (best == gq) {
#pragma unroll
                        for (int q = 0; q < 4; ++q) { s4[q] = sel[4 * gq + q]; p4[q] = lg[4 * gq + q]; } }
                    int i0 = 0; float v0 = s4[0], pp0 = p4[0];
#pragma unroll
                    for (int q = 1; q < 4; ++q) if (s4[q] > v0) { v0 = s4[q]; i0 = q; pp0 = p4[q]; }
                    int i1 = -1; float v1 = -INFINITY, pp1 = 0.f;
#pragma unroll
                    for (int q = 0; q < 4; ++q) if (q != i0 && s4[q] > v1) { v1 = s4[q]; i1 = q; pp1 = p4[q]; }
                    const float wsum = pp0 + pp1, w0 = pp0 / wsum, w1 = pp1 / wsum;
                    const int e0 = best * 4 + i0, e1 = best * 4 + i1;
                    if ((lane & 31) == 0) {
                        const int lp0 = __hip_atomic_fetch_add(lcnt + e0, 1, __ATOMIC_RELAXED, __HIP_MEMORY_SCOPE_WORKGROUP), lp1 = __hip_atomic_fetch_add(lcnt + e1, 1, __ATOMIC_RELAXED, __HIP_MEMORY_SCOPE_WORKGROUP);
                        LAS int* ri = rinfo + (F.wave * 16 + it * RPI + r) * 8;
                        ri[0] = e0; ri[1] = e1; ri[2] = lp0; ri[3] = lp1; ri[4] = __builtin_bit_cast(int, w0); ri[5] = __builtin_bit_cast(int, w1);
                    }
                }
            }
        }
#undef RP_LOAD_X
#undef RP_LOAD_TOK
#undef RP_LOAD_O
        if (MODE == 1) {
            __syncthreads();
            if (F.tid < 16) lcnt[16 + F.tid] = (int)__hip_atomic_fetch_add(F.ctl + CW_CNT + 64 * layer + F.tid, (unsigned)lcnt[F.tid], RLX_AGENT);
            __syncthreads();
            if (F.tid < 128) { const LAS int* ri = rinfo + F.tid * 8; const int row = batch * 128 + F.tid; const int e0 = ri[0], e1 = ri[1], p0 = lcnt[16 + e0] + ri[2], p1 = lcnt[16 + e1] + ri[3];
                int* LIST = (int*)(F.ws + WS_LIST); LIST[e0 * LCAP + p0] = row; LIST[e1 * LCAP + p1] = row;
                u32x4 ti; ti.x = (unsigned)(e0 << 16) | (unsigned)p0; ti.y = (unsigned)(e1 << 16) | (unsigned)p1; ti.z = (unsigned)ri[4]; ti.w = (unsigned)ri[5];
                *(u32x4*)(F.ws + WS_TOK + (size_t)row * 16) = ti; }
        }
    }
    __syncthreads();
}

#define LBAR() do { asm volatile("s_waitcnt lgkmcnt(0)" ::: "memory"); __builtin_amdgcn_s_barrier(); asm volatile("" ::: "memory"); } while (0)
__device__ __forceinline__ float incl_sum(float v, int lane) {
#pragma unroll
    for (int o = 1; o < 64; o <<= 1) { const float t = __shfl_up(v, o); if (lane >= o) v += t; }
    return v;
}
__device__ __forceinline__ float incl_max(float v, int lane) {
#pragma unroll
    for (int o = 1; o < 64; o <<= 1) { const float t = __shfl_up(v, o); if (lane >= o) v = fmaxf(v, t); }
    return v;
}
__device__ __forceinline__ void phase_scan(Frame& F, int mode = 0) {
    LAS float* wkA = (LAS float*)(F.lds + 0);
    LAS float* decA = (LAS float*)(F.lds + 32768);
    LAS float* tot = (LAS float*)(F.lds + 33280);
    LAS float* bst = (LAS float*)(F.lds + 33792);
    LAS float* cmx = (LAS float*)(F.lds + 34304);
    LAS float* rst = (LAS float*)(F.lds + 34816);
    LAS float* xw = (LAS float*)(F.lds + 35328);
    LAS unsigned char* ring = F.lds + 40960;
    constexpr int SLOT = 12288;
    const int lane = F.lane, w = F.wave, tid = F.tid;
    for (int unit = F.vcu; unit < 256; unit += F.G) {
        const int bh = unit >> 4, slice = unit & 15;
        const float* IG = (const float*)(F.ws + WS_IG) + (size_t)bh * SEQ; const float* LF = (const float*)(F.ws + WS_LF) + (size_t)bh * SEQ;
        __syncthreads();
        if (mode < 2) {
        float p[16], g[16], pm[16];
#pragma unroll
        for (int q = 0; q < 16; ++q) { const int c = 16 * w + q; p[q] = incl_sum(LF[c * 64 + lane], lane); if (lane == 63) tot[c] = p[q]; }
        __syncthreads();
        if (tid < 128) { const float v = tot[tid]; const float inc = incl_sum(v, lane); if (tid == 63) xw[0] = inc; bst[tid] = inc - v; }
        __syncthreads();
        if (tid >= 64 && tid < 128) bst[tid] += xw[0];
        __syncthreads();
#pragma unroll
        for (int q = 0; q < 16; ++q) { const int c = 16 * w + q; p[q] += bst[c]; g[q] = IG[c * 64 + lane] - p[q]; pm[q] = incl_max(g[q], lane); if (lane == 63) cmx[c] = pm[q]; }
        __syncthreads();
        if (tid < 128) { const float v = cmx[tid]; const float inc = incl_max(v, lane); if (tid == 63) xw[1] = inc; float ex = __shfl_up(inc, 1); if (lane == 0) ex = 0.f; rst[tid] = fmaxf(ex, 0.f); }
        __syncthreads();
        if (tid >= 64 && tid < 128) rst[tid] = fmaxf(rst[tid], xw[1]);
        __syncthreads();
#pragma unroll
        for (int q = 0; q < 16; ++q) { const int c = 16 * w + q; const float Rs = rst[c], Rn = fmaxf(Rs, cmx[c]), Rrun = fmaxf(Rs, pm[q]);
            wkA[c * 64 + lane] = expf(g[q] - Rn); if (lane == 0) decA[c] = expf(Rs - Rn);
            if (slice == 0) { const size_t o = (size_t)bh * SEQ + c * 64 + lane; ((float*)(F.ws + WS_GA))[o] = g[q]; ((float*)(F.ws + WS_RR))[o] = Rrun; ((float*)(F.ws + WS_MM))[o] = p[q] + Rrun;
                if (lane == 0) ((float*)(F.ws + WS_RC))[bh * NCH + c] = Rs; } }
        }
        __syncthreads();
        if (mode == 1) continue;
        const int dkh = slice & 1, dvs = slice >> 1;
        const bf16_t* KTg = (const bf16_t*)(F.ws + WS_KT) + ((size_t)bh * NCH * DK + 64 * dkh) * 64;
        const bf16_t* VTg = (const bf16_t*)(F.ws + WS_VT) + ((size_t)bh * NCH * DV + 32 * dvs) * 64;
        const int dkr = 64 * dkh + 16 * (w >> 1), dvc = 32 * dvs + 16 * (w & 1);
        bf16_t* STp = (bf16_t*)(F.ws + WS_ST) + ((size_t)bh * NCH * DV + dvc + (lane & 15)) * DK + dkr + 4 * (lane >> 4);
        float* NSp = (float*)(F.ws + WS_NS) + (size_t)bh * NCH * DK + dkr + 4 * (lane >> 4);
        const bool ns_writer = (dvs == 0) && ((w & 1) == 0) && ((lane & 15) == 0);
        f32x4 accS = (f32x4){0.f, 0.f, 0.f, 0.f}, accN = (f32x4){0.f, 0.f, 0.f, 0.f};
        constexpr int PD = 4;
        u32x4 gk[PD], gv[PD];
        const int wr0 = (tid >> 3) * 128 + (((tid & 7) ^ ((tid >> 3) & 7)) << 4);
        const int arow = 16 * (w >> 1) + (lane & 15), brow = 16 * (w & 1) + (lane & 15), lq = lane >> 4;
#define SC_LOAD(set, cc) do { gk[set] = *(const u32x4*)(KTg + (size_t)(cc) * DK * 64 + tid * 8); if (tid < 256) gv[set] = *(const u32x4*)(VTg + (size_t)(cc) * DV * 64 + tid * 8); } while (0)
#define SC_WRITE(set, slot) do { LAS unsigned char* sb_ = ring + (slot) * SLOT; *(LAS u32x4*)(sb_ + wr0) = gk[set]; if (tid < 256) *(LAS u32x4*)(sb_ + 8192 + wr0) = gv[set]; } while (0)
#pragma unroll
        for (int q = 0; q < PD; ++q) SC_LOAD(q, q);
        SC_WRITE(0, 0); SC_WRITE(1, 1);
        SC_LOAD(0, PD); SC_LOAD(1, PD + 1);
        LBAR();
        for (int c0 = 0; c0 < NCH; c0 += PD) {
#pragma unroll
            for (int q2 = 0; q2 < PD; q2 += 2) {
                { const int cw = c0 + q2 + 2;
                  if (cw < NCH) { SC_WRITE((q2 + 2) % PD, (q2 + 2) % PD); SC_WRITE((q2 + 3) % PD, (q2 + 3) % PD);
                      if (cw + PD < NCH) { SC_LOAD((q2 + 2) % PD, cw + PD); SC_LOAD((q2 + 3) % PD, cw + PD + 1); } } }
#pragma unroll
                for (int qq = 0; qq < 2; ++qq) {
                    const int q = q2 + qq, c = c0 + q;
                    if (mode < 3) { { u32x2 o; o.x = pk2(accS[0], accS[1]); o.y = pk2(accS[2], accS[3]); *(u32x2*)(STp + (size_t)c * DV * DK) = o; }
                    if (ns_writer) *(f32x4*)(NSp + (size_t)c * DK) = accN; }
                    const float dec = decA[c];
                    accS = accS * dec; accN = accN * dec;
                    const LAS unsigned char* sb = ring + q * SLOT;
#pragma unroll
                    for (int kk = 0; kk < 2; ++kk) {
                        const LAS f32x4* wp = (const LAS f32x4*)(wkA + c * 64 + kk * 32 + 8 * lq);
                        const f32x4 w0 = wp[0], w1 = wp[1];
                        const u32x4 ka = *(const LAS u32x4*)(sb + arow * 128 + (((4 * kk + lq) ^ (arow & 7)) << 4));
                        const u32x4 vv = *(const LAS u32x4*)(sb + 8192 + brow * 128 + (((4 * kk + lq) ^ (brow & 7)) << 4));
                        u32x4 bv, b1;
                        bv.x = pk2(bflo(vv.x) * w0[0], bfhi(vv.x) * w0[1]); bv.y = pk2(bflo(vv.y) * w0[2], bfhi(vv.y) * w0[3]);
                        bv.z = pk2(bflo(vv.z) * w1[0], bfhi(vv.z) * w1[1]); bv.w = pk2(bflo(vv.w) * w1[2], bfhi(vv.w) * w1[3]);
                        b1.x = pk2(w0[0], w0[1]); b1.y = pk2(w0[2], w0[3]); b1.z = pk2(w1[0], w1[1]); b1.w = pk2(w1[2], w1[3]);
                        const bf16x8 af = __builtin_bit_cast(bf16x8, ka);
                        accS = __builtin_amdgcn_mfma_f32_16x16x32_bf16(af, __builtin_bit_cast(bf16x8, bv), accS, 0, 0, 0);
                        accN = __builtin_amdgcn_mfma_f32_16x16x32_bf16(af, __builtin_bit_cast(bf16x8, b1), accN, 0, 0, 0);
                    }
                }
                LBAR();
            }
        }
        asm volatile("" :: "v"(accS), "v"(accN));
#undef SC_LOAD
#undef SC_WRITE
    }
    __syncthreads();
}

constexpr int OC_AP = 0, OC_STRIDE = 400, OC_BVEC = 25600, OC_INV = 26368, OC_PART = 26624, OC_GS = 28672, OC_RT = 28928, OC_EMM = 29184, OC_HT = 32768, OC_HSTR = 528;
__device__ __forceinline__ void phase_out(Frame& F) {
    LAS unsigned char* AP = F.lds + OC_AP; LAS unsigned char* HT = F.lds + OC_HT;
    LAS float* bvec = (LAS float*)(F.lds + OC_BVEC); LAS float* inv = (LAS float*)(F.lds + OC_INV); LAS float* part = (LAS float*)(F.lds + OC_PART);
    LAS float* gs = (LAS float*)(F.lds + OC_GS); LAS float* Rt = (LAS float*)(F.lds + OC_RT); LAS float* emm = (LAS float*)(F.lds + OC_EMM);
    const int lane = F.lane, w = F.wave, tid = F.tid, l15 = lane & 15, lq = lane >> 4;
    const bf16_t* Qg = (const bf16_t*)(F.ws + WS_Q); const bf16_t* Kg = (const bf16_t*)(F.ws + WS_K);
    const bf16_t* VTg = (const bf16_t*)(F.ws + WS_VT); const bf16_t* STg = (const bf16_t*)(F.ws + WS_ST); const bf16_t* OGS = (const bf16_t*)(F.ws + WS_OGS);
    const float* GAg = (const float*)(F.ws + WS_GA); const float* RRg = (const float*)(F.ws + WS_RR); const float* MMg = (const float*)(F.ws + WS_MM);
    const float* NSg = (const float*)(F.ws + WS_NS); const float* RCg = (const float*)(F.ws + WS_RC); const float* MNG = F.in[I_MNG];
    bf16_t* HN = (bf16_t*)(F.ws + WS_U);
    const int mt = w >> 1, ntb = (w & 1) * 2, tq = tid >> 3, pq = tid & 7, NU = 16 * NCH;
    u32x4 bfr[2][6], qk[4], og[4]; f32x4 ng0, ng1; float sc_g = 0.f, sc_r = 0.f, sc_m = 0.f, sc_b = 0.f, Rc = 0.f;
    LAS unsigned char* QL = F.lds + 69632; LAS unsigned char* KL = F.lds + 86016;
    const int prow = tid >> 4, pch = tid & 15;
    const int pwr = prow * 256 + ((pch ^ (prow & 15)) << 4);
#define OC_LOAD_MAIN(U_) do { const int bh_ = (U_) >> 7, c_ = (U_) & 127, tk_ = (bh_ >> 2) * SEQ + c_ * 64, h_ = bh_ & 3; \
        _Pragma("unroll") for (int n = 0; n < 2; ++n) { const int dv = 32 * w + 16 * n + l15; \
            _Pragma("unroll") for (int kk = 0; kk < 2; ++kk) bfr[n][kk] = *(const u32x4*)(VTg + ((((size_t)bh_ * NCH + c_) * DV + dv) << 6) + 32 * kk + 8 * lq); \
            _Pragma("unroll") for (int kk = 0; kk < 4; ++kk) bfr[n][2 + kk] = *(const u32x4*)(STg + (((size_t)bh_ * NCH + c_) * DV + dv) * DK + 32 * kk + 8 * lq); } \
        qk[0] = *(const u32x4*)(Qg + (size_t)(tk_ + prow) * MQK + h_ * DK + 8 * pch); qk[1] = *(const u32x4*)(Qg + (size_t)(tk_ + prow + 32) * MQK + h_ * DK + 8 * pch); \
        qk[2] = *(const u32x4*)(Kg + (size_t)(tk_ + prow) * MQK + h_ * DK + 8 * pch); qk[3] = *(const u32x4*)(Kg + (size_t)(tk_ + prow + 32) * MQK + h_ * DK + 8 * pch); \
        if (tid < 64) { const size_t o_ = (size_t)bh_ * SEQ + c_ * 64 + tid; sc_g = GAg[o_]; sc_r = RRg[o_]; sc_m = MMg[o_]; sc_b = 1.0f; } \
        else if (tid < 192) sc_b = NSg[((size_t)bh_ * NCH + c_) * DK + tid - 64]; \
        Rc = RCg[bh_ * NCH + c_]; } while (0)
#define OC_LOAD_OGS(U_) do { const int bh_ = (U_) >> 7, c_ = (U_) & 127, tk_ = (bh_ >> 2) * SEQ + c_ * 64, h_ = bh_ & 3; \
        _Pragma("unroll") for (int q = 0; q < 4; ++q) og[q] = *(const u32x4*)(OGS + (size_t)(tk_ + (tid >> 5) + 16 * q) * MV + h_ * DV + 8 * (tid & 31)); \
        ng0 = *(const f32x4*)(MNG + h_ * DV + 8 * (tid & 31)); ng1 = *(const f32x4*)(MNG + h_ * DV + 8 * (tid & 31) + 4); } while (0)
    int unit = F.vcu;
    if (unit < NU) { OC_LOAD_MAIN(unit); OC_LOAD_OGS(unit); }
    for (; unit < NU; unit += F.G) {
        const int bh = unit >> 7, c = unit & 127, b = bh >> 2, h = bh & 3;
        const int tk0 = b * SEQ + c * 64;
        if (tid < 64) { gs[tid] = sc_g; Rt[tid] = sc_r; emm[tid] = expf(-sc_m); }
        if (tid < 192) bvec[tid] = sc_b;
        *(LAS u32x4*)(QL + pwr) = qk[0]; *(LAS u32x4*)(QL + 8192 + pwr) = qk[1]; *(LAS u32x4*)(KL + pwr) = qk[2]; *(LAS u32x4*)(KL + 8192 + pwr) = qk[3];
        const float Rc_cur = Rc;
        LBAR();
        u32x4 qa[4], kb[2][4];
#pragma unroll
        for (int kk = 0; kk < 4; ++kk) { { const int row = 16 * mt + l15; qa[kk] = *(const LAS u32x4*)(QL + row * 256 + (((4 * kk + lq) ^ (row & 15)) << 4)); }
#pragma unroll
            for (int n = 0; n < 2; ++n) { const int row = 16 * (ntb + n) + l15; kb[n][kk] = *(const LAS u32x4*)(KL + row * 256 + (((4 * kk + lq) ^ (row & 15)) << 4)); } }
        const u32x4 q0 = *(const LAS u32x4*)(QL + tq * 256 + (((2 * pq) ^ (tq & 15)) << 4)), q1 = *(const LAS u32x4*)(QL + tq * 256 + (((2 * pq + 1) ^ (tq & 15)) << 4));
        f32x4 pacc[2];
#pragma unroll
        for (int n = 0; n < 2; ++n) { pacc[n] = (f32x4){0.f, 0.f, 0.f, 0.f};
#pragma unroll
            for (int kk = 0; kk < 4; ++kk) pacc[n] = __builtin_amdgcn_mfma_f32_16x16x32_bf16(__builtin_bit_cast(bf16x8, qa[kk]), __builtin_bit_cast(bf16x8, kb[n][kk]), pacc[n], 0, 0, 0); }
#pragma unroll
        for (int n = 0; n < 2; ++n) { const int sl = 16 * (ntb + n) + l15; const float gsv = gs[sl];
#pragma unroll
            for (int r = 0; r < 4; ++r) { const int tl = 16 * mt + 4 * lq + r; const float pv = (sl <= tl) ? pacc[n][r] * expf(gsv - Rt[tl]) : 0.f;
                *(LAS bf16_t*)(AP + tl * OC_STRIDE + sl * 2) = (bf16_t)f2bf(pv); } }
        { const float wq = expf(Rc_cur - Rt[tq]);
          u32x4 o0, o1;
          o0.x = pk2(bflo(q0.x) * wq, bfhi(q0.x) * wq); o0.y = pk2(bflo(q0.y) * wq, bfhi(q0.y) * wq); o0.z = pk2(bflo(q0.z) * wq, bfhi(q0.z) * wq); o0.w = pk2(bflo(q0.w) * wq, bfhi(q0.w) * wq);
          o1.x = pk2(bflo(q1.x) * wq, bfhi(q1.x) * wq); o1.y = pk2(bflo(q1.y) * wq, bfhi(q1.y) * wq); o1.z = pk2(bflo(q1.z) * wq, bfhi(q1.z) * wq); o1.w = pk2(bflo(q1.w) * wq, bfhi(q1.w) * wq);
          *(LAS u32x4*)(AP + tq * OC_STRIDE + 128 + 32 * pq) = o0; *(LAS u32x4*)(AP + tq * OC_STRIDE + 128 + 32 * pq + 16) = o1; }
        LBAR();
        { float s = 0.f;
#pragma unroll
          for (int q = 0; q < 3; ++q) { const u32x4 a = *(const LAS u32x4*)(AP + tq * OC_STRIDE + 48 * pq + 16 * q); const LAS f32x4* bp = (const LAS f32x4*)(bvec + 24 * pq + 8 * q); const f32x4 b0 = bp[0], b1 = bp[1];
              s += bflo(a.x) * b0[0] + bfhi(a.x) * b0[1] + bflo(a.y) * b0[2] + bfhi(a.y) * b0[3] + bflo(a.z) * b1[0] + bfhi(a.z) * b1[1] + bflo(a.w) * b1[2] + bfhi(a.w) * b1[3]; }
          s += __shfl_xor(s, 1); s += __shfl_xor(s, 2); s += __shfl_xor(s, 4);
          if (pq == 0) inv[tq] = 1.0f / fmaxf(fabsf(s), emm[tq]); }
        f32x4 acc[4][2];
#pragma unroll
        for (int m = 0; m < 4; ++m)
#pragma unroll
            for (int n = 0; n < 2; ++n) acc[m][n] = (f32x4){0.f, 0.f, 0.f, 0.f};
#pragma unroll
        for (int kk = 0; kk < 6; ++kk) {
            bf16x8 af[4];
#pragma unroll
            for (int m = 0; m < 4; ++m) af[m] = *(const LAS bf16x8*)(AP + (16 * m + l15) * OC_STRIDE + 64 * kk + 16 * lq);
#pragma unroll
            for (int m = 0; m < 4; ++m)
#pragma unroll
                for (int n = 0; n < 2; ++n) acc[m][n] = __builtin_amdgcn_mfma_f32_16x16x32_bf16(af[m], __builtin_bit_cast(bf16x8, bfr[n][kk]), acc[m][n], 0, 0, 0);
        }
        const int nxt = unit + F.G;
        if (nxt < NU) OC_LOAD_MAIN(nxt);
        LBAR();
#pragma unroll
        for (int m = 0; m < 4; ++m)
#pragma unroll
            for (int r = 0; r < 4; ++r) { const int tl = 16 * m + 4 * lq + r; const float iv = inv[tl];
                const float h0 = acc[m][0][r] * iv, h1 = acc[m][1][r] * iv;
                *(LAS bf16_t*)(HT + tl * OC_HSTR + (32 * w + l15) * 2) = (bf16_t)f2bf(h0); *(LAS bf16_t*)(HT + tl * OC_HSTR + (32 * w + 16 + l15) * 2) = (bf16_t)f2bf(h1);
                float s = h0 * h0 + h1 * h1; s += __shfl_xor(s, 1); s += __shfl_xor(s, 2); s += __shfl_xor(s, 4); s += __shfl_xor(s, 8);
                if (l15 == 0) part[w * 64 + tl] = s; }
        LBAR();
#pragma unroll
        for (int q = 0; q < 4; ++q) { const int row = (tid >> 5) + 16 * q, ch = tid & 31; float ss = 0.f;
#pragma unroll
            for (int ww = 0; ww < 8; ++ww) ss += part[ww * 64 + row];
            const float rs = 1.0f / sqrtf(ss * (1.0f / DV) + EPS);
            const u32x4 hv = *(const LAS u32x4*)(HT + row * OC_HSTR + ch * 16); const u32x4 g = og[q];
            float f0 = bflo(hv.x) * rs * ng0[0] * bflo(g.x), f1 = bfhi(hv.x) * rs * ng0[1] * bfhi(g.x), f2 = bflo(hv.y) * rs * ng0[2] * bflo(g.y), f3 = bfhi(hv.y) * rs * ng0[3] * bfhi(g.y);
            float f4 = bflo(hv.z) * rs * ng1[0] * bflo(g.z), f5 = bfhi(hv.z) * rs * ng1[1] * bfhi(g.z), f6 = bflo(hv.w) * rs * ng1[2] * bflo(g.w), f7 = bfhi(hv.w) * rs * ng1[3] * bfhi(g.w);
            if (FP8_MOUT) { u32x2 o8; o8.x = pk4_fp8_sat(2.f * f0, 2.f * f1, 2.f * f2, 2.f * f3); o8.y = pk4_fp8_sat(2.f * f4, 2.f * f5, 2.f * f6, 2.f * f7);
                *(u32x2*)((unsigned char*)HN + (size_t)(tk0 + row) * MV + h * DV + 8 * ch) = o8; }
            else { u32x4 o; o.x = pk2(f0, f1); o.y = pk2(f2, f3); o.z = pk2(f4, f5); o.w = pk2(f6, f7);
            *(u32x4*)(HN + (size_t)(tk0 + row) * MV + h * DV + 8 * ch) = o; } }
        if (nxt < NU) OC_LOAD_OGS(nxt);
    }
#undef OC_LOAD_MAIN
#undef OC_LOAD_OGS
    __syncthreads();
}

__device__ __forceinline__ void phase_conv(Frame& F) {
    const bf16_t* BG = (const bf16_t*)(F.ws + WS_BG); const bf16_t* Z = (const bf16_t*)(F.ws + WS_Z); bf16_t* Y = (bf16_t*)(F.ws + WS_Y);
    const int cg = F.tid & 127, rsub = F.tid >> 7, col = 8 * cg;
    float w0[8], w1[8], w2[8], cb[8];
#pragma unroll
    for (int i = 0; i < 8; ++i) { w0[i] = F.in[I_CCW][col + i]; w1[i] = F.in[I_CCW][D + col + i]; w2[i] = F.in[I_CCW][2 * D + col + i]; cb[i] = F.in[I_CCB][col + i]; }
    for (int batch = F.vcu; batch < T / 128; batch += F.G) {
        const int t0 = batch * 128 + rsub * 32, s0 = t0 % SEQ;
        u32x4 z2 = (u32x4){0u, 0u, 0u, 0u}, z1 = z2;
        if (s0 >= 2) z2 = *(const u32x4*)(Z + (size_t)(t0 - 2) * D + col);
        if (s0 >= 1) z1 = *(const u32x4*)(Z + (size_t)(t0 - 1) * D + col);
#pragma unroll 4
        for (int r = 0; r < 32; ++r) {
            const u32x4 z0 = *(const u32x4*)(Z + (size_t)(t0 + r) * D + col), bg = *(const u32x4*)(BG + (size_t)(t0 + r) * D + col);
            float o[8];
#pragma unroll
            for (int i = 0; i < 4; ++i) {
                o[2 * i] = bflo(bg[i]) * (w0[2 * i] * bflo(z2[i]) + w1[2 * i] * bflo(z1[i]) + w2[2 * i] * bflo(z0[i]) + cb[2 * i]);
                o[2 * i + 1] = bfhi(bg[i]) * (w0[2 * i + 1] * bfhi(z2[i]) + w1[2 * i + 1] * bfhi(z1[i]) + w2[2 * i + 1] * bfhi(z0[i]) + cb[2 * i + 1]); }
            if (FP8_COUT) { u32x2 o8; o8.x = pk4_fp8_sat(o[0], o[1], o[2], o[3]); o8.y = pk4_fp8_sat(o[4], o[5], o[6], o[7]); *(u32x2*)((unsigned char*)Y + (size_t)(t0 + r) * D + col) = o8; }
            else { u32x4 ov; ov.x = pk2(o[0], o[1]); ov.y = pk2(o[2], o[3]); ov.z = pk2(o[4], o[5]); ov.w = pk2(o[6], o[7]);
            *(u32x4*)(Y + (size_t)(t0 + r) * D + col) = ov; }
            z2 = z1; z1 = z0;
        }
    }
}

__device__ __forceinline__ void moe_table(Frame& F, int layer) {
    __syncthreads();
    if (F.tid == 0) { int a = 0; for (int e = 0; e < NE; ++e) { const int c = (int)__hip_atomic_load(F.ctl + CW_CNT + 64 * layer + e, RLX_AGENT); F.MISC[16 + e] = (unsigned)a; F.MISC[40 + e] = (unsigned)c; a += (c + 255) >> 8; } F.MISC[16 + NE] = (unsigned)a; }
    __syncthreads();
}

#ifndef TIMER_PHASE
#define TIMER_PHASE (-1)
#endif
#define STAMP(k) do { if (TIMER_PHASE >= 0 && blockIdx.x == 0 && threadIdx.x == 0) { unsigned long long t_ = __builtin_amdgcn_s_memrealtime(); ((unsigned long long*)karg_ptr(21))[4096 + (k)] = t_; } } while (0)
constexpr int N_PHASES = 17;
#define WSP(T_, off) ((T_*)(F.ws + (off)))
__global__ void __launch_bounds__(NTHR, 2) fwd_kernel(Args args) {
    extern __shared__ __attribute__((aligned(16))) unsigned char lds_raw[];
#define MAKE_FRAME() Frame F; { int t_ = threadIdx.x, bx_ = blockIdx.x, g_ = gridDim.x; asm volatile("" : "+v"(t_), "+s"(bx_), "+s"(g_)); \
        F.lds = (LAS unsigned char*)lds_raw; F.MISC = (volatile LAS unsigned*)(F.lds + MISC_OFF); F.tid = t_; F.lane = t_ & 63; F.wave = __builtin_amdgcn_readfirstlane(t_ >> 6); \
        F.G = g_; F.bx = bx_; F.vcu = (g_ % 8 == 0) ? (bx_ % 8) * (g_ / 8) + bx_ / 8 : bx_; }
    const int lo = args.ph_lo, hi = args.ph_hi;
    const bool one_launch = (hi - lo) > 1;
    XcdBarrier bar;
    { MAKE_FRAME();
      for (int u = F.tid; u < 256; u += NTHR) F.MISC[u] = 0u;
      __syncthreads();
      bar.bar = (unsigned*)(F.ctl + CW_BAR); bar.x = 0; bar.st = nullptr;
      if (one_launch) bar = xcd_barrier_post((unsigned*)(F.ctl + CW_BAR), F.MISC + 8); }
    STAMP(0);
#ifdef PH_ONLY
#define IN(k) ((k) == PH_ONLY && lo <= (k) && (k) < hi)
#else
#define IN(k) (lo <= (k) && (k) < hi)
#endif
#define SEAM(k) do { if (IN(k) && IN((k) + 1)) { xcd_barrier(bar); STAMP((k) + 1); } } while (0)
#ifndef DUP_MODE
#define DUP_MODE 0
#endif
#ifndef DUP_PHASE
#define DUP_PHASE (-1)
#endif
#define PHASE(k) if (IN(k)) { for (int rep_ = 0; rep_ < (((k) == DUP_PHASE) ? 2 : 1); ++rep_) { MAKE_FRAME(); asm volatile("; PHASE_MARK " #k);
#define END_PHASE(k) } } SEAM(k);
    PHASE(0) phase_prologue(F); END_PHASE(0)
    PHASE(1) row_pass<0>(F, 0); END_PHASE(1)
    PHASE(2) pg8::DenseOrder S; S.init(T, 3 * D, F.G, F.bx);
        pg8::EpiM1 E{WSP(bf16_t, WS_Q), WSP(bf16_t, WS_K), WSP(bf16_t, WS_KT), WSP(bf16_t, WS_VT), WSP(bf16_t, WS_OGS), F.lds + EPI_OFF};
        if (FP8_G1 == 2) { S.init(T, 4 * 256, F.G, F.bx); { pg8::Gemm g{WSP(bf16_t, WS_U), WSP(bf16_t, WS_W0), D};
                pg8::gemm_phase<pg8::EpiM1, pg8::DenseOrder, false, true, true>(F.lds, g, S, E, F.tid); }
            S.init(T, 8 * 256, F.G, F.bx); S.pn0 = 4; { pg8::Gemm g{WSP(bf16_t, WS_U8), (const bf16_t*)(F.ws + WS_W0 + 2 * MiB), D / 2, 0x7a7a7a7a, 0x7f7f7f7f};
                pg8::gemm_phase<pg8::EpiM1, pg8::DenseOrder, true, true, true, true>(F.lds, g, S, E, F.tid); } }
        else if (FP8_G1) { pg8::Gemm g{WSP(bf16_t, WS_U8), WSP(bf16_t, WS_W0), D / 2, 0x7a7a7a7a, 0x7f7f7f7f};
            pg8::gemm_phase<pg8::EpiM1, pg8::DenseOrder, true, true, true, true>(F.lds, g, S, E, F.tid); }
        else { pg8::Gemm g{WSP(bf16_t, WS_U), WSP(bf16_t, WS_W0), D};
            pg8::gemm_phase<pg8::EpiM1, pg8::DenseOrder, false, true, true>(F.lds, g, S, E, F.tid); } END_PHASE(2)
    PHASE(3) phase_scan(F, rep_ == 0 ? 0 : DUP_MODE); END_PHASE(3)
    PHASE(4) phase_out(F); END_PHASE(4)
    PHASE(5) pg8::DenseOrder S; S.init(T, D, F.G, F.bx);
        pg8::EpiRes<true> E{F.in[I_X], WSP(bf16_t, WS_XB), WSP(float, WS_MOD) + 2 * D, (DBG_SKIP & 1) ? 0.f : 1.f};
        if (FP8_MOUT) { pg8::Gemm g{WSP(bf16_t, WS_U), WSP(bf16_t, WS_W1), D / 2, 0x7a7a7a7a, 0x7e7e7e7e};
            pg8::gemm_phase<pg8::EpiRes<true>, pg8::DenseOrder, true, true, true, true>(F.lds, g, S, E, F.tid); }
        else { pg8::Gemm g{WSP(bf16_t, WS_U), WSP(bf16_t, WS_W1), D};
            pg8::gemm_phase<pg8::EpiRes<true>, pg8::DenseOrder, false, true, true>(F.lds, g, S, E, F.tid); } END_PHASE(5)
#define WL(L_, off) WSP(bf16_t, ((L_) == 0 ? (size_t)0 : WS_WL1) + (off))
#define MOE_BLOCK(L, p0, p1, p2) \
    PHASE(p0) row_pass<1>(F, L); END_PHASE(p0) \
    PHASE(p1) moe_table(F, L); \
        pg8::Gemm g{WSP(bf16_t, WS_U8), WL(L, WS_WUP), D / 2, 0x7a7a7a7a, 0x7f7f7f7f, (LAS int*)(F.lds + EPI_OFF), (const int*)(F.ctl + 16)}; pg8::MoeOrder S{(const LAS int*)(F.MISC + 16), (const LAS int*)(F.MISC + 40), WSP(const int, WS_LIST), F.G, F.vcu, 1024}; \
        pg8::EpiGlu<true, true> E{WSP(bf16_t, WS_A8), DE, 0, nullptr, 0, 2.0f}; \
        pg8::gemm_phase<pg8::EpiGlu<true, true>, pg8::MoeOrder, true, true, true, true>(F.lds, g, S, E, F.tid); END_PHASE(p1) \
    PHASE(p2) moe_table(F, L); \
        pg8::Gemm g{WSP(bf16_t, WS_A8), WL(L, WS_WDN), DE / 2, 0x7b7b7b7b, 0x7e7e7e7e}; pg8::MoeOrder S{(const LAS int*)(F.MISC + 16), (const LAS int*)(F.MISC + 40), nullptr, F.G, F.vcu, 1024}; \
        pg8::EpiBf E{WSP(bf16_t, WS_O), D}; \
        pg8::gemm_phase<pg8::EpiBf, pg8::MoeOrder, true, true, true, true>(F.lds, g, S, E, F.tid); END_PHASE(p2)
    MOE_BLOCK(0, 6, 7, 8)
    PHASE(9) row_pass<2>(F, 1); convert_weights(F, 1); END_PHASE(9)
    PHASE(10) pg8::DenseOrder S; S.init(T, 3 * D, F.G, F.bx);
        pg8::EpiGlu<false> E{WSP(bf16_t, WS_Z), D, 4, WSP(bf16_t, WS_BG), D, 0.f};
        if (FP8_CIN) { pg8::Gemm g{WSP(bf16_t, WS_U8), WL(1, WS_W0), D / 2, 0x7a7a7a7a, 0x7f7f7f7f};
            pg8::gemm_phase<pg8::EpiGlu<false>, pg8::DenseOrder, true, true, true, true>(F.lds, g, S, E, F.tid); }
        else { pg8::Gemm g{WSP(bf16_t, WS_U), WL(1, WS_W0), D};
            pg8::gemm_phase<pg8::EpiGlu<false>, pg8::DenseOrder, false, true, true>(F.lds, g, S, E, F.tid); } END_PHASE(10)
    PHASE(11) phase_conv(F); END_PHASE(11)
    PHASE(12) pg8::DenseOrder S; S.init(T, D, F.G, F.bx);
        pg8::EpiRes<false> E{WSP(bf16_t, WS_XB), WSP(bf16_t, WS_XB), WSP(float, WS_MOD) + (size_t)NB * 6 * D + 2 * D, (DBG_SKIP & 4) ? 0.f : 1.f};
        if (FP8_COUT) { pg8::Gemm g{WSP(bf16_t, WS_Y), WL(1, WS_W1), D / 2, 0x7a7a7a7a, 0x7f7f7f7f};
            pg8::gemm_phase<pg8::EpiRes<false>, pg8::DenseOrder, true, true, true, true>(F.lds, g, S, E, F.tid); }
        else { pg8::Gemm g{WSP(bf16_t, WS_Y), WL(1, WS_W1), D};
            pg8::gemm_phase<pg8::EpiRes<false>, pg8::DenseOrder, false, true, true>(F.lds, g, S, E, F.tid); } END_PHASE(12)
    MOE_BLOCK(1, 13, 14, 15)
    if (IN(16)) { MAKE_FRAME(); asm volatile("; PHASE_MARK 16"); row_pass<3>(F, 1);
    }

    if (TIMER_PHASE >= 0 && one_launch) {
        STAMP(17);
        xcd_barrier(bar);
        const unsigned long long* ts = (const unsigned long long*)karg_ptr(21) + 4096;
        const unsigned long long d = __hip_atomic_load(ts + TIMER_PHASE + 1, RLX_AGENT) - __hip_atomic_load(ts + TIMER_PHASE, RLX_AGENT);
        const unsigned long long t0 = __builtin_amdgcn_s_memrealtime();
        while (__builtin_amdgcn_s_memrealtime() - t0 < 4ull * d) __builtin_amdgcn_s_sleep(8);
    }
#undef IN
#undef SEAM
}

extern "C" void kernel_launch(void* const* d_in, const int* in_sizes, int n_in, void* d_out, int out_size, void* d_ws, size_t ws_size, hipStream_t stream) {
    static int grid = 0;
    if (grid == 0) {
        if (n_in != 20 || in_sizes[0] != T * D || out_size != T * D || ws_size < WS_END) { fprintf(stderr, "kernel_launch: unexpected shapes: n_in %d in0 %d out %d ws %zu\n", n_in, n_in > 0 ? in_sizes[0] : -1, out_size, ws_size); grid = -1; return; }
        int dev = 0, cus = 0, per_cu = 0;
        if (hipGetDevice(&dev) != hipSuccess || hipDeviceGetAttribute(&cus, hipDeviceAttributeMultiprocessorCount, dev) != hipSuccess) { grid = -1; return; }
        if (hipFuncSetAttribute((const void*)fwd_kernel, hipFuncAttributeMaxDynamicSharedMemorySize, LDS_BYTES) != hipSuccess) { fprintf(stderr, "kernel_launch: hipFuncSetAttribute failed\n"); grid = -1; return; }
        if (hipOccupancyMaxActiveBlocksPerMultiprocessor(&per_cu, (const void*)fwd_kernel, NTHR, LDS_BYTES) != hipSuccess || per_cu < 1) { fprintf(stderr, "kernel_launch: occupancy query says %d blocks per CU\n", per_cu); (void)hipGetLastError(); grid = -1; return; }
        grid = cus;
        if (grid != 256) fprintf(stderr, "kernel_launch: %d CUs (built for 256)\n", grid);
    }
    if (grid < 0) return;
    (void)hipMemsetAsync((char*)d_ws + WS_CTL, 0, CTL_ZERO_BYTES, stream);
    Args a{};
    for (int i = 0; i < 20; ++i) a.in[i] = (const float*)d_in[i];
    a.out = (float*)d_out; a.ws = (unsigned char*)d_ws;
#if MK_N_LAUNCHES == 1
    a.ph_lo = 0; a.ph_hi = N_PHASES;
    void* kargs[] = {&a};
    hipError_t e = hipLaunchCooperativeKernel((const void*)fwd_kernel, dim3(grid), dim3(NTHR), kargs, LDS_BYTES, stream);
    if (e != hipSuccess) fprintf(stderr, "kernel_launch: cooperative launch failed: %s\n", hipGetErrorString(e));
#else
    for (int p = 0; p < N_PHASES; ++p) { a.ph_lo = p; a.ph_hi = p + 1; hipLaunchKernelGGL(fwd_kernel, dim3(grid), dim3(NTHR), LDS_BYTES, stream, a); }
#endif
}
```

```cpp
#include <hip/hip_runtime.h>
#include <cstdio>
#include <cstdint>

#ifndef FP8_G1
#define FP8_G1 2
#endif
#ifndef FP8_MOUT
#define FP8_MOUT 1
#endif
#ifndef FP8_COUT
#define FP8_COUT 1
#endif
#ifndef FP8_CIN
#define FP8_CIN 1
#endif
#ifndef I8_G1
#define I8_G1 1
#endif
#ifndef I8_CIN
#define I8_CIN 1
#endif
#ifndef I8_UP
#define I8_UP 1
#endif
#ifndef DBG_SKIP
#define DBG_SKIP 0
#endif
#ifndef MK_N_LAUNCHES
#define MK_N_LAUNCHES 1
#endif

#define LAS __attribute__((address_space(3)))
#define GAS __attribute__((address_space(1)))
typedef unsigned short bf16_t;
typedef short bf16x8 __attribute__((ext_vector_type(8)));
typedef float f32x4 __attribute__((ext_vector_type(4)));
typedef float f32x2 __attribute__((ext_vector_type(2)));
typedef unsigned u32x4 __attribute__((ext_vector_type(4)));
typedef unsigned u32x2 __attribute__((ext_vector_type(2)));
typedef GAS unsigned gu32;
#define RLX_AGENT __ATOMIC_RELAXED, __HIP_MEMORY_SCOPE_AGENT
#define LDS_WAIT() asm volatile("s_waitcnt lgkmcnt(0)" ::: "memory")
#define VM_WAIT() asm volatile("s_waitcnt vmcnt(0)" ::: "memory")

constexpr int NB = 4, SEQ = 8192, D = 1024, T = NB * SEQ;
constexpr int NH = 4, DK = 128, DV = 256, MQK = NH * DK, MV = NH * DV, MPROJ = 2 * MQK + 2 * MV + 2 * NH;
constexpr int CH = 64, NCH = SEQ / CH;
constexpr int NE = 16, DE = 512, LCAP = 65536;
constexpr int SLOT_ROWS = 2 * T + NE * 256;
constexpr float EPS = 1e-6f;
constexpr int NWAVES = 8, NTHR = 512;

constexpr size_t MiB = 1u << 20;
constexpr size_t WS_CTL = 0, CTL_ZERO_BYTES = 64 * 1024;
constexpr size_t WS_MOD = 1 * MiB;
constexpr size_t WS_W0 = 2 * MiB;
constexpr size_t WS_W1 = 8 * MiB;
constexpr size_t WS_WUP = 10 * MiB;
constexpr size_t WS_WDN = 42 * MiB;
constexpr size_t WS_WL1 = 338 * MiB;
constexpr size_t WS_IG = 62 * MiB;
constexpr size_t WS_LF = WS_IG + 512 * 1024;
constexpr size_t WS_GA = WS_LF + 512 * 1024;
constexpr size_t WS_RR = WS_GA + 512 * 1024;
constexpr size_t WS_MM = WS_RR + 512 * 1024;
constexpr size_t WS_RC = WS_MM + 512 * 1024;
constexpr size_t WS_NS = 65 * MiB;
constexpr size_t WS_TOK = 66 * MiB;
constexpr size_t WS_LIST = 67 * MiB;
constexpr size_t WS_SA = 71 * MiB;
constexpr size_t WS_SASLOT = 72 * MiB;
constexpr size_t WS_U = 72 * MiB;
constexpr size_t WS_Q = 136 * MiB;
constexpr size_t WS_K = 168 * MiB;
constexpr size_t WS_KT = 200 * MiB;
constexpr size_t WS_VT = 232 * MiB;
constexpr size_t WS_OGS = 296 * MiB;
constexpr size_t WS_ST = 360 * MiB;
constexpr size_t WS_A = 136 * MiB;
constexpr size_t WS_O = 204 * MiB;
constexpr size_t WS_BG = 136 * MiB;
constexpr size_t WS_Z = 200 * MiB;
constexpr size_t WS_Y = 264 * MiB;
constexpr size_t WS_XB = 400 * MiB;
constexpr size_t WS_U8 = 464 * MiB;
constexpr size_t WS_A8 = 136 * MiB;
constexpr size_t WS_END = 496 * MiB;
static_assert(WS_A + (size_t)SLOT_ROWS * DE * 2 <= WS_O && WS_O + (size_t)SLOT_ROWS * D * 2 <= WS_ST, "moe map");

constexpr int CW_CNT = 64;
constexpr int CW_CVT = 256;
constexpr int CW_BAR = 1024;

constexpr int RING_BYTES = 131072;
constexpr int MISC_OFF = RING_BYTES;
constexpr int EPI_OFF = MISC_OFF + 1024;
constexpr int SA_OFF = EPI_OFF + 16384;
constexpr int LDS_BYTES = 150528;
constexpr float W8_Q = 576.f, W8_STEP = 1.f / 576.f;

typedef __bf16 bf16x2_t __attribute__((ext_vector_type(2)));
__device__ __forceinline__ unsigned f2bf(float f) { return (unsigned)__builtin_bit_cast(unsigned short, (__bf16)f); }
__device__ __forceinline__ unsigned pk2(float lo, float hi) { bf16x2_t v; v[0] = (__bf16)lo; v[1] = (__bf16)hi; return __builtin_bit_cast(unsigned, v); }
__device__ __forceinline__ float bf2f(unsigned short h) { return __builtin_bit_cast(float, (unsigned)h << 16); }
__device__ __forceinline__ float bflo(unsigned w) { return __builtin_bit_cast(float, w << 16); }
__device__ __forceinline__ float bfhi(unsigned w) { return __builtin_bit_cast(float, w & 0xffff0000u); }
__device__ __forceinline__ unsigned cvt_pk_bf16(float lo, float hi) { unsigned r; asm volatile("v_cvt_pk_bf16_f32 %0, %1, %2" : "=v"(r) : "v"(lo), "v"(hi)); return r; }
__device__ __forceinline__ unsigned pk4_fp8(float a, float b, float c, float d) { int w = 0; w = __builtin_amdgcn_cvt_pk_fp8_f32(a, b, w, false); w = __builtin_amdgcn_cvt_pk_fp8_f32(c, d, w, true); return (unsigned)w; }
__device__ __forceinline__ unsigned pk4_fp8_sat(float a, float b, float c, float d) {
    return pk4_fp8(__builtin_amdgcn_fmed3f(a, -448.f, 448.f), __builtin_amdgcn_fmed3f(b, -448.f, 448.f), __builtin_amdgcn_fmed3f(c, -448.f, 448.f), __builtin_amdgcn_fmed3f(d, -448.f, 448.f)); }
__device__ __forceinline__ unsigned pk4_i8(float a, float b, float c, float d) {
    const float M_ = 12582912.f;
    const unsigned ua = __float_as_uint(a + M_), ub = __float_as_uint(b + M_), uc = __float_as_uint(c + M_), ud = __float_as_uint(d + M_);
    return (ua & 0xffu) | ((ub & 0xffu) << 8) | ((uc & 0xffu) << 16) | (ud << 24); }
__device__ __forceinline__ unsigned pk4_i8c(float a, float b, float c, float d) {
    return pk4_i8(__builtin_amdgcn_fmed3f(a, -127.f, 127.f), __builtin_amdgcn_fmed3f(b, -127.f, 127.f), __builtin_amdgcn_fmed3f(c, -127.f, 127.f), __builtin_amdgcn_fmed3f(d, -127.f, 127.f)); }
__device__ __forceinline__ float fast_exp(float x) { return __builtin_amdgcn_exp2f(x * 1.44269504089f); }
__device__ __forceinline__ float sigmoidf_(float x) { return __builtin_amdgcn_rcpf(1.0f + fast_exp(-x)); }

namespace pg8 {
constexpr int BM = 256, BK = 64, HALF = 128, HTB = HALF * BK * 2, STAGE_BYTES = 8 * HTB, NXCD = 8, WGM = 8;
__host__ __device__ __forceinline__ int lds_byte(int r, int c) { const int st = (r >> 4) * 2 + (c >> 5), rr = r & 15, cc = c & 31, ob = rr * 64 + cc * 2; return st * 1024 + (ob ^ (((ob >> 9) & 1) << 5)); }
__host__ __device__ __forceinline__ void stage_rc(int b, int& R, int& C) { const int st = b / 1024, sb = b % 1024, swz = sb ^ (((sb >> 9) & 1) << 5); R = (st >> 1) * 16 + swz / 64; C = (st & 1) * 32 + (swz % 64) / 2; }
__host__ __device__ __forceinline__ int perm32(int rho) { const int n = rho >> 4, i = rho & 15; return 8 * (i >> 2) + 4 * n + (i & 3); }

struct Unit { int arow0, brow0, pm, pn, e, nvalid; const int* alist; const float* ascale; };
typedef int i32x8 __attribute__((ext_vector_type(8)));
typedef int i32x4 __attribute__((ext_vector_type(4)));
template <int Q> struct Frag;
template <> struct Frag<0> { bf16x8 h[2]; };
template <> struct Frag<1> { i32x8 v; };
template <> struct Frag<2> { i32x4 h[2]; };
struct Gemm { const bf16_t* A; const bf16_t* Bt; int K; int scale_w = 0x7f7f7f7f, scale_a = 0x7f7f7f7f; LAS int* tokbuf = nullptr; const int* zero = nullptr; LAS float* sabuf = nullptr; float wscale = 1.f; };

struct DenseOrder {
    int nM, nN, nwg, G, c, pn0 = 0;
    const float* sa = nullptr;
    __device__ void init(int M, int N, int G_, int c_) { nM = M / BM; nN = N / BM; nwg = nM * nN; G = G_; c = c_; }
    __device__ bool next(int i, Unit& u) const {
        const long L = (long)i * G + c; if (L >= nwg) return false;
        int wgid = (int)L; { const int q = nwg / NXCD, r = nwg % NXCD, xcd = wgid % NXCD, off = wgid / NXCD; wgid = (xcd < r ? xcd * (q + 1) : r * (q + 1) + (xcd - r) * q) + off; }
        const int nig = WGM * nN, gid = wgid / nig, fm = gid * WGM, gsz = (nM - fm) < WGM ? (nM - fm) : WGM;
        u.pm = fm + ((wgid % nig) % gsz); u.pn = pn0 + (wgid % nig) / gsz; u.arow0 = u.pm * BM; u.brow0 = u.pn * BM; u.e = 0; u.nvalid = 256; u.alist = nullptr; u.ascale = sa ? sa + u.arow0 : nullptr; return true;
    }
};
struct MoeOrder {
    const LAS int* tpre; const LAS int* cnt; const int* list; int G, vcu, bn; const float* sa = nullptr;
    __device__ bool next(int i, Unit& u) const {
        const int U = i * G + vcu, rt = U >> 2, pn = U & 3;
        if (rt >= tpre[NE]) return false;
        int e = 0;
#pragma unroll
        for (int k = 1; k < NE; ++k) e += (rt >= tpre[k]) ? 1 : 0;
        const int r = rt - tpre[e];
        u.arow0 = rt * BM; u.brow0 = e * bn + pn * BM; u.pm = rt; u.pn = pn; u.e = e; u.nvalid = min(256, cnt[e] - r * 256); u.alist = list ? list + e * LCAP + r * 256 : nullptr; u.ascale = sa ? sa + e * LCAP + r * 256 : nullptr; return true;
    }
};

template <class Epi, class Sched, bool GATHER, bool ALIGN_EPI, bool SP2, int Q = 0>
__device__ __forceinline__ void gemm_phase(LAS unsigned char* lds, const Gemm g, const Sched& S, const Epi& E, const int tid) {
    const int wid = __builtin_amdgcn_readfirstlane(tid >> 6), lane = tid & 63, wr = wid >> 2, wc = wid & 3, fr = lane & 15, fq = lane >> 4;
    const int K = g.K, nt = K / BK;
    unsigned voffA[2], voffB[2];
#pragma unroll
    for (int i = 0; i < 2; ++i) { int R, C; stage_rc(tid * 16 + i * 8192, R, C); const int Rb = Epi::PERM ? ((R & ~31) + perm32(R & 31)) : R;
        voffA[i] = (unsigned)(R * K + C) * 2u; voffB[i] = (unsigned)(Rb * K + C) * 2u; }
    const size_t kstep = (size_t)(BK * 2);
    const size_t hstep = (size_t)HALF * K * 2;
    const unsigned ldsw = (unsigned)wid * 1024u;
    const int aoff = lds_byte(wr * 64 + fr, fq * 8); int boff = 65536 + lds_byte(wc * 32 + fr, fq * 8); asm volatile("" : "+v"(boff));
#define PG8_SA(b, h) (((b) * 2 + (h)) * HTB)
#define PG8_SB(b, h) ((4 + (b) * 2 + (h)) * HTB)
#define PG8_SBR(b, h) (((b) * 2 + (h)) * HTB)
#define PG8_STAGE(bufoff, gbase, voff) do { _Pragma("unroll") for (int _i = 0; _i < 2; ++_i) \
        __builtin_amdgcn_global_load_lds((const unsigned*)((const char*)(gbase) + (voff)[_i]), (LAS unsigned*)(lds + (bufoff) + ldsw + _i * 8192), 16, 0, 0); } while (0)
#define PG8_STAGE_A(bufoff, kb, h, vo) do { if constexpr (GATHER) { PG8_STAGE(bufoff, kb, (vo)[h]); } else { PG8_STAGE(bufoff, (kb) + (h) * hstep, voffA); } } while (0)
#define PG8_LDF(dst, off) do { if constexpr (Q == 1) { const i32x4 lo_ = *(const LAS i32x4*)(lds + (off)), hi_ = *(const LAS i32x4*)(lds + (off) + 1024); (dst).v = __builtin_shufflevector(lo_, hi_, 0, 1, 2, 3, 4, 5, 6, 7); } \
        else if constexpr (Q == 2) { (dst).h[0] = *(const LAS i32x4*)(lds + (off)); (dst).h[1] = *(const LAS i32x4*)(lds + (off) + 1024); } \
        else { (dst).h[0] = *(const LAS bf16x8*)(lds + (off)); (dst).h[1] = *(const LAS bf16x8*)(lds + (off) + 1024); } } while (0)
#define PG8_LDA(dst, b, h) do { _Pragma("unroll") for (int m = 0; m < 4; ++m) PG8_LDF(dst[m], PG8_SA(b, h) + aoff + m * 2048); } while (0)
#define PG8_LDB(dst, b, h) do { _Pragma("unroll") for (int n = 0; n < 2; ++n) PG8_LDF(dst[n], PG8_SBR(b, h) + boff + n * 2048); } while (0)
#define PG8_MMA(ai, bj, At, Bt) do { __builtin_amdgcn_s_setprio(1); _Pragma("unroll") for (int m = 0; m < 4; ++m) _Pragma("unroll") for (int n = 0; n < 2; ++n) { \
        if constexpr (Q == 1) acc[ai][bj][m][n] = __builtin_amdgcn_mfma_scale_f32_16x16x128_f8f6f4(Bt[n].v, At[m].v, acc[ai][bj][m][n], 0, 0, 0, g.scale_w, 0, g.scale_a); \
        else if constexpr (Q == 2) { _Pragma("unroll") for (int k = 0; k < 2; ++k) acc[ai][bj][m][n] = __builtin_bit_cast(f32x4, __builtin_amdgcn_mfma_i32_16x16x64_i8(Bt[n].h[k], At[m].h[k], __builtin_bit_cast(i32x4, acc[ai][bj][m][n]), 0, 0, 0)); } \
        else { _Pragma("unroll") for (int k = 0; k < 2; ++k) acc[ai][bj][m][n] = __builtin_amdgcn_mfma_f32_16x16x32_bf16(Bt[n].h[k], At[m].h[k], acc[ai][bj][m][n], 0, 0, 0); } } \
        __builtin_amdgcn_s_setprio(0); } while (0)
#define PG8_WAIT_V(n) asm volatile("s_waitcnt vmcnt(" #n ")" ::: "memory")
#define PG8_WAIT_L(n) asm volatile("s_waitcnt lgkmcnt(" #n ")" ::: "memory")
#define PG8_BAR __builtin_amdgcn_s_barrier()
#define PG8_SCHED __builtin_amdgcn_sched_barrier(0)
    Unit cur, nxt; int ui = 0;
    if (!S.next(0, cur)) return;
    f32x4 acc[2][2][4][2];
#pragma unroll
    for (int a = 0; a < 2; ++a)
#pragma unroll
        for (int b = 0; b < 2; ++b)
#pragma unroll
            for (int m = 0; m < 4; ++m)
#pragma unroll
                for (int n = 0; n < 2; ++n) acc[a][b][m][n] = (f32x4){0.f, 0.f, 0.f, 0.f};
    Frag<Q> At[4], B0[2], B1[2];
    unsigned vg[2][2];
#define PG8_GATHER(u) do { _Pragma("unroll") for (int _h = 0; _h < 2; ++_h) _Pragma("unroll") for (int _i = 0; _i < 2; ++_i) { int _R, _C; stage_rc(tid * 16 + _i * 8192, _R, _C); \
        const int _r = _h * HALF + _R; int _tok; if ((u).alist) _tok = (_r < (u).nvalid) ? (u).alist[_r] : 0; else _tok = (u).arow0 + _r; vg[_h][_i] = (unsigned)(_tok * K + _C) * 2u; } } while (0)
#define PG8_GATHER_LDS(u) do { _Pragma("unroll") for (int _h = 0; _h < 2; ++_h) _Pragma("unroll") for (int _i = 0; _i < 2; ++_i) { int _R, _C; stage_rc(tid * 16 + _i * 8192, _R, _C); \
        const int _r = _h * HALF + _R; const int _tok = (u).alist ? g.tokbuf[_r] : (u).arow0 + _r; vg[_h][_i] = (unsigned)(_tok * K + _C) * 2u; } } while (0)
    const char* cA; const char* cB = (const char*)g.Bt + (size_t)cur.brow0 * K * 2;
    if constexpr (GATHER) { cA = (const char*)g.A; PG8_GATHER(cur); } else { cA = (const char*)g.A + (size_t)cur.arow0 * K * 2;
#pragma unroll
        for (int h = 0; h < 2; ++h)
#pragma unroll
            for (int i = 0; i < 2; ++i) vg[h][i] = 0u; }
    if constexpr (SP2) {
        PG8_STAGE(PG8_SB(0, 0), cB, voffB); PG8_STAGE(PG8_SB(0, 1), cB + hstep, voffB); PG8_STAGE_A(PG8_SA(0, 0), cA, 0, vg); PG8_STAGE_A(PG8_SA(0, 1), cA, 1, vg);
        if (wr == 1) PG8_BAR;
        PG8_WAIT_V(2); PG8_BAR;
        PG8_STAGE(PG8_SB(1, 0), cB + kstep, voffB); PG8_STAGE_A(PG8_SA(1, 0), cA + kstep, 0, vg); PG8_STAGE(PG8_SB(1, 1), cB + hstep + kstep, voffB);
        PG8_WAIT_V(6); PG8_BAR;
    } else {
        PG8_STAGE(PG8_SB(0, 0), cB, voffB); PG8_STAGE_A(PG8_SA(0, 0), cA, 0, vg); PG8_STAGE(PG8_SB(0, 1), cB + hstep, voffB); PG8_STAGE_A(PG8_SA(0, 1), cA, 1, vg);
        if (wr == 1) PG8_BAR;
        PG8_WAIT_V(4); PG8_BAR;
        PG8_STAGE(PG8_SB(1, 0), cB + kstep, voffB); PG8_STAGE_A(PG8_SA(1, 0), cA + kstep, 0, vg); PG8_STAGE(PG8_SB(1, 1), cB + hstep + kstep, voffB);
        PG8_WAIT_V(6); PG8_BAR;
    }
    for (;;) {
        const bool has_next = S.next(ui + 1, nxt);
        if constexpr (GATHER) { if (g.tokbuf && has_next && nxt.alist && wid < 4) {
                const int r_ = wid * 64 + lane; const int* sp_ = (r_ < nxt.nvalid) ? nxt.alist + r_ : g.zero;
                __builtin_amdgcn_global_load_lds((const unsigned*)sp_, (LAS unsigned*)(g.tokbuf + wid * 64), 4, 0, 0); } }
        if constexpr (Q == 2) { if (wid < 4) {
                const int r_ = wid * 64 + lane; const float* sp_ = (r_ < cur.nvalid) ? cur.ascale + r_ : (const float*)g.zero;
                __builtin_amdgcn_global_load_lds((const unsigned*)sp_, (LAS unsigned*)(g.sabuf + (ui & 1) * 256 + wid * 64), 4, 0, 0); } }
        const char* nA; const char* nB = has_next ? (const char*)g.Bt + (size_t)nxt.brow0 * K * 2 : cB;
        if constexpr (GATHER) nA = cA; else nA = has_next ? (const char*)g.A + (size_t)nxt.arow0 * K * 2 : cA;
#pragma unroll 1
        for (int t = 0; t < nt; t += 2) {
            const bool last = (t == nt - 2);
            const char* a1 = cA + (size_t)(t + 1) * kstep;
            const char* a2 = last ? nA : cA + (size_t)(t + 2) * kstep; const char* b2 = last ? nB : cB + (size_t)(t + 2) * kstep;
            const char* a3 = a2 + kstep; const char* b3 = b2 + kstep;
            if constexpr (SP2) {
            PG8_LDB(B0, 0, 0); PG8_LDB(B1, 0, 1); PG8_SCHED; PG8_LDA(At, 0, 0); PG8_STAGE_A(PG8_SA(1, 1), a1, 1, vg);
            if constexpr (GATHER) { if (last && has_next) { if (g.tokbuf) PG8_GATHER_LDS(nxt); else PG8_GATHER(nxt); } }
            PG8_WAIT_V(8); PG8_WAIT_L(0); PG8_BAR; PG8_MMA(0, 0, At, B0); PG8_MMA(0, 1, At, B1); PG8_BAR; PG8_SCHED;
            PG8_LDA(At, 0, 1); PG8_STAGE(PG8_SB(0, 0), b2, voffB); PG8_STAGE(PG8_SB(0, 1), b2 + hstep, voffB); PG8_STAGE_A(PG8_SA(0, 0), a2, 0, vg);
            PG8_WAIT_V(8); PG8_WAIT_L(0); PG8_BAR; PG8_MMA(1, 0, At, B0); PG8_MMA(1, 1, At, B1); PG8_BAR; PG8_SCHED;
            PG8_LDB(B0, 1, 0); PG8_LDB(B1, 1, 1); PG8_SCHED; PG8_LDA(At, 1, 0); PG8_STAGE_A(PG8_SA(0, 1), a2, 1, vg);
            PG8_WAIT_V(8); PG8_WAIT_L(0); PG8_BAR; PG8_MMA(0, 0, At, B0); PG8_MMA(0, 1, At, B1); PG8_BAR; PG8_SCHED;
            PG8_LDA(At, 1, 1); PG8_STAGE(PG8_SB(1, 0), b3, voffB); PG8_STAGE(PG8_SB(1, 1), b3 + hstep, voffB); PG8_STAGE_A(PG8_SA(1, 0), a3, 0, vg);
            PG8_WAIT_V(8); PG8_WAIT_L(0); PG8_BAR; PG8_MMA(1, 0, At, B0); PG8_MMA(1, 1, At, B1); PG8_BAR; PG8_SCHED;
            } else {
            PG8_LDB(B0, 0, 0); PG8_SCHED; PG8_LDA(At, 0, 0); PG8_STAGE_A(PG8_SA(1, 1), a1, 1, vg);
            if constexpr (GATHER) { if (last && has_next) PG8_GATHER(nxt); }
            PG8_WAIT_L(8); PG8_BAR; PG8_WAIT_L(0); PG8_MMA(0, 0, At, B0); PG8_BAR; PG8_SCHED;
            PG8_LDB(B1, 0, 1); PG8_STAGE(PG8_SB(0, 0), b2, voffB);
            PG8_BAR; PG8_WAIT_L(0); PG8_MMA(0, 1, At, B1); PG8_BAR;
            PG8_LDA(At, 0, 1); PG8_STAGE_A(PG8_SA(0, 0), a2, 0, vg);
            PG8_BAR; PG8_WAIT_L(0); PG8_MMA(1, 0, At, B0); PG8_BAR; PG8_SCHED;
            PG8_STAGE(PG8_SB(0, 1), b2 + hstep, voffB);
            PG8_WAIT_V(6); PG8_BAR; PG8_MMA(1, 1, At, B1); PG8_BAR;
            PG8_LDB(B0, 1, 0); PG8_SCHED; PG8_LDA(At, 1, 0); PG8_STAGE_A(PG8_SA(0, 1), a2, 1, vg);
            PG8_WAIT_L(8); PG8_BAR; PG8_WAIT_L(0); PG8_MMA(0, 0, At, B0); PG8_BAR; PG8_SCHED;
            PG8_LDB(B1, 1, 1); PG8_STAGE(PG8_SB(1, 0), b3, voffB);
            PG8_BAR; PG8_WAIT_L(0); PG8_MMA(0, 1, At, B1); PG8_BAR;
            PG8_LDA(At, 1, 1); PG8_STAGE_A(PG8_SA(1, 0), a3, 0, vg);
            PG8_BAR; PG8_WAIT_L(0); PG8_MMA(1, 0, At, B0); PG8_BAR; PG8_SCHED;
            PG8_STAGE(PG8_SB(1, 1), b3 + hstep, voffB);
            PG8_WAIT_V(6); PG8_BAR; PG8_MMA(1, 1, At, B1); PG8_BAR;
            }
        }
        if constexpr (ALIGN_EPI) { if (wr == 0) PG8_BAR; }
        if constexpr (Q == 2) {
            const LAS float* sb_ = g.sabuf + (ui & 1) * 256 + wr * 64 + fr;
#pragma unroll
            for (int a = 0; a < 2; ++a)
#pragma unroll
                for (int m = 0; m < 4; ++m) { const float rs_ = sb_[a * 128 + m * 16] * g.wscale;
#pragma unroll
                    for (int b = 0; b < 2; ++b)
#pragma unroll
                        for (int n = 0; n < 2; ++n) { const i32x4 iv_ = __builtin_bit_cast(i32x4, acc[a][b][m][n]); acc[a][b][m][n] = __builtin_convertvector(iv_, f32x4) * rs_; } }
        }
        E(acc, cur, wr, wc, fr, fq);
        if (!has_next) break;
#pragma unroll
        for (int a = 0; a < 2; ++a)
#pragma unroll
            for (int b = 0; b < 2; ++b)
#pragma unroll
                for (int m = 0; m < 4; ++m)
#pragma unroll
                    for (int n = 0; n < 2; ++n) acc[a][b][m][n] = (f32x4){0.f, 0.f, 0.f, 0.f};
        cur = nxt; cA = nA; cB = nB; ++ui;
        if constexpr (ALIGN_EPI) { if (wr == 1) PG8_BAR; }
    }
    PG8_WAIT_V(0);
    if constexpr (!ALIGN_EPI) { if (wr == 0) PG8_BAR; }
    PG8_BAR;
#undef PG8_SA
#undef PG8_SB
#undef PG8_SBR
#undef PG8_STAGE
#undef PG8_STAGE_A
#undef PG8_GATHER
#undef PG8_GATHER_LDS
#undef PG8_LDF
#undef PG8_LDA
#undef PG8_LDB
#undef PG8_MMA
#undef PG8_WAIT_V
#undef PG8_WAIT_L
#undef PG8_BAR
#undef PG8_SCHED
}


struct EpiM1 {
    static constexpr bool PERM = true;
    bf16_t* Q; bf16_t* Kn; bf16_t* KT; bf16_t* VT; bf16_t* OGS; LAS unsigned char* tlds;
    __device__ __forceinline__ void operator()(const f32x4 (&acc)[2][2][4][2], const Unit& u, int wr, int wc, int fr, int fq) const {
        const int row0 = u.arow0 + wr * 64 + fr, pn = u.pn;
        if (pn < 4 || pn >= 8) {
            bf16_t* base; int ldc, colt; float sc = 1.f; const bool sig = pn >= 8;
            if (pn < 2) { base = Q; ldc = MQK; colt = pn * 256; sc = 0.08838834764831845f; }
            else if (pn < 4) { base = Kn; ldc = MQK; colt = (pn - 2) * 256; }
            else { base = OGS; ldc = MV; colt = (pn - 8) * 256; }
            const int col0 = colt + wc * 32 + 8 * fq;
#pragma unroll
            for (int ai = 0; ai < 2; ++ai)
#pragma unroll
                for (int m = 0; m < 4; ++m) { bf16_t* rowp = base + (size_t)(row0 + ai * HALF + m * 16) * ldc + col0;
#pragma unroll
                    for (int bj = 0; bj < 2; ++bj) { f32x4 v0 = acc[ai][bj][m][0] * sc, v1 = acc[ai][bj][m][1] * sc;
                        if (sig) {
#pragma unroll
                            for (int j = 0; j < 4; ++j) { v0[j] = sigmoidf_(v0[j]); v1[j] = sigmoidf_(v1[j]); } }
                        u32x4 w; w.x = cvt_pk_bf16(v0[0], v0[1]); w.y = cvt_pk_bf16(v0[2], v0[3]); w.z = cvt_pk_bf16(v1[0], v1[1]); w.w = cvt_pk_bf16(v1[2], v1[3]);
                        *(u32x4*)(rowp + bj * HALF) = w; } }
        }
        if (pn >= 2 && pn < 8) {
            const int b = u.arow0 / SEQ, s0 = (u.arow0 % SEQ) + wr * 64;
            bf16_t* base; int colt, feat;
            if (pn < 4) { base = KT; colt = (pn - 2) * 256; feat = DK; } else { base = VT; colt = (pn - 4) * 256; feat = DV; }
            LAS unsigned char* tb = tlds + (wr * 4 + wc) * 2048;
            const int lane = fq * 16 + fr;
#pragma unroll
            for (int ai = 0; ai < 2; ++ai) {
                const int ch = (s0 + ai * HALF) >> 6;
#pragma unroll
                for (int bj = 0; bj < 2; ++bj) {
                    const int col = colt + bj * HALF + wc * 32, hd = col / feat, f0 = col % feat;
                    bf16_t* xb = base + ((((size_t)(b * NH + hd) * NCH + ch) * feat + f0) << 6);
#pragma unroll
                    for (int n = 0; n < 2; ++n) {
#pragma unroll
                        for (int m = 0; m < 4; ++m)
#pragma unroll
                            for (int j = 0; j < 4; ++j) { const int t = m * 16 + fr;
                                *(LAS bf16_t*)(tb + (4 * fq + j) * 128 + ((((t >> 3) ^ (2 * fq)) & 7) << 4) + (t & 7) * 2) = (bf16_t)f2bf(acc[ai][bj][m][n][j]); }
#pragma unroll
                        for (int q = 0; q < 2; ++q) { const int id = lane + 64 * q, cr = id >> 3, p = id & 7, tc = (p ^ (2 * (cr >> 2))) & 7;
                            const u32x4 v = *(const LAS u32x4*)(tb + id * 16);
                            *(u32x4*)(xb + (size_t)(8 * (cr >> 2) + 4 * n + (cr & 3)) * 64 + tc * 8) = v; }
                    }
                }
            }
        }
    }
};
template <bool BASE_F32> struct EpiRes {
    static constexpr bool PERM = true;
    const void* base; bf16_t* out; const float* gate; float mul;
    __device__ __forceinline__ void operator()(const f32x4 (&acc)[2][2][4][2], const Unit& u, int wr, int wc, int fr, int fq) const {
        const int row0 = u.arow0 + wr * 64 + fr, col0 = u.pn * BM + wc * 32 + 8 * fq, b = u.arow0 / SEQ;
        f32x4 gv[2][2];
#pragma unroll
        for (int bj = 0; bj < 2; ++bj)
#pragma unroll
            for (int n = 0; n < 2; ++n) gv[bj][n] = *(const f32x4*)(gate + (size_t)b * 6 * D + col0 + bj * HALF + n * 4) * mul;
        u32x4 t[2][4][2];
#pragma unroll
        for (int ai = 0; ai < 2; ++ai)
#pragma unroll
            for (int m = 0; m < 4; ++m)
#pragma unroll
                for (int bj = 0; bj < 2; ++bj) { const f32x4 v0 = gv[bj][0] * acc[ai][bj][m][0], v1 = gv[bj][1] * acc[ai][bj][m][1];
                    t[ai][m][bj].x = cvt_pk_bf16(v0[0], v0[1]); t[ai][m][bj].y = cvt_pk_bf16(v0[2], v0[3]); t[ai][m][bj].z = cvt_pk_bf16(v1[0], v1[1]); t[ai][m][bj].w = cvt_pk_bf16(v1[2], v1[3]); }
        if (BASE_F32) {
#pragma unroll
            for (int ai = 0; ai < 2; ++ai) {
                f32x4 bf[4][2][2];
#pragma unroll
                for (int m = 0; m < 4; ++m)
#pragma unroll
                    for (int bj = 0; bj < 2; ++bj) { const float* p = (const float*)base + (size_t)(row0 + ai * HALF + m * 16) * D + col0 + bj * HALF; bf[m][bj][0] = *(const f32x4*)p; bf[m][bj][1] = *(const f32x4*)(p + 4); }
                asm volatile("" ::: "memory");
#pragma unroll
                for (int m = 0; m < 4; ++m)
#pragma unroll
                    for (int bj = 0; bj < 2; ++bj) { const f32x4 a0 = bf[m][bj][0], a1 = bf[m][bj][1]; const u32x4 c = t[ai][m][bj]; u32x4 w;
                        w.x = cvt_pk_bf16(a0[0] + bflo(c.x), a0[1] + bfhi(c.x)); w.y = cvt_pk_bf16(a0[2] + bflo(c.y), a0[3] + bfhi(c.y));
                        w.z = cvt_pk_bf16(a1[0] + bflo(c.z), a1[1] + bfhi(c.z)); w.w = cvt_pk_bf16(a1[2] + bflo(c.w), a1[3] + bfhi(c.w));
                        *(u32x4*)(out + (size_t)(row0 + ai * HALF + m * 16) * D + col0 + bj * HALF) = w; }
                asm volatile("" ::: "memory");
            }
        } else {
            u32x4 bw[2][4][2];
#pragma unroll
            for (int ai = 0; ai < 2; ++ai)
#pragma unroll
                for (int m = 0; m < 4; ++m)
#pragma unroll
                    for (int bj = 0; bj < 2; ++bj) bw[ai][m][bj] = *(const u32x4*)((const bf16_t*)base + (size_t)(row0 + ai * HALF + m * 16) * D + col0 + bj * HALF);
            asm volatile("" ::: "memory");
#pragma unroll
            for (int ai = 0; ai < 2; ++ai)
#pragma unroll
                for (int m = 0; m < 4; ++m)
#pragma unroll
                    for (int bj = 0; bj < 2; ++bj) { const u32x4 a = bw[ai][m][bj], c = t[ai][m][bj]; u32x4 w;
                        w.x = cvt_pk_bf16(bflo(a.x) + bflo(c.x), bfhi(a.x) + bfhi(c.x)); w.y = cvt_pk_bf16(bflo(a.y) + bflo(c.y), bfhi(a.y) + bfhi(c.y));
                        w.z = cvt_pk_bf16(bflo(a.z) + bflo(c.z), bfhi(a.z) + bfhi(c.z)); w.w = cvt_pk_bf16(bflo(a.w) + bflo(c.w), bfhi(a.w) + bfhi(c.w));
                        *(u32x4*)(out + (size_t)(row0 + ai * HALF + m * 16) * D + col0 + bj * HALF) = w; }
        }
    }
};
struct EpiBf {
    static constexpr bool PERM = true;
    bf16_t* O; int ldc;
    __device__ __forceinline__ void operator()(const f32x4 (&acc)[2][2][4][2], const Unit& u, int wr, int wc, int fr, int fq) const {
        const int row0 = u.arow0 + wr * 64 + fr, col0 = u.pn * BM + wc * 32 + 8 * fq;
#pragma unroll
        for (int ai = 0; ai < 2; ++ai)
#pragma unroll
            for (int m = 0; m < 4; ++m) { bf16_t* rowp = O + (size_t)(row0 + ai * HALF + m * 16) * ldc + col0;
#pragma unroll
                for (int bj = 0; bj < 2; ++bj) { const f32x4 v0 = acc[ai][bj][m][0], v1 = acc[ai][bj][m][1];
                    u32x4 w; w.x = cvt_pk_bf16(v0[0], v0[1]); w.y = cvt_pk_bf16(v0[2], v0[3]); w.z = cvt_pk_bf16(v1[0], v1[1]); w.w = cvt_pk_bf16(v1[2], v1[3]);
                    *(u32x4*)(rowp + bj * HALF) = w; } }
    }
};
template <bool SILU, bool F8OUT = false> struct EpiGlu {
    static constexpr bool PERM = true;
    bf16_t* O; int ldc; int plain_tiles; bf16_t* P; int ldp; float f8scale;
    __device__ __forceinline__ void operator()(const f32x4 (&acc)[2][2][4][2], const Unit& u, int wr, int wc, int fr, int fq) const {
        const int row0 = u.arow0 + wr * 64 + fr;
        if (u.pn < plain_tiles) {
            const int col0 = u.pn * BM + wc * 32 + 8 * fq;
#pragma unroll
            for (int ai = 0; ai < 2; ++ai)
#pragma unroll
                for (int m = 0; m < 4; ++m) { bf16_t* rowp = P + (size_t)(row0 + ai * HALF + m * 16) * ldp + col0;
#pragma unroll
                    for (int bj = 0; bj < 2; ++bj) { const f32x4 v0 = acc[ai][bj][m][0], v1 = acc[ai][bj][m][1];
                        u32x4 w; w.x = cvt_pk_bf16(v0[0], v0[1]); w.y = cvt_pk_bf16(v0[2], v0[3]); w.z = cvt_pk_bf16(v1[0], v1[1]); w.w = cvt_pk_bf16(v1[2], v1[3]);
                        *(u32x4*)(rowp + bj * HALF) = w; } }
            return;
        }
        const int col0 = (u.pn - plain_tiles) * HALF + wc * 32 + 8 * fq;
#pragma unroll
        for (int ai = 0; ai < 2; ++ai)
#pragma unroll
            for (int m = 0; m < 4; ++m) { bf16_t* rowp = O + (size_t)(row0 + ai * HALF + m * 16) * ldc + col0;
                f32x4 v0 = acc[ai][0][m][0], v1 = acc[ai][0][m][1]; const f32x4 u0 = acc[ai][1][m][0], u1 = acc[ai][1][m][1];
                if (SILU) {
#pragma unroll
                    for (int j = 0; j < 4; ++j) { v0[j] = v0[j] * sigmoidf_(v0[j]); v1[j] = v1[j] * sigmoidf_(v1[j]); } }
                v0 = v0 * u0; v1 = v1 * u1;
                if constexpr (F8OUT) { v0 = v0 * f8scale; v1 = v1 * f8scale; u32x2 w8; w8.x = pk4_fp8_sat(v0[0], v0[1], v0[2], v0[3]); w8.y = pk4_fp8_sat(v1[0], v1[1], v1[2], v1[3]);
                    *(u32x2*)((unsigned char*)O + (size_t)(row0 + ai * HALF + m * 16) * ldc + col0) = w8; }
                else { u32x4 w; w.x = cvt_pk_bf16(v0[0], v0[1]); w.y = cvt_pk_bf16(v0[2], v0[3]); w.z = cvt_pk_bf16(v1[0], v1[1]); w.w = cvt_pk_bf16(v1[2], v1[3]);
                    *(u32x4*)rowp = w; } }
    }
};
}

#define XB_TMO      128
#define XB_XCNT(j)  (256  + 64 * (j))
#define XB_XSUB(j)  (1280 + 64 * (j))
#define XB_XGEN(j)  (2304 + 64 * (j))
#define XB_TOP      3328
#define XB_TOPGEN   3392
#define XCD_BAR_WORDS 3456
#define XB_SPIN_CAP (1u << 18)
__device__ __forceinline__ unsigned xb_ld(unsigned* p)              { return __hip_atomic_load(p, __ATOMIC_RELAXED, __HIP_MEMORY_SCOPE_AGENT); }
__device__ __forceinline__ unsigned xb_add(unsigned* p, unsigned v) { return __hip_atomic_fetch_add(p, v, __ATOMIC_RELAXED, __HIP_MEMORY_SCOPE_AGENT); }
__device__ __forceinline__ unsigned xb_xcc_id() { return (unsigned)__builtin_amdgcn_s_getreg((3 << 11) | 20) & 0xFu; }
#define XB_SPIN(cond, bar) do { unsigned _sp = 0; while (cond) { __builtin_amdgcn_s_sleep(1); \
    if ((++_sp & 255u) == 0u) { if (xb_ld(&(bar)[XB_TMO])) break; if (_sp > XB_SPIN_CAP) { atomicAdd(&(bar)[XB_TMO], 1u); break; } } } } while (0)
struct XcdBarrier { unsigned* bar; unsigned x; volatile LAS unsigned* st; };
__device__ __forceinline__ XcdBarrier xcd_barrier_post(unsigned* bar, volatile LAS unsigned* st) {
    XcdBarrier b; b.bar = bar; b.x = xb_xcc_id(); b.st = st;
    if (threadIdx.x == 0) (void)xb_add(&bar[XB_XCNT(b.x)], 1u);
    return b;
}
__device__ __forceinline__ void xcd_barrier_complete(unsigned* bar, unsigned x, unsigned& nloc, unsigned& nx) {
    const unsigned G = gridDim.x * gridDim.y * gridDim.z;
    unsigned sum, cnt, mine, sp = 0u;
    for (;;) {
        sum = 0u; cnt = 0u; mine = 0u;
#pragma unroll
        for (unsigned j = 0; j < 16; ++j) { const unsigned c = xb_ld(&bar[XB_XCNT(j)]); sum += c; cnt += (c > 0u) ? 1u : 0u; mine = (j == x) ? c : mine; }
        if (sum == G) break;
        __builtin_amdgcn_s_sleep(1);
        if ((++sp & 255u) == 0u) { if (xb_ld(&bar[XB_TMO])) break; if (sp > XB_SPIN_CAP) { atomicAdd(&bar[XB_TMO], 1u); break; } }
    }
    nloc = mine > 0u ? mine : 1u; nx = cnt > 0u ? cnt : 1u;
}
__device__ __forceinline__ void xcd_barrier(const XcdBarrier& b) {
    asm volatile("s_waitcnt vmcnt(0)" ::: "memory");
    __syncthreads();
    if (threadIdx.x == 0) {
        unsigned* bar = b.bar;
        __builtin_amdgcn_s_waitcnt(0);
        unsigned nloc = b.st[0], nx = b.st[1];
        if (nloc == 0u) { xcd_barrier_complete(bar, b.x, nloc, nx); b.st[0] = nloc; b.st[1] = nx; }
        const unsigned old = xb_add(&bar[XB_XSUB(b.x)], 1u);
        const unsigned gen = old / nloc;
        if (old + 1u == (gen + 1u) * nloc) {
            __builtin_amdgcn_fence(__ATOMIC_RELEASE, "agent");
            asm volatile("s_waitcnt vmcnt(0)" ::: "memory");
            const unsigned og = xb_add(&bar[XB_TOP], 1u);
            const unsigned tg = og / nx;
            if (og + 1u == (tg + 1u) * nx) xb_add(&bar[XB_TOPGEN], 1u);
            else XB_SPIN(xb_ld(&bar[XB_TOPGEN]) == tg, bar);
            __builtin_amdgcn_fence(__ATOMIC_ACQUIRE, "agent");
            xb_add(&bar[XB_XGEN(b.x)], 1u);
            asm volatile("s_waitcnt vmcnt(0)" ::: "memory");
        } else {
            XB_SPIN(xb_ld(&bar[XB_XGEN(b.x)]) == gen, bar);
            __builtin_amdgcn_fence(__ATOMIC_ACQUIRE, "agent");
            asm volatile("s_waitcnt vmcnt(0)" ::: "memory");
        }
    }
    __syncthreads();
}

struct Args { const float* in[20]; float* out; unsigned char* ws; int ph_lo, ph_hi; };
__device__ __forceinline__ const void* karg_ptr(int idx) {
    unsigned long long v = (unsigned long long)((const void* const __attribute__((address_space(4)))*)__builtin_amdgcn_kernarg_segment_ptr())[idx];
    asm volatile("" : "+s"(v)); return (const void*)(const GAS char*)v;
}
struct InProxy { __device__ __forceinline__ const float* operator[](int i) const { return (const float*)karg_ptr(i); } };
struct WsProxy { __device__ __forceinline__ operator unsigned char*() const { return (unsigned char*)karg_ptr(21); }
                 __device__ __forceinline__ unsigned char* operator+(size_t o) const { return (unsigned char*)karg_ptr(21) + o; } };
struct OutProxy { __device__ __forceinline__ operator float*() const { return (float*)karg_ptr(20); }
                  __device__ __forceinline__ float* operator+(size_t o) const { return (float*)karg_ptr(20) + o; } };
struct CtlProxy { __device__ __forceinline__ operator gu32*() const { return (gu32*)karg_ptr(21); }
                  __device__ __forceinline__ gu32* operator+(int o) const { return (gu32*)karg_ptr(21) + o; } };
struct Frame {
    LAS unsigned char* lds; volatile LAS unsigned* MISC; CtlProxy ctl;
    int tid, lane, wave, vcu, G, bx;
    InProxy in; OutProxy out; WsProxy ws;
};
enum { I_X = 0, I_C, I_N1G, I_N2G, I_WADA, I_BADA, I_MWIN, I_MBG, I_MNG, I_MWOUT, I_CWIN, I_CCW, I_CCB, I_CWOUT, I_WR, I_BR, I_EWG, I_EWU, I_EWD, I_FG };

__device__ __forceinline__ float wave_sum(float v) {
#pragma unroll
    for (int o = 1; o < 64; o <<= 1) v += __shfl_xor(v, o);
    return v;
}

__device__ __forceinline__ int glu_row(int n, int which) { return (n >> 7) * 256 + which * 128 + (n & 127); }
struct CvtItem { const float* src; bf16_t* dst; int ldw, K; float f8scale; bool i8; };
constexpr int CVT_IN = 16 * 96, CVT_OUT = 16 * 32, CVT_G = NE * 16 * 16, CVT_D = NE * 8 * 32, CVT_ITEMS = CVT_IN + CVT_OUT + 2 * CVT_G + CVT_D;
__device__ __forceinline__ CvtItem cvt_decode(Frame& F, int L, int it) {
    const size_t lo_ = (L == 0) ? 0 : WS_WL1;
    CvtItem d; d.f8scale = 0.f; d.i8 = false; int r = it;
    if (r < CVT_IN) { const int kb = r / 96, nb = r % 96, n0 = nb * 32; d.K = D;
        if (L == 0) { d.src = F.in[I_MWIN] + (size_t)kb * 64 * MPROJ + n0; d.ldw = MPROJ;
            if (I8_G1) { d.dst = (bf16_t*)((unsigned char*)(F.ws + lo_ + WS_W0) + (size_t)n0 * D + kb * 64); d.f8scale = W8_Q; d.i8 = true; }
            else if (FP8_G1 == 1 || (FP8_G1 == 2 && n0 >= 1024)) { d.dst = (bf16_t*)((unsigned char*)(F.ws + lo_ + WS_W0) + (FP8_G1 == 2 ? 2 * MiB : 0) + (size_t)n0 * D + kb * 64); d.f8scale = 32.f; } else d.dst = (bf16_t*)(F.ws + lo_ + WS_W0) + (size_t)n0 * D + kb * 64; }
        else { int dr; if (n0 < D) dr = n0; else if (n0 < 2 * D) dr = D + glu_row(n0 - D, 0); else dr = D + glu_row(n0 - 2 * D, 1);
            d.src = F.in[I_CWIN] + (size_t)kb * 64 * 3 * D + n0; d.ldw = 3 * D;
            if (I8_CIN) { d.dst = (bf16_t*)((unsigned char*)(F.ws + lo_ + WS_W0) + (size_t)dr * D + kb * 64); d.f8scale = W8_Q; d.i8 = true; }
            else if (FP8_CIN) { d.dst = (bf16_t*)((unsigned char*)(F.ws + lo_ + WS_W0) + (size_t)dr * D + kb * 64); d.f8scale = 32.f; } else d.dst = (bf16_t*)(F.ws + lo_ + WS_W0) + (size_t)dr * D + kb * 64; }
        return d; } r -= CVT_IN;
    if (r < CVT_OUT) { const int kb = r / 32, nb = r % 32; d.K = D; d.ldw = D; d.src = (L == 0 ? F.in[I_MWOUT] : F.in[I_CWOUT]) + (size_t)kb * 64 * D + nb * 32;
        if ((L == 1 && FP8_COUT) || (L == 0 && FP8_MOUT)) { d.dst = (bf16_t*)((unsigned char*)(F.ws + lo_ + WS_W1) + (size_t)nb * 32 * D + kb * 64); d.f8scale = 32.f; } else d.dst = (bf16_t*)(F.ws + lo_ + WS_W1) + (size_t)nb * 32 * D + kb * 64; return d; } r -= CVT_OUT;
    if (r < 2 * CVT_G) { const int which = r / CVT_G; r %= CVT_G; const int e = r / 256, kb = (r % 256) / 16, nb = r % 16, n0 = nb * 32; d.K = D; d.ldw = DE;
        d.src = (which == 0 ? F.in[I_EWG] : F.in[I_EWU]) + ((size_t)L * NE + e) * D * DE + (size_t)kb * 64 * DE + n0;
        d.dst = (bf16_t*)((unsigned char*)(F.ws + lo_ + WS_WUP) + (size_t)e * 1024 * D + (size_t)glu_row(n0, which) * D + kb * 64); d.f8scale = I8_UP ? W8_Q : 32.f; d.i8 = I8_UP; return d; } r -= 2 * CVT_G;
    { const int e = r / 256, kb = (r % 256) / 32, nb = r % 32; d.K = DE; d.ldw = D;
      d.src = F.in[I_EWD] + ((size_t)L * NE + e) * DE * D + (size_t)kb * 64 * D + nb * 32;
      d.dst = (bf16_t*)((unsigned char*)(F.ws + lo_ + WS_WDN) + (size_t)e * D * DE + (size_t)nb * 32 * DE + kb * 64); d.f8scale = 16.f; }
    return d;
}
__device__ __forceinline__ void convert_weights(Frame& F, int L) {
    LAS float* scr = (LAS float*)(F.lds + F.wave * 16384);
    const int gw = F.vcu * NWAVES + F.wave, NGW = F.G * NWAVES, lane = F.lane;
    float ld[32];
    CvtItem cur, nxt;
    int it = gw;
    if (it < CVT_ITEMS) { cur = cvt_decode(F, L, it);
#pragma unroll
        for (int i = 0; i < 32; ++i) ld[i] = cur.src[(size_t)(2 * i + (lane >> 5)) * cur.ldw + (lane & 31)]; }
    for (; it < CVT_ITEMS; it += NGW) {
#pragma unroll
        for (int i = 0; i < 32; ++i) scr[(2 * i + (lane >> 5)) * 33 + (lane & 31)] = ld[i];
        const bool more = it + NGW < CVT_ITEMS;
        if (more) { nxt = cvt_decode(F, L, it + NGW);
#pragma unroll
            for (int i = 0; i < 32; ++i) ld[i] = nxt.src[(size_t)(2 * i + (lane >> 5)) * nxt.ldw + (lane & 31)]; }
        LDS_WAIT(); asm volatile("" ::: "memory");
        const int c = lane & 7;
#pragma unroll
        for (int j = 0; j < 4; ++j) { const int n = (lane >> 3) + 8 * j; const LAS float* s = scr + (8 * c) * 33 + n;
            if (cur.f8scale != 0.f) { const float f = cur.f8scale; u32x2 o8;
                if (cur.i8) { o8.x = pk4_i8c(s[0 * 33] * f, s[1 * 33] * f, s[2 * 33] * f, s[3 * 33] * f); o8.y = pk4_i8c(s[4 * 33] * f, s[5 * 33] * f, s[6 * 33] * f, s[7 * 33] * f); }
                else { o8.x = pk4_fp8(s[0 * 33] * f, s[1 * 33] * f, s[2 * 33] * f, s[3 * 33] * f); o8.y = pk4_fp8(s[4 * 33] * f, s[5 * 33] * f, s[6 * 33] * f, s[7 * 33] * f); }
                *(GAS u32x2*)((unsigned char*)cur.dst + (size_t)n * cur.K + 8 * c) = o8; }
            else { u32x4 o; o.x = pk2(s[0 * 33], s[1 * 33]); o.y = pk2(s[2 * 33], s[3 * 33]); o.z = pk2(s[4 * 33], s[5 * 33]); o.w = pk2(s[6 * 33], s[7 * 33]);
                *(GAS u32x4*)(cur.dst + (size_t)n * cur.K + 8 * c) = o; } }
        LDS_WAIT(); asm volatile("" ::: "memory");
        cur = nxt;
    }
}

__device__ __forceinline__ void phase_prologue(Frame& F) {
    float* MOD = (float*)(F.ws + WS_MOD);
    LAS float* cond = (LAS float*)(F.lds + 0);
    LAS float* red = (LAS float*)(F.lds + 16384);
    bool did = false;
    for (int task = F.bx; task < 192; task += F.G) {
        if (did) __syncthreads();
        did = true;
        for (int i = F.tid; i < NB * D; i += NTHR) { const int b = i / D, k = i % D; const float c = F.in[I_C][i]; cond[k * 4 + b] = c * sigmoidf_(c); }
        __syncthreads();
        const int layer = task / 96, col = (task % 96) * 64 + F.lane;
        const float* W = F.in[I_WADA] + (size_t)layer * D * 6 * D;
        float a0 = 0.f, a1 = 0.f, a2 = 0.f, a3 = 0.f;
#pragma unroll 8
        for (int kk = 0; kk < 128; ++kk) { const int k = F.wave * 128 + kk; const float w = W[(size_t)k * 6 * D + col]; const f32x4 c4 = *(const LAS f32x4*)(cond + k * 4);
            a0 += c4[0] * w; a1 += c4[1] * w; a2 += c4[2] * w; a3 += c4[3] * w; }
        red[(F.wave * 4 + 0) * 64 + F.lane] = a0; red[(F.wave * 4 + 1) * 64 + F.lane] = a1; red[(F.wave * 4 + 2) * 64 + F.lane] = a2; red[(F.wave * 4 + 3) * 64 + F.lane] = a3;
        __syncthreads();
        if (F.tid < 256) { const int b = F.tid >> 6, l = F.tid & 63; float s = 0.f;
#pragma unroll
            for (int w = 0; w < 8; ++w) s += red[(w * 4 + b) * 64 + l];
            const int c = (task % 96) * 64 + l;
            MOD[((size_t)layer * NB + b) * 6 * D + c] = s + F.in[I_BADA][(size_t)layer * 6 * D + c]; }
    }
    __syncthreads();
    convert_weights(F, 0);
}

template <int N>
__device__ __forceinline__ void xreduce(float (&v)[N], int lane) {
    constexpr int STEPS = (N == 32) ? 5 : 4;
#pragma unroll
    for (int i = 0; i < N / 2; ++i) { const auto r = __builtin_amdgcn_permlane32_swap(__builtin_bit_cast(unsigned, v[i]), __builtin_bit_cast(unsigned, v[i + N / 2]), false, false);
        const unsigned r0_ = r[0], r1_ = r[1]; v[i] = __uint_as_float(r0_) + __uint_as_float(r1_); }
#pragma unroll
    for (int i = 0; i < N / 4; ++i) { const auto r = __builtin_amdgcn_permlane16_swap(__builtin_bit_cast(unsigned, v[i]), __builtin_bit_cast(unsigned, v[i + N / 4]), false, false);
        const unsigned r0_ = r[0], r1_ = r[1]; v[i] = __uint_as_float(r0_) + __uint_as_float(r1_); }
#pragma unroll
    for (int step = 2; step < STEPS; ++step) {
        const int M = 32 >> step, n = N >> step;
        const bool up = (lane & M) != 0;
#pragma unroll
        for (int i = 0; i < n / 2; ++i) { float a = v[i], b = v[i + n / 2]; asm volatile("" : "+v"(a), "+v"(b));
            const float send = up ? a : b, keep = up ? b : a; v[i] = keep + __shfl_xor(send, M); }
    }
    if (N == 16) v[0] += __shfl_xor(v[0], 2);
    v[0] += __shfl_xor(v[0], 1);
}

constexpr int RP_WL = 0, RP_RINFO = 65536, RP_LCNT = RP_RINFO + 128 * 8 * 4, RP_TPRE = RP_LCNT + 256;
template <int MODE>
__device__ __forceinline__ void row_pass(Frame& F, int layer) {
    constexpr int DOTS = (MODE == 0) ? 8 : (MODE == 1 ? 16 : 0);
    constexpr int RPI = 2, NIT = 16 / RPI, NV = (DOTS > 0) ? RPI * DOTS : 16;
    constexpr bool COMBINE = (MODE == 2 || MODE == 3), MODUL = (MODE != 3);
    const float* MOD = (const float*)(F.ws + WS_MOD);
    LAS float* wl = (LAS float*)(F.lds + RP_WL);
    LAS int* rinfo = (LAS int*)(F.lds + RP_RINFO);
    LAS int* lcnt = (LAS int*)(F.lds + RP_LCNT);
    LAS int* tpre = (LAS int*)(F.lds + RP_TPRE);
    const float* xin = F.in[I_X];
    bf16_t* XB = (bf16_t*)(F.ws + WS_XB);
    float* xout = F.out;
    bf16_t* U = (bf16_t*)(F.ws + WS_U);
    const bf16_t* O = (const bf16_t*)(F.ws + WS_O);
    const unsigned char* TOKp = (const unsigned char*)(F.ws + WS_TOK);
    const int lane = F.lane;
    const int clayer = (MODE == 2) ? 0 : 1;
    if (DOTS > 0) { constexpr int NQ = D * (DOTS > 0 ? DOTS : 4) / 4 / NTHR;
        f32x4 tv[NQ];
#pragma unroll
        for (int q = 0; q < NQ; ++q) { const int piece = F.tid + q * NTHR, k = piece / (DOTS / 4), c4 = piece % (DOTS / 4);
            tv[q] = (DOTS == 8) ? *(const f32x4*)(F.in[I_MWIN] + (size_t)k * MPROJ + 3072 + 4 * c4) : *(const f32x4*)(F.in[I_WR] + (size_t)piece * 4); }
#pragma unroll
        for (int q = 0; q < NQ; ++q) { const int piece = F.tid + q * NTHR, k = piece / (DOTS / 4), c4 = piece % (DOTS / 4), jj = k >> 8, l = (k >> 2) & 63, ii = k & 3;
            const int rot = (DOTS == 16) ? ((l >> 2) & 3) : ((l >> 3) & 1), ch = (c4 + rot) & (DOTS / 4 - 1);
            *(LAS f32x4*)(wl + ((jj * 4 + ii) * 64 + l) * DOTS + ch * 4) = tv[q]; } }
    if (COMBINE && F.tid == 0) { int a = 0; for (int e = 0; e < NE; ++e) { tpre[e] = a; a += ((int)__hip_atomic_load(F.ctl + CW_CNT + 64 * clayer + e, RLX_AGENT) + 255) >> 8; } tpre[NE] = a; }
    float brt[16];
    if (MODE == 1) {
#pragma unroll
        for (int e = 0; e < 16; ++e) brt[e] = F.in[I_BR][e]; }
    for (int batch = F.vcu; batch < T / 128; batch += F.G) {
        __syncthreads();
        if (MODE == 1 && F.tid < 32) lcnt[F.tid] = 0;
        __syncthreads();
        const int row_base = batch * 128 + F.wave * 16, b = row_base / SEQ;
        const float* gam = (MODE == 3) ? F.in[I_FG] : ((MODE == 1) ? F.in[I_N2G] + (size_t)layer * D : F.in[I_N1G] + (size_t)layer * D);
        const float* mod = MOD + ((size_t)layer * NB + b) * 6 * D;
        const float* shp = mod + ((MODE == 1) ? 3 * D : 0); const float* scp = shp + D;
        const float* g2p = MOD + ((size_t)clayer * NB + b) * 6 * D + 5 * D;
        f32x4 gm[4], sh[4], sc[4], g2[4];
#pragma unroll
        for (int j = 0; j < 4; ++j) { gm[j] = *(const f32x4*)(gam + 256 * j + 4 * lane);
            if (MODUL) { sh[j] = *(const f32x4*)(shp + 256 * j + 4 * lane); sc[j] = *(const f32x4*)(scp + 256 * j + 4 * lane) + 1.0f; }
            if (COMBINE) g2[j] = *(const f32x4*)(g2p + 256 * j + 4 * lane); }
        f32x4 xn[RPI][4]; u32x2 on[RPI][2][4]; u32x4 tkn[RPI], tkn2[RPI];
#define RP_LOAD_X(IT) do { _Pragma("unroll") for (int r = 0; r < RPI; ++r) _Pragma("unroll") for (int j = 0; j < 4; ++j) { \
            if (MODE == 0) xn[r][j] = *(const f32x4*)(xin + (size_t)(row_base + (IT) * RPI + r) * D + 256 * j + 4 * lane); \
            else { const u32x2 xb_ = *(const u32x2*)(XB + (size_t)(row_base + (IT) * RPI + r) * D + 256 * j + 4 * lane); xn[r][j] = (f32x4){bflo(xb_.x), bfhi(xb_.x), bflo(xb_.y), bfhi(xb_.y)}; } } } while (0)
#define RP_LOAD_TOK(dst, IT) do { _Pragma("unroll") for (int r = 0; r < RPI; ++r) dst[r] = *(const u32x4*)(TOKp + (size_t)(row_base + (IT) * RPI + r) * 16); } while (0)
#define RP_LOAD_O(tk) do { _Pragma("unroll") for (int r = 0; r < RPI; ++r) { const unsigned tx_ = tk[r].x, ty_ = tk[r].y; \
            const int e0_ = __builtin_amdgcn_readfirstlane((int)(tx_ >> 16)), e1_ = __builtin_amdgcn_readfirstlane((int)(ty_ >> 16)); \
            const int s0_ = tpre[e0_] * 256 + (int)(tx_ & 0xffffu), s1_ = tpre[e1_] * 256 + (int)(ty_ & 0xffffu); \
            _Pragma("unroll") for (int j = 0; j < 4; ++j) { on[r][0][j] = *(const u32x2*)(O + (size_t)s0_ * D + 256 * j + 4 * lane); on[r][1][j] = *(const u32x2*)(O + (size_t)s1_ * D + 256 * j + 4 * lane); } } } while (0)
        RP_LOAD_X(0);
        if (COMBINE) { RP_LOAD_TOK(tkn, 0); RP_LOAD_O(tkn); RP_LOAD_TOK(tkn2, 1); }
#pragma unroll 1
        for (int it = 0; it < NIT; ++it) {
            const int r0 = row_base + it * RPI;
            f32x4 x[RPI][4]; u32x2 oc[RPI][2][4]; float w0c[RPI], w1c[RPI];
#pragma unroll
            for (int r = 0; r < RPI; ++r) {
#pragma unroll
                for (int j = 0; j < 4; ++j) { x[r][j] = xn[r][j]; if (COMBINE) { oc[r][0][j] = on[r][0][j]; oc[r][1][j] = on[r][1][j]; } }
                if (COMBINE) { const unsigned wz_ = tkn[r].z, ww_ = tkn[r].w; w0c[r] = __uint_as_float(wz_); w1c[r] = __uint_as_float(ww_); } }
            if (it + 1 < NIT) {
                RP_LOAD_X(it + 1);
                if (COMBINE) {
#pragma unroll
                    for (int r = 0; r < RPI; ++r) tkn[r] = tkn2[r];
                    RP_LOAD_O(tkn);
                    if (it + 2 < NIT) RP_LOAD_TOK(tkn2, it + 2); } }
            if (COMBINE) {
#pragma unroll
                for (int r = 0; r < RPI; ++r)
#pragma unroll
                    for (int j = 0; j < 4; ++j) { const u32x2 a = oc[r][0][j], c = oc[r][1][j]; const float w0 = w0c[r], w1 = w1c[r];
                        f32x4 mo; mo[0] = w0 * bflo(a.x) + w1 * bflo(c.x); mo[1] = w0 * bfhi(a.x) + w1 * bfhi(c.x); mo[2] = w0 * bflo(a.y) + w1 * bflo(c.y); mo[3] = w0 * bfhi(a.y) + w1 * bfhi(c.y);
                        x[r][j] = x[r][j] + g2[j] * mo;
                        if (MODE == 2) { u32x2 xw_; xw_.x = pk2(x[r][j][0], x[r][j][1]); xw_.y = pk2(x[r][j][2], x[r][j][3]); *(u32x2*)(XB + (size_t)(r0 + r) * D + 256 * j + 4 * lane) = xw_; } }
            }
            float rstd[RPI];
#pragma unroll
            for (int r = 0; r < RPI; ++r) { float s = 0.f;
#pragma unroll
                for (int j = 0; j < 4; ++j) s += (x[r][j][0] * x[r][j][0] + x[r][j][1] * x[r][j][1]) + (x[r][j][2] * x[r][j][2] + x[r][j][3] * x[r][j][3]);
                rstd[r] = 1.0f / sqrtf(wave_sum(s) * (1.0f / D) + EPS); }
            constexpr bool I8 = (MODE == 0 && I8_G1) || (MODE == 1 && I8_UP) || (MODE == 2 && I8_CIN);
            float qinv[RPI], rscale[RPI];
#pragma unroll
            for (int r = 0; r < RPI; ++r) {
#pragma unroll
                for (int j = 0; j < 4; ++j) { f32x4 y = x[r][j] * rstd[r] * gm[j]; if (MODUL) y = y * sc[j] + sh[j]; x[r][j] = y; }
                if (I8) { float am = 0.f;
#pragma unroll
                    for (int j = 0; j < 4; ++j) am = fmaxf(fmaxf(am, fmaxf(fabsf(x[r][j][0]), fabsf(x[r][j][1]))), fmaxf(fabsf(x[r][j][2]), fabsf(x[r][j][3])));
#pragma unroll
                    for (int o = 1; o < 64; o <<= 1) am = fmaxf(am, __shfl_xor(am, o));
                    am = fmaxf(am, 1e-20f); qinv[r] = 127.f / am; rscale[r] = am * (1.f / 127.f);
                    if (MODE != 1 && lane == 0) ((float*)(F.ws + WS_SA))[r0 + r] = rscale[r]; } }
#pragma unroll
            for (int r = 0; r < RPI; ++r)
#pragma unroll
                for (int j = 0; j < 4; ++j) { const f32x4 y = x[r][j];
                    if (MODE == 3) *(f32x4*)(xout + (size_t)(r0 + r) * D + 256 * j + 4 * lane) = y;
                    else if (I8) { const f32x4 yq = y * qinv[r]; *(unsigned*)((unsigned char*)(F.ws + WS_U8) + (size_t)(r0 + r) * D + 256 * j + 4 * lane) = pk4_i8(yq[0], yq[1], yq[2], yq[3]); }
                    else if (MODE == 1 || (MODE == 2 && FP8_CIN) || (MODE == 0 && FP8_G1)) { *(unsigned*)((unsigned char*)(F.ws + WS_U8) + (size_t)(r0 + r) * D + 256 * j + 4 * lane) = pk4_fp8(y[0], y[1], y[2], y[3]);
                        if (MODE == 0 && FP8_G1 == 2) { u32x2 w; w.x = pk2(y[0], y[1]); w.y = pk2(y[2], y[3]); *(u32x2*)(U + (size_t)(r0 + r) * D + 256 * j + 4 * lane) = w; } }
                    else { u32x2 w; w.x = pk2(y[0], y[1]); w.y = pk2(y[2], y[3]); *(u32x2*)(U + (size_t)(r0 + r) * D + 256 * j + 4 * lane) = w; } }
            if (DOTS > 0) {
                float v[NV];
#pragma unroll
                for (int i = 0; i < NV; ++i) v[i] = 0.f;
#pragma unroll
                for (int j = 0; j < 4; ++j)
#pragma unroll
                    for (int i = 0; i < 4; ++i) {
                        float w[DOTS > 0 ? DOTS : 1];
#pragma unroll
                        for (int q = 0; q < DOTS / 4; ++q) { const int rot = (DOTS == 16) ? ((lane >> 2) & 3) : ((lane >> 3) & 1);
                            const f32x4 t4 = *(const LAS f32x4*)(wl + ((j * 4 + i) * 64 + lane) * DOTS + ((q + rot) & (DOTS / 4 - 1)) * 4); w[4 * q] = t4[0]; w[4 * q + 1] = t4[1]; w[4 * q + 2] = t4[2]; w[4 * q + 3] = t4[3]; }
#pragma unroll
                        for (int r = 0; r < RPI; ++r)
#pragma unroll
                            for (int e = 0; e < DOTS; ++e) v[r * DOTS + e] += x[r][j][i] * w[e];
                        asm volatile("" ::: "memory"); }
                xreduce<NV>(v, lane);
                const float tot = v[0];
                if (MODE == 0) {
                    const int idx = lane >> 2, r = idx >> 3, gi = idx & 7, row = r0 + r, bb = row / SEQ, s = row % SEQ;
                    if ((lane & 3) == 0) {
                        const float pre = tot + F.in[I_MBG][gi];
                        if (gi < 4) ((float*)(F.ws + WS_IG))[(size_t)(bb * NH + gi) * SEQ + s] = pre;
                        else { const float ls = (pre >= 0.f) ? -log1pf(expf(-pre)) : (pre - log1pf(expf(pre))); ((float*)(F.ws + WS_LF))[(size_t)(bb * NH + gi - 4) * SEQ + s] = ls; }
                    }
                }
                if (MODE == 1) {
                    const int r = lane >> 5;
                    float lg[16], mx = -INFINITY;
#pragma unroll
                    for (int e = 0; e < 16; ++e) { lg[e] = __shfl(tot, 32 * r + 2 * e); mx = fmaxf(mx, lg[e]); }
                    float se = 0.f;
#pragma unroll
                    for (int e = 0; e < 16; ++e) { lg[e] = __builtin_amdgcn_exp2f((lg[e] - mx) * 1.44269504089f); se += lg[e]; }
                    const float inv = 1.0f / se;
                    float sel[16];
#pragma unroll
                    for (int e = 0; e < 16; ++e) { lg[e] *= inv; sel[e] = lg[e] + brt[e]; }
                    int best = 0; float bscore = -INFINITY;
#pragma unroll
                    for (int gq = 0; gq < 4; ++gq) { const float a = sel[4 * gq], bq = sel[4 * gq + 1], c = sel[4 * gq + 2], d = sel[4 * gq + 3];
                        const float m1 = fmaxf(fmaxf(a, bq), fmaxf(c, d));
                        const float lo1 = fminf(a, bq), hi1 = fmaxf(a, bq), lo2 = fminf(c, d), hi2 = fmaxf(c, d);
                        const float m2 = fmaxf(fminf(hi1, hi2), fmaxf(lo1, lo2));
                        const float gs = m1 + m2; if (gs > bscore) { bscore = gs; best = gq; } }
                    float s4[4], p4[4];
#pragma unroll
                    for (int q = 0; q < 4; ++q) { s4[q] = -INFINITY; p4[q] = 0.f; }
#pragma unroll
                    for (int gq = 0; gq < 4; ++gq) if (best == gq) {
#pragma unroll
                        for (int q = 0; q < 4; ++q) { s4[q] = sel[4 * gq + q]; p4[q] = lg[4 * gq + q]; } }
                    int i0 = 0; float v0 = s4[0], pp0 = p4[0];
#pragma unroll
                    for (int q = 1; q < 4; ++q) if (s4[q] > v0) { v0 = s4[q]; i0 = q; pp0 = p4[q]; }
                    int i1 = -1; float v1 = -INFINITY, pp1 = 0.f;
#pragma unroll
                    for (int q = 0; q < 4; ++q) if (q != i0 && s4[q] > v1) { v1 = s4[q]; i1 = q; pp1 = p4[q]; }
                    const float wsum = pp0 + pp1, w0 = pp0 / wsum, w1 = pp1 / wsum;
                    const int e0 = best * 4 + i0, e1 = best * 4 + i1;
                    if ((lane & 31) == 0) {
                        const int lp0 = __hip_atomic_fetch_add(lcnt + e0, 1, __ATOMIC_RELAXED, __HIP_MEMORY_SCOPE_WORKGROUP), lp1 = __hip_atomic_fetch_add(lcnt + e1, 1, __ATOMIC_RELAXED, __HIP_MEMORY_SCOPE_WORKGROUP);
                        LAS int* ri = rinfo + (F.wave * 16 + it * RPI + r) * 8;
                        ri[0] = e0; ri[1] = e1; ri[2] = lp0; ri[3] = lp1; ri[4] = __builtin_bit_cast(int, w0); ri[5] = __builtin_bit_cast(int, w1);
                        if (I8) { const float rsc_ = r ? rscale[RPI - 1] : rscale[0]; ri[6] = __builtin_bit_cast(int, rsc_); }
                    }
                }
            }
        }
#undef RP_LOAD_X
#undef RP_LOAD_TOK
#undef RP_LOAD_O
        if (MODE == 1) {
            __syncthreads();
            if (F.tid < 16) lcnt[16 + F.tid] = (int)__hip_atomic_fetch_add(F.ctl + CW_CNT + 64 * layer + F.tid, (unsigned)lcnt[F.tid], RLX_AGENT);
            __syncthreads();
            if (F.tid < 128) { const LAS int* ri = rinfo + F.tid * 8; const int row = batch * 128 + F.tid; const int e0 = ri[0], e1 = ri[1], p0 = lcnt[16 + e0] + ri[2], p1 = lcnt[16 + e1] + ri[3];
                int* LIST = (int*)(F.ws + WS_LIST); LIST[e0 * LCAP + p0] = row; LIST[e1 * LCAP + p1] = row;
                if (I8_UP) { int* SAS = (int*)(F.ws + WS_SASLOT); const int rs_ = ri[6]; SAS[e0 * LCAP + p0] = rs_; SAS[e1 * LCAP + p1] = rs_; }
                u32x4 ti; ti.x = (unsigned)(e0 << 16) | (unsigned)p0; ti.y = (unsigned)(e1 << 16) | (unsigned)p1; ti.z = (unsigned)ri[4]; ti.w = (unsigned)ri[5];
                *(u32x4*)(F.ws + WS_TOK + (size_t)row * 16) = ti; }
        }
    }
    __syncthreads();
}

#define LBAR() do { asm volatile("s_waitcnt lgkmcnt(0)" ::: "memory"); __builtin_amdgcn_s_barrier(); asm volatile("" ::: "memory"); } while (0)
__device__ __forceinline__ float incl_sum(float v, int lane) {
#pragma unroll
    for (int o = 1; o < 64; o <<= 1) { const float t = __shfl_up(v, o); if (lane >= o) v += t; }
    return v;
}
__device__ __forceinline__ float incl_max(float v, int lane) {
#pragma unroll
    for (int o = 1; o < 64; o <<= 1) { const float t = __shfl_up(v, o); if (lane >= o) v = fmaxf(v, t); }
    return v;
}
__device__ __forceinline__ void phase_scan(Frame& F, int mode = 0) {
    LAS float* wkA = (LAS float*)(F.lds + 0);
    LAS float* decA = (LAS float*)(F.lds + 32768);
    LAS float* tot = (LAS float*)(F.lds + 33280);
    LAS float* bst = (LAS float*)(F.lds + 33792);
    LAS float* cmx = (LAS float*)(F.lds + 34304);
    LAS float* rst = (LAS float*)(F.lds + 34816);
    LAS float* xw = (LAS float*)(F.lds + 35328);
    LAS unsigned char* ring = F.lds + 40960;
    constexpr int SLOT = 12288;
    const int lane = F.lane, w = F.wave, tid = F.tid;
    for (int unit = F.vcu; unit < 256; unit += F.G) {
        const int bh = unit >> 4, slice = unit & 15;
        const float* IG = (const float*)(F.ws + WS_IG) + (size_t)bh * SEQ; const float* LF = (const float*)(F.ws + WS_LF) + (size_t)bh * SEQ;
        __syncthreads();
        if (mode < 2) {
        float p[16], g[16], pm[16];
#pragma unroll
        for (int q = 0; q < 16; ++q) { const int c = 16 * w + q; p[q] = incl_sum(LF[c * 64 + lane], lane); if (lane == 63) tot[c] = p[q]; }
        __syncthreads();
        if (tid < 128) { const float v = tot[tid]; const float inc = incl_sum(v, lane); if (tid == 63) xw[0] = inc; bst[tid] = inc - v; }
        __syncthreads();
        if (tid >= 64 && tid < 128) bst[tid] += xw[0];
        __syncthreads();
#pragma unroll
        for (int q = 0; q < 16; ++q) { const int c = 16 * w + q; p[q] += bst[c]; g[q] = IG[c * 64 + lane] - p[q]; pm[q] = incl_max(g[q], lane); if (lane == 63) cmx[c] = pm[q]; }
        __syncthreads();
        if (tid < 128) { const float v = cmx[tid]; const float inc = incl_max(v, lane); if (tid == 63) xw[1] = inc; float ex = __shfl_up(inc, 1); if (lane == 0) ex = 0.f; rst[tid] = fmaxf(ex, 0.f); }
        __syncthreads();
        if (tid >= 64 && tid < 128) rst[tid] = fmaxf(rst[tid], xw[1]);
        __syncthreads();
#pragma unroll
        for (int q = 0; q < 16; ++q) { const int c = 16 * w + q; const float Rs = rst[c], Rn = fmaxf(Rs, cmx[c]), Rrun = fmaxf(Rs, pm[q]);
            wkA[c * 64 + lane] = expf(g[q] - Rn); if (lane == 0) decA[c] = expf(Rs - Rn);
            if (slice == 0) { const size_t o = (size_t)bh * SEQ + c * 64 + lane; ((float*)(F.ws + WS_GA))[o] = g[q]; ((float*)(F.ws + WS_RR))[o] = Rrun; ((float*)(F.ws + WS_MM))[o] = p[q] + Rrun;
                if (lane == 0) ((float*)(F.ws + WS_RC))[bh * NCH + c] = Rs; } }
        }
        __syncthreads();
        if (mode == 1) continue;
        const int dkh = slice & 1, dvs = slice >> 1;
        const bf16_t* KTg = (const bf16_t*)(F.ws + WS_KT) + ((size_t)bh * NCH * DK + 64 * dkh) * 64;
        const bf16_t* VTg = (const bf16_t*)(F.ws + WS_VT) + ((size_t)bh * NCH * DV + 32 * dvs) * 64;
        const int dkr = 64 * dkh + 16 * (w >> 1), dvc = 32 * dvs + 16 * (w & 1);
        bf16_t* STp = (bf16_t*)(F.ws + WS_ST) + ((size_t)bh * NCH * DV + dvc + (lane & 15)) * DK + dkr + 4 * (lane >> 4);
        float* NSp = (float*)(F.ws + WS_NS) + (size_t)bh * NCH * DK + dkr + 4 * (lane >> 4);
        const bool ns_writer = (dvs == 0) && ((w & 1) == 0) && ((lane & 15) == 0);
        f32x4 accS = (f32x4){0.f, 0.f, 0.f, 0.f}, accN = (f32x4){0.f, 0.f, 0.f, 0.f};
        constexpr int PD = 4;
        u32x4 gk[PD], gv[PD];
        const int wr0 = (tid >> 3) * 128 + (((tid & 7) ^ ((tid >> 3) & 7)) << 4);
        const int arow = 16 * (w >> 1) + (lane & 15), brow = 16 * (w & 1) + (lane & 15), lq = lane >> 4;
#define SC_LOAD(set, cc) do { gk[set] = *(const u32x4*)(KTg + (size_t)(cc) * DK * 64 + tid * 8); if (tid < 256) gv[set] = *(const u32x4*)(VTg + (size_t)(cc) * DV * 64 + tid * 8); } while (0)
#define SC_WRITE(set, slot) do { LAS unsigned char* sb_ = ring + (slot) * SLOT; *(LAS u32x4*)(sb_ + wr0) = gk[set]; if (tid < 256) *(LAS u32x4*)(sb_ + 8192 + wr0) = gv[set]; } while (0)
#pragma unroll
        for (int q = 0; q < PD; ++q) SC_LOAD(q, q);
        SC_WRITE(0, 0); SC_WRITE(1, 1);
        SC_LOAD(0, PD); SC_LOAD(1, PD + 1);
        LBAR();
        for (int c0 = 0; c0 < NCH; c0 += PD) {
#pragma unroll
            for (int q2 = 0; q2 < PD; q2 += 2) {
                { const int cw = c0 + q2 + 2;
                  if (cw < NCH) { SC_WRITE((q2 + 2) % PD, (q2 + 2) % PD); SC_WRITE((q2 + 3) % PD, (q2 + 3) % PD);
                      if (cw + PD < NCH) { SC_LOAD((q2 + 2) % PD, cw + PD); SC_LOAD((q2 + 3) % PD, cw + PD + 1); } } }
#pragma unroll
                for (int qq = 0; qq < 2; ++qq) {
                    const int q = q2 + qq, c = c0 + q;
                    if (mode < 3) { { u32x2 o; o.x = pk2(accS[0], accS[1]); o.y = pk2(accS[2], accS[3]); *(u32x2*)(STp + (size_t)c * DV * DK) = o; }
                    if (ns_writer) *(f32x4*)(NSp + (size_t)c * DK) = accN; }
                    const float dec = decA[c];
                    accS = accS * dec; accN = accN * dec;
                    const LAS unsigned char* sb = ring + q * SLOT;
#pragma unroll
                    for (int kk = 0; kk < 2; ++kk) {
                        const LAS f32x4* wp = (const LAS f32x4*)(wkA + c * 64 + kk * 32 + 8 * lq);
                        const f32x4 w0 = wp[0], w1 = wp[1];
                        const u32x4 ka = *(const LAS u32x4*)(sb + arow * 128 + (((4 * kk + lq) ^ (arow & 7)) << 4));
                        const u32x4 vv = *(const LAS u32x4*)(sb + 8192 + brow * 128 + (((4 * kk + lq) ^ (brow & 7)) << 4));
                        u32x4 bv, b1;
                        bv.x = pk2(bflo(vv.x) * w0[0], bfhi(vv.x) * w0[1]); bv.y = pk2(bflo(vv.y) * w0[2], bfhi(vv.y) * w0[3]);
                        bv.z = pk2(bflo(vv.z) * w1[0], bfhi(vv.z) * w1[1]); bv.w = pk2(bflo(vv.w) * w1[2], bfhi(vv.w) * w1[3]);
                        b1.x = pk2(w0[0], w0[1]); b1.y = pk2(w0[2], w0[3]); b1.z = pk2(w1[0], w1[1]); b1.w = pk2(w1[2], w1[3]);
                        const bf16x8 af = __builtin_bit_cast(bf16x8, ka);
                        accS = __builtin_amdgcn_mfma_f32_16x16x32_bf16(af, __builtin_bit_cast(bf16x8, bv), accS, 0, 0, 0);
                        accN = __builtin_amdgcn_mfma_f32_16x16x32_bf16(af, __builtin_bit_cast(bf16x8, b1), accN, 0, 0, 0);
                    }
                }
                LBAR();
            }
        }
        asm volatile("" :: "v"(accS), "v"(accN));
#undef SC_LOAD
#undef SC_WRITE
    }
    __syncthreads();
}

constexpr int OC_AP = 0, OC_STRIDE = 400, OC_BVEC = 25600, OC_INV = 26368, OC_PART = 26624, OC_GS = 28672, OC_RT = 28928, OC_EMM = 29184, OC_HT = 32768, OC_HSTR = 528;
__device__ __forceinline__ void phase_out(Frame& F) {
    LAS unsigned char* AP = F.lds + OC_AP; LAS unsigned char* HT = F.lds + OC_HT;
    LAS float* bvec = (LAS float*)(F.lds + OC_BVEC); LAS float* inv = (LAS float*)(F.lds + OC_INV); LAS float* part = (LAS float*)(F.lds + OC_PART);
    LAS float* gs = (LAS float*)(F.lds + OC_GS); LAS float* Rt = (LAS float*)(F.lds + OC_RT); LAS float* emm = (LAS float*)(F.lds + OC_EMM);
    const int lane = F.lane, w = F.wave, tid = F.tid, l15 = lane & 15, lq = lane >> 4;
    const bf16_t* Qg = (const bf16_t*)(F.ws + WS_Q); const bf16_t* Kg = (const bf16_t*)(F.ws + WS_K);
    const bf16_t* VTg = (const bf16_t*)(F.ws + WS_VT); const bf16_t* STg = (const bf16_t*)(F.ws + WS_ST); const bf16_t* OGS = (const bf16_t*)(F.ws + WS_OGS);
    const float* GAg = (const float*)(F.ws + WS_GA); const float* RRg = (const float*)(F.ws + WS_RR); const float* MMg = (const float*)(F.ws + WS_MM);
    const float* NSg = (const float*)(F.ws + WS_NS); const float* RCg = (const float*)(F.ws + WS_RC); const float* MNG = F.in[I_MNG];
    bf16_t* HN = (bf16_t*)(F.ws + WS_U);
    const int mt = w >> 1, ntb = (w & 1) * 2, tq = tid >> 3, pq = tid & 7, NU = 16 * NCH;
    u32x4 bfr[2][6], qk[4], og[4]; f32x4 ng0, ng1; float sc_g = 0.f, sc_r = 0.f, sc_m = 0.f, sc_b = 0.f, Rc = 0.f;
    LAS unsigned char* QL = F.lds + 69632; LAS unsigned char* KL = F.lds + 86016;
    const int prow = tid >> 4, pch = tid & 15;
    const int pwr = prow * 256 + ((pch ^ (prow & 15)) << 4);
#define OC_LOAD_MAIN(U_) do { const int bh_ = (U_) >> 7, c_ = (U_) & 127, tk_ = (bh_ >> 2) * SEQ + c_ * 64, h_ = bh_ & 3; \
        _Pragma("unroll") for (int n = 0; n < 2; ++n) { const int dv = 32 * w + 16 * n + l15; \
            _Pragma("unroll") for (int kk = 0; kk < 2; ++kk) bfr[n][kk] = *(const u32x4*)(VTg + ((((size_t)bh_ * NCH + c_) * DV + dv) << 6) + 32 * kk + 8 * lq); \
            _Pragma("unroll") for (int kk = 0; kk < 4; ++kk) bfr[n][2 + kk] = *(const u32x4*)(STg + (((size_t)bh_ * NCH + c_) * DV + dv) * DK + 32 * kk + 8 * lq); } \
        qk[0] = *(const u32x4*)(Qg + (size_t)(tk_ + prow) * MQK + h_ * DK + 8 * pch); qk[1] = *(const u32x4*)(Qg + (size_t)(tk_ + prow + 32) * MQK + h_ * DK + 8 * pch); \
        qk[2] = *(const u32x4*)(Kg + (size_t)(tk_ + prow) * MQK + h_ * DK + 8 * pch); qk[3] = *(const u32x4*)(Kg + (size_t)(tk_ + prow + 32) * MQK + h_ * DK + 8 * pch); \
        if (tid < 64) { const size_t o_ = (size_t)bh_ * SEQ + c_ * 64 + tid; sc_g = GAg[o_]; sc_r = RRg[o_]; sc_m = MMg[o_]; sc_b = 1.0f; } \
        else if (tid < 192) sc_b = NSg[((size_t)bh_ * NCH + c_) * DK + tid - 64]; \
        Rc = RCg[bh_ * NCH + c_]; } while (0)
#define OC_LOAD_OGS(U_) do { const int bh_ = (U_) >> 7, c_ = (U_) & 127, tk_ = (bh_ >> 2) * SEQ + c_ * 64, h_ = bh_ & 3; \
        _Pragma("unroll") for (int q = 0; q < 4; ++q) og[q] = *(const u32x4*)(OGS + (size_t)(tk_ + (tid >> 5) + 16 * q) * MV + h_ * DV + 8 * (tid & 31)); \
        ng0 = *(const f32x4*)(MNG + h_ * DV + 8 * (tid & 31)); ng1 = *(const f32x4*)(MNG + h_ * DV + 8 * (tid & 31) + 4); } while (0)
    int unit = F.vcu;
    if (unit < NU) { OC_LOAD_MAIN(unit); OC_LOAD_OGS(unit); }
    for (; unit < NU; unit += F.G) {
        const int bh = unit >> 7, c = unit & 127, b = bh >> 2, h = bh & 3;
        const int tk0 = b * SEQ + c * 64;
        if (tid < 64) { gs[tid] = sc_g; Rt[tid] = sc_r; emm[tid] = expf(-sc_m); }
        if (tid < 192) bvec[tid] = sc_b;
        *(LAS u32x4*)(QL + pwr) = qk[0]; *(LAS u32x4*)(QL + 8192 + pwr) = qk[1]; *(LAS u32x4*)(KL + pwr) = qk[2]; *(LAS u32x4*)(KL + 8192 + pwr) = qk[3];
        const float Rc_cur = Rc;
        LBAR();
        u32x4 qa[4], kb[2][4];
#pragma unroll
        for (int kk = 0; kk < 4; ++kk) { { const int row = 16 * mt + l15; qa[kk] = *(const LAS u32x4*)(QL + row * 256 + (((4 * kk + lq) ^ (row & 15)) << 4)); }
#pragma unroll
            for (int n = 0; n < 2; ++n) { const int row = 16 * (ntb + n) + l15; kb[n][kk] = *(const LAS u32x4*)(KL + row * 256 + (((4 * kk + lq) ^ (row & 15)) << 4)); } }
        const u32x4 q0 = *(const LAS u32x4*)(QL + tq * 256 + (((2 * pq) ^ (tq & 15)) << 4)), q1 = *(const LAS u32x4*)(QL + tq * 256 + (((2 * pq + 1) ^ (tq & 15)) << 4));
        f32x4 pacc[2];
#pragma unroll
        for (int n = 0; n < 2; ++n) { pacc[n] = (f32x4){0.f, 0.f, 0.f, 0.f};
#pragma unroll
            for (int kk = 0; kk < 4; ++kk) pacc[n] = __builtin_amdgcn_mfma_f32_16x16x32_bf16(__builtin_bit_cast(bf16x8, qa[kk]), __builtin_bit_cast(bf16x8, kb[n][kk]), pacc[n], 0, 0, 0); }
#pragma unroll
        for (int n = 0; n < 2; ++n) { const int sl = 16 * (ntb + n) + l15; const float gsv = gs[sl];
#pragma unroll
            for (int r = 0; r < 4; ++r) { const int tl = 16 * mt + 4 * lq + r; const float pv = (sl <= tl) ? pacc[n][r] * expf(gsv - Rt[tl]) : 0.f;
                *(LAS bf16_t*)(AP + tl * OC_STRIDE + sl * 2) = (bf16_t)f2bf(pv); } }
        { const float wq = expf(Rc_cur - Rt[tq]);
          u32x4 o0, o1;
          o0.x = pk2(bflo(q0.x) * wq, bfhi(q0.x) * wq); o0.y = pk2(bflo(q0.y) * wq, bfhi(q0.y) * wq); o0.z = pk2(bflo(q0.z) * wq, bfhi(q0.z) * wq); o0.w = pk2(bflo(q0.w) * wq, bfhi(q0.w) * wq);
          o1.x = pk2(bflo(q1.x) * wq, bfhi(q1.x) * wq); o1.y = pk2(bflo(q1.y) * wq, bfhi(q1.y) * wq); o1.z = pk2(bflo(q1.z) * wq, bfhi(q1.z) * wq); o1.w = pk2(bflo(q1.w) * wq, bfhi(q1.w) * wq);
          *(LAS u32x4*)(AP + tq * OC_STRIDE + 128 + 32 * pq) = o0; *(LAS u32x4*)(AP + tq * OC_STRIDE + 128 + 32 * pq + 16) = o1; }
        LBAR();
        { float s = 0.f;
#pragma unroll
          for (int q = 0; q < 3; ++q) { const u32x4 a = *(const LAS u32x4*)(AP + tq * OC_STRIDE + 48 * pq + 16 * q); const LAS f32x4* bp = (const LAS f32x4*)(bvec + 24 * pq + 8 * q); const f32x4 b0 = bp[0], b1 = bp[1];
              s += bflo(a.x) * b0[0] + bfhi(a.x) * b0[1] + bflo(a.y) * b0[2] + bfhi(a.y) * b0[3] + bflo(a.z) * b1[0] + bfhi(a.z) * b1[1] + bflo(a.w) * b1[2] + bfhi(a.w) * b1[3]; }
          s += __shfl_xor(s, 1); s += __shfl_xor(s, 2); s += __shfl_xor(s, 4);
          if (pq == 0) inv[tq] = 1.0f / fmaxf(fabsf(s), emm[tq]); }
        f32x4 acc[4][2];
#pragma unroll
        for (int m = 0; m < 4; ++m)
#pragma unroll
            for (int n = 0; n < 2; ++n) acc[m][n] = (f32x4){0.f, 0.f, 0.f, 0.f};
#pragma unroll
        for (int kk = 0; kk < 6; ++kk) {
            bf16x8 af[4];
#pragma unroll
            for (int m = 0; m < 4; ++m) af[m] = *(const LAS bf16x8*)(AP + (16 * m + l15) * OC_STRIDE + 64 * kk + 16 * lq);
#pragma unroll
            for (int m = 0; m < 4; ++m)
#pragma unroll
                for (int n = 0; n < 2; ++n) acc[m][n] = __builtin_amdgcn_mfma_f32_16x16x32_bf16(af[m], __builtin_bit_cast(bf16x8, bfr[n][kk]), acc[m][n], 0, 0, 0);
        }
        const int nxt = unit + F.G;
        if (nxt < NU) OC_LOAD_MAIN(nxt);
        LBAR();
#pragma unroll
        for (int m = 0; m < 4; ++m)
#pragma unroll
            for (int r = 0; r < 4; ++r) { const int tl = 16 * m + 4 * lq + r; const float iv = inv[tl];
                const float h0 = acc[m][0][r] * iv, h1 = acc[m][1][r] * iv;
                *(LAS bf16_t*)(HT + tl * OC_HSTR + (32 * w + l15) * 2) = (bf16_t)f2bf(h0); *(LAS bf16_t*)(HT + tl * OC_HSTR + (32 * w + 16 + l15) * 2) = (bf16_t)f2bf(h1);
                float s = h0 * h0 + h1 * h1; s += __shfl_xor(s, 1); s += __shfl_xor(s, 2); s += __shfl_xor(s, 4); s += __shfl_xor(s, 8);
                if (l15 == 0) part[w * 64 + tl] = s; }
        LBAR();
#pragma unroll
        for (int q = 0; q < 4; ++q) { const int row = (tid >> 5) + 16 * q, ch = tid & 31; float ss = 0.f;
#pragma unroll
            for (int ww = 0; ww < 8; ++ww) ss += part[ww * 64 + row];
            const float rs = 1.0f / sqrtf(ss * (1.0f / DV) + EPS);
            const u32x4 hv = *(const LAS u32x4*)(HT + row * OC_HSTR + ch * 16); const u32x4 g = og[q];
            float f0 = bflo(hv.x) * rs * ng0[0] * bflo(g.x), f1 = bfhi(hv.x) * rs * ng0[1] * bfhi(g.x), f2 = bflo(hv.y) * rs * ng0[2] * bflo(g.y), f3 = bfhi(hv.y) * rs * ng0[3] * bfhi(g.y);
            float f4 = bflo(hv.z) * rs * ng1[0] * bflo(g.z), f5 = bfhi(hv.z) * rs * ng1[1] * bfhi(g.z), f6 = bflo(hv.w) * rs * ng1[2] * bflo(g.w), f7 = bfhi(hv.w) * rs * ng1[3] * bfhi(g.w);
            if (FP8_MOUT) { u32x2 o8; o8.x = pk4_fp8_sat(2.f * f0, 2.f * f1, 2.f * f2, 2.f * f3); o8.y = pk4_fp8_sat(2.f * f4, 2.f * f5, 2.f * f6, 2.f * f7);
                *(u32x2*)((unsigned char*)HN + (size_t)(tk0 + row) * MV + h * DV + 8 * ch) = o8; }
            else { u32x4 o; o.x = pk2(f0, f1); o.y = pk2(f2, f3); o.z = pk2(f4, f5); o.w = pk2(f6, f7);
            *(u32x4*)(HN + (size_t)(tk0 + row) * MV + h * DV + 8 * ch) = o; } }
        if (nxt < NU) OC_LOAD_OGS(nxt);
    }
#undef OC_LOAD_MAIN
#undef OC_LOAD_OGS
    __syncthreads();
}

__device__ __forceinline__ void phase_conv(Frame& F) {
    const bf16_t* BG = (const bf16_t*)(F.ws + WS_BG); const bf16_t* Z = (const bf16_t*)(F.ws + WS_Z); bf16_t* Y = (bf16_t*)(F.ws + WS_Y);
    const int cg = F.tid & 127, rsub = F.tid >> 7, col = 8 * cg;
    float w0[8], w1[8], w2[8], cb[8];
#pragma unroll
    for (int i = 0; i < 8; ++i) { w0[i] = F.in[I_CCW][col + i]; w1[i] = F.in[I_CCW][D + col + i]; w2[i] = F.in[I_CCW][2 * D + col + i]; cb[i] = F.in[I_CCB][col + i]; }
    for (int batch = F.vcu; batch < T / 128; batch += F.G) {
        const int t0 = batch * 128 + rsub * 32, s0 = t0 % SEQ;
        u32x4 z2 = (u32x4){0u, 0u, 0u, 0u}, z1 = z2;
        if (s0 >= 2) z2 = *(const u32x4*)(Z + (size_t)(t0 - 2) * D + col);
        if (s0 >= 1) z1 = *(const u32x4*)(Z + (size_t)(t0 - 1) * D + col);
#pragma unroll 4
        for (int r = 0; r < 32; ++r) {
            const u32x4 z0 = *(const u32x4*)(Z + (size_t)(t0 + r) * D + col), bg = *(const u32x4*)(BG + (size_t)(t0 + r) * D + col);
            float o[8];
#pragma unroll
            for (int i = 0; i < 4; ++i) {
                o[2 * i] = bflo(bg[i]) * (w0[2 * i] * bflo(z2[i]) + w1[2 * i] * bflo(z1[i]) + w2[2 * i] * bflo(z0[i]) + cb[2 * i]);
                o[2 * i + 1] = bfhi(bg[i]) * (w0[2 * i + 1] * bfhi(z2[i]) + w1[2 * i + 1] * bfhi(z1[i]) + w2[2 * i + 1] * bfhi(z0[i]) + cb[2 * i + 1]); }
            if (FP8_COUT) { u32x2 o8; o8.x = pk4_fp8_sat(o[0], o[1], o[2], o[3]); o8.y = pk4_fp8_sat(o[4], o[5], o[6], o[7]); *(u32x2*)((unsigned char*)Y + (size_t)(t0 + r) * D + col) = o8; }
            else { u32x4 ov; ov.x = pk2(o[0], o[1]); ov.y = pk2(o[2], o[3]); ov.z = pk2(o[4], o[5]); ov.w = pk2(o[6], o[7]);
            *(u32x4*)(Y + (size_t)(t0 + r) * D + col) = ov; }
            z2 = z1; z1 = z0;
        }
    }
}

__device__ __forceinline__ void moe_table(Frame& F, int layer) {
    __syncthreads();
    if (F.tid == 0) { int a = 0; for (int e = 0; e < NE; ++e) { const int c = (int)__hip_atomic_load(F.ctl + CW_CNT + 64 * layer + e, RLX_AGENT); F.MISC[16 + e] = (unsigned)a; F.MISC[40 + e] = (unsigned)c; a += (c + 255) >> 8; } F.MISC[16 + NE] = (unsigned)a; }
    __syncthreads();
}

#ifndef TIMER_PHASE
#define TIMER_PHASE (-1)
#endif
#define STAMP(k) do { if (TIMER_PHASE >= 0 && blockIdx.x == 0 && threadIdx.x == 0) { unsigned long long t_ = __builtin_amdgcn_s_memrealtime(); ((unsigned long long*)karg_ptr(21))[4096 + (k)] = t_; } } while (0)
constexpr int N_PHASES = 17;
#define WSP(T_, off) ((T_*)(F.ws + (off)))
__global__ void __launch_bounds__(NTHR, 2) fwd_kernel(Args args) {
    extern __shared__ __attribute__((aligned(16))) unsigned char lds_raw[];
#define MAKE_FRAME() Frame F; { int t_ = threadIdx.x, bx_ = blockIdx.x, g_ = gridDim.x; asm volatile("" : "+v"(t_), "+s"(bx_), "+s"(g_)); \
        F.lds = (LAS unsigned char*)lds_raw; F.MISC = (volatile LAS unsigned*)(F.lds + MISC_OFF); F.tid = t_; F.lane = t_ & 63; F.wave = __builtin_amdgcn_readfirstlane(t_ >> 6); \
        F.G = g_; F.bx = bx_; F.vcu = (g_ % 8 == 0) ? (bx_ % 8) * (g_ / 8) + bx_ / 8 : bx_; }
    const int lo = args.ph_lo, hi = args.ph_hi;
    const bool one_launch = (hi - lo) > 1;
    XcdBarrier bar;
    { MAKE_FRAME();
      for (int u = F.tid; u < 256; u += NTHR) F.MISC[u] = 0u;
      __syncthreads();
      bar.bar = (unsigned*)(F.ctl + CW_BAR); bar.x = 0; bar.st = nullptr;
      if (one_launch) bar = xcd_barrier_post((unsigned*)(F.ctl + CW_BAR), F.MISC + 8); }
    STAMP(0);
#ifdef PH_ONLY
#define IN(k) ((k) == PH_ONLY && lo <= (k) && (k) < hi)
#else
#define IN(k) (lo <= (k) && (k) < hi)
#endif
#define SEAM(k) do { if (IN(k) && IN((k) + 1)) { xcd_barrier(bar); STAMP((k) + 1); } } while (0)
#ifndef DUP_MODE
#define DUP_MODE 0
#endif
#ifndef DUP_PHASE
#define DUP_PHASE (-1)
#endif
#define PHASE(k) if (IN(k)) { for (int rep_ = 0; rep_ < (((k) == DUP_PHASE) ? 2 : 1); ++rep_) { MAKE_FRAME(); asm volatile("; PHASE_MARK " #k);
#define END_PHASE(k) } } SEAM(k);
    PHASE(0) phase_prologue(F); END_PHASE(0)
    PHASE(1) row_pass<0>(F, 0); END_PHASE(1)
    PHASE(2) pg8::DenseOrder S; S.init(T, 3 * D, F.G, F.bx);
        pg8::EpiM1 E{WSP(bf16_t, WS_Q), WSP(bf16_t, WS_K), WSP(bf16_t, WS_KT), WSP(bf16_t, WS_VT), WSP(bf16_t, WS_OGS), F.lds + EPI_OFF};
        if (I8_G1) { S.sa = WSP(const float, WS_SA); pg8::Gemm g{WSP(bf16_t, WS_U8), WSP(bf16_t, WS_W0), D / 2, 0x7f7f7f7f, 0x7f7f7f7f, nullptr, (const int*)(F.ctl + 16), (LAS float*)(F.lds + SA_OFF), W8_STEP};
            pg8::gemm_phase<pg8::EpiM1, pg8::DenseOrder, true, true, true, 2>(F.lds, g, S, E, F.tid); }
        else if (FP8_G1 == 2) { S.init(T, 4 * 256, F.G, F.bx); { pg8::Gemm g{WSP(bf16_t, WS_U), WSP(bf16_t, WS_W0), D};
                pg8::gemm_phase<pg8::EpiM1, pg8::DenseOrder, false, true, true>(F.lds, g, S, E, F.tid); }
            S.init(T, 8 * 256, F.G, F.bx); S.pn0 = 4; { pg8::Gemm g{WSP(bf16_t, WS_U8), (const bf16_t*)(F.ws + WS_W0 + 2 * MiB), D / 2, 0x7a7a7a7a, 0x7f7f7f7f};
                pg8::gemm_phase<pg8::EpiM1, pg8::DenseOrder, true, true, true, true>(F.lds, g, S, E, F.tid); } }
        else if (FP8_G1) { pg8::Gemm g{WSP(bf16_t, WS_U8), WSP(bf16_t, WS_W0), D / 2, 0x7a7a7a7a, 0x7f7f7f7f};
            pg8::gemm_phase<pg8::EpiM1, pg8::DenseOrder, true, true, true, true>(F.lds, g, S, E, F.tid); }
        else { pg8::Gemm g{WSP(bf16_t, WS_U), WSP(bf16_t, WS_W0), D};
            pg8::gemm_phase<pg8::EpiM1, pg8::DenseOrder, false, true, true>(F.lds, g, S, E, F.tid); } END_PHASE(2)
    PHASE(3) phase_scan(F, rep_ == 0 ? 0 : DUP_MODE); END_PHASE(3)
    PHASE(4) phase_out(F); END_PHASE(4)
    PHASE(5) pg8::DenseOrder S; S.init(T, D, F.G, F.bx);
        pg8::EpiRes<true> E{F.in[I_X], WSP(bf16_t, WS_XB), WSP(float, WS_MOD) + 2 * D, (DBG_SKIP & 1) ? 0.f : 1.f};
        if (FP8_MOUT) { pg8::Gemm g{WSP(bf16_t, WS_U), WSP(bf16_t, WS_W1), D / 2, 0x7a7a7a7a, 0x7e7e7e7e};
            pg8::gemm_phase<pg8::EpiRes<true>, pg8::DenseOrder, true, true, true, true>(F.lds, g, S, E, F.tid); }
        else { pg8::Gemm g{WSP(bf16_t, WS_U), WSP(bf16_t, WS_W1), D};
            pg8::gemm_phase<pg8::EpiRes<true>, pg8::DenseOrder, false, true, true>(F.lds, g, S, E, F.tid); } END_PHASE(5)
#define WL(L_, off) WSP(bf16_t, ((L_) == 0 ? (size_t)0 : WS_WL1) + (off))
#define MOE_BLOCK(L, p0, p1, p2) \
    PHASE(p0) row_pass<1>(F, L); END_PHASE(p0) \
    PHASE(p1) moe_table(F, L); \
        pg8::Gemm g{WSP(bf16_t, WS_U8), WL(L, WS_WUP), D / 2, 0x7a7a7a7a, 0x7f7f7f7f, (LAS int*)(F.lds + EPI_OFF), (const int*)(F.ctl + 16), (LAS float*)(F.lds + SA_OFF), W8_STEP}; \
        pg8::MoeOrder S{(const LAS int*)(F.MISC + 16), (const LAS int*)(F.MISC + 40), WSP(const int, WS_LIST), F.G, F.vcu, 1024, I8_UP ? WSP(const float, WS_SASLOT) : nullptr}; \
        pg8::EpiGlu<true, true> E{WSP(bf16_t, WS_A8), DE, 0, nullptr, 0, 2.0f}; \
        pg8::gemm_phase<pg8::EpiGlu<true, true>, pg8::MoeOrder, true, true, true, I8_UP ? 2 : 1>(F.lds, g, S, E, F.tid); END_PHASE(p1) \
    PHASE(p2) moe_table(F, L); \
        pg8::Gemm g{WSP(bf16_t, WS_A8), WL(L, WS_WDN), DE / 2, 0x7b7b7b7b, 0x7e7e7e7e}; pg8::MoeOrder S{(const LAS int*)(F.MISC + 16), (const LAS int*)(F.MISC + 40), nullptr, F.G, F.vcu, 1024}; \
        pg8::EpiBf E{WSP(bf16_t, WS_O), D}; \
        pg8::gemm_phase<pg8::EpiBf, pg8::MoeOrder, true, true, true, true>(F.lds, g, S, E, F.tid); END_PHASE(p2)
    MOE_BLOCK(0, 6, 7, 8)
    PHASE(9) row_pass<2>(F, 1); convert_weights(F, 1); END_PHASE(9)
    PHASE(10) pg8::DenseOrder S; S.init(T, 3 * D, F.G, F.bx);
        pg8::EpiGlu<false> E{WSP(bf16_t, WS_Z), D, 4, WSP(bf16_t, WS_BG), D, 0.f};
        if (I8_CIN) { S.sa = WSP(const float, WS_SA); pg8::Gemm g{WSP(bf16_t, WS_U8), WL(1, WS_W0), D / 2, 0x7f7f7f7f, 0x7f7f7f7f, nullptr, (const int*)(F.ctl + 16), (LAS float*)(F.lds + SA_OFF), W8_STEP};
            pg8::gemm_phase<pg8::EpiGlu<false>, pg8::DenseOrder, true, true, true, 2>(F.lds, g, S, E, F.tid); }
        else if (FP8_CIN) { pg8::Gemm g{WSP(bf16_t, WS_U8), WL(1, WS_W0), D / 2, 0x7a7a7a7a, 0x7f7f7f7f};
            pg8::gemm_phase<pg8::EpiGlu<false>, pg8::DenseOrder, true, true, true, true>(F.lds, g, S, E, F.tid); }
        else { pg8::Gemm g{WSP(bf16_t, WS_U), WL(1, WS_W0), D};
            pg8::gemm_phase<pg8::EpiGlu<false>, pg8::DenseOrder, false, true, true>(F.lds, g, S, E, F.tid); } END_PHASE(10)
    PHASE(11) phase_conv(F); END_PHASE(11)
    PHASE(12) pg8::DenseOrder S; S.init(T, D, F.G, F.bx);
        pg8::EpiRes<false> E{WSP(bf16_t, WS_XB), WSP(bf16_t, WS_XB), WSP(float, WS_MOD) + (size_t)NB * 6 * D + 2 * D, (DBG_SKIP & 4) ? 0.f : 1.f};
        if (FP8_COUT) { pg8::Gemm g{WSP(bf16_t, WS_Y), WL(1, WS_W1), D / 2, 0x7a7a7a7a, 0x7f7f7f7f};
            pg8::gemm_phase<pg8::EpiRes<false>, pg8::DenseOrder, true, true, true, true>(F.lds, g, S, E, F.tid); }
        else { pg8::Gemm g{WSP(bf16_t, WS_Y), WL(1, WS_W1), D};
            pg8::gemm_phase<pg8::EpiRes<false>, pg8::DenseOrder, false, true, true>(F.lds, g, S, E, F.tid); } END_PHASE(12)
    MOE_BLOCK(1, 13, 14, 15)
    if (IN(16)) { MAKE_FRAME(); asm volatile("; PHASE_MARK 16"); row_pass<3>(F, 1);
    }

    if (TIMER_PHASE >= 0 && one_launch) {
        STAMP(17);
        xcd_barrier(bar);
        const unsigned long long* ts = (const unsigned long long*)karg_ptr(21) + 4096;
        const unsigned long long d = __hip_atomic_load(ts + TIMER_PHASE + 1, RLX_AGENT) - __hip_atomic_load(ts + TIMER_PHASE, RLX_AGENT);
        const unsigned long long t0 = __builtin_amdgcn_s_memrealtime();
        while (__builtin_amdgcn_s_memrealtime() - t0 < 4ull * d) __builtin_amdgcn_s_sleep(8);
    }
#undef IN
#undef SEAM
}

extern "C" void kernel_launch(void* const* d_in, const int* in_sizes, int n_in, void* d_out, int out_size, void* d_ws, size_t ws_size, hipStream_t stream) {
    static int grid = 0;
    if (grid == 0) {
        if (n_in != 20 || in_sizes[0] != T * D || out_size != T * D || ws_size < WS_END) { fprintf(stderr, "kernel_launch: unexpected shapes: n_in %d in0 %d out %d ws %zu\n", n_in, n_in > 0 ? in_sizes[0] : -1, out_size, ws_size); grid = -1; return; }
        int dev = 0, cus = 0, per_cu = 0;
        if (hipGetDevice(&dev) != hipSuccess || hipDeviceGetAttribute(&cus, hipDeviceAttributeMultiprocessorCount, dev) != hipSuccess) { grid = -1; return; }
        if (hipFuncSetAttribute((const void*)fwd_kernel, hipFuncAttributeMaxDynamicSharedMemorySize, LDS_BYTES) != hipSuccess) { fprintf(stderr, "kernel_launch: hipFuncSetAttribute failed\n"); grid = -1; return; }
        if (hipOccupancyMaxActiveBlocksPerMultiprocessor(&per_cu, (const void*)fwd_kernel, NTHR, LDS_BYTES) != hipSuccess || per_cu < 1) { fprintf(stderr, "kernel_launch: occupancy query says %d blocks per CU\n", per_cu); (void)hipGetLastError(); grid = -1; return; }
        grid = cus;
        if (grid != 256) fprintf(stderr, "kernel_launch: %d CUs (built for 256)\n", grid);
    }
    if (grid < 0) return;
    (void)hipMemsetAsync((char*)d_ws + WS_CTL, 0, CTL_ZERO_BYTES, stream);
    Args a{};
    for (int i = 0; i < 20; ++i) a.in[i] = (const float*)d_in[i];
    a.out = (float*)d_out; a.ws = (unsigned char*)d_ws;
#if MK_N_LAUNCHES == 1
    a.ph_lo = 0; a.ph_hi = N_PHASES;
    void* kargs[] = {&a};
    hipError_t e = hipLaunchCooperativeKernel((const void*)fwd_kernel, dim3(grid), dim3(NTHR), kargs, LDS_BYTES, stream);
    if (e != hipSuccess) fprintf(stderr, "kernel_launch: cooperative launch failed: %s\n", hipGetErrorString(e));
#else
    for (int p = 0; p < N_PHASES; ++p) { a.ph_lo = p; a.ph_hi = p + 1; hipLaunchKernelGGL(fwd_kernel, dim3(grid), dim3(NTHR), LDS_BYTES, stream, a); }
#endif
}
```

```cpp
#include <hip/hip_runtime.h>
#include <cstdio>
#include <cstdint>
#include <type_traits>

#ifndef FP8_G1
#define FP8_G1 2
#endif
#ifndef FP8_MOUT
#define FP8_MOUT 1
#endif
#ifndef FP8_COUT
#define FP8_COUT 1
#endif
#ifndef FP8_CIN
#define FP8_CIN 1
#endif
#ifndef I8_G1
#define I8_G1 1
#endif
#ifndef I8_CIN
#define I8_CIN 1
#endif
#ifndef I8_UP
#define I8_UP 1
#endif
#ifndef F8_O
#define F8_O 1
#endif
#ifndef F8_BZ
#define F8_BZ 1
#endif
#ifndef MOE_TAILS
#define MOE_TAILS 1
#endif
#ifndef EARLY_INV
#define EARLY_WB 0
#define FIRST_WB 0
#define DIRECT_REL 1
#define ADA_FLAG 1
#define EARLY_INV 1
#endif
#ifndef DBG_SKIP
#define DBG_SKIP 0
#endif
#ifndef MK_N_LAUNCHES
#define MK_N_LAUNCHES 1
#endif

#define LAS __attribute__((address_space(3)))
#define GAS __attribute__((address_space(1)))
typedef unsigned short bf16_t;
typedef short bf16x8 __attribute__((ext_vector_type(8)));
typedef float f32x4 __attribute__((ext_vector_type(4)));
typedef float f32x2 __attribute__((ext_vector_type(2)));
typedef unsigned u32x4 __attribute__((ext_vector_type(4)));
typedef unsigned u32x2 __attribute__((ext_vector_type(2)));
typedef GAS unsigned gu32;
#define RLX_AGENT __ATOMIC_RELAXED, __HIP_MEMORY_SCOPE_AGENT
#define LDS_WAIT() asm volatile("s_waitcnt lgkmcnt(0)" ::: "memory")
#define VM_WAIT() asm volatile("s_waitcnt vmcnt(0)" ::: "memory")

constexpr int NB = 4, SEQ = 8192, D = 1024, T = NB * SEQ;
constexpr int NH = 4, DK = 128, DV = 256, MQK = NH * DK, MV = NH * DV, MPROJ = 2 * MQK + 2 * MV + 2 * NH;
constexpr int CH = 64, NCH = SEQ / CH;
constexpr int NE = 16, DE = 512, LCAP = 65536;
constexpr int SLOT_ROWS = 2 * T + NE * 256;
constexpr float EPS = 1e-6f;
constexpr int NWAVES = 8, NTHR = 512;

constexpr size_t MiB = 1u << 20;
constexpr size_t WS_CTL = 0, CTL_ZERO_BYTES = 64 * 1024;
constexpr size_t WS_MOD = 1 * MiB;
constexpr size_t WS_W0 = 2 * MiB;
constexpr size_t WS_W1 = 8 * MiB;
constexpr size_t WS_WUP = 10 * MiB;
constexpr size_t WS_WDN = 42 * MiB;
constexpr size_t WS_WL1 = 338 * MiB;
constexpr size_t WS_IG = 62 * MiB;
constexpr size_t WS_LF = WS_IG + 512 * 1024;
constexpr size_t WS_GA = WS_LF + 512 * 1024;
constexpr size_t WS_RR = WS_GA + 512 * 1024;
constexpr size_t WS_MM = WS_RR + 512 * 1024;
constexpr size_t WS_RC = WS_MM + 512 * 1024;
constexpr size_t WS_NS = 65 * MiB;
constexpr size_t WS_TOK = 66 * MiB;
constexpr size_t WS_LIST = 67 * MiB;
constexpr size_t WS_SA = 71 * MiB;
constexpr size_t WS_SASLOT = 72 * MiB;
constexpr size_t WS_U = 72 * MiB;
constexpr size_t WS_Q = 136 * MiB;
constexpr size_t WS_K = 168 * MiB;
constexpr size_t WS_KT = 200 * MiB;
constexpr size_t WS_VT = 232 * MiB;
constexpr size_t WS_OGS = 296 * MiB;
constexpr size_t WS_ST = 360 * MiB;
constexpr size_t WS_A = 136 * MiB;
constexpr size_t WS_O = 204 * MiB;
constexpr size_t WS_BG = 136 * MiB;
constexpr size_t WS_Z = 200 * MiB;
constexpr size_t WS_Y = 264 * MiB;
constexpr size_t WS_XB = 400 * MiB;
constexpr size_t WS_U8 = 464 * MiB;
constexpr size_t WS_A8 = 136 * MiB;
constexpr size_t WS_END = 496 * MiB;
static_assert(WS_A + (size_t)SLOT_ROWS * DE * 2 <= WS_O && WS_O + (size_t)SLOT_ROWS * D * 2 <= WS_ST, "moe map");

constexpr int CW_CNT = 64;
constexpr int CW_CVT = 256;
constexpr int CW_T2 = 512;
constexpr int CW_ADA = 528;
constexpr int CW_BAR = 1024;

constexpr int RING_BYTES = 131072;
constexpr int MISC_OFF = RING_BYTES;
constexpr int EPI_OFF = MISC_OFF + 1024;
constexpr int SA_OFF = EPI_OFF + 16384;
constexpr int LDS_BYTES = 150528;
constexpr float W8_Q = 576.f, W8_STEP = 1.f / 576.f;

typedef __bf16 bf16x2_t __attribute__((ext_vector_type(2)));
__device__ __forceinline__ unsigned f2bf(float f) { return (unsigned)__builtin_bit_cast(unsigned short, (__bf16)f); }
__device__ __forceinline__ unsigned pk2(float lo, float hi) { bf16x2_t v; v[0] = (__bf16)lo; v[1] = (__bf16)hi; return __builtin_bit_cast(unsigned, v); }
__device__ __forceinline__ float bf2f(unsigned short h) { return __builtin_bit_cast(float, (unsigned)h << 16); }
__device__ __forceinline__ float bflo(unsigned w) { return __builtin_bit_cast(float, w << 16); }
__device__ __forceinline__ float bfhi(unsigned w) { return __builtin_bit_cast(float, w & 0xffff0000u); }
__device__ __forceinline__ unsigned cvt_pk_bf16(float lo, float hi) { unsigned r; asm volatile("v_cvt_pk_bf16_f32 %0, %1, %2" : "=v"(r) : "v"(lo), "v"(hi)); return r; }
__device__ __forceinline__ unsigned pk4_fp8(float a, float b, float c, float d) { int w = 0; w = __builtin_amdgcn_cvt_pk_fp8_f32(a, b, w, false); w = __builtin_amdgcn_cvt_pk_fp8_f32(c, d, w, true); return (unsigned)w; }
__device__ __forceinline__ unsigned pk4_fp8_sat(float a, float b, float c, float d) {
    return pk4_fp8(__builtin_amdgcn_fmed3f(a, -448.f, 448.f), __builtin_amdgcn_fmed3f(b, -448.f, 448.f), __builtin_amdgcn_fmed3f(c, -448.f, 448.f), __builtin_amdgcn_fmed3f(d, -448.f, 448.f)); }
__device__ __forceinline__ unsigned pk4_i8(float a, float b, float c, float d) {
    const float M_ = 12582912.f;
    const unsigned ua = __float_as_uint(a + M_), ub = __float_as_uint(b + M_), uc = __float_as_uint(c + M_), ud = __float_as_uint(d + M_);
    return (ua & 0xffu) | ((ub & 0xffu) << 8) | ((uc & 0xffu) << 16) | (ud << 24); }
__device__ __forceinline__ unsigned pk4_i8c(float a, float b, float c, float d) {
    return pk4_i8(__builtin_amdgcn_fmed3f(a, -127.f, 127.f), __builtin_amdgcn_fmed3f(b, -127.f, 127.f), __builtin_amdgcn_fmed3f(c, -127.f, 127.f), __builtin_amdgcn_fmed3f(d, -127.f, 127.f)); }
__device__ __forceinline__ f32x4 o4(unsigned w) { const f32x2 lo = __builtin_amdgcn_cvt_pk_f32_fp8((int)w, false), hi = __builtin_amdgcn_cvt_pk_f32_fp8((int)w, true); return (f32x4){lo[0], lo[1], hi[0], hi[1]}; }
__device__ __forceinline__ f32x4 o4(u32x2 w) { return (f32x4){bflo(w.x), bfhi(w.x), bflo(w.y), bfhi(w.y)}; }
__device__ __forceinline__ float fast_exp(float x) { return __builtin_amdgcn_exp2f(x * 1.44269504089f); }
__device__ __forceinline__ float sigmoidf_(float x) { return __builtin_amdgcn_rcpf(1.0f + fast_exp(-x)); }

namespace pg8 {
constexpr int BM = 256, BK = 64, HALF = 128, HTB = HALF * BK * 2, STAGE_BYTES = 8 * HTB, NXCD = 8, WGM = 8;
__host__ __device__ __forceinline__ int lds_byte(int r, int c) { const int st = (r >> 4) * 2 + (c >> 5), rr = r & 15, cc = c & 31, ob = rr * 64 + cc * 2; return st * 1024 + (ob ^ (((ob >> 9) & 1) << 5)); }
__host__ __device__ __forceinline__ void stage_rc(int b, int& R, int& C) { const int st = b / 1024, sb = b % 1024, swz = sb ^ (((sb >> 9) & 1) << 5); R = (st >> 1) * 16 + swz / 64; C = (st & 1) * 32 + (swz % 64) / 2; }
__host__ __device__ __forceinline__ int perm32(int rho) { const int n = rho >> 4, i = rho & 15; return 8 * (i >> 2) + 4 * n + (i & 3); }

struct Unit { int arow0, brow0, pm, pn, e, nvalid; const int* alist; const float* ascale; };
typedef int i32x8 __attribute__((ext_vector_type(8)));
typedef int i32x4 __attribute__((ext_vector_type(4)));
template <int Q> struct Frag;
template <> struct Frag<0> { bf16x8 h[2]; };
template <> struct Frag<1> { i32x8 v; };
template <> struct Frag<2> { i32x4 h[2]; };
struct Gemm { const bf16_t* A; const bf16_t* Bt; int K; int scale_w = 0x7f7f7f7f, scale_a = 0x7f7f7f7f; LAS int* tokbuf = nullptr; const int* zero = nullptr; LAS float* sabuf = nullptr; float wscale = 1.f; };

struct DenseOrder {
    int nM, nN, nwg, G, c, pn0 = 0;
    const float* sa = nullptr;
    __device__ void init(int M, int N, int G_, int c_) { nM = M / BM; nN = N / BM; nwg = nM * nN; G = G_; c = c_; }
    __device__ bool next(int i, Unit& u) const {
        const long L = (long)i * G + c; if (L >= nwg) return false;
        int wgid = (int)L; { const int q = nwg / NXCD, r = nwg % NXCD, xcd = wgid % NXCD, off = wgid / NXCD; wgid = (xcd < r ? xcd * (q + 1) : r * (q + 1) + (xcd - r) * q) + off; }
        const int nig = WGM * nN, gid = wgid / nig, fm = gid * WGM, gsz = (nM - fm) < WGM ? (nM - fm) : WGM;
        u.pm = fm + ((wgid % nig) % gsz); u.pn = pn0 + (wgid % nig) / gsz; u.arow0 = u.pm * BM; u.brow0 = u.pn * BM; u.e = 0; u.nvalid = 256; u.alist = nullptr; u.ascale = sa ? sa + u.arow0 : nullptr; return true;
    }
};
struct MoeOrder {
    const LAS int* tpre; const LAS int* cnt; const int* list; int G, vcu, bn; const float* sa = nullptr; int u0 = 0, ulim = 1 << 30;
    __device__ bool next(int i, Unit& u) const {
        const int U = u0 + i * G + vcu, rt = U >> 2, pn = U & 3;
        if (U >= ulim || rt >= tpre[NE]) return false;
        int e = 0;
#pragma unroll
        for (int k = 1; k < NE; ++k) e += (rt >= tpre[k]) ? 1 : 0;
        const int r = rt - tpre[e];
        u.arow0 = rt * BM; u.brow0 = e * bn + pn * BM; u.pm = rt; u.pn = pn; u.e = e; u.nvalid = min(256, cnt[e] - r * 256); u.alist = list ? list + e * LCAP + r * 256 : nullptr; u.ascale = sa ? sa + e * LCAP + r * 256 : nullptr; return true;
    }
};

template <class Epi, class Sched, bool GATHER, bool ALIGN_EPI, bool SP2, int Q = 0>
__device__ __forceinline__ void gemm_phase(LAS unsigned char* lds, const Gemm g, const Sched& S, const Epi& E, const int tid) {
    const int wid = __builtin_amdgcn_readfirstlane(tid >> 6), lane = tid & 63, wr = wid >> 2, wc = wid & 3, fr = lane & 15, fq = lane >> 4;
    const int K = g.K, nt = K / BK;
    unsigned voffA[2], voffB[2];
#pragma unroll
    for (int i = 0; i < 2; ++i) { int R, C; stage_rc(tid * 16 + i * 8192, R, C); const int Rb = Epi::PERM ? ((R & ~31) + perm32(R & 31)) : R;
        voffA[i] = (unsigned)(R * K + C) * 2u; voffB[i] = (unsigned)(Rb * K + C) * 2u; }
    const size_t kstep = (size_t)(BK * 2);
    const size_t hstep = (size_t)HALF * K * 2;
    const unsigned ldsw = (unsigned)wid * 1024u;
    const int aoff = lds_byte(wr * 64 + fr, fq * 8); int boff = 65536 + lds_byte(wc * 32 + fr, fq * 8); asm volatile("" : "+v"(boff));
#define PG8_SA(b, h) (((b) * 2 + (h)) * HTB)
#define PG8_SB(b, h) ((4 + (b) * 2 + (h)) * HTB)
#define PG8_SBR(b, h) (((b) * 2 + (h)) * HTB)
#define PG8_STAGE(bufoff, gbase, voff) do { _Pragma("unroll") for (int _i = 0; _i < 2; ++_i) \
        __builtin_amdgcn_global_load_lds((const unsigned*)((const char*)(gbase) + (voff)[_i]), (LAS unsigned*)(lds + (bufoff) + ldsw + _i * 8192), 16, 0, 0); } while (0)
#define PG8_STAGE_A(bufoff, kb, h, vo) do { if constexpr (GATHER) { PG8_STAGE(bufoff, kb, (vo)[h]); } else { PG8_STAGE(bufoff, (kb) + (h) * hstep, voffA); } } while (0)
#define PG8_LDF(dst, off) do { if constexpr (Q == 1) { const i32x4 lo_ = *(const LAS i32x4*)(lds + (off)), hi_ = *(const LAS i32x4*)(lds + (off) + 1024); (dst).v = __builtin_shufflevector(lo_, hi_, 0, 1, 2, 3, 4, 5, 6, 7); } \
        else if constexpr (Q == 2) { (dst).h[0] = *(const LAS i32x4*)(lds + (off)); (dst).h[1] = *(const LAS i32x4*)(lds + (off) + 1024); } \
        else { (dst).h[0] = *(const LAS bf16x8*)(lds + (off)); (dst).h[1] = *(const LAS bf16x8*)(lds + (off) + 1024); } } while (0)
#define PG8_LDA(dst, b, h) do { _Pragma("unroll") for (int m = 0; m < 4; ++m) PG8_LDF(dst[m], PG8_SA(b, h) + aoff + m * 2048); } while (0)
#define PG8_LDB(dst, b, h) do { _Pragma("unroll") for (int n = 0; n < 2; ++n) PG8_LDF(dst[n], PG8_SBR(b, h) + boff + n * 2048); } while (0)
#define PG8_MMA(ai, bj, At, Bt) do { __builtin_amdgcn_s_setprio(1); _Pragma("unroll") for (int m = 0; m < 4; ++m) _Pragma("unroll") for (int n = 0; n < 2; ++n) { \
        if constexpr (Q == 1) acc[ai][bj][m][n] = __builtin_amdgcn_mfma_scale_f32_16x16x128_f8f6f4(Bt[n].v, At[m].v, acc[ai][bj][m][n], 0, 0, 0, g.scale_w, 0, g.scale_a); \
        else if constexpr (Q == 2) { _Pragma("unroll") for (int k = 0; k < 2; ++k) acc[ai][bj][m][n] = __builtin_bit_cast(f32x4, __builtin_amdgcn_mfma_i32_16x16x64_i8(Bt[n].h[k], At[m].h[k], __builtin_bit_cast(i32x4, acc[ai][bj][m][n]), 0, 0, 0)); } \
        else { _Pragma("unroll") for (int k = 0; k < 2; ++k) acc[ai][bj][m][n] = __builtin_amdgcn_mfma_f32_16x16x32_bf16(Bt[n].h[k], At[m].h[k], acc[ai][bj][m][n], 0, 0, 0); } } \
        __builtin_amdgcn_s_setprio(0); } while (0)
#define PG8_WAIT_V(n) asm volatile("s_waitcnt vmcnt(" #n ")" ::: "memory")
#define PG8_WAIT_L(n) asm volatile("s_waitcnt lgkmcnt(" #n ")" ::: "memory")
#define PG8_BAR __builtin_amdgcn_s_barrier()
#define PG8_SCHED __builtin_amdgcn_sched_barrier(0)
    Unit cur, nxt; int ui = 0;
    if (!S.next(0, cur)) return;
    f32x4 acc[2][2][4][2];
#pragma unroll
    for (int a = 0; a < 2; ++a)
#pragma unroll
        for (int b = 0; b < 2; ++b)
#pragma unroll
            for (int m = 0; m < 4; ++m)
#pragma unroll
                for (int n = 0; n < 2; ++n) acc[a][b][m][n] = (f32x4){0.f, 0.f, 0.f, 0.f};
    Frag<Q> At[4], B0[2], B1[2];
    unsigned vg[2][2];
#define PG8_GATHER(u) do { _Pragma("unroll") for (int _h = 0; _h < 2; ++_h) _Pragma("unroll") for (int _i = 0; _i < 2; ++_i) { int _R, _C; stage_rc(tid * 16 + _i * 8192, _R, _C); \
        const int _r = _h * HALF + _R; int _tok; if (g.tokbuf) _tok = (u).alist[min(_r, (u).nvalid - 1)]; else _tok = (u).arow0 + _r; vg[_h][_i] = (unsigned)(_tok * K + _C) * 2u; } } while (0)
#define PG8_GATHER_LDS(u) do { _Pragma("unroll") for (int _h = 0; _h < 2; ++_h) _Pragma("unroll") for (int _i = 0; _i < 2; ++_i) { int _R, _C; stage_rc(tid * 16 + _i * 8192, _R, _C); \
        const int _r = _h * HALF + _R; const int _tok = (u).alist ? g.tokbuf[_r] : (u).arow0 + _r; vg[_h][_i] = (unsigned)(_tok * K + _C) * 2u; } } while (0)
    const char* cA; const char* cB = (const char*)g.Bt + (size_t)cur.brow0 * K * 2;
    if constexpr (GATHER) { cA = (const char*)g.A; PG8_GATHER(cur); } else { cA = (const char*)g.A + (size_t)cur.arow0 * K * 2;
#pragma unroll
        for (int h = 0; h < 2; ++h)
#pragma unroll
            for (int i = 0; i < 2; ++i) vg[h][i] = 0u; }
    if constexpr (SP2) {
        PG8_STAGE(PG8_SB(0, 0), cB, voffB); PG8_STAGE(PG8_SB(0, 1), cB + hstep, voffB); PG8_STAGE_A(PG8_SA(0, 0), cA, 0, vg); PG8_STAGE_A(PG8_SA(0, 1), cA, 1, vg);
        if (wr == 1) PG8_BAR;
        PG8_WAIT_V(2); PG8_BAR;
        PG8_STAGE(PG8_SB(1, 0), cB + kstep, voffB); PG8_STAGE_A(PG8_SA(1, 0), cA + kstep, 0, vg); PG8_STAGE(PG8_SB(1, 1), cB + hstep + kstep, voffB);
        PG8_WAIT_V(6); PG8_BAR;
    } else {
        PG8_STAGE(PG8_SB(0, 0), cB, voffB); PG8_STAGE_A(PG8_SA(0, 0), cA, 0, vg); PG8_STAGE(PG8_SB(0, 1), cB + hstep, voffB); PG8_STAGE_A(PG8_SA(0, 1), cA, 1, vg);
        if (wr == 1) PG8_BAR;
        PG8_WAIT_V(4); PG8_BAR;
        PG8_STAGE(PG8_SB(1, 0), cB + kstep, voffB); PG8_STAGE_A(PG8_SA(1, 0), cA + kstep, 0, vg); PG8_STAGE(PG8_SB(1, 1), cB + hstep + kstep, voffB);
        PG8_WAIT_V(6); PG8_BAR;
    }
    for (;;) {
        const bool has_next = S.next(ui + 1, nxt);
        if constexpr (GATHER) { if (g.tokbuf && has_next && nxt.alist && wid < 4) {
                const int r_ = wid * 64 + lane; const int* sp_ = (r_ < nxt.nvalid) ? nxt.alist + r_ : g.zero;
                __builtin_amdgcn_global_load_lds((const unsigned*)sp_, (LAS unsigned*)(g.tokbuf + wid * 64), 4, 0, 0); } }
        if constexpr (Q == 2) { if (wid < 4) {
                const int r_ = wid * 64 + lane; const float* sp_ = (r_ < cur.nvalid) ? cur.ascale + r_ : (const float*)g.zero;
                __builtin_amdgcn_global_load_lds((const unsigned*)sp_, (LAS unsigned*)(g.sabuf + (ui & 1) * 256 + wid * 64), 4, 0, 0); } }
        const char* nA; const char* nB = has_next ? (const char*)g.Bt + (size_t)nxt.brow0 * K * 2 : cB;
        if constexpr (GATHER) nA = cA; else nA = has_next ? (const char*)g.A + (size_t)nxt.arow0 * K * 2 : cA;
#pragma unroll 1
        for (int t = 0; t < nt; t += 2) {
            const bool last = (t == nt - 2);
            const char* a1 = cA + (size_t)(t + 1) * kstep;
            const char* a2 = last ? nA : cA + (size_t)(t + 2) * kstep; const char* b2 = last ? nB : cB + (size_t)(t + 2) * kstep;
            const char* a3 = a2 + kstep; const char* b3 = b2 + kstep;
            if constexpr (SP2) {
            PG8_LDB(B0, 0, 0); PG8_LDB(B1, 0, 1); PG8_SCHED; PG8_LDA(At, 0, 0); PG8_STAGE_A(PG8_SA(1, 1), a1, 1, vg);
            if constexpr (GATHER) { if (last && has_next) { if (g.tokbuf) PG8_GATHER_LDS(nxt); else PG8_GATHER(nxt); } }
            PG8_WAIT_V(8); PG8_WAIT_L(0); PG8_BAR; PG8_MMA(0, 0, At, B0); PG8_MMA(0, 1, At, B1); PG8_BAR; PG8_SCHED;
            PG8_LDA(At, 0, 1); PG8_STAGE(PG8_SB(0, 0), b2, voffB); PG8_STAGE(PG8_SB(0, 1), b2 + hstep, voffB); PG8_STAGE_A(PG8_SA(0, 0), a2, 0, vg);
            PG8_WAIT_V(8); PG8_WAIT_L(0); PG8_BAR; PG8_MMA(1, 0, At, B0); PG8_MMA(1, 1, At, B1); PG8_BAR; PG8_SCHED;
            PG8_LDB(B0, 1, 0); PG8_LDB(B1, 1, 1); PG8_SCHED; PG8_LDA(At, 1, 0); PG8_STAGE_A(PG8_SA(0, 1), a2, 1, vg);
            PG8_WAIT_V(8); PG8_WAIT_L(0); PG8_BAR; PG8_MMA(0, 0, At, B0); PG8_MMA(0, 1, At, B1); PG8_BAR; PG8_SCHED;
            PG8_LDA(At, 1, 1); PG8_STAGE(PG8_SB(1, 0), b3, voffB); PG8_STAGE(PG8_SB(1, 1), b3 + hstep, voffB); PG8_STAGE_A(PG8_SA(1, 0), a3, 0, vg);
            PG8_WAIT_V(8); PG8_WAIT_L(0); PG8_BAR; PG8_MMA(1, 0, At, B0); PG8_MMA(1, 1, At, B1); PG8_BAR; PG8_SCHED;
            } else {
            PG8_LDB(B0, 0, 0); PG8_SCHED; PG8_LDA(At, 0, 0); PG8_STAGE_A(PG8_SA(1, 1), a1, 1, vg);
            if constexpr (GATHER) { if (last && has_next) PG8_GATHER(nxt); }
            PG8_WAIT_L(8); PG8_BAR; PG8_WAIT_L(0); PG8_MMA(0, 0, At, B0); PG8_BAR; PG8_SCHED;
            PG8_LDB(B1, 0, 1); PG8_STAGE(PG8_SB(0, 0), b2, voffB);
            PG8_BAR; PG8_WAIT_L(0); PG8_MMA(0, 1, At, B1); PG8_BAR;
            PG8_LDA(At, 0, 1); PG8_STAGE_A(PG8_SA(0, 0), a2, 0, vg);
            PG8_BAR; PG8_WAIT_L(0); PG8_MMA(1, 0, At, B0); PG8_BAR; PG8_SCHED;
            PG8_STAGE(PG8_SB(0, 1), b2 + hstep, voffB);
            PG8_WAIT_V(6); PG8_BAR; PG8_MMA(1, 1, At, B1); PG8_BAR;
            PG8_LDB(B0, 1, 0); PG8_SCHED; PG8_LDA(At, 1, 0); PG8_STAGE_A(PG8_SA(0, 1), a2, 1, vg);
            PG8_WAIT_L(8); PG8_BAR; PG8_WAIT_L(0); PG8_MMA(0, 0, At, B0); PG8_BAR; PG8_SCHED;
            PG8_LDB(B1, 1, 1); PG8_STAGE(PG8_SB(1, 0), b3, voffB);
            PG8_BAR; PG8_WAIT_L(0); PG8_MMA(0, 1, At, B1); PG8_BAR;
            PG8_LDA(At, 1, 1); PG8_STAGE_A(PG8_SA(1, 0), a3, 0, vg);
            PG8_BAR; PG8_WAIT_L(0); PG8_MMA(1, 0, At, B0); PG8_BAR; PG8_SCHED;
            PG8_STAGE(PG8_SB(1, 1), b3 + hstep, voffB);
            PG8_WAIT_V(6); PG8_BAR; PG8_MMA(1, 1, At, B1); PG8_BAR;
            }
        }
        if constexpr (ALIGN_EPI) { if (wr == 0) PG8_BAR; }
        if constexpr (Q == 2) {
            const LAS float* sb_ = g.sabuf + (ui & 1) * 256 + wr * 64 + fr;
#pragma unroll
            for (int a = 0; a < 2; ++a)
#pragma unroll
                for (int m = 0; m < 4; ++m) { const float rs_ = sb_[a * 128 + m * 16] * g.wscale;
#pragma unroll
                    for (int b = 0; b < 2; ++b)
#pragma unroll
                        for (int n = 0; n < 2; ++n) { const i32x4 iv_ = __builtin_bit_cast(i32x4, acc[a][b][m][n]); acc[a][b][m][n] = __builtin_convertvector(iv_, f32x4) * rs_; } }
        }
        E(acc, cur, wr, wc, fr, fq);
        if (!has_next) break;
#pragma unroll
        for (int a = 0; a < 2; ++a)
#pragma unroll
            for (int b = 0; b < 2; ++b)
#pragma unroll
                for (int m = 0; m < 4; ++m)
#pragma unroll
                    for (int n = 0; n < 2; ++n) acc[a][b][m][n] = (f32x4){0.f, 0.f, 0.f, 0.f};
        cur = nxt; cA = nA; cB = nB; ++ui;
        if constexpr (ALIGN_EPI) { if (wr == 1) PG8_BAR; }
    }
    PG8_WAIT_V(0);
    if constexpr (!ALIGN_EPI) { if (wr == 0) PG8_BAR; }
    PG8_BAR;
#undef PG8_SA
#undef PG8_SB
#undef PG8_SBR
#undef PG8_STAGE
#undef PG8_STAGE_A
#undef PG8_GATHER
#undef PG8_GATHER_LDS
#undef PG8_LDF
#undef PG8_LDA
#undef PG8_LDB
#undef PG8_MMA
#undef PG8_WAIT_V
#undef PG8_WAIT_L
#undef PG8_BAR
#undef PG8_SCHED
}


struct EpiM1 {
    static constexpr bool PERM = true;
    bf16_t* Q; bf16_t* Kn; bf16_t* KT; bf16_t* VT; bf16_t* OGS; LAS unsigned char* tlds;
    __device__ __forceinline__ void operator()(const f32x4 (&acc)[2][2][4][2], const Unit& u, int wr, int wc, int fr, int fq) const {
        const int row0 = u.arow0 + wr * 64 + fr, pn = u.pn;
        if (pn < 4 || pn >= 8) {
            bf16_t* base; int ldc, colt; float sc = 1.f; const bool sig = pn >= 8;
            if (pn < 2) { base = Q; ldc = MQK; colt = pn * 256; sc = 0.08838834764831845f; }
            else if (pn < 4) { base = Kn; ldc = MQK; colt = (pn - 2) * 256; }
            else { base = OGS; ldc = MV; colt = (pn - 8) * 256; }
            const int col0 = colt + wc * 32 + 8 * fq;
#pragma unroll
            for (int ai = 0; ai < 2; ++ai)
#pragma unroll
                for (int m = 0; m < 4; ++m) { bf16_t* rowp = base + (size_t)(row0 + ai * HALF + m * 16) * ldc + col0;
#pragma unroll
                    for (int bj = 0; bj < 2; ++bj) { f32x4 v0 = acc[ai][bj][m][0] * sc, v1 = acc[ai][bj][m][1] * sc;
                        if (sig) {
#pragma unroll
                            for (int j = 0; j < 4; ++j) { v0[j] = sigmoidf_(v0[j]); v1[j] = sigmoidf_(v1[j]); } }
                        u32x4 w; w.x = cvt_pk_bf16(v0[0], v0[1]); w.y = cvt_pk_bf16(v0[2], v0[3]); w.z = cvt_pk_bf16(v1[0], v1[1]); w.w = cvt_pk_bf16(v1[2], v1[3]);
                        __builtin_nontemporal_store(w, (u32x4*)(rowp + bj * HALF)); } }
        }
        if (pn >= 2 && pn < 8) {
            const int b = u.arow0 / SEQ, s0 = (u.arow0 % SEQ) + wr * 64;
            bf16_t* base; int colt, feat;
            if (pn < 4) { base = KT; colt = (pn - 2) * 256; feat = DK; } else { base = VT; colt = (pn - 4) * 256; feat = DV; }
            LAS unsigned char* tb = tlds + (wr * 4 + wc) * 2048;
            const int lane = fq * 16 + fr;
#pragma unroll
            for (int ai = 0; ai < 2; ++ai) {
                const int ch = (s0 + ai * HALF) >> 6;
#pragma unroll
                for (int bj = 0; bj < 2; ++bj) {
                    const int col = colt + bj * HALF + wc * 32, hd = col / feat, f0 = col % feat;
                    bf16_t* xb = base + ((((size_t)(b * NH + hd) * NCH + ch) * feat + f0) << 6);
#pragma unroll
                    for (int n = 0; n < 2; ++n) {
#pragma unroll
                        for (int m = 0; m < 4; ++m)
#pragma unroll
                            for (int j = 0; j < 4; ++j) { const int t = m * 16 + fr;
                                *(LAS bf16_t*)(tb + (4 * fq + j) * 128 + ((((t >> 3) ^ (2 * fq)) & 7) << 4) + (t & 7) * 2) = (bf16_t)f2bf(acc[ai][bj][m][n][j]); }
#pragma unroll
                        for (int q = 0; q < 2; ++q) { const int id = lane + 64 * q, cr = id >> 3, p = id & 7, tc = (p ^ (2 * (cr >> 2))) & 7;
                            const u32x4 v = *(const LAS u32x4*)(tb + id * 16);
                            *(u32x4*)(xb + (size_t)(8 * (cr >> 2) + 4 * n + (cr & 3)) * 64 + tc * 8) = v; }
                    }
                }
            }
        }
    }
};
template <bool BASE_F32> struct EpiRes {
    static constexpr bool PERM = true;
    const void* base; bf16_t* out; const float* gate; float mul;
    __device__ __forceinline__ void operator()(const f32x4 (&acc)[2][2][4][2], const Unit& u, int wr, int wc, int fr, int fq) const {
        const int row0 = u.arow0 + wr * 64 + fr, col0 = u.pn * BM + wc * 32 + 8 * fq, b = u.arow0 / SEQ;
        f32x4 gv[2][2];
#pragma unroll
        for (int bj = 0; bj < 2; ++bj)
#pragma unroll
            for (int n = 0; n < 2; ++n) gv[bj][n] = *(const f32x4*)(gate + (size_t)b * 6 * D + col0 + bj * HALF + n * 4);
        if (BASE_F32) {
#pragma unroll
            for (int ai = 0; ai < 2; ++ai) {
                f32x4 bf[4][2][2];
#pragma unroll
                for (int m = 0; m < 4; ++m)
#pragma unroll
                    for (int bj = 0; bj < 2; ++bj) { const float* p = (const float*)base + (size_t)(row0 + ai * HALF + m * 16) * D + col0 + bj * HALF; bf[m][bj][0] = __builtin_nontemporal_load((const f32x4*)p); bf[m][bj][1] = __builtin_nontemporal_load((const f32x4*)(p + 4)); }
                asm volatile("" ::: "memory");
#pragma unroll
                for (int m = 0; m < 4; ++m)
#pragma unroll
                    for (int bj = 0; bj < 2; ++bj) { const f32x4 a0 = bf[m][bj][0] + (gv[bj][0] * mul) * acc[ai][bj][m][0], a1 = bf[m][bj][1] + (gv[bj][1] * mul) * acc[ai][bj][m][1]; u32x4 w;
                        w.x = cvt_pk_bf16(a0[0], a0[1]); w.y = cvt_pk_bf16(a0[2], a0[3]); w.z = cvt_pk_bf16(a1[0], a1[1]); w.w = cvt_pk_bf16(a1[2], a1[3]);
                        *(u32x4*)(out + (size_t)(row0 + ai * HALF + m * 16) * D + col0 + bj * HALF) = w; }
                asm volatile("" ::: "memory");
            }
        } else {
            u32x4 bw[2][4][2];
#pragma unroll
            for (int ai = 0; ai < 2; ++ai)
#pragma unroll
                for (int m = 0; m < 4; ++m)
#pragma unroll
                    for (int bj = 0; bj < 2; ++bj) bw[ai][m][bj] = *(const u32x4*)((const bf16_t*)base + (size_t)(row0 + ai * HALF + m * 16) * D + col0 + bj * HALF);
            asm volatile("" ::: "memory");
#pragma unroll
            for (int ai = 0; ai < 2; ++ai)
#pragma unroll
                for (int m = 0; m < 4; ++m)
#pragma unroll
                    for (int bj = 0; bj < 2; ++bj) { const u32x4 a = bw[ai][m][bj]; const f32x4 c0 = (gv[bj][0] * mul) * acc[ai][bj][m][0], c1 = (gv[bj][1] * mul) * acc[ai][bj][m][1]; u32x4 w;
                        w.x = cvt_pk_bf16(bflo(a.x) + c0[0], bfhi(a.x) + c0[1]); w.y = cvt_pk_bf16(bflo(a.y) + c0[2], bfhi(a.y) + c0[3]);
                        w.z = cvt_pk_bf16(bflo(a.z) + c1[0], bfhi(a.z) + c1[1]); w.w = cvt_pk_bf16(bflo(a.w) + c1[2], bfhi(a.w) + c1[3]);
                        *(u32x4*)(out + (size_t)(row0 + ai * HALF + m * 16) * D + col0 + bj * HALF) = w; }
        }
    }
};
struct EpiBf {
    static constexpr bool PERM = true;
    bf16_t* O; int ldc; float f8scale = 0.f;
    __device__ __forceinline__ void operator()(const f32x4 (&acc)[2][2][4][2], const Unit& u, int wr, int wc, int fr, int fq) const {
        const int row0 = u.arow0 + wr * 64 + fr, col0 = u.pn * BM + wc * 32 + 8 * fq;
        if (f8scale != 0.f) {
#pragma unroll
            for (int ai = 0; ai < 2; ++ai)
#pragma unroll
                for (int m = 0; m < 4; ++m) { unsigned char* rowp = (unsigned char*)O + (size_t)(row0 + ai * HALF + m * 16) * ldc + col0;
#pragma unroll
                    for (int bj = 0; bj < 2; ++bj) { const f32x4 v0 = acc[ai][bj][m][0] * f8scale, v1 = acc[ai][bj][m][1] * f8scale;
                        u32x2 w8; w8.x = pk4_fp8_sat(v0[0], v0[1], v0[2], v0[3]); w8.y = pk4_fp8_sat(v1[0], v1[1], v1[2], v1[3]);
                        *(u32x2*)(rowp + bj * HALF) = w8; } }
            return;
        }
#pragma unroll
        for (int ai = 0; ai < 2; ++ai)
#pragma unroll
            for (int m = 0; m < 4; ++m) { bf16_t* rowp = O + (size_t)(row0 + ai * HALF + m * 16) * ldc + col0;
#pragma unroll
                for (int bj = 0; bj < 2; ++bj) { const f32x4 v0 = acc[ai][bj][m][0], v1 = acc[ai][bj][m][1];
                    u32x4 w; w.x = cvt_pk_bf16(v0[0], v0[1]); w.y = cvt_pk_bf16(v0[2], v0[3]); w.z = cvt_pk_bf16(v1[0], v1[1]); w.w = cvt_pk_bf16(v1[2], v1[3]);
                    *(u32x4*)(rowp + bj * HALF) = w; } }
    }
};
template <bool SILU, bool F8OUT = false> struct EpiGlu {
    static constexpr bool PERM = true;
    bf16_t* O; int ldc; int plain_tiles; bf16_t* P; int ldp; float f8scale;
    __device__ __forceinline__ void operator()(const f32x4 (&acc)[2][2][4][2], const Unit& u, int wr, int wc, int fr, int fq) const {
        const int row0 = u.arow0 + wr * 64 + fr;
        if (u.pn < plain_tiles) {
            const int col0 = u.pn * BM + wc * 32 + 8 * fq;
#pragma unroll
            for (int ai = 0; ai < 2; ++ai)
#pragma unroll
                for (int m = 0; m < 4; ++m) { bf16_t* rowp = P + (size_t)(row0 + ai * HALF + m * 16) * ldp + col0;
#pragma unroll
                    for (int bj = 0; bj < 2; ++bj) { const f32x4 v0 = acc[ai][bj][m][0], v1 = acc[ai][bj][m][1];
                        if constexpr (F8OUT) { const f32x4 s0 = v0 * f8scale, s1 = v1 * f8scale; u32x2 w8; w8.x = pk4_fp8_sat(s0[0], s0[1], s0[2], s0[3]); w8.y = pk4_fp8_sat(s1[0], s1[1], s1[2], s1[3]);
                            *(u32x2*)((unsigned char*)P + (size_t)(row0 + ai * HALF + m * 16) * ldp + col0 + bj * HALF) = w8; continue; }
                        u32x4 w; w.x = cvt_pk_bf16(v0[0], v0[1]); w.y = cvt_pk_bf16(v0[2], v0[3]); w.z = cvt_pk_bf16(v1[0], v1[1]); w.w = cvt_pk_bf16(v1[2], v1[3]);
                        *(u32x4*)(rowp + bj * HALF) = w; } }
            return;
        }
        const int col0 = (u.pn - plain_tiles) * HALF + wc * 32 + 8 * fq;
#pragma unroll
        for (int ai = 0; ai < 2; ++ai)
#pragma unroll
            for (int m = 0; m < 4; ++m) { bf16_t* rowp = O + (size_t)(row0 + ai * HALF + m * 16) * ldc + col0;
                f32x4 v0 = acc[ai][0][m][0], v1 = acc[ai][0][m][1]; const f32x4 u0 = acc[ai][1][m][0], u1 = acc[ai][1][m][1];
                if (SILU) {
#pragma unroll
                    for (int j = 0; j < 4; ++j) { v0[j] = v0[j] * sigmoidf_(v0[j]); v1[j] = v1[j] * sigmoidf_(v1[j]); } }
                v0 = v0 * u0; v1 = v1 * u1;
                if constexpr (F8OUT) { v0 = v0 * f8scale; v1 = v1 * f8scale; u32x2 w8; w8.x = pk4_fp8_sat(v0[0], v0[1], v0[2], v0[3]); w8.y = pk4_fp8_sat(v1[0], v1[1], v1[2], v1[3]);
                    *(u32x2*)((unsigned char*)O + (size_t)(row0 + ai * HALF + m * 16) * ldc + col0) = w8; }
                else { u32x4 w; w.x = cvt_pk_bf16(v0[0], v0[1]); w.y = cvt_pk_bf16(v0[2], v0[3]); w.z = cvt_pk_bf16(v1[0], v1[1]); w.w = cvt_pk_bf16(v1[2], v1[3]);
                    *(u32x4*)rowp = w; } }
    }
};
}

#define XB_TMO      128
#define XB_XCNT(j)  (256  + 64 * (j))
#define XB_XSUB(j)  (1280 + 64 * (j))
#define XB_XGEN(j)  (2304 + 64 * (j))
#define XB_TOP      3328
#define XB_TOPGEN   3392
#define XCD_BAR_WORDS 3456
#define XB_SPIN_CAP (1u << 18)
__device__ __forceinline__ unsigned xb_ld(unsigned* p)              { return __hip_atomic_load(p, __ATOMIC_RELAXED, __HIP_MEMORY_SCOPE_AGENT); }
__device__ __forceinline__ unsigned xb_add(unsigned* p, unsigned v) { return __hip_atomic_fetch_add(p, v, __ATOMIC_RELAXED, __HIP_MEMORY_SCOPE_AGENT); }
__device__ __forceinline__ unsigned xb_xcc_id() { return (unsigned)__builtin_amdgcn_s_getreg((3 << 11) | 20) & 0xFu; }
#define XB_SPIN(cond, bar) do { unsigned _sp = 0; while (cond) { __builtin_amdgcn_s_sleep(1); \
    if ((++_sp & 255u) == 0u) { if (xb_ld(&(bar)[XB_TMO])) break; if (_sp > XB_SPIN_CAP) { atomicAdd(&(bar)[XB_TMO], 1u); break; } } } } while (0)
struct XcdBarrier { unsigned* bar; unsigned x; volatile LAS unsigned* st; };
__device__ __forceinline__ XcdBarrier xcd_barrier_post(unsigned* bar, volatile LAS unsigned* st) {
    XcdBarrier b; b.bar = bar; b.x = xb_xcc_id(); b.st = st;
    if (threadIdx.x == 0) (void)xb_add(&bar[XB_XCNT(b.x)], 1u);
    return b;
}
__device__ __forceinline__ void xcd_barrier_complete(unsigned* bar, unsigned x, unsigned& nloc, unsigned& nx) {
    const unsigned G = gridDim.x * gridDim.y * gridDim.z;
    unsigned sum, cnt, mine, sp = 0u;
    for (;;) {
        sum = 0u; cnt = 0u; mine = 0u;
#pragma unroll
        for (unsigned j = 0; j < 16; ++j) { const unsigned c = xb_ld(&bar[XB_XCNT(j)]); sum += c; cnt += (c > 0u) ? (1u + (256u << j)) : 0u; mine = (j == x) ? c : mine; }
        if (sum == G) break;
        __builtin_amdgcn_s_sleep(1);
        if ((++sp & 255u) == 0u) { if (xb_ld(&bar[XB_TMO])) break; if (sp > XB_SPIN_CAP) { atomicAdd(&bar[XB_TMO], 1u); break; } }
    }
    nloc = mine > 0u ? mine : 1u; nx = (cnt & 255u) > 0u ? cnt : (1u + (256u << x));
}
__device__ __forceinline__ void xcd_barrier(const XcdBarrier& b) {
    asm volatile("s_waitcnt vmcnt(0)" ::: "memory");
    __syncthreads();
    if (threadIdx.x == 0) {
        unsigned* bar = b.bar;
        __builtin_amdgcn_s_waitcnt(0);
        unsigned nloc = b.st[0], nx = b.st[1];
        if (nloc == 0u) { xcd_barrier_complete(bar, b.x, nloc, nx); b.st[0] = nloc; b.st[1] = nx; }
#if EARLY_WB
        __builtin_amdgcn_fence(__ATOMIC_RELEASE, "agent");
        asm volatile("s_waitcnt vmcnt(0)" ::: "memory");
#endif
        const unsigned old = xb_add(&bar[XB_XSUB(b.x)], 1u);
        const unsigned gen = old / nloc;
        if (old + 1u == (gen + 1u) * nloc) {
#if !EARLY_WB
            __builtin_amdgcn_fence(__ATOMIC_RELEASE, "agent");
            asm volatile("s_waitcnt vmcnt(0)" ::: "memory");
#endif
            const unsigned og = xb_add(&bar[XB_TOP], 1u);
            const unsigned nxc = nx & 255u;
            const unsigned tg = og / nxc;
#if EARLY_INV
            asm volatile("buffer_inv sc1" ::: "memory");
#endif
#if DIRECT_REL
            if (og + 1u == (tg + 1u) * nxc) { for (unsigned m = nx >> 8; m; m &= m - 1u) xb_add(&bar[XB_XGEN(__builtin_ctz(m))], 1u); }
            else XB_SPIN(xb_ld(&bar[XB_XGEN(b.x)]) == gen, bar);
            asm volatile("s_waitcnt vmcnt(0)" ::: "memory");
#else
            if (og + 1u == (tg + 1u) * nxc) xb_add(&bar[XB_TOPGEN], 1u);
            else XB_SPIN(xb_ld(&bar[XB_TOPGEN]) == tg, bar);
#if EARLY_INV
            asm volatile("s_waitcnt vmcnt(0)" ::: "memory");
#else
            __builtin_amdgcn_fence(__ATOMIC_ACQUIRE, "agent");
#endif
            xb_add(&bar[XB_XGEN(b.x)], 1u);
            asm volatile("s_waitcnt vmcnt(0)" ::: "memory");
#endif
        } else {
#if EARLY_INV
#if FIRST_WB
            if (old == gen * nloc) asm volatile("buffer_wbl2 sc1" ::: "memory");
#endif
            asm volatile("buffer_inv sc1" ::: "memory");
            XB_SPIN(xb_ld(&bar[XB_XGEN(b.x)]) == gen, bar);
#else
            XB_SPIN(xb_ld(&bar[XB_XGEN(b.x)]) == gen, bar);
            __builtin_amdgcn_fence(__ATOMIC_ACQUIRE, "agent");
#endif
            asm volatile("s_waitcnt vmcnt(0)" ::: "memory");
        }
    }
    __syncthreads();
}

struct Args { const float* in[20]; float* out; unsigned char* ws; int ph_lo, ph_hi; };
__device__ __forceinline__ const void* karg_ptr(int idx) {
    unsigned long long v = (unsigned long long)((const void* const __attribute__((address_space(4)))*)__builtin_amdgcn_kernarg_segment_ptr())[idx];
    asm volatile("" : "+s"(v)); return (const void*)(const GAS char*)v;
}
struct InProxy { __device__ __forceinline__ const float* operator[](int i) const { return (const float*)karg_ptr(i); } };
struct WsProxy { __device__ __forceinline__ operator unsigned char*() const { return (unsigned char*)karg_ptr(21); }
                 __device__ __forceinline__ unsigned char* operator+(size_t o) const { return (unsigned char*)karg_ptr(21) + o; } };
struct OutProxy { __device__ __forceinline__ operator float*() const { return (float*)karg_ptr(20); }
                  __device__ __forceinline__ float* operator+(size_t o) const { return (float*)karg_ptr(20) + o; } };
struct CtlProxy { __device__ __forceinline__ operator gu32*() const { return (gu32*)karg_ptr(21); }
                  __device__ __forceinline__ gu32* operator+(int o) const { return (gu32*)karg_ptr(21) + o; } };
struct Frame {
    LAS unsigned char* lds; volatile LAS unsigned* MISC; CtlProxy ctl;
    int tid, lane, wave, vcu, G, bx;
    InProxy in; OutProxy out; WsProxy ws;
};
enum { I_X = 0, I_C, I_N1G, I_N2G, I_WADA, I_BADA, I_MWIN, I_MBG, I_MNG, I_MWOUT, I_CWIN, I_CCW, I_CCB, I_CWOUT, I_WR, I_BR, I_EWG, I_EWU, I_EWD, I_FG };

template <int CTRL> __device__ __forceinline__ float dpp_f(float v) { return __builtin_bit_cast(float, __builtin_amdgcn_update_dpp(0, __builtin_bit_cast(int, v), CTRL, 0xf, 0xf, true)); }
__device__ __forceinline__ float lane_f(float v, int l) { return __builtin_bit_cast(float, __builtin_amdgcn_readlane(__builtin_bit_cast(int, v), l)); }
__device__ __forceinline__ float wave_sum(float v) {
    v += dpp_f<0xB1>(v); v += dpp_f<0x4E>(v); v += dpp_f<0x141>(v); v += dpp_f<0x140>(v);
    return (lane_f(v, 0) + lane_f(v, 16)) + (lane_f(v, 32) + lane_f(v, 48));
}
__device__ __forceinline__ float wave_max(float v) {
    v = fmaxf(v, dpp_f<0xB1>(v)); v = fmaxf(v, dpp_f<0x4E>(v)); v = fmaxf(v, dpp_f<0x141>(v)); v = fmaxf(v, dpp_f<0x140>(v));
    return fmaxf(fmaxf(lane_f(v, 0), lane_f(v, 16)), fmaxf(lane_f(v, 32), lane_f(v, 48)));
}

__device__ __forceinline__ int glu_row(int n, int which) { return (n >> 7) * 256 + which * 128 + (n & 127); }
struct CvtItem { const float* src; bf16_t* dst; int ldw, K; float f8scale; bool i8; bool far; };
constexpr int CVT_IN = 16 * 96, CVT_OUT = 16 * 32, CVT_G = NE * 16 * 16, CVT_D = NE * 8 * 32, CVT_ITEMS = CVT_IN + CVT_OUT + 2 * CVT_G + CVT_D;
__device__ __forceinline__ CvtItem cvt_decode(Frame& F, int L, int it) {
    const size_t lo_ = (L == 0) ? 0 : WS_WL1;
    CvtItem d; d.f8scale = 0.f; d.i8 = false; d.far = (it >= CVT_IN); int r = it;
    if (r < CVT_IN) { const int kb = r / 96, nb = r % 96, n0 = nb * 32; d.K = D;
        if (L == 0) { d.src = F.in[I_MWIN] + (size_t)kb * 64 * MPROJ + n0; d.ldw = MPROJ;
            if (I8_G1) { d.dst = (bf16_t*)((unsigned char*)(F.ws + lo_ + WS_W0) + (size_t)n0 * D + kb * 64); d.f8scale = W8_Q; d.i8 = true; }
            else if (FP8_G1 == 1 || (FP8_G1 == 2 && n0 >= 1024)) { d.dst = (bf16_t*)((unsigned char*)(F.ws + lo_ + WS_W0) + (FP8_G1 == 2 ? 2 * MiB : 0) + (size_t)n0 * D + kb * 64); d.f8scale = 32.f; } else d.dst = (bf16_t*)(F.ws + lo_ + WS_W0) + (size_t)n0 * D + kb * 64; }
        else { int dr; if (n0 < D) dr = n0; else if (n0 < 2 * D) dr = D + glu_row(n0 - D, 0); else dr = D + glu_row(n0 - 2 * D, 1);
            d.src = F.in[I_CWIN] + (size_t)kb * 64 * 3 * D + n0; d.ldw = 3 * D;
            if (I8_CIN) { d.dst = (bf16_t*)((unsigned char*)(F.ws + lo_ + WS_W0) + (size_t)dr * D + kb * 64); d.f8scale = W8_Q; d.i8 = true; }
            else if (FP8_CIN) { d.dst = (bf16_t*)((unsigned char*)(F.ws + lo_ + WS_W0) + (size_t)dr * D + kb * 64); d.f8scale = 32.f; } else d.dst = (bf16_t*)(F.ws + lo_ + WS_W0) + (size_t)dr * D + kb * 64; }
        return d; } r -= CVT_IN;
    if (r < CVT_OUT) { const int kb = r / 32, nb = r % 32; d.K = D; d.ldw = D; d.src = (L == 0 ? F.in[I_MWOUT] : F.in[I_CWOUT]) + (size_t)kb * 64 * D + nb * 32;
        if ((L == 1 && FP8_COUT) || (L == 0 && FP8_MOUT)) { d.dst = (bf16_t*)((unsigned char*)(F.ws + lo_ + WS_W1) + (size_t)nb * 32 * D + kb * 64); d.f8scale = 32.f; } else d.dst = (bf16_t*)(F.ws + lo_ + WS_W1) + (size_t)nb * 32 * D + kb * 64; return d; } r -= CVT_OUT;
    if (r < 2 * CVT_G) { const int which = r / CVT_G; r %= CVT_G; const int e = r / 256, kb = (r % 256) / 16, nb = r % 16, n0 = nb * 32; d.K = D; d.ldw = DE;
        d.src = (which == 0 ? F.in[I_EWG] : F.in[I_EWU]) + ((size_t)L * NE + e) * D * DE + (size_t)kb * 64 * DE + n0;
        d.dst = (bf16_t*)((unsigned char*)(F.ws + lo_ + WS_WUP) + (size_t)e * 1024 * D + (size_t)glu_row(n0, which) * D + kb * 64); d.f8scale = I8_UP ? W8_Q : 32.f; d.i8 = I8_UP; return d; } r -= 2 * CVT_G;
    { const int e = r / 256, kb = (r % 256) / 32, nb = r % 32; d.K = DE; d.ldw = D;
      d.src = F.in[I_EWD] + ((size_t)L * NE + e) * DE * D + (size_t)kb * 64 * D + nb * 32;
      d.dst = (bf16_t*)((unsigned char*)(F.ws + lo_ + WS_WDN) + (size_t)e * D * DE + (size_t)nb * 32 * DE + kb * 64); d.f8scale = 16.f; }
    return d;
}
__device__ __forceinline__ void convert_weights(Frame& F, int L) {
    LAS float* scr = (LAS float*)(F.lds + F.wave * 16384);
    const int gw = F.vcu * NWAVES + F.wave, NGW = F.G * NWAVES, lane = F.lane;
    float ld[32];
    CvtItem cur, nxt;
    int it = gw;
    if (it < CVT_ITEMS) { cur = cvt_decode(F, L, it);
#pragma unroll
        for (int i = 0; i < 32; ++i) ld[i] = __builtin_nontemporal_load(cur.src + (size_t)(2 * i + (lane >> 5)) * cur.ldw + (lane & 31)); }
    for (; it < CVT_ITEMS; it += NGW) {
#pragma unroll
        for (int i = 0; i < 32; ++i) scr[(2 * i + (lane >> 5)) * 33 + (lane & 31)] = ld[i];
        const bool more = it + NGW < CVT_ITEMS;
        if (more) { nxt = cvt_decode(F, L, it + NGW);
#pragma unroll
            for (int i = 0; i < 32; ++i) ld[i] = __builtin_nontemporal_load(nxt.src + (size_t)(2 * i + (lane >> 5)) * nxt.ldw + (lane & 31)); }
        LDS_WAIT(); asm volatile("" ::: "memory");
        const int c = lane & 7;
#pragma unroll
        for (int j = 0; j < 4; ++j) { const int n = (lane >> 3) + 8 * j; const LAS float* s = scr + (8 * c) * 33 + n;
            if (cur.f8scale != 0.f) { const float f = cur.f8scale; u32x2 o8;
                if (cur.i8) { o8.x = pk4_i8c(s[0 * 33] * f, s[1 * 33] * f, s[2 * 33] * f, s[3 * 33] * f); o8.y = pk4_i8c(s[4 * 33] * f, s[5 * 33] * f, s[6 * 33] * f, s[7 * 33] * f); }
                else { o8.x = pk4_fp8(s[0 * 33] * f, s[1 * 33] * f, s[2 * 33] * f, s[3 * 33] * f); o8.y = pk4_fp8(s[4 * 33] * f, s[5 * 33] * f, s[6 * 33] * f, s[7 * 33] * f); }
                if (cur.far) __builtin_nontemporal_store(o8, (GAS u32x2*)((unsigned char*)cur.dst + (size_t)n * cur.K + 8 * c)); else *(GAS u32x2*)((unsigned char*)cur.dst + (size_t)n * cur.K + 8 * c) = o8; }
            else { u32x4 o; o.x = pk2(s[0 * 33], s[1 * 33]); o.y = pk2(s[2 * 33], s[3 * 33]); o.z = pk2(s[4 * 33], s[5 * 33]); o.w = pk2(s[6 * 33], s[7 * 33]);
                *(GAS u32x4*)(cur.dst + (size_t)n * cur.K + 8 * c) = o; } }
        LDS_WAIT(); asm volatile("" ::: "memory");
        cur = nxt;
    }
}

__device__ __forceinline__ void phase_prologue(Frame& F) {
    float* MOD = (float*)(F.ws + WS_MOD);
    LAS float* cond = (LAS float*)(F.lds + 0);
    LAS float* red = (LAS float*)(F.lds + 16384);
    bool did = false; int ndone = 0;
    for (int task = F.bx; task < 192; task += F.G) {
        if (did) __syncthreads();
        did = true;
        const int layer = task / 96, cg = F.lane & 15, rg = F.lane >> 4;
        const float* W = F.in[I_WADA] + (size_t)layer * D * 6 * D + (task % 96) * 64 + 4 * cg + (size_t)(F.wave * 128 + rg) * 6 * D;
        float cv[NB * D / NTHR]; f32x4 wv[32]; float bias_ = 0.f;
#pragma unroll
        for (int q = 0; q < NB * D / NTHR; ++q) cv[q] = F.in[I_C][F.tid + q * NTHR];
#pragma unroll
        for (int i = 0; i < 32; ++i) wv[i] = __builtin_nontemporal_load((const f32x4*)(W + (size_t)(i * 4) * 6 * D));
        if (F.tid < 256) bias_ = F.in[I_BADA][(size_t)layer * 6 * D + (task % 96) * 64 + (F.tid & 63)];
#pragma unroll
        for (int q = 0; q < NB * D / NTHR; ++q) { const int i = F.tid + q * NTHR, b = i / D, k = i % D; const float c = cv[q]; cond[k * 4 + b] = c * sigmoidf_(c); }
        __syncthreads();
        f32x4 ab[4];
#pragma unroll
        for (int bb = 0; bb < 4; ++bb) ab[bb] = (f32x4){0.f, 0.f, 0.f, 0.f};
#pragma unroll
        for (int i = 0; i < 32; ++i) { const f32x4 c4 = *(const LAS f32x4*)(cond + (F.wave * 128 + i * 4 + rg) * 4);
#pragma unroll
            for (int bb = 0; bb < 4; ++bb) ab[bb] = ab[bb] + wv[i] * c4[bb]; }
#pragma unroll
        for (int bb = 0; bb < 4; ++bb)
#pragma unroll
            for (int c = 0; c < 4; ++c) { float v = ab[bb][c]; v += __shfl_xor(v, 16); v += __shfl_xor(v, 32); ab[bb][c] = v; }
        if (rg == 0) {
#pragma unroll
            for (int bb = 0; bb < 4; ++bb) *(LAS f32x4*)(red + (F.wave * 4 + bb) * 64 + 4 * cg) = ab[bb]; }
        __syncthreads();
        if (F.tid < 256) { const int b = F.tid >> 6, l = F.tid & 63; float s = 0.f;
#pragma unroll
            for (int w = 0; w < 8; ++w) s += red[(w * 4 + b) * 64 + l];
            const int c = (task % 96) * 64 + l;
#if ADA_FLAG
            __hip_atomic_store(&MOD[((size_t)layer * NB + b) * 6 * D + c], s + bias_, __ATOMIC_RELAXED, __HIP_MEMORY_SCOPE_AGENT); }
        ++ndone;
#else
            MOD[((size_t)layer * NB + b) * 6 * D + c] = s + bias_; }
#endif
    }
#if ADA_FLAG
    asm volatile("s_waitcnt vmcnt(0)" ::: "memory");
    __syncthreads();
    if (ndone && F.tid == 0) (void)__hip_atomic_fetch_add(F.ctl + CW_ADA, (unsigned)ndone, RLX_AGENT);
#else
    __syncthreads();
#endif
#ifdef P0_SPLIT
    if (blockIdx.x == 0 && threadIdx.x == 0) ((unsigned long long*)karg_ptr(21))[4096 + 18] = __builtin_amdgcn_s_memrealtime();
#endif
    convert_weights(F, 0);
}

template <int N>
__device__ __forceinline__ void xreduce(float (&v)[N], int lane) {
    constexpr int STEPS = (N == 32) ? 5 : 4;
#pragma unroll
    for (int i = 0; i < N / 2; ++i) { const auto r = __builtin_amdgcn_permlane32_swap(__builtin_bit_cast(unsigned, v[i]), __builtin_bit_cast(unsigned, v[i + N / 2]), false, false);
        const unsigned r0_ = r[0], r1_ = r[1]; v[i] = __uint_as_float(r0_) + __uint_as_float(r1_); }
#pragma unroll
    for (int i = 0; i < N / 4; ++i) { const auto r = __builtin_amdgcn_permlane16_swap(__builtin_bit_cast(unsigned, v[i]), __builtin_bit_cast(unsigned, v[i + N / 4]), false, false);
        const unsigned r0_ = r[0], r1_ = r[1]; v[i] = __uint_as_float(r0_) + __uint_as_float(r1_); }
#pragma unroll
    for (int step = 2; step < STEPS; ++step) {
        const int M = 32 >> step, n = N >> step;
        const bool up = (lane & M) != 0;
#pragma unroll
        for (int i = 0; i < n / 2; ++i) { float a = v[i], b = v[i + n / 2]; asm volatile("" : "+v"(a), "+v"(b));
            const float send = up ? a : b, keep = up ? b : a; v[i] = keep + __shfl_xor(send, M); }
    }
    if (N == 16) v[0] += __shfl_xor(v[0], 2);
    v[0] += __shfl_xor(v[0], 1);
}

constexpr int RP_WL = 0, RP_WTS = 2064, RP_WHI = 0, RP_WLO = 16 * RP_WTS, RP_CVEC = 66048, RP_LG = 66560, RP_RINFO = 75776, RP_LCNT = RP_RINFO + 128 * 8 * 4, RP_TPRE = RP_LCNT + 256;
#ifndef ROUTER_MFMA
#define ROUTER_MFMA 1
#endif
template <int MODE>
__device__ __forceinline__ void row_pass(Frame& F, int layer) {
    constexpr int DOTS = (MODE == 0) ? 8 : (MODE == 1 ? 16 : 0);
    constexpr int RPI = 2, NIT = 16 / RPI, NV = (DOTS > 0) ? RPI * DOTS : 16;
    constexpr bool COMBINE = (MODE == 2 || MODE == 3), MODUL = (MODE != 3), MFMA_DOTS = (MODE == 1) && ROUTER_MFMA;
    const float* MOD = (const float*)(F.ws + WS_MOD);
    LAS float* wl = (LAS float*)(F.lds + RP_WL);
    LAS int* rinfo = (LAS int*)(F.lds + RP_RINFO);
    LAS int* lcnt = (LAS int*)(F.lds + RP_LCNT);
    LAS int* tpre = (LAS int*)(F.lds + RP_TPRE);
    const float* xin = F.in[I_X];
    bf16_t* XB = (bf16_t*)(F.ws + WS_XB);
    float* xout = F.out;
    bf16_t* U = (bf16_t*)(F.ws + WS_U);
    const bf16_t* O = (const bf16_t*)(F.ws + WS_O);
    const unsigned char* TOKp = (const unsigned char*)(F.ws + WS_TOK);
    const int lane = F.lane;
    const int clayer = (MODE == 2) ? 0 : 1;
    if (DOTS > 0 && !MFMA_DOTS) { constexpr int NQ = D * (DOTS > 0 ? DOTS : 4) / 4 / NTHR;
        f32x4 tv[NQ];
#pragma unroll
        for (int q = 0; q < NQ; ++q) { const int piece = F.tid + q * NTHR, k = piece / (DOTS / 4), c4 = piece % (DOTS / 4);
            tv[q] = (DOTS == 8) ? *(const f32x4*)(F.in[I_MWIN] + (size_t)k * MPROJ + 3072 + 4 * c4) : *(const f32x4*)(F.in[I_WR] + (size_t)piece * 4); }
#pragma unroll
        for (int q = 0; q < NQ; ++q) { const int piece = F.tid + q * NTHR, k = piece / (DOTS / 4), c4 = piece % (DOTS / 4), jj = k >> 8, l = (k >> 2) & 63, ii = k & 3;
            const int rot = (DOTS == 16) ? ((l >> 2) & 3) : ((l >> 3) & 1), ch = (c4 + rot) & (DOTS / 4 - 1);
            *(LAS f32x4*)(wl + ((jj * 4 + ii) * 64 + l) * DOTS + ch * 4) = tv[q]; } }
    if (COMBINE && F.tid < 64) { const int e = F.tid & 15; const int tiles = ((int)__hip_atomic_load(F.ctl + CW_CNT + 64 * clayer + e, RLX_AGENT) + 255) >> 8; int inc = tiles;
#pragma unroll
        for (int o = 1; o < 16; o <<= 1) { const int t_ = __shfl_up(inc, o); if (e >= o) inc += t_; }
        if (F.tid < 16) { tpre[e] = inc - tiles; if (e == NE - 1) tpre[NE] = inc; } }
    float brt[16];
    if (MODE == 1) {
#pragma unroll
        for (int e = 0; e < 16; ++e) brt[e] = F.in[I_BR][e]; }
    for (int batch = F.vcu; batch < T / 128; batch += F.G) {
        __syncthreads();
        if (MODE == 1 && F.tid < 32) lcnt[F.tid] = 0;
        __syncthreads();
        const int row_base = batch * 128 + F.wave * 16, b = row_base / SEQ;
        const float* gam = (MODE == 3) ? F.in[I_FG] : ((MODE == 1) ? F.in[I_N2G] + (size_t)layer * D : F.in[I_N1G] + (size_t)layer * D);
        const float* mod = MOD + ((size_t)layer * NB + b) * 6 * D;
        const float* shp = mod + ((MODE == 1) ? 3 * D : 0); const float* scp = shp + D;
        const float* g2p = MOD + ((size_t)clayer * NB + b) * 6 * D + 5 * D;
        if constexpr (MFMA_DOTS) {
            LAS unsigned char* ldsb = F.lds; LAS float* part = (LAS float*)(F.lds + RP_LG); LAS float* cvec = (LAS float*)(F.lds + RP_CVEC);
            { const int k0 = 2 * F.tid; const float* WR = F.in[I_WR];
              const f32x2 gg = *(const f32x2*)(gam + k0), ss = *(const f32x2*)(scp + k0), hh = *(const f32x2*)(shp + k0);
              f32x4 wa[4], wb[4];
#pragma unroll
              for (int q = 0; q < 4; ++q) { wa[q] = *(const f32x4*)(WR + (size_t)k0 * 16 + 4 * q); wb[q] = *(const f32x4*)(WR + (size_t)(k0 + 1) * 16 + 4 * q); }
              const float a0 = gg[0] * (ss[0] + 1.f), a1 = gg[1] * (ss[1] + 1.f);
              float cp[16];
#pragma unroll
              for (int e = 0; e < 16; ++e) { const float w0 = wa[e >> 2][e & 3], w1 = wb[e >> 2][e & 3], p0 = a0 * w0, p1 = a1 * w1;
                  const unsigned hw = pk2(p0, p1), lw = pk2(p0 - bflo(hw), p1 - bfhi(hw));
                  *(LAS unsigned*)(ldsb + RP_WHI + e * RP_WTS + 4 * F.tid) = hw; *(LAS unsigned*)(ldsb + RP_WLO + e * RP_WTS + 4 * F.tid) = lw;
                  cp[e] = hh[0] * w0 + hh[1] * w1; }
              xreduce<16>(cp, lane);
              if ((lane & 3) == 0) part[F.wave * 16 + (lane >> 2)] = cp[0]; }
            __syncthreads();
            if (F.tid < 16) { float c = 0.f;
#pragma unroll
                for (int w8 = 0; w8 < 8; ++w8) c += part[w8 * 16 + F.tid];
                cvec[F.tid] = c; }
            __syncthreads();
        }
        f32x4 gm[4], sh[4], sc[4], g2[4];
#pragma unroll
        for (int j = 0; j < 4; ++j) { gm[j] = *(const f32x4*)(gam + 256 * j + 4 * lane);
            if (MODUL) { sh[j] = *(const f32x4*)(shp + 256 * j + 4 * lane); sc[j] = *(const f32x4*)(scp + 256 * j + 4 * lane) + 1.0f; }
            if (COMBINE) g2[j] = *(const f32x4*)(g2p + 256 * j + 4 * lane); }
        typedef typename std::conditional<F8_O != 0, unsigned, u32x2>::type oword_t;
        f32x4 xn[RPI][4]; oword_t on[RPI][2][4]; u32x4 tkn[RPI], tkn2[RPI];
#define RP_LOAD_X(IT) do { _Pragma("unroll") for (int r = 0; r < RPI; ++r) _Pragma("unroll") for (int j = 0; j < 4; ++j) { \
            if (MODE == 0) xn[r][j] = __builtin_nontemporal_load((const f32x4*)(xin + (size_t)(row_base + (IT) * RPI + r) * D + 256 * j + 4 * lane));   \
            else { const u32x2 xb_ = (MODE == 1) ? *(const u32x2*)(XB + (size_t)(row_base + (IT) * RPI + r) * D + 256 * j + 4 * lane) : __builtin_nontemporal_load((const u32x2*)(XB + (size_t)(row_base + (IT) * RPI + r) * D + 256 * j + 4 * lane)); xn[r][j] = (f32x4){bflo(xb_.x), bfhi(xb_.x), bflo(xb_.y), bfhi(xb_.y)}; } } } while (0)
#define RP_LOAD_TOK(dst, IT) do { _Pragma("unroll") for (int r = 0; r < RPI; ++r) dst[r] = __builtin_nontemporal_load((const u32x4*)(TOKp + (size_t)(row_base + (IT) * RPI + r) * 16)); } while (0)
#define RP_LOAD_O(tk) do { _Pragma("unroll") for (int r = 0; r < RPI; ++r) { const unsigned tx_ = tk[r].x, ty_ = tk[r].y; \
            const int e0_ = __builtin_amdgcn_readfirstlane((int)(tx_ >> 16)), e1_ = __builtin_amdgcn_readfirstlane((int)(ty_ >> 16)); \
            const int s0_ = tpre[e0_] * 256 + (int)(tx_ & 0xffffu), s1_ = tpre[e1_] * 256 + (int)(ty_ & 0xffffu); \
            _Pragma("unroll") for (int j = 0; j < 4; ++j) { if (F8_O) { on[r][0][j] = __builtin_nontemporal_load((const oword_t*)((const unsigned char*)O + (size_t)s0_ * D + 256 * j + 4 * lane)); on[r][1][j] = __builtin_nontemporal_load((const oword_t*)((const unsigned char*)O + (size_t)s1_ * D + 256 * j + 4 * lane)); } \
                else { on[r][0][j] = *(const oword_t*)(O + (size_t)s0_ * D + 256 * j + 4 * lane); on[r][1][j] = *(const oword_t*)(O + (size_t)s1_ * D + 256 * j + 4 * lane); } } } } while (0)
        RP_LOAD_X(0);
        if (COMBINE) { RP_LOAD_TOK(tkn, 0); RP_LOAD_O(tkn); RP_LOAD_TOK(tkn2, 1); }
#pragma unroll 1
        for (int it = 0; it < NIT; ++it) {
            const int r0 = row_base + it * RPI;
            f32x4 x[RPI][4]; oword_t oc[RPI][2][4]; float w0c[RPI], w1c[RPI];
#pragma unroll
            for (int r = 0; r < RPI; ++r) {
#pragma unroll
                for (int j = 0; j < 4; ++j) { x[r][j] = xn[r][j]; if (COMBINE) { oc[r][0][j] = on[r][0][j]; oc[r][1][j] = on[r][1][j]; } }
                if (COMBINE) { const unsigned wz_ = tkn[r].z, ww_ = tkn[r].w; w0c[r] = __uint_as_float(wz_) * (F8_O ? 0.0625f : 1.f); w1c[r] = __uint_as_float(ww_) * (F8_O ? 0.0625f : 1.f); } }
            if (it + 1 < NIT) {
                RP_LOAD_X(it + 1);
                if (COMBINE) {
#pragma unroll
                    for (int r = 0; r < RPI; ++r) tkn[r] = tkn2[r];
                    RP_LOAD_O(tkn);
                    if (it + 2 < NIT) RP_LOAD_TOK(tkn2, it + 2); } }
            if (COMBINE) {
#pragma unroll
                for (int r = 0; r < RPI; ++r)
#pragma unroll
                    for (int j = 0; j < 4; ++j) { const float w0 = w0c[r], w1 = w1c[r];
                        const f32x4 mo = o4(oc[r][0][j]) * w0 + o4(oc[r][1][j]) * w1;
                        x[r][j] = x[r][j] + g2[j] * mo;
                        if (MODE == 2) { u32x2 xw_; xw_.x = pk2(x[r][j][0], x[r][j][1]); xw_.y = pk2(x[r][j][2], x[r][j][3]); __builtin_nontemporal_store(xw_, (u32x2*)(XB + (size_t)(r0 + r) * D + 256 * j + 4 * lane)); } }
            }
            float rstd[RPI];
#pragma unroll
            for (int r = 0; r < RPI; ++r) { float s = 0.f;
#pragma unroll
                for (int j = 0; j < 4; ++j) s += (x[r][j][0] * x[r][j][0] + x[r][j][1] * x[r][j][1]) + (x[r][j][2] * x[r][j][2] + x[r][j][3] * x[r][j][3]);
                rstd[r] = 1.0f / sqrtf(wave_sum(s) * (1.0f / D) + EPS); }
            constexpr bool I8 = (MODE == 0 && I8_G1) || (MODE == 1 && I8_UP) || (MODE == 2 && I8_CIN);
            float qinv[RPI], rscale[RPI];
#pragma unroll
            for (int r = 0; r < RPI; ++r) {
#pragma unroll
                for (int j = 0; j < 4; ++j) { f32x4 y = x[r][j] * rstd[r] * gm[j]; if (MODUL) y = y * sc[j] + sh[j]; x[r][j] = y; }
                if (I8) { float am = 0.f;
#pragma unroll
                    for (int j = 0; j < 4; ++j) am = fmaxf(fmaxf(am, fmaxf(fabsf(x[r][j][0]), fabsf(x[r][j][1]))), fmaxf(fabsf(x[r][j][2]), fabsf(x[r][j][3])));
                    am = wave_max(am);
                    am = fmaxf(am, 1e-20f); qinv[r] = 127.f / am; rscale[r] = am * (1.f / 127.f);
                    if (MODE != 1 && lane == 0) ((float*)(F.ws + WS_SA))[r0 + r] = rscale[r]; } }
#pragma unroll
            for (int r = 0; r < RPI; ++r)
#pragma unroll
                for (int j = 0; j < 4; ++j) { const f32x4 y = x[r][j];
                    if (MODE == 3) *(f32x4*)(xout + (size_t)(r0 + r) * D + 256 * j + 4 * lane) = y;
                    else if (I8) { const f32x4 yq = y * qinv[r]; *(unsigned*)((unsigned char*)(F.ws + WS_U8) + (size_t)(r0 + r) * D + 256 * j + 4 * lane) = pk4_i8(yq[0], yq[1], yq[2], yq[3]); }
                    else if (MODE == 1 || (MODE == 2 && FP8_CIN) || (MODE == 0 && FP8_G1)) { *(unsigned*)((unsigned char*)(F.ws + WS_U8) + (size_t)(r0 + r) * D + 256 * j + 4 * lane) = pk4_fp8(y[0], y[1], y[2], y[3]);
                        if (MODE == 0 && FP8_G1 == 2) { u32x2 w; w.x = pk2(y[0], y[1]); w.y = pk2(y[2], y[3]); *(u32x2*)(U + (size_t)(r0 + r) * D + 256 * j + 4 * lane) = w; } }
                    else { u32x2 w; w.x = pk2(y[0], y[1]); w.y = pk2(y[2], y[3]); *(u32x2*)(U + (size_t)(r0 + r) * D + 256 * j + 4 * lane) = w; } }
            if (DOTS > 0) {
                float v[NV];
#pragma unroll
                for (int i = 0; i < NV; ++i) v[i] = 0.f;
                if constexpr (!MFMA_DOTS) {
#pragma unroll
                for (int j = 0; j < 4; ++j)
#pragma unroll
                    for (int i = 0; i < 4; ++i) {
                        float w[DOTS > 0 ? DOTS : 1];
#pragma unroll
                        for (int q = 0; q < DOTS / 4; ++q) { const int rot = (DOTS == 16) ? ((lane >> 2) & 3) : ((lane >> 3) & 1);
                            const f32x4 t4 = *(const LAS f32x4*)(wl + ((j * 4 + i) * 64 + lane) * DOTS + ((q + rot) & (DOTS / 4 - 1)) * 4); w[4 * q] = t4[0]; w[4 * q + 1] = t4[1]; w[4 * q + 2] = t4[2]; w[4 * q + 3] = t4[3]; }
#pragma unroll
                        for (int r = 0; r < RPI; ++r)
#pragma unroll
                            for (int e = 0; e < DOTS; ++e) v[r * DOTS + e] += x[r][j][i] * w[e];
                        asm volatile("" ::: "memory"); }
                xreduce<NV>(v, lane);
                }
                const float tot = v[0];
                if (MODE == 0) {
                    const int idx = lane >> 2, r = idx >> 3, gi = idx & 7, row = r0 + r, bb = row / SEQ, s = row % SEQ;
                    if ((lane & 3) == 0) {
                        const float pre = tot + F.in[I_MBG][gi];
                        if (gi < 4) ((float*)(F.ws + WS_IG))[(size_t)(bb * NH + gi) * SEQ + s] = pre;
                        else { const float ls = (pre >= 0.f) ? -log1pf(expf(-pre)) : (pre - log1pf(expf(pre))); ((float*)(F.ws + WS_LF))[(size_t)(bb * NH + gi - 4) * SEQ + s] = ls; }
                    }
                }
                if (MODE == 1 && MFMA_DOTS) { if (I8 && (lane & 31) == 0) { const int r = lane >> 5; const float rsc_ = r ? rscale[RPI - 1] : rscale[0]; rinfo[(F.wave * 16 + it * RPI + r) * 8 + 6] = __builtin_bit_cast(int, rsc_); } }
                if (MODE == 1 && !MFMA_DOTS) {
                    const int r = lane >> 5;
                    float lg[16], mx = -INFINITY;
                    if constexpr (MFMA_DOTS) { const LAS f32x4* lp = (const LAS f32x4*)(F.lds + RP_LG + 8 * 64 + F.wave * 1088 + (it * RPI + r) * 64); const LAS f32x4* cp4 = (const LAS f32x4*)(F.lds + RP_CVEC);
                        const float rs_ = r ? rstd[RPI - 1] : rstd[0];
#pragma unroll
                        for (int q = 0; q < 4; ++q) { const f32x4 d4 = lp[q], c4 = cp4[q];
#pragma unroll
                            for (int i = 0; i < 4; ++i) { lg[4 * q + i] = rs_ * d4[i] + c4[i]; mx = fmaxf(mx, lg[4 * q + i]); } } }
                    else {
#pragma unroll
                    for (int e = 0; e < 16; ++e) { lg[e] = __shfl(tot, 32 * r + 2 * e); mx = fmaxf(mx, lg[e]); } }
                    float se = 0.f;
#pragma unroll
                    for (int e = 0; e < 16; ++e) { lg[e] = __builtin_amdgcn_exp2f((lg[e] - mx) * 1.44269504089f); se += lg[e]; }
                    const float inv = 1.0f / se;
                    float sel[16];
#pragma unroll
                    for (int e = 0; e < 16; ++e) { lg[e] *= inv; sel[e] = lg[e] + brt[e]; }
                    int best = 0; float bscore = -INFINITY;
#pragma unroll
                    for (int gq = 0; gq < 4; ++gq) { const float a = sel[4 * gq], bq = sel[4 * gq + 1], c = sel[4 * gq + 2], d = sel[4 * gq + 3];
                        const float m1 = fmaxf(fmaxf(a, bq), fmaxf(c, d));
                        const float lo1 = fminf(a, bq), hi1 = fmaxf(a, bq), lo2 = fminf(c, d), hi2 = fmaxf(c, d);
                        const float m2 = fmaxf(fminf(hi1, hi2), fmaxf(lo1, lo2));
                        const float gs = m1 + m2; if (gs > bscore) { bscore = gs; best = gq; } }
                    float s4[4], p4[4];
#pragma unroll
                    for (int q = 0; q < 4; ++q) { s4[q] = -INFINITY; p4[q] = 0.f; }
#pragma unroll
                    for (int gq = 0; gq < 4; ++gq) if (best == gq) {
#pragma unroll
                        for (int q = 0; q < 4; ++q) { s4[q] = sel[4 * gq + q]; p4[q] = lg[4 * gq + q]; } }
                    int i0 = 0; float v0 = s4[0], pp0 = p4[0];
#pragma unroll
                    for (int q = 1; q < 4; ++q) if (s4[q] > v0) { v0 = s4[q]; i0 = q; pp0 = p4[q]; }
                    int i1 = -1; float v1 = -INFINITY, pp1 = 0.f;
#pragma unroll
                    for (int q = 0; q < 4; ++q) if (q != i0 && s4[q] > v1) { v1 = s4[q]; i1 = q; pp1 = p4[q]; }
                    const float wsum = pp0 + pp1, w0 = pp0 / wsum, w1 = pp1 / wsum;
                    const int e0 = best * 4 + i0, e1 = best * 4 + i1;
                    if ((lane & 31) == 0) {
                        const int lp0 = __hip_atomic_fetch_add(lcnt + e0, 1, __ATOMIC_RELAXED, __HIP_MEMORY_SCOPE_WORKGROUP), lp1 = __hip_atomic_fetch_add(lcnt + e1, 1, __ATOMIC_RELAXED, __HIP_MEMORY_SCOPE_WORKGROUP);
                        LAS int* ri = rinfo + (F.wave * 16 + it * RPI + r) * 8;
                        ri[0] = e0; ri[1] = e1; ri[2] = lp0; ri[3] = lp1; ri[4] = __builtin_bit_cast(int, w0); ri[5] = __builtin_bit_cast(int, w1);
                        if (I8) { const float rsc_ = r ? rscale[RPI - 1] : rscale[0]; ri[6] = __builtin_bit_cast(int, rsc_); }
                    }
                }
            }
        }
        if constexpr (MFMA_DOTS) {
            LAS unsigned char* ldsb = F.lds; LAS float* cvec = (LAS float*)(F.lds + RP_CVEC);
            { const int fr = lane & 15, fq = lane >> 4;
              const bf16_t* xr = XB + (size_t)(row_base + fr) * D + 8 * fq;
              const LAS unsigned char* bh = ldsb + RP_WHI + fr * RP_WTS + 16 * fq; const LAS unsigned char* bl = ldsb + RP_WLO + fr * RP_WTS + 16 * fq;
              f32x4 dacc = (f32x4){0.f, 0.f, 0.f, 0.f}, sacc = dacc;
#pragma unroll 1
              for (int g = 0; g < 2; ++g) {
                  u32x4 av[16];
#pragma unroll
                  for (int q = 0; q < 16; ++q) av[q] = *(const u32x4*)(xr + (g * 16 + q) * 32);
#pragma unroll
                  for (int q = 0; q < 16; ++q) { const u32x4 b0 = *(const LAS u32x4*)(bh + (g * 16 + q) * 64), b1 = *(const LAS u32x4*)(bl + (g * 16 + q) * 64);
                      dacc = __builtin_amdgcn_mfma_f32_16x16x32_bf16(__builtin_bit_cast(bf16x8, av[q]), __builtin_bit_cast(bf16x8, b0), dacc, 0, 0, 0);
                      dacc = __builtin_amdgcn_mfma_f32_16x16x32_bf16(__builtin_bit_cast(bf16x8, av[q]), __builtin_bit_cast(bf16x8, b1), dacc, 0, 0, 0);
                      sacc = __builtin_amdgcn_mfma_f32_16x16x32_bf16(__builtin_bit_cast(bf16x8, av[q]), __builtin_bit_cast(bf16x8, av[q]), sacc, 0, 0, 0); }
              }
              LAS float* lgw = (LAS float*)(F.lds + RP_LG + 8 * 64 + F.wave * 1088);
#pragma unroll
              for (int j = 0; j < 4; ++j) lgw[(4 * fq + j) * 16 + fr] = dacc[j];
              { const float s0_ = sacc[0], s1_ = sacc[1], s2_ = sacc[2], s3_ = sacc[3]; const int jj = fr & 3;
                if ((fr >> 2) == fq) lgw[256 + fr] = (jj == 0) ? s0_ : (jj == 1) ? s1_ : (jj == 2) ? s2_ : s3_; }
              { const int row = lane & 15, grp = lane >> 4;
                const f32x4 d4 = *(const LAS f32x4*)(lgw + row * 16 + 4 * grp), c4 = *(const LAS f32x4*)(cvec + 4 * grp), b4 = *(const f32x4*)(F.in[I_BR] + 4 * grp);
                const float rs_ = 1.0f / sqrtf(lgw[256 + row] * (1.0f / D) + EPS);
                float pr[4], sl[4], mx = -INFINITY;
#pragma unroll
                for (int i = 0; i < 4; ++i) { pr[i] = rs_ * d4[i] + c4[i]; mx = fmaxf(mx, pr[i]); }
                mx = fmaxf(mx, __shfl_xor(mx, 16)); mx = fmaxf(mx, __shfl_xor(mx, 32));
                float se = 0.f;
#pragma unroll
                for (int i = 0; i < 4; ++i) { pr[i] = __builtin_amdgcn_exp2f((pr[i] - mx) * 1.44269504089f); se += pr[i]; }
                se += __shfl_xor(se, 16); se += __shfl_xor(se, 32);
                const float inv = 1.0f / se;
#pragma unroll
                for (int i = 0; i < 4; ++i) { pr[i] *= inv; sl[i] = pr[i] + b4[i]; }
                float gsc;
                { const float a = sl[0], bq = sl[1], c = sl[2], d = sl[3];
                  const float m1 = fmaxf(fmaxf(a, bq), fmaxf(c, d));
                  const float lo1 = fminf(a, bq), hi1 = fmaxf(a, bq), lo2 = fminf(c, d), hi2 = fmaxf(c, d);
                  const float m2 = fmaxf(fminf(hi1, hi2), fmaxf(lo1, lo2)); gsc = m1 + m2; }
                const float g0 = __shfl(gsc, row), g1 = __shfl(gsc, row + 16), g2 = __shfl(gsc, row + 32), g3 = __shfl(gsc, row + 48);
                int best = 0; float bscore = g0;
                if (g1 > bscore) { bscore = g1; best = 1; } if (g2 > bscore) { bscore = g2; best = 2; } if (g3 > bscore) { bscore = g3; best = 3; }
                if (grp == best) {
                    int i0 = 0; float v0 = sl[0], pp0 = pr[0];
#pragma unroll
                    for (int q = 1; q < 4; ++q) if (sl[q] > v0) { v0 = sl[q]; i0 = q; pp0 = pr[q]; }
                    int i1 = -1; float v1 = -INFINITY, pp1 = 0.f;
#pragma unroll
                    for (int q = 0; q < 4; ++q) if (q != i0 && sl[q] > v1) { v1 = sl[q]; i1 = q; pp1 = pr[q]; }
                    const float wsum = pp0 + pp1, w0 = pp0 / wsum, w1 = pp1 / wsum;
                    const int e0 = best * 4 + i0, e1 = best * 4 + i1;
                    const int lp0 = __hip_atomic_fetch_add(lcnt + e0, 1, __ATOMIC_RELAXED, __HIP_MEMORY_SCOPE_WORKGROUP), lp1 = __hip_atomic_fetch_add(lcnt + e1, 1, __ATOMIC_RELAXED, __HIP_MEMORY_SCOPE_WORKGROUP);
                    LAS int* ri = rinfo + (F.wave * 16 + row) * 8;
                    ri[0] = e0; ri[1] = e1; ri[2] = lp0; ri[3] = lp1; ri[4] = __builtin_bit_cast(int, w0); ri[5] = __builtin_bit_cast(int, w1);
                } } }
        }
#undef RP_LOAD_X
#undef RP_LOAD_TOK
#undef RP_LOAD_O
        if (MODE == 1) {
            __syncthreads();
            if (F.tid < 16) lcnt[16 + F.tid] = (int)__hip_atomic_fetch_add(F.ctl + CW_CNT + 64 * layer + F.tid, (unsigned)lcnt[F.tid], RLX_AGENT);
            __syncthreads();
            if (F.tid < 128) { const LAS int* ri = rinfo + F.tid * 8; const int row = batch * 128 + F.tid; const int e0 = ri[0], e1 = ri[1], p0 = lcnt[16 + e0] + ri[2], p1 = lcnt[16 + e1] + ri[3];
                int* LIST = (int*)(F.ws + WS_LIST); LIST[e0 * LCAP + p0] = row; LIST[e1 * LCAP + p1] = row;
                if (I8_UP) { int* SAS = (int*)(F.ws + WS_SASLOT); const int rs_ = ri[6]; SAS[e0 * LCAP + p0] = rs_; SAS[e1 * LCAP + p1] = rs_; }
                u32x4 ti; ti.x = (unsigned)(e0 << 16) | (unsigned)p0; ti.y = (unsigned)(e1 << 16) | (unsigned)p1; ti.z = (unsigned)ri[4]; ti.w = (unsigned)ri[5];
                *(u32x4*)(F.ws + WS_TOK + (size_t)row * 16) = ti; }
        }
    }
    __syncthreads();
}

#define LBAR() do { asm volatile("s_waitcnt lgkmcnt(0)" ::: "memory"); __builtin_amdgcn_s_barrier(); asm volatile("" ::: "memory"); } while (0)
template <int CTRL, int ROWMASK> __device__ __forceinline__ float dpp_upd(float old, float v) {
    return __builtin_bit_cast(float, __builtin_amdgcn_update_dpp(__builtin_bit_cast(int, old), __builtin_bit_cast(int, v), CTRL, ROWMASK, 0xf, false)); }
__device__ __forceinline__ float incl_sum(float v, int lane) {
    v += dpp_upd<0x111, 0xf>(0.f, v); v += dpp_upd<0x112, 0xf>(0.f, v); v += dpp_upd<0x114, 0xf>(0.f, v); v += dpp_upd<0x118, 0xf>(0.f, v);
    v += dpp_upd<0x142, 0xa>(0.f, v); v += dpp_upd<0x143, 0xc>(0.f, v);
    return v;
}
__device__ __forceinline__ float incl_max(float v, int lane) {
    const float ni = -INFINITY;
    v = fmaxf(v, dpp_upd<0x111, 0xf>(ni, v)); v = fmaxf(v, dpp_upd<0x112, 0xf>(ni, v)); v = fmaxf(v, dpp_upd<0x114, 0xf>(ni, v)); v = fmaxf(v, dpp_upd<0x118, 0xf>(ni, v));
    v = fmaxf(v, dpp_upd<0x142, 0xa>(ni, v)); v = fmaxf(v, dpp_upd<0x143, 0xc>(ni, v));
    return v;
}
__device__ __forceinline__ void phase_scan(Frame& F, int mode = 0) {
    LAS float* wkA = (LAS float*)(F.lds + 0);
    LAS float* decA = (LAS float*)(F.lds + 32768);
    LAS float* tot = (LAS float*)(F.lds + 33280);
    LAS float* bst = (LAS float*)(F.lds + 33792);
    LAS float* cmx = (LAS float*)(F.lds + 34304);
    LAS float* rst = (LAS float*)(F.lds + 34816);
    LAS float* xw = (LAS float*)(F.lds + 35328);
    LAS unsigned char* ring = F.lds + 40960;
    constexpr int SLOT = 12288;
    const int lane = F.lane, w = F.wave, tid = F.tid;
    for (int unit = F.vcu; unit < 256; unit += F.G) {
        const int bh = unit >> 4, slice = unit & 15;
        const float* IG = (const float*)(F.ws + WS_IG) + (size_t)bh * SEQ; const float* LF = (const float*)(F.ws + WS_LF) + (size_t)bh * SEQ;
        __syncthreads();
        if (mode < 2) {
        float p[16], g[16], pm[16];
        { float lf_[16], ig_[16];
#pragma unroll
          for (int q = 0; q < 16; ++q) { const int c = 16 * w + q; lf_[q] = LF[c * 64 + lane]; ig_[q] = IG[c * 64 + lane]; }
#pragma unroll
          for (int q = 0; q < 16; ++q) { const int c = 16 * w + q; p[q] = incl_sum(lf_[q], lane); g[q] = ig_[q] - p[q]; pm[q] = incl_max(g[q], lane); if (lane == 63) { tot[c] = p[q]; cmx[c] = pm[q]; } } }
        __syncthreads();
        if (tid < 64) { const float a = tot[2 * tid], b2 = tot[2 * tid + 1], sm = a + b2; const float inc = incl_sum(sm, lane); const float ex0 = inc - sm, ex1 = ex0 + a;
            bst[2 * tid] = ex0; bst[2 * tid + 1] = ex1;
            const float m0 = cmx[2 * tid] - ex0, m1 = cmx[2 * tid + 1] - ex1, mm = fmaxf(m0, m1); const float incm = incl_max(mm, lane);
            float exm = __shfl_up(incm, 1); if (lane == 0) exm = 0.f; exm = fmaxf(exm, 0.f);
            cmx[2 * tid] = m0; cmx[2 * tid + 1] = m1; rst[2 * tid] = exm; rst[2 * tid + 1] = fmaxf(exm, m0); }
        __syncthreads();
#pragma unroll
        for (int q = 0; q < 16; ++q) { const int c = 16 * w + q; const float bs = bst[c]; p[q] += bs; g[q] -= bs; pm[q] -= bs;
            const float Rs = rst[c], Rn = fmaxf(Rs, cmx[c]), Rrun = fmaxf(Rs, pm[q]);
            wkA[c * 64 + lane] = fast_exp(g[q] - Rn); if (lane == 0) decA[c] = fast_exp(Rs - Rn);
            if (slice == 0) { const size_t o = (size_t)bh * SEQ + c * 64 + lane; ((float*)(F.ws + WS_GA))[o] = g[q]; ((float*)(F.ws + WS_RR))[o] = Rrun; ((float*)(F.ws + WS_MM))[o] = p[q] + Rrun;
                if (lane == 0) ((float*)(F.ws + WS_RC))[bh * NCH + c] = Rs; } }
        }
        __syncthreads();
        if (mode == 1) continue;
        const int dkh = slice & 1, dvs = slice >> 1;
        const bf16_t* KTg = (const bf16_t*)(F.ws + WS_KT) + ((size_t)bh * NCH * DK + 64 * dkh) * 64;
        const bf16_t* VTg = (const bf16_t*)(F.ws + WS_VT) + ((size_t)bh * NCH * DV + 32 * dvs) * 64;
        const int dkr = 64 * dkh + 16 * (w >> 1), dvc = 32 * dvs + 16 * (w & 1);
        bf16_t* STp = (bf16_t*)(F.ws + WS_ST) + ((size_t)bh * NCH * DV + dvc + (lane & 15)) * DK + dkr + 4 * (lane >> 4);
        float* NSp = (float*)(F.ws + WS_NS) + (size_t)bh * NCH * DK + dkr + 4 * (lane >> 4);
        const bool nown = (dvs == (w >> 1)) && ((w & 1) == 0);
        const bool ns_writer = nown && ((lane & 15) == 0);
        f32x4 accS = (f32x4){0.f, 0.f, 0.f, 0.f}, accN = (f32x4){0.f, 0.f, 0.f, 0.f};
        constexpr int PD = 4;
        u32x4 gk[PD], gv[PD];
        const int wr0 = (tid >> 3) * 128 + (((tid & 7) ^ ((tid >> 3) & 7)) << 4);
        const int arow = 16 * (w >> 1) + (lane & 15), brow = 16 * (w & 1) + (lane & 15), lq = lane >> 4;
#define SC_LOAD(set, cc) do { gk[set] = *(const u32x4*)(KTg + (size_t)(cc) * DK * 64 + tid * 8); if (tid < 256) gv[set] = *(const u32x4*)(VTg + (size_t)(cc) * DV * 64 + tid * 8); } while (0)
#define SC_WRITE(set, slot) do { LAS unsigned char* sb_ = ring + (slot) * SLOT; *(LAS u32x4*)(sb_ + wr0) = gk[set]; if (tid < 256) *(LAS u32x4*)(sb_ + 8192 + wr0) = gv[set]; } while (0)
#pragma unroll
        for (int q = 0; q < PD; ++q) SC_LOAD(q, q);
        SC_WRITE(0, 0); SC_WRITE(1, 1);
        SC_LOAD(0, PD); SC_LOAD(1, PD + 1);
        LBAR();
        for (int c0 = 0; c0 < NCH; c0 += PD) {
#pragma unroll
            for (int q2 = 0; q2 < PD; q2 += 2) {
                { const int cw = c0 + q2 + 2;
                  if (cw < NCH) { SC_WRITE((q2 + 2) % PD, (q2 + 2) % PD); SC_WRITE((q2 + 3) % PD, (q2 + 3) % PD);
                      if (cw + PD < NCH) { SC_LOAD((q2 + 2) % PD, cw + PD); SC_LOAD((q2 + 3) % PD, cw + PD + 1); } } }
#pragma unroll
                for (int qq = 0; qq < 2; ++qq) {
                    const int q = q2 + qq, c = c0 + q;
                    if (mode < 3) { { u32x2 o; o.x = pk2(accS[0], accS[1]); o.y = pk2(accS[2], accS[3]); *(u32x2*)(STp + (size_t)c * DV * DK) = o; }
                    if (ns_writer) *(f32x4*)(NSp + (size_t)c * DK) = accN; }
                    const float dec = decA[c];
                    accS = accS * dec; accN = accN * dec;
                    const LAS unsigned char* sb = ring + q * SLOT;
#pragma unroll
                    for (int kk = 0; kk < 2; ++kk) {
                        const LAS f32x4* wp = (const LAS f32x4*)(wkA + c * 64 + kk * 32 + 8 * lq);
                        const f32x4 w0 = wp[0], w1 = wp[1];
                        const u32x4 ka = *(const LAS u32x4*)(sb + arow * 128 + (((4 * kk + lq) ^ (arow & 7)) << 4));
                        const u32x4 vv = *(const LAS u32x4*)(sb + 8192 + brow * 128 + (((4 * kk + lq) ^ (brow & 7)) << 4));
                        u32x4 bv, b1;
                        bv.x = pk2(bflo(vv.x) * w0[0], bfhi(vv.x) * w0[1]); bv.y = pk2(bflo(vv.y) * w0[2], bfhi(vv.y) * w0[3]);
                        bv.z = pk2(bflo(vv.z) * w1[0], bfhi(vv.z) * w1[1]); bv.w = pk2(bflo(vv.w) * w1[2], bfhi(vv.w) * w1[3]);
                        b1.x = pk2(w0[0], w0[1]); b1.y = pk2(w0[2], w0[3]); b1.z = pk2(w1[0], w1[1]); b1.w = pk2(w1[2], w1[3]);
                        const bf16x8 af = __builtin_bit_cast(bf16x8, ka);
                        accS = __builtin_amdgcn_mfma_f32_16x16x32_bf16(af, __builtin_bit_cast(bf16x8, bv), accS, 0, 0, 0);
                        accN = __builtin_amdgcn_mfma_f32_16x16x32_bf16(af, __builtin_bit_cast(bf16x8, b1), accN, 0, 0, 0);
                    }
                }
                LBAR();
            }
        }
        asm volatile("" :: "v"(accS), "v"(accN));
#undef SC_LOAD
#undef SC_WRITE
    }
    __syncthreads();
}

constexpr int OC_AP = 0, OC_STRIDE = 400, OC_BVEC = 25600, OC_INV = 26368, OC_PART = 26624, OC_GS = 28672, OC_RT = 28928, OC_EMM = 29184, OC_HT = 32768, OC_HSTR = 528;
__device__ __forceinline__ void phase_out(Frame& F) {
    LAS unsigned char* AP = F.lds + OC_AP; LAS unsigned char* HT = F.lds + OC_HT;
    LAS float* bvec = (LAS float*)(F.lds + OC_BVEC); LAS float* inv = (LAS float*)(F.lds + OC_INV); LAS float* part = (LAS float*)(F.lds + OC_PART);
    LAS float* gs = (LAS float*)(F.lds + OC_GS); LAS float* Rt = (LAS float*)(F.lds + OC_RT); LAS float* emm = (LAS float*)(F.lds + OC_EMM);
    const int lane = F.lane, w = F.wave, tid = F.tid, l15 = lane & 15, lq = lane >> 4;
    const bf16_t* Qg = (const bf16_t*)(F.ws + WS_Q); const bf16_t* Kg = (const bf16_t*)(F.ws + WS_K);
    const bf16_t* VTg = (const bf16_t*)(F.ws + WS_VT); const bf16_t* STg = (const bf16_t*)(F.ws + WS_ST); const bf16_t* OGS = (const bf16_t*)(F.ws + WS_OGS);
    const float* GAg = (const float*)(F.ws + WS_GA); const float* RRg = (const float*)(F.ws + WS_RR); const float* MMg = (const float*)(F.ws + WS_MM);
    const float* NSg = (const float*)(F.ws + WS_NS); const float* RCg = (const float*)(F.ws + WS_RC); const float* MNG = F.in[I_MNG];
    bf16_t* HN = (bf16_t*)(F.ws + WS_U);
    const int mt = w >> 1, ntb = (w & 1) * 2, tq = tid >> 3, pq = tid & 7, NU = 16 * NCH;
    u32x4 bfr[2][6], qk[4], og[4]; f32x4 ng0, ng1; float sc_g = 0.f, sc_r = 0.f, sc_m = 0.f, sc_b = 0.f, Rc = 0.f;
    LAS unsigned char* QL = F.lds + 69632; LAS unsigned char* KL = F.lds + 86016;
    const int prow = tid >> 4, pch = tid & 15;
    const int pwr = prow * 256 + ((pch ^ (prow & 15)) << 4);
    unsigned lo_st[2], lo_vt[2];
#pragma unroll
    for (int n = 0; n < 2; ++n) { const int dv = 32 * w + 16 * n + l15; lo_st[n] = (unsigned)((dv * DK + 8 * lq) * 2); lo_vt[n] = (unsigned)((dv * 64 + 8 * lq) * 2); }
    const unsigned lo_q = (unsigned)((prow * MQK + 8 * pch) * 2), lo_og = (unsigned)(((tid >> 5) * MV + 8 * (tid & 31)) * 2), lo_ng = (unsigned)(8 * (tid & 31) * 4), lo_t = (unsigned)(tid * 4);
#define OC_AT(T_, base_, off_) (*(const T_*)((const char*)(base_) + (off_)))
#define OC_NT(T_, base_, off_) __builtin_nontemporal_load((const T_*)((const char*)(base_) + (off_)))
#define OC_LOAD_MAIN(U_) do { const int bh_ = (U_) >> 7, c_ = (U_) & 127, tk_ = (bh_ >> 2) * SEQ + c_ * 64, h_ = bh_ & 3; \
        const bf16_t* vb_ = VTg + ((((size_t)bh_ * NCH + c_) * DV) << 6); \
        _Pragma("unroll") for (int n = 0; n < 2; ++n) { _Pragma("unroll") for (int kk = 0; kk < 2; ++kk) bfr[n][kk] = OC_NT(u32x4, vb_ + 32 * kk, lo_vt[n]); } \
        const bf16_t* qb_ = Qg + (size_t)tk_ * MQK + h_ * DK; const bf16_t* kb_ = Kg + (size_t)tk_ * MQK + h_ * DK; \
        qk[0] = OC_NT(u32x4, qb_, lo_q); qk[1] = OC_NT(u32x4, qb_ + 32 * MQK, lo_q); qk[2] = OC_NT(u32x4, kb_, lo_q); qk[3] = OC_NT(u32x4, kb_ + 32 * MQK, lo_q); \
        if (tid < 64) { const size_t o_ = (size_t)bh_ * SEQ + c_ * 64; sc_g = OC_AT(float, GAg + o_, lo_t); sc_r = OC_AT(float, RRg + o_, lo_t); sc_m = OC_AT(float, MMg + o_, lo_t); sc_b = 1.0f; } \
        else if (tid < 192) sc_b = OC_AT(float, NSg + ((size_t)bh_ * NCH + c_) * DK - 64, lo_t); \
        Rc = RCg[bh_ * NCH + c_]; } while (0)
#define OC_LOAD_ST(U_) do { const int bh_ = (U_) >> 7, c_ = (U_) & 127; const bf16_t* sb_ = STg + ((size_t)bh_ * NCH + c_) * DV * DK; \
        _Pragma("unroll") for (int n = 0; n < 2; ++n) { _Pragma("unroll") for (int kk = 0; kk < 4; ++kk) bfr[n][2 + kk] = OC_NT(u32x4, sb_ + 32 * kk, lo_st[n]); } } while (0)
#define OC_LOAD_OGS(U_) do { const int bh_ = (U_) >> 7, c_ = (U_) & 127, tk_ = (bh_ >> 2) * SEQ + c_ * 64, h_ = bh_ & 3; const bf16_t* ob_ = OGS + (size_t)tk_ * MV + h_ * DV; \
        _Pragma("unroll") for (int q = 0; q < 4; ++q) og[q] = OC_NT(u32x4, ob_ + (size_t)q * 16 * MV, lo_og); \
        ng0 = OC_AT(f32x4, MNG + h_ * DV, lo_ng); ng1 = OC_AT(f32x4, MNG + h_ * DV + 4, lo_ng); } while (0)
    int unit = F.vcu;
    if (unit < NU) { OC_LOAD_ST(unit); OC_LOAD_MAIN(unit); OC_LOAD_OGS(unit); }
    for (; unit < NU; unit += F.G) {
        const int bh = unit >> 7, c = unit & 127, b = bh >> 2, h = bh & 3;
        const int tk0 = b * SEQ + c * 64;
        if (tid < 64) { gs[tid] = sc_g; Rt[tid] = sc_r; emm[tid] = fast_exp(-sc_m); }
        if (tid < 192) bvec[tid] = sc_b;
        *(LAS u32x4*)(QL + pwr) = qk[0]; *(LAS u32x4*)(QL + 8192 + pwr) = qk[1]; *(LAS u32x4*)(KL + pwr) = qk[2]; *(LAS u32x4*)(KL + 8192 + pwr) = qk[3];
        const float Rc_cur = Rc;
        LBAR();
        u32x4 qa[4], kb[2][4];
#pragma unroll
        for (int kk = 0; kk < 4; ++kk) { { const int row = 16 * mt + l15; qa[kk] = *(const LAS u32x4*)(QL + row * 256 + (((4 * kk + lq) ^ (row & 15)) << 4)); }
#pragma unroll
            for (int n = 0; n < 2; ++n) { const int row = 16 * (ntb + n) + l15; kb[n][kk] = *(const LAS u32x4*)(KL + row * 256 + (((4 * kk + lq) ^ (row & 15)) << 4)); } }
        const u32x4 q0 = *(const LAS u32x4*)(QL + tq * 256 + (((2 * pq) ^ (tq & 15)) << 4)), q1 = *(const LAS u32x4*)(QL + tq * 256 + (((2 * pq + 1) ^ (tq & 15)) << 4));
        { const float wq = fast_exp(Rc_cur - Rt[tq]);
          u32x4 o0, o1;
          o0.x = pk2(bflo(q0.x) * wq, bfhi(q0.x) * wq); o0.y = pk2(bflo(q0.y) * wq, bfhi(q0.y) * wq); o0.z = pk2(bflo(q0.z) * wq, bfhi(q0.z) * wq); o0.w = pk2(bflo(q0.w) * wq, bfhi(q0.w) * wq);
          o1.x = pk2(bflo(q1.x) * wq, bfhi(q1.x) * wq); o1.y = pk2(bflo(q1.y) * wq, bfhi(q1.y) * wq); o1.z = pk2(bflo(q1.z) * wq, bfhi(q1.z) * wq); o1.w = pk2(bflo(q1.w) * wq, bfhi(q1.w) * wq);
          *(LAS u32x4*)(AP + tq * OC_STRIDE + 128 + 32 * pq) = o0; *(LAS u32x4*)(AP + tq * OC_STRIDE + 128 + 32 * pq + 16) = o1; }
        f32x4 pacc[2];
#pragma unroll
        for (int n = 0; n < 2; ++n) { pacc[n] = (f32x4){0.f, 0.f, 0.f, 0.f};
#pragma unroll
            for (int kk = 0; kk < 4; ++kk) pacc[n] = __builtin_amdgcn_mfma_f32_16x16x32_bf16(__builtin_bit_cast(bf16x8, qa[kk]), __builtin_bit_cast(bf16x8, kb[n][kk]), pacc[n], 0, 0, 0); }
        LBAR();
        f32x4 acc[4][2];
#pragma unroll
        for (int m = 0; m < 4; ++m)
#pragma unroll
            for (int n = 0; n < 2; ++n) acc[m][n] = (f32x4){0.f, 0.f, 0.f, 0.f};
#pragma unroll
        for (int kk = 2; kk < 6; ++kk) {
            bf16x8 af[4];
#pragma unroll
            for (int m = 0; m < 4; ++m) af[m] = *(const LAS bf16x8*)(AP + (16 * m + l15) * OC_STRIDE + 64 * kk + 16 * lq);
#pragma unroll
            for (int m = 0; m < 4; ++m)
#pragma unroll
                for (int n = 0; n < 2; ++n) acc[m][n] = __builtin_amdgcn_mfma_f32_16x16x32_bf16(af[m], __builtin_bit_cast(bf16x8, bfr[n][kk]), acc[m][n], 0, 0, 0);
        }
        const int nxt = unit + F.G;
        if (nxt < NU) OC_LOAD_ST(nxt);
#pragma unroll
        for (int n = 0; n < 2; ++n) { const int sl = 16 * (ntb + n) + l15; const float gsv = gs[sl];
#pragma unroll
            for (int r = 0; r < 4; ++r) { const int tl = 16 * mt + 4 * lq + r; const float pv = (sl <= tl) ? pacc[n][r] * fast_exp(gsv - Rt[tl]) : 0.f;
                *(LAS bf16_t*)(AP + tl * OC_STRIDE + sl * 2) = (bf16_t)f2bf(pv); } }
        LBAR();
        { float s = 0.f;
#pragma unroll
          for (int q = 0; q < 3; ++q) { const u32x4 a = *(const LAS u32x4*)(AP + tq * OC_STRIDE + 48 * pq + 16 * q); const LAS f32x4* bp = (const LAS f32x4*)(bvec + 24 * pq + 8 * q); const f32x4 b0 = bp[0], b1 = bp[1];
              s += bflo(a.x) * b0[0] + bfhi(a.x) * b0[1] + bflo(a.y) * b0[2] + bfhi(a.y) * b0[3] + bflo(a.z) * b1[0] + bfhi(a.z) * b1[1] + bflo(a.w) * b1[2] + bfhi(a.w) * b1[3]; }
          s += dpp_f<0xB1>(s); s += dpp_f<0x4E>(s); s += dpp_f<0x141>(s);
          if (pq == 0) inv[tq] = 1.0f / fmaxf(fabsf(s), emm[tq]); }
#pragma unroll
        for (int kk = 0; kk < 2; ++kk) {
            bf16x8 af[4];
#pragma unroll
            for (int m = 0; m < 4; ++m) af[m] = *(const LAS bf16x8*)(AP + (16 * m + l15) * OC_STRIDE + 64 * kk + 16 * lq);
#pragma unroll
            for (int m = 0; m < 4; ++m)
#pragma unroll
                for (int n = 0; n < 2; ++n) acc[m][n] = __builtin_amdgcn_mfma_f32_16x16x32_bf16(af[m], __builtin_bit_cast(bf16x8, bfr[n][kk]), acc[m][n], 0, 0, 0);
        }
        if (nxt < NU) OC_LOAD_MAIN(nxt);
        LBAR();
#pragma unroll
        for (int m = 0; m < 4; ++m)
#pragma unroll
            for (int r = 0; r < 4; ++r) { const int tl = 16 * m + 4 * lq + r; const float iv = inv[tl];
                const f32x2 h01 = (f32x2){acc[m][0][r], acc[m][1][r]} * iv; const float h0 = h01[0], h1 = h01[1];
                *(LAS bf16_t*)(HT + tl * OC_HSTR + (32 * w + l15) * 2) = (bf16_t)f2bf(h0); *(LAS bf16_t*)(HT + tl * OC_HSTR + (32 * w + 16 + l15) * 2) = (bf16_t)f2bf(h1);
                float s = h0 * h0 + h1 * h1; s += dpp_f<0xB1>(s); s += dpp_f<0x4E>(s); s += dpp_f<0x141>(s); s += dpp_f<0x140>(s);
                if (l15 == 0) part[w * 64 + tl] = s; }
        LBAR();
#pragma unroll
        for (int q = 0; q < 4; ++q) { const int row = (tid >> 5) + 16 * q, ch = tid & 31; float ss = 0.f;
#pragma unroll
            for (int ww = 0; ww < 8; ++ww) ss += part[ww * 64 + row];
            const float rs = 1.0f / sqrtf(ss * (1.0f / DV) + EPS);
            const u32x4 hv = *(const LAS u32x4*)(HT + row * OC_HSTR + ch * 16); const u32x4 g = og[q];
            const float rs2 = FP8_MOUT ? 2.f * rs : rs;
            const f32x4 fa = ((f32x4){bflo(hv.x), bfhi(hv.x), bflo(hv.y), bfhi(hv.y)} * (ng0 * rs2)) * (f32x4){bflo(g.x), bfhi(g.x), bflo(g.y), bfhi(g.y)};
            const f32x4 fb = ((f32x4){bflo(hv.z), bfhi(hv.z), bflo(hv.w), bfhi(hv.w)} * (ng1 * rs2)) * (f32x4){bflo(g.z), bfhi(g.z), bflo(g.w), bfhi(g.w)};
            const float f0 = fa[0], f1 = fa[1], f2 = fa[2], f3 = fa[3], f4 = fb[0], f5 = fb[1], f6 = fb[2], f7 = fb[3];
            if (FP8_MOUT) { u32x2 o8; o8.x = pk4_fp8_sat(f0, f1, f2, f3); o8.y = pk4_fp8_sat(f4, f5, f6, f7);
                *(u32x2*)((unsigned char*)HN + (size_t)(tk0 + row) * MV + h * DV + 8 * ch) = o8; }
            else { u32x4 o; o.x = pk2(f0, f1); o.y = pk2(f2, f3); o.z = pk2(f4, f5); o.w = pk2(f6, f7);
            *(u32x4*)(HN + (size_t)(tk0 + row) * MV + h * DV + 8 * ch) = o; } }
        if (nxt < NU) OC_LOAD_OGS(nxt);
    }
#undef OC_LOAD_MAIN
#undef OC_AT
#undef OC_NT
#undef OC_LOAD_ST
#undef OC_LOAD_OGS
    __syncthreads();
}

__device__ __forceinline__ void phase_conv(Frame& F) {
    const bf16_t* BG = (const bf16_t*)(F.ws + WS_BG); const bf16_t* Z = (const bf16_t*)(F.ws + WS_Z); bf16_t* Y = (bf16_t*)(F.ws + WS_Y);
    const int cg = F.tid & 127, rsub = F.tid >> 7, col = 8 * cg;
    float w0[8], w1[8], w2[8], cb[8];
#pragma unroll
    for (int i = 0; i < 8; ++i) { w0[i] = F.in[I_CCW][col + i]; w1[i] = F.in[I_CCW][D + col + i]; w2[i] = F.in[I_CCW][2 * D + col + i]; cb[i] = F.in[I_CCB][col + i]; }
    for (int batch = F.vcu; batch < T / 128; batch += F.G) {
        const int t0 = batch * 128 + rsub * 32, s0 = t0 % SEQ;
        if (F8_BZ) {
            const unsigned char* Z8 = (const unsigned char*)Z; const unsigned char* B8 = (const unsigned char*)BG;
            u32x2 p2 = (u32x2){0u, 0u}, p1 = p2;
            if (s0 >= 2) p2 = *(const u32x2*)(Z8 + (size_t)(t0 - 2) * D + col);
            if (s0 >= 1) p1 = *(const u32x2*)(Z8 + (size_t)(t0 - 1) * D + col);
            f32x4 z2a = o4(p2.x), z2b = o4(p2.y), z1a = o4(p1.x), z1b = o4(p1.y);
#pragma unroll 4
            for (int r = 0; r < 32; ++r) {
                const u32x2 p0 = __builtin_nontemporal_load((const u32x2*)(Z8 + (size_t)(t0 + r) * D + col)), pb = __builtin_nontemporal_load((const u32x2*)(B8 + (size_t)(t0 + r) * D + col));
                const f32x4 z0a = o4(p0.x), z0b = o4(p0.y), ba = o4(pb.x), bb = o4(pb.y);
                float o[8];
#pragma unroll
                for (int i = 0; i < 4; ++i) {
                    o[i] = ba[i] * 0.0625f * ((w0[i] * z2a[i] + w1[i] * z1a[i] + w2[i] * z0a[i]) * 0.0625f + cb[i]);
                    o[4 + i] = bb[i] * 0.0625f * ((w0[4 + i] * z2b[i] + w1[4 + i] * z1b[i] + w2[4 + i] * z0b[i]) * 0.0625f + cb[4 + i]); }
                if (FP8_COUT) { u32x2 o8; o8.x = pk4_fp8_sat(o[0], o[1], o[2], o[3]); o8.y = pk4_fp8_sat(o[4], o[5], o[6], o[7]); *(u32x2*)((unsigned char*)Y + (size_t)(t0 + r) * D + col) = o8; }
                else { u32x4 ov; ov.x = pk2(o[0], o[1]); ov.y = pk2(o[2], o[3]); ov.z = pk2(o[4], o[5]); ov.w = pk2(o[6], o[7]); *(u32x4*)(Y + (size_t)(t0 + r) * D + col) = ov; }
                z2a = z1a; z2b = z1b; z1a = z0a; z1b = z0b;
            }
            continue;
        }
        u32x4 z2 = (u32x4){0u, 0u, 0u, 0u}, z1 = z2;
        if (s0 >= 2) z2 = *(const u32x4*)(Z + (size_t)(t0 - 2) * D + col);
        if (s0 >= 1) z1 = *(const u32x4*)(Z + (size_t)(t0 - 1) * D + col);
#pragma unroll 4
        for (int r = 0; r < 32; ++r) {
            const u32x4 z0 = *(const u32x4*)(Z + (size_t)(t0 + r) * D + col), bg = *(const u32x4*)(BG + (size_t)(t0 + r) * D + col);
            float o[8];
#pragma unroll
            for (int i = 0; i < 4; ++i) {
                o[2 * i] = bflo(bg[i]) * (w0[2 * i] * bflo(z2[i]) + w1[2 * i] * bflo(z1[i]) + w2[2 * i] * bflo(z0[i]) + cb[2 * i]);
                o[2 * i + 1] = bfhi(bg[i]) * (w0[2 * i + 1] * bfhi(z2[i]) + w1[2 * i + 1] * bfhi(z1[i]) + w2[2 * i + 1] * bfhi(z0[i]) + cb[2 * i + 1]); }
            if (FP8_COUT) { u32x2 o8; o8.x = pk4_fp8_sat(o[0], o[1], o[2], o[3]); o8.y = pk4_fp8_sat(o[4], o[5], o[6], o[7]); *(u32x2*)((unsigned char*)Y + (size_t)(t0 + r) * D + col) = o8; }
            else { u32x4 ov; ov.x = pk2(o[0], o[1]); ov.y = pk2(o[2], o[3]); ov.z = pk2(o[4], o[5]); ov.w = pk2(o[6], o[7]);
            *(u32x4*)(Y + (size_t)(t0 + r) * D + col) = ov; }
            z2 = z1; z1 = z0;
        }
    }
}

__device__ __forceinline__ void moe_table(Frame& F, int layer) {
    __syncthreads();
    if (F.tid < 64) { const int e = F.tid & 15; const int c = (int)__hip_atomic_load(F.ctl + CW_CNT + 64 * layer + e, RLX_AGENT); const int tiles = (c + 255) >> 8; int inc = tiles;
#pragma unroll
        for (int o = 1; o < 16; o <<= 1) { const int t_ = __shfl_up(inc, o); if (e >= o) inc += t_; }
        if (F.tid < 16) { F.MISC[16 + e] = (unsigned)(inc - tiles); F.MISC[40 + e] = (unsigned)c; if (e == NE - 1) F.MISC[16 + NE] = (unsigned)inc; } }
    __syncthreads();
}

#ifndef TIMER_PHASE
#define TIMER_PHASE (-1)
#endif
#define STAMP(k) do { if (TIMER_PHASE >= 0 && blockIdx.x == 0 && threadIdx.x == 0) { unsigned long long t_ = __builtin_amdgcn_s_memrealtime(); ((unsigned long long*)karg_ptr(21))[4096 + (k)] = t_; } } while (0)
constexpr int N_PHASES = 17;
#define WSP(T_, off) ((T_*)(F.ws + (off)))
__global__ void __launch_bounds__(NTHR, 2) fwd_kernel(Args args) {
    extern __shared__ __attribute__((aligned(16))) unsigned char lds_raw[];
#define MAKE_FRAME() Frame F; { int t_ = threadIdx.x, bx_ = blockIdx.x, g_ = gridDim.x; asm volatile("" : "+v"(t_), "+s"(bx_), "+s"(g_)); \
        F.lds = (LAS unsigned char*)lds_raw; F.MISC = (volatile LAS unsigned*)(F.lds + MISC_OFF); F.tid = t_; F.lane = t_ & 63; F.wave = __builtin_amdgcn_readfirstlane(t_ >> 6); \
        F.G = g_; F.bx = bx_; F.vcu = (g_ % 8 == 0) ? (bx_ % 8) * (g_ / 8) + bx_ / 8 : bx_; }
    const int lo = args.ph_lo, hi = args.ph_hi;
    const bool one_launch = (hi - lo) > 1;
    XcdBarrier bar;
    { MAKE_FRAME();
      for (int u = F.tid; u < 256; u += NTHR) F.MISC[u] = 0u;
      __syncthreads();
      bar.bar = (unsigned*)(F.ctl + CW_BAR); bar.x = 0; bar.st = nullptr;
      if (one_launch) bar = xcd_barrier_post((unsigned*)(F.ctl + CW_BAR), F.MISC + 8); }
    STAMP(0);
#ifdef PH_ONLY
#define IN(k) ((k) == PH_ONLY && lo <= (k) && (k) < hi)
#else
#define IN(k) (lo <= (k) && (k) < hi)
#endif
#define SEAM(k) do { if (IN(k) && IN((k) + 1)) { xcd_barrier(bar); STAMP((k) + 1); } } while (0)
#ifndef DUP_MODE
#define DUP_MODE 0
#endif
#ifndef DUP_PHASE
#define DUP_PHASE (-1)
#endif
#define PHASE(k) if (IN(k)) { for (int rep_ = 0; rep_ < (((k) == DUP_PHASE) ? 2 : 1); ++rep_) { MAKE_FRAME(); asm volatile("; PHASE_MARK " #k);
#define END_PHASE(k) } } SEAM(k);
#if ADA_FLAG
    PHASE(0) phase_prologue(F); } }
    PHASE(1) if (IN(0)) { if (F.tid == 0) { unsigned sp_ = 0; while (__hip_atomic_load(F.ctl + CW_ADA, RLX_AGENT) < 192u) { __builtin_amdgcn_s_sleep(2); if (++sp_ > (1u << 22)) break; }
                 asm volatile("buffer_inv sc1\n\ts_waitcnt vmcnt(0)" ::: "memory"); }
             __syncthreads(); }
        row_pass<0>(F, 0); END_PHASE(1)
#else
    PHASE(0) phase_prologue(F); END_PHASE(0)
    PHASE(1) row_pass<0>(F, 0); END_PHASE(1)
#endif
    PHASE(2) pg8::DenseOrder S; S.init(T, 3 * D, F.G, F.bx);
        pg8::EpiM1 E{WSP(bf16_t, WS_Q), WSP(bf16_t, WS_K), WSP(bf16_t, WS_KT), WSP(bf16_t, WS_VT), WSP(bf16_t, WS_OGS), F.lds + EPI_OFF};
        if (I8_G1) { S.sa = WSP(const float, WS_SA); pg8::Gemm g{WSP(bf16_t, WS_U8), WSP(bf16_t, WS_W0), D / 2, 0x7f7f7f7f, 0x7f7f7f7f, nullptr, (const int*)(F.ctl + 16), (LAS float*)(F.lds + SA_OFF), W8_STEP};
            pg8::gemm_phase<pg8::EpiM1, pg8::DenseOrder, true, true, true, 2>(F.lds, g, S, E, F.tid); }
        else if (FP8_G1 == 2) { S.init(T, 4 * 256, F.G, F.bx); { pg8::Gemm g{WSP(bf16_t, WS_U), WSP(bf16_t, WS_W0), D};
                pg8::gemm_phase<pg8::EpiM1, pg8::DenseOrder, false, true, true>(F.lds, g, S, E, F.tid); }
            S.init(T, 8 * 256, F.G, F.bx); S.pn0 = 4; { pg8::Gemm g{WSP(bf16_t, WS_U8), (const bf16_t*)(F.ws + WS_W0 + 2 * MiB), D / 2, 0x7a7a7a7a, 0x7f7f7f7f};
                pg8::gemm_phase<pg8::EpiM1, pg8::DenseOrder, true, true, true, true>(F.lds, g, S, E, F.tid); } }
        else if (FP8_G1) { pg8::Gemm g{WSP(bf16_t, WS_U8), WSP(bf16_t, WS_W0), D / 2, 0x7a7a7a7a, 0x7f7f7f7f};
            pg8::gemm_phase<pg8::EpiM1, pg8::DenseOrder, true, true, true, true>(F.lds, g, S, E, F.tid); }
        else { pg8::Gemm g{WSP(bf16_t, WS_U), WSP(bf16_t, WS_W0), D};
            pg8::gemm_phase<pg8::EpiM1, pg8::DenseOrder, false, true, true>(F.lds, g, S, E, F.tid); } END_PHASE(2)
    PHASE(3) phase_scan(F, rep_ == 0 ? 0 : DUP_MODE); END_PHASE(3)
    PHASE(4) phase_out(F); END_PHASE(4)
    PHASE(5) pg8::DenseOrder S; S.init(T, D, F.G, F.bx);
        pg8::EpiRes<true> E{F.in[I_X], WSP(bf16_t, WS_XB), WSP(float, WS_MOD) + 2 * D, (DBG_SKIP & 1) ? 0.f : 1.f};
        if (FP8_MOUT) { pg8::Gemm g{WSP(bf16_t, WS_U), WSP(bf16_t, WS_W1), D / 2, 0x7a7a7a7a, 0x7e7e7e7e};
            pg8::gemm_phase<pg8::EpiRes<true>, pg8::DenseOrder, true, true, true, true>(F.lds, g, S, E, F.tid); }
        else { pg8::Gemm g{WSP(bf16_t, WS_U), WSP(bf16_t, WS_W1), D};
            pg8::gemm_phase<pg8::EpiRes<true>, pg8::DenseOrder, false, true, true>(F.lds, g, S, E, F.tid); } END_PHASE(5)
#define WL(L_, off) WSP(bf16_t, ((L_) == 0 ? (size_t)0 : WS_WL1) + (off))
#define MOE_UP_CALL(L, U0_, ULIM_) { pg8::Gemm g{WSP(bf16_t, WS_U8), WL(L, WS_WUP), D / 2, 0x7a7a7a7a, 0x7f7f7f7f, (LAS int*)(F.lds + EPI_OFF), (const int*)(F.ctl + 16), (LAS float*)(F.lds + SA_OFF), W8_STEP}; \
        pg8::MoeOrder S{(const LAS int*)(F.MISC + 16), (const LAS int*)(F.MISC + 40), WSP(const int, WS_LIST), F.G, F.vcu, 1024, I8_UP ? WSP(const float, WS_SASLOT) : nullptr, (U0_), (ULIM_)}; \
        pg8::EpiGlu<true, true> E{WSP(bf16_t, WS_A8), DE, 0, nullptr, 0, 2.0f}; \
        pg8::gemm_phase<pg8::EpiGlu<true, true>, pg8::MoeOrder, true, true, true, I8_UP ? 2 : 1>(F.lds, g, S, E, F.tid); }
#define MOE_DN_CALL(L, VCU_, U0_, ULIM_) { pg8::Gemm g{WSP(bf16_t, WS_A8), WL(L, WS_WDN), DE / 2, 0x7b7b7b7b, 0x7e7e7e7e}; \
        pg8::MoeOrder S{(const LAS int*)(F.MISC + 16), (const LAS int*)(F.MISC + 40), nullptr, F.G, (VCU_), 1024, nullptr, (U0_), (ULIM_)}; \
        pg8::EpiBf E{WSP(bf16_t, WS_O), D, F8_O ? 16.f : 0.f}; \
        pg8::gemm_phase<pg8::EpiBf, pg8::MoeOrder, true, true, true, true>(F.lds, g, S, E, F.tid); }
#define MOE_COUNTS() const int total_ = 4 * __builtin_amdgcn_readfirstlane((int)F.MISC[16 + NE]), nfull_ = MOE_TAILS ? (total_ / F.G) * F.G : total_
#define MOE_BLOCK(L, p0, p1, p2) \
    PHASE(p0) row_pass<1>(F, L); END_PHASE(p0) \
    PHASE(p1) moe_table(F, L); MOE_COUNTS(); MOE_UP_CALL(L, 0, nfull_) END_PHASE(p1) \
    PHASE(p2) moe_table(F, L); \
        { MOE_COUNTS(); if (nfull_ + F.vcu < total_) { MOE_UP_CALL(L, nfull_, total_) \
              asm volatile("s_waitcnt vmcnt(0)" ::: "memory"); __syncthreads(); \
              if (F.tid == 0) { __builtin_amdgcn_fence(__ATOMIC_RELEASE, "agent"); (void)__hip_atomic_fetch_add(F.ctl + CW_T2 + (L), 1u, RLX_AGENT); } } } \
        { MAKE_FRAME(); MOE_COUNTS(); MOE_DN_CALL(L, F.vcu, 0, nfull_) } \
        { MAKE_FRAME(); MOE_COUNTS(); if (nfull_ + (F.G - 1 - F.vcu) < total_) { \
              if (F.tid == 0) { unsigned sp_ = 0; while (__hip_atomic_load(F.ctl + CW_T2 + (L), RLX_AGENT) < (unsigned)(total_ - nfull_)) { __builtin_amdgcn_s_sleep(2); if (++sp_ > (1u << 22)) break; } \
                  __builtin_amdgcn_fence(__ATOMIC_ACQUIRE, "agent"); } \
              __syncthreads(); \
              MOE_DN_CALL(L, F.G - 1 - F.vcu, nfull_, total_) } } END_PHASE(p2)
    MOE_BLOCK(0, 6, 7, 8)
    PHASE(9) row_pass<2>(F, 1); convert_weights(F, 1); END_PHASE(9)
    PHASE(10) pg8::DenseOrder S; S.init(T, 3 * D, F.G, F.bx);
        pg8::EpiGlu<false> E{WSP(bf16_t, WS_Z), D, 4, WSP(bf16_t, WS_BG), D, 0.f};
        if (I8_CIN && F8_BZ) { S.sa = WSP(const float, WS_SA); pg8::Gemm g{WSP(bf16_t, WS_U8), WL(1, WS_W0), D / 2, 0x7f7f7f7f, 0x7f7f7f7f, nullptr, (const int*)(F.ctl + 16), (LAS float*)(F.lds + SA_OFF), W8_STEP};
            pg8::EpiGlu<false, true> E8{WSP(bf16_t, WS_Z), D, 4, WSP(bf16_t, WS_BG), D, 16.f};
            pg8::gemm_phase<pg8::EpiGlu<false, true>, pg8::DenseOrder, true, true, true, 2>(F.lds, g, S, E8, F.tid); }
        else if (I8_CIN) { S.sa = WSP(const float, WS_SA); pg8::Gemm g{WSP(bf16_t, WS_U8), WL(1, WS_W0), D / 2, 0x7f7f7f7f, 0x7f7f7f7f, nullptr, (const int*)(F.ctl + 16), (LAS float*)(F.lds + SA_OFF), W8_STEP};
            pg8::gemm_phase<pg8::EpiGlu<false>, pg8::DenseOrder, true, true, true, 2>(F.lds, g, S, E, F.tid); }
        else if (FP8_CIN) { pg8::Gemm g{WSP(bf16_t, WS_U8), WL(1, WS_W0), D / 2, 0x7a7a7a7a, 0x7f7f7f7f};
            pg8::gemm_phase<pg8::EpiGlu<false>, pg8::DenseOrder, true, true, true, true>(F.lds, g, S, E, F.tid); }
        else { pg8::Gemm g{WSP(bf16_t, WS_U), WL(1, WS_W0), D};
            pg8::gemm_phase<pg8::EpiGlu<false>, pg8::DenseOrder, false, true, true>(F.lds, g, S, E, F.tid); } END_PHASE(10)
    PHASE(11) phase_conv(F); END_PHASE(11)
    PHASE(12) pg8::DenseOrder S; S.init(T, D, F.G, F.bx);
        pg8::EpiRes<false> E{WSP(bf16_t, WS_XB), WSP(bf16_t, WS_XB), WSP(float, WS_MOD) + (size_t)NB * 6 * D + 2 * D, (DBG_SKIP & 4) ? 0.f : 1.f};
        if (FP8_COUT) { pg8::Gemm g{WSP(bf16_t, WS_Y), WL(1, WS_W1), D / 2, 0x7a7a7a7a, 0x7f7f7f7f};
            pg8::gemm_phase<pg8::EpiRes<false>, pg8::DenseOrder, true, true, true, true>(F.lds, g, S, E, F.tid); }
        else { pg8::Gemm g{WSP(bf16_t, WS_Y), WL(1, WS_W1), D};
            pg8::gemm_phase<pg8::EpiRes<false>, pg8::DenseOrder, false, true, true>(F.lds, g, S, E, F.tid); } END_PHASE(12)
    MOE_BLOCK(1, 13, 14, 15)
    if (IN(16)) { MAKE_FRAME(); asm volatile("; PHASE_MARK 16"); row_pass<3>(F, 1);
    }

    if (TIMER_PHASE >= 0 && one_launch) {
        STAMP(17);
        xcd_barrier(bar);
        const unsigned long long* ts = (const unsigned long long*)karg_ptr(21) + 4096;
#ifdef P0_SPLIT
        const unsigned long long d = __hip_atomic_load(ts + 18, RLX_AGENT) - __hip_atomic_load(ts + 0, RLX_AGENT);
#else
        const unsigned long long d = __hip_atomic_load(ts + TIMER_PHASE + 1, RLX_AGENT) - __hip_atomic_load(ts + TIMER_PHASE, RLX_AGENT);
#endif
        const unsigned long long t0 = __builtin_amdgcn_s_memrealtime();
        while (__builtin_amdgcn_s_memrealtime() - t0 < 4ull * d) __builtin_amdgcn_s_sleep(8);
    }
#undef IN
#undef SEAM
}

extern "C" void kernel_launch(void* const* d_in, const int* in_sizes, int n_in, void* d_out, int out_size, void* d_ws, size_t ws_size, hipStream_t stream) {
    static int grid = 0;
    if (grid == 0) {
        if (n_in != 20 || in_sizes[0] != T * D || out_size != T * D || ws_size < WS_END) { fprintf(stderr, "kernel_launch: unexpected shapes: n_in %d in0 %d out %d ws %zu\n", n_in, n_in > 0 ? in_sizes[0] : -1, out_size, ws_size); grid = -1; return; }
        int dev = 0, cus = 0, per_cu = 0;
        if (hipGetDevice(&dev) != hipSuccess || hipDeviceGetAttribute(&cus, hipDeviceAttributeMultiprocessorCount, dev) != hipSuccess) { grid = -1; return; }
        if (hipFuncSetAttribute((const void*)fwd_kernel, hipFuncAttributeMaxDynamicSharedMemorySize, LDS_BYTES) != hipSuccess) { fprintf(stderr, "kernel_launch: hipFuncSetAttribute failed\n"); grid = -1; return; }
        if (hipOccupancyMaxActiveBlocksPerMultiprocessor(&per_cu, (const void*)fwd_kernel, NTHR, LDS_BYTES) != hipSuccess || per_cu < 1) { fprintf(stderr, "kernel_launch: occupancy query says %d blocks per CU\n", per_cu); (void)hipGetLastError(); grid = -1; return; }
        grid = cus;
        if (grid != 256) fprintf(stderr, "kernel_launch: %d CUs (built for 256)\n", grid);
    }
    if (grid < 0) return;
    (void)hipMemsetAsync((char*)d_ws + WS_CTL, 0, CTL_ZERO_BYTES, stream);
    Args a{};
    for (int i = 0; i < 20; ++i) a.in[i] = (const float*)d_in[i];
    a.out = (float*)d_out; a.ws = (unsigned char*)d_ws;
#if MK_N_LAUNCHES == 1
    a.ph_lo = 0; a.ph_hi = N_PHASES;
    void* kargs[] = {&a};
    hipError_t e = hipLaunchCooperativeKernel((const void*)fwd_kernel, dim3(grid), dim3(NTHR), kargs, LDS_BYTES, stream);
    if (e != hipSuccess) fprintf(stderr, "kernel_launch: cooperative launch failed: %s\n", hipGetErrorString(e));
#else
    for (int p = 0; p < N_PHASES; ++p) { a.ph_lo = p; a.ph_hi = p + 1; hipLaunchKernelGGL(fwd_kernel, dim3(grid), dim3(NTHR), LDS_BYTES, stream, a); }
#endif
}
```
